# Optimizing an MI355X kernel written in HIP

```python
import math
import jax
import jax.numpy as jnp
from jax import lax
import numpy as np

D_MODEL = 1024
BATCH = 8
SEQ = 4096
DEPTH = 2

GRID_W = 64
CTX_LEN = 256
NORM_EPS = 1e-6

NA_HEADS = 8
NA_HEAD_DIM = 64
NA_WIDTH = NA_HEADS * NA_HEAD_DIM
NA_WIN_ROWS = 8
NA_WIN_COLS = 16
POOL_WINDOWS = (2, 4, 8, 16)
POOL_GROUPS = 4
POOL_GROUP_DIM = 64
POOL_WIDTH = POOL_GROUPS * POOL_GROUP_DIM
GLA_HEADS = 4
GLA_DK = 32
GLA_DV = 64
GLA_WIDTH = GLA_HEADS * GLA_DV
GLA_GATE_RANK = 16
GLA_TAU = 16.0
GLA_CHUNK = 64
ROPE_BASE = 10000.0

MIX_WIDTH = NA_WIDTH + POOL_WIDTH + GLA_WIDTH
SPLIT_SIZES = (NA_WIDTH, NA_WIDTH, NA_WIDTH, POOL_WIDTH, GLA_HEADS * GLA_DK, GLA_HEADS * GLA_DK,
               GLA_WIDTH, GLA_WIDTH, GLA_GATE_RANK, GLA_GATE_RANK)
IN_WIDTH = sum(SPLIT_SIZES)
SPLIT_POINTS = tuple(int(s) for s in np.cumsum(SPLIT_SIZES)[:-1])

N_EXPERTS = 256
TOP_K = 8
N_GROUPS = 8
TOPK_GROUPS = 4
D_EXPERT = 256
ROUTED_SCALE = 2.5
MOE_BLOCK = 128

kernel_name = "hymba_na_pool_gla_moe_prefix_dit"


def rmsnorm(x, g):
    xf = x.astype(jnp.float32)
    y = xf * lax.rsqrt(jnp.mean(xf * xf, axis=-1, keepdims=True) + NORM_EPS)
    return (y * g.astype(jnp.float32)).astype(x.dtype)


def modulate(h, shift, scale):
    return h * (1 + scale) + shift


def to_blhd(t, n_heads):
    b, l, _ = t.shape
    return t.reshape(b, l, n_heads, -1)


def to_bhld(t, n_heads):
    return to_blhd(t, n_heads).transpose(0, 2, 1, 3)


def neighborhood_attention(q, k, v, k_ctx, v_ctx, rpb):
    bsz, L, H, dh = q.shape
    rows = L // GRID_W
    wr = min(NA_WIN_ROWS, rows)
    r = jnp.arange(rows)
    key_rows = jnp.clip(r - wr // 2, 0, rows - wr)[:, None] + jnp.arange(wr)[None, :]
    col = jnp.arange(GRID_W)
    col_start = jnp.clip(col - NA_WIN_COLS // 2, 0, GRID_W - NA_WIN_COLS)
    col_mask = (col[None, :] >= col_start[:, None]) & (col[None, :] < col_start[:, None] + NA_WIN_COLS)
    dr = key_rows - r[:, None] + NA_WIN_ROWS - 1
    dc = jnp.clip(col[None, :] - col[:, None], -(NA_WIN_COLS - 1), NA_WIN_COLS - 1) + NA_WIN_COLS - 1
    bias = rpb[:, dr][:, :, :, dc]
    bias = bias.transpose(0, 1, 3, 2, 4).astype(jnp.float32)

    qg = q.reshape(bsz, rows, GRID_W, H, dh)
    kg = jnp.take(k.reshape(bsz, rows, GRID_W, H, dh), key_rows, axis=1)
    vg = jnp.take(v.reshape(bsz, rows, GRID_W, H, dh), key_rows, axis=1)
    scale = dh ** -0.5
    s_loc = jnp.einsum('brqhd,brwkhd->bhrqwk', qg, kg, preferred_element_type=jnp.float32) * scale + bias
    s_loc = jnp.where(col_mask[:, None, :], s_loc, -jnp.inf)
    s_ctx = jnp.einsum('brqhd,bchd->bhrqc', qg, k_ctx, preferred_element_type=jnp.float32) * scale
    n_loc = wr * GRID_W
    s = jnp.concatenate([s_loc.reshape(bsz, H, rows, GRID_W, n_loc), s_ctx], axis=-1)
    p = jax.nn.softmax(s, axis=-1).astype(v.dtype)
    p_loc = p[..., :n_loc].reshape(bsz, H, rows, GRID_W, wr, GRID_W)
    p_ctx = p[..., n_loc:]
    o = (jnp.einsum('bhrqwk,brwkhd->brqhd', p_loc, vg)
         + jnp.einsum('bhrqc,bchd->brqhd', p_ctx, v_ctx))
    return o.reshape(bsz, L, H * dh)


def context_attention(q, k, v):
    bsz, n, H, dh = q.shape
    s = jnp.einsum('bqhd,bkhd->bhqk', q, k, preferred_element_type=jnp.float32) * dh ** -0.5
    p = jax.nn.softmax(s, axis=-1).astype(v.dtype)
    return jnp.einsum('bhqk,bkhd->bqhd', p, v).reshape(bsz, n, H * dh)


def multiscale_pool(u, w_pool, pool_scale):
    bsz, L, C = u.shape
    uf = u.astype(jnp.float32)
    cs = jnp.concatenate([jnp.zeros((bsz, 1, C), jnp.float32), jnp.cumsum(uf, axis=1)], axis=1)
    t = jnp.arange(L)
    outs = []
    for g, w in enumerate(POOL_WINDOWS):
        lo = jnp.clip(t - w // 2, 0, L - 1)
        hi = jnp.clip(t + w - w // 2 - 1, 0, L - 1)
        sl = slice(g * POOL_GROUP_DIM, (g + 1) * POOL_GROUP_DIM)
        csg = cs[..., sl]
        mean = (csg[:, hi + 1] - csg[:, lo]) / (hi - lo + 1).astype(jnp.float32)[:, None]
        outs.append((mean - uf[..., sl]) @ w_pool[g].astype(jnp.float32))
    return (jnp.concatenate(outs, axis=-1) * pool_scale.astype(jnp.float32)).astype(u.dtype)


def gla_log_decay(a_low, w2, b2):
    logits = a_low.astype(jnp.float32) @ w2.astype(jnp.float32) + b2.astype(jnp.float32)
    return to_bhld(jax.nn.log_sigmoid(logits) / GLA_TAU, GLA_HEADS)


def axial_rope(x, row, col):
    half = x.shape[-1] // 2
    quarter = half // 2
    inv_freq = ROPE_BASE ** (-jnp.arange(quarter, dtype=jnp.float32) / quarter)

    def rotate(xp, pos):
        ang = pos.astype(jnp.float32)[:, None] * inv_freq[None, :]
        cos, sin = jnp.cos(ang), jnp.sin(ang)
        x1, x2 = xp[..., :quarter], xp[..., quarter:]
        return jnp.concatenate([x1 * cos - x2 * sin, x2 * cos + x1 * sin], axis=-1)

    xf = x.astype(jnp.float32)
    return jnp.concatenate([rotate(xf[..., :half], row), rotate(xf[..., half:], col)], axis=-1).astype(x.dtype)


def gla_chunk_scan(q, k, v, log_a, s0):
    bsz, H, L, dk = q.shape
    dv = v.shape[-1]
    n = L // GLA_CHUNK
    shp = (bsz, H, n, GLA_CHUNK)
    qf = q.astype(jnp.float32).reshape(*shp, dk)
    kf = k.astype(jnp.float32).reshape(*shp, dk)
    vf = v.astype(jnp.float32).reshape(*shp, dv)
    b = jnp.cumsum(log_a.reshape(*shp, dk), axis=3)
    b_last = b[:, :, :, -1:, :]
    q_in = qf * jnp.exp(b)
    k_in = kf * jnp.exp(-b)
    k_st = kf * jnp.exp(b_last - b)
    lower = jnp.tril(jnp.ones((GLA_CHUNK, GLA_CHUNK), bool))
    att = jnp.where(lower, jnp.einsum('bhncd,bhnsd->bhncs', q_in, k_in), 0.0)
    o = jnp.einsum('bhncs,bhnsv->bhncv', att, vf)
    kv = jnp.einsum('bhncd,bhncv->bhndv', k_st, vf)
    decay = jnp.exp(b_last[:, :, :, 0, :])

    def step(S, inp):
        dec, kv_n = inp
        return dec[..., None] * S + kv_n, S

    s_final, s_prev = lax.scan(step, s0.astype(jnp.float32),
                               (jnp.moveaxis(decay, 2, 0), jnp.moveaxis(kv, 2, 0)))
    o = o + jnp.einsum('bhncd,nbhdv->bhncv', q_in, s_prev)
    return o.reshape(bsz, H, L, dv), s_final


def gla_bidir(q, k, v, la_f, la_b, s_f0, s_b0):
    o_f, s_f = gla_chunk_scan(q, k, v, la_f, s_f0)
    flip = lambda t: jnp.flip(t, axis=2)
    o_b, s_b = gla_chunk_scan(flip(q), flip(k), flip(v), flip(la_b), s_b0)
    return o_f + flip(o_b), s_f, s_b


def gla_inputs(p, w_gf, b_gf, w_gb, b_gb):
    q = to_bhld(p[4], GLA_HEADS) * GLA_DK ** -0.5
    k = to_bhld(p[5], GLA_HEADS)
    v = to_bhld(p[6], GLA_HEADS)
    return q, k, v, gla_log_decay(p[8], w_gf, b_gf), gla_log_decay(p[9], w_gb, b_gb)


def gla_output(o, r, g):
    n = o * lax.rsqrt(jnp.mean(o * o, axis=-1, keepdims=True) + NORM_EPS) * g.astype(jnp.float32)
    bsz, H, L, dv = n.shape
    n = n.transpose(0, 2, 1, 3).reshape(bsz, L, H * dv)
    return (n * jax.nn.silu(r.astype(jnp.float32))).astype(r.dtype)


def swiglu(h, w_in, w_down):
    g, u = jnp.split(h @ w_in, 2, axis=-1)
    return (jax.nn.silu(g) * u) @ w_down


def moe_dispatch(h, top_e, w, w_e_in, w_e_down):
    T, D = h.shape
    A = T * TOP_K
    flat_e = top_e.reshape(A)
    order = jnp.argsort(flat_e)
    sorted_e = flat_e[order]
    counts = jnp.bincount(flat_e, length=N_EXPERTS)
    padded = (counts + MOE_BLOCK - 1) // MOE_BLOCK * MOE_BLOCK
    start = jnp.cumsum(counts) - counts
    pad_end = jnp.cumsum(padded)
    pad_start = pad_end - padded
    dest = pad_start[sorted_e] + jnp.arange(A) - start[sorted_e]
    n_blocks = -(-A // MOE_BLOCK) + N_EXPERTS
    slots = n_blocks * MOE_BLOCK
    slot_tok = jnp.zeros((slots,), jnp.int32).at[dest].set((order // TOP_K).astype(jnp.int32))
    slot_w = jnp.zeros((slots,), jnp.float32).at[dest].set(w.reshape(A)[order])
    block_e = jnp.minimum(jnp.searchsorted(pad_end, jnp.arange(n_blocks) * MOE_BLOCK, side='right'),
                          N_EXPERTS - 1)

    def step(out, blk):
        tok, wt, e = blk
        y = swiglu(h[tok], w_e_in[e], w_e_down[e])
        return out.at[tok].add(y.astype(jnp.float32) * wt[:, None]), None

    out, _ = lax.scan(step, jnp.zeros((T, D), jnp.float32),
                      (slot_tok.reshape(n_blocks, MOE_BLOCK), slot_w.reshape(n_blocks, MOE_BLOCK), block_e))
    return out


def moe_ffn(h, w_router, b_router, w_e_in, w_e_down, w_sh_in, w_sh_down):
    T = h.shape[0]
    scores = jax.nn.sigmoid(jnp.dot(h, w_router, preferred_element_type=jnp.float32))
    biased = scores + b_router.astype(jnp.float32)
    grp_score = lax.top_k(biased.reshape(T, N_GROUPS, N_EXPERTS // N_GROUPS), 2)[0].sum(-1)
    _, top_g = lax.top_k(grp_score, TOPK_GROUPS)
    gmask = jax.nn.one_hot(top_g, N_GROUPS, dtype=jnp.float32).sum(1) > 0
    masked = jnp.where(jnp.repeat(gmask, N_EXPERTS // N_GROUPS, axis=1), biased, -jnp.inf)
    _, top_e = lax.top_k(masked, TOP_K)
    w = jnp.take_along_axis(scores, top_e, axis=1)
    w = w / jnp.sum(w, axis=-1, keepdims=True) * ROUTED_SCALE
    routed = moe_dispatch(h, top_e, w, w_e_in, w_e_down)
    shared = swiglu(h, w_sh_in, w_sh_down).astype(jnp.float32)
    return (routed + shared).astype(h.dtype)


def setup_inputs(seed: int = 0) -> dict:
    key = jax.random.key(seed)
    ks = jax.random.split(key, 26)
    f32 = jnp.float32
    D, E, F = D_MODEL, N_EXPERTS, D_EXPERT

    def nrm(k, shape, scale):
        return jax.random.normal(k, shape, f32) * scale

    return {
        "x": nrm(ks[0], (BATCH, SEQ, D), 1.0),
        "c": nrm(ks[1], (BATCH, D), 1.0),
        "ctx": nrm(ks[2], (BATCH, CTX_LEN, D), 1.0),
        "c_ctx": nrm(ks[3], (D,), 1.0),
        "w_mod": nrm(ks[4], (DEPTH, D, 6 * D), 0.3 * D ** -0.5),
        "b_mod": nrm(ks[5], (DEPTH, 6 * D), 0.02),
        "g_mix": 1.0 + nrm(ks[6], (DEPTH, D), 0.02),
        "w_in": nrm(ks[7], (DEPTH, D, IN_WIDTH), D ** -0.5),
        "rpb": nrm(ks[8], (DEPTH, NA_HEADS, 2 * NA_WIN_ROWS - 1, 2 * NA_WIN_COLS - 1), 0.1),
        "w_pool": nrm(ks[9], (DEPTH, POOL_GROUPS, POOL_GROUP_DIM, POOL_GROUP_DIM), POOL_GROUP_DIM ** -0.5),
        "pool_scale": 1.0 + nrm(ks[10], (DEPTH, POOL_WIDTH), 0.1),
        "w_gate_f": nrm(ks[11], (DEPTH, GLA_GATE_RANK, GLA_HEADS * GLA_DK), GLA_GATE_RANK ** -0.5),
        "b_gate_f": nrm(ks[12], (DEPTH, GLA_HEADS * GLA_DK), 0.1),
        "w_gate_b": nrm(ks[13], (DEPTH, GLA_GATE_RANK, GLA_HEADS * GLA_DK), GLA_GATE_RANK ** -0.5),
        "b_gate_b": nrm(ks[14], (DEPTH, GLA_HEADS * GLA_DK), 0.1),
        "g_gla": 1.0 + nrm(ks[15], (DEPTH, GLA_DV), 0.02),
        "w_out": nrm(ks[16], (DEPTH, MIX_WIDTH, D), MIX_WIDTH ** -0.5),
        "g_ffn": 1.0 + nrm(ks[17], (DEPTH, D), 0.02),
        "w_router": nrm(ks[18], (DEPTH, D, E), D ** -0.5),
        "b_router": nrm(ks[19], (DEPTH, E), 0.01),
        "w_e_in": nrm(ks[20], (DEPTH, E, D, 2 * F), D ** -0.5),
        "w_e_down": nrm(ks[21], (DEPTH, E, F, D), F ** -0.5),
        "w_sh_in": nrm(ks[22], (DEPTH, D, 2 * F), D ** -0.5),
        "w_sh_down": nrm(ks[23], (DEPTH, F, D), F ** -0.5),
        "g_final": 1.0 + nrm(ks[24], (D,), 0.02),
    }


def reference(x, c, ctx, c_ctx, w_mod, b_mod, g_mix, w_in, rpb, w_pool, pool_scale,
              w_gate_f, b_gate_f, w_gate_b, b_gate_b, g_gla, w_out, g_ffn,
              w_router, b_router, w_e_in, w_e_down, w_sh_in, w_sh_down, g_final):
    bsz, seq, d = x.shape
    n_ctx = ctx.shape[1]
    t = jnp.arange(seq)
    row, col = t // GRID_W, t % GRID_W
    xc = ctx
    for layer in range(DEPTH):
        last = layer == DEPTH - 1
        mx = jnp.split((jax.nn.silu(c) @ w_mod[layer] + b_mod[layer])[:, None, :], 6, axis=-1)
        mc = jnp.split(jax.nn.silu(c_ctx) @ w_mod[layer] + b_mod[layer], 6, axis=-1)

        hx = modulate(rmsnorm(x, g_mix[layer]), mx[0], mx[1])
        hc = modulate(rmsnorm(xc, g_mix[layer]), mc[0], mc[1])
        px = jnp.split(hx @ w_in[layer], SPLIT_POINTS, axis=-1)
        pc = jnp.split(hc @ w_in[layer], SPLIT_POINTS, axis=-1)

        k_ctx = to_blhd(pc[1], NA_HEADS)
        v_ctx = to_blhd(pc[2], NA_HEADS)
        oa = neighborhood_attention(to_blhd(px[0], NA_HEADS), to_blhd(px[1], NA_HEADS),
                                    to_blhd(px[2], NA_HEADS), k_ctx, v_ctx, rpb[layer])
        ob = multiscale_pool(px[3], w_pool[layer], pool_scale[layer])
        qc_, kc_, vc_, lafc, labc = gla_inputs(pc, w_gate_f[layer], b_gate_f[layer], w_gate_b[layer], b_gate_b[layer])
        zero_state = jnp.zeros((bsz, GLA_HEADS, GLA_DK, GLA_DV), jnp.float32)
        o_gla_c, s_f, s_b = gla_bidir(qc_, kc_, vc_, lafc, labc, zero_state, zero_state)
        qx_, kx_, vx_, lafx, labx = gla_inputs(px, w_gate_f[layer], b_gate_f[layer], w_gate_b[layer], b_gate_b[layer])
        o_gla_x, _, _ = gla_bidir(axial_rope(qx_, row, col), axial_rope(kx_, row, col), vx_, lafx, labx, s_f, s_b)
        oc = gla_output(o_gla_x, px[7], g_gla[layer])

        x = x + mx[2] * (jnp.concatenate([oa, ob, oc], axis=-1) @ w_out[layer])
        if not last:
            oa_c = context_attention(to_blhd(pc[0], NA_HEADS), k_ctx, v_ctx)
            ob_c = multiscale_pool(pc[3], w_pool[layer], pool_scale[layer])
            oc_c = gla_output(o_gla_c, pc[7], g_gla[layer])
            xc = xc + mc[2] * (jnp.concatenate([oa_c, ob_c, oc_c], axis=-1) @ w_out[layer])

        hx2 = modulate(rmsnorm(x, g_ffn[layer]), mx[3], mx[4]).reshape(bsz * seq, d)
        moe_args = (w_router[layer], b_router[layer], w_e_in[layer], w_e_down[layer],
                    w_sh_in[layer], w_sh_down[layer])
        if not last:
            hc2 = modulate(rmsnorm(xc, g_ffn[layer]), mc[3], mc[4]).reshape(bsz * n_ctx, d)
            y = moe_ffn(jnp.concatenate([hc2, hx2], axis=0), *moe_args)
            xc = xc + mc[5] * y[:bsz * n_ctx].reshape(bsz, n_ctx, d)
            x = x + mx[5] * y[bsz * n_ctx:].reshape(bsz, seq, d)
        else:
            x = x + mx[5] * moe_ffn(hx2, *moe_args).reshape(bsz, seq, d)
    return rmsnorm(x, g_final)
```

```cpp
#include <hip/hip_runtime.h>
#include <stdint.h>
#include <stdio.h>

#define DI __device__ __forceinline__
typedef unsigned short bf16_t;
typedef short bf16x8 __attribute__((ext_vector_type(8)));
typedef short bf16x4 __attribute__((ext_vector_type(4)));
typedef float f32x4 __attribute__((ext_vector_type(4)));

namespace {
constexpr int D = 1024, NB = 8, SEQ = 4096, NCTX = 256;
constexpr int MC = NB * NCTX, ML = NB * SEQ, MT = MC + ML;
constexpr int INW = 2592, INWP = 2816;
constexpr int NE = 256, NE1 = 257;
constexpr int NTHR = 512;
constexpr int LDS_BYTES = 152 * 1024;
constexpr int CAP = MT;
constexpr int NSLOT = 68;
constexpr float EPS = 1e-6f;

struct P {
  const float *x, *c, *ctx, *c_ctx, *w_mod, *b_mod, *g_mix, *w_in, *rpb, *w_pool, *pool_scale,
      *w_gate_f, *b_gate_f, *w_gate_b, *b_gate_b, *g_gla, *w_out, *g_ffn, *w_router, *b_router,
      *w_e_in, *w_e_down, *w_sh_in, *w_sh_down, *g_final;
  float* out;
  char* ws;
};

constexpr size_t al256(size_t x) { return (x + 255) & ~(size_t)255; }
constexpr size_t OFF_BAR = 0;
constexpr size_t OFF_CNT = OFF_BAR + 16384;
constexpr size_t ZERO_BYTES = 16384 + 4096;
constexpr size_t OFF_MOD = OFF_CNT + 4096;
constexpr size_t OFF_ROPE = OFF_MOD + al256((size_t)2 * 9 * 6144 * 4);
constexpr size_t OFF_GMIX = OFF_ROPE + al256(64 * 8 * 2 * 4);
constexpr size_t OFF_GFFN = OFF_GMIX + al256(2 * 1024 * 4);
constexpr size_t OFF_GFINAL = OFF_GFFN + al256(2 * 1024 * 4);
constexpr size_t OFF_RPB = OFF_GFINAL + al256(1024 * 4);
constexpr size_t OFF_WPOOL = OFF_RPB + al256(2 * 3720 * 4);
constexpr size_t OFF_PSCALE = OFF_WPOOL + al256(2 * 4 * 4096 * 4);
constexpr size_t OFF_WGF = OFF_PSCALE + al256(2 * 256 * 4);
constexpr size_t OFF_WGB = OFF_WGF + al256(2 * 16 * 128 * 4);
constexpr size_t OFF_BGF = OFF_WGB + al256(2 * 16 * 128 * 4);
constexpr size_t OFF_BGB = OFF_BGF + al256(2 * 128 * 4);
constexpr size_t OFF_GGLA = OFF_BGB + al256(2 * 128 * 4);
constexpr size_t OFF_BROUTER = OFF_GGLA + al256(2 * 64 * 4);
constexpr size_t OFF_WIN = OFF_BROUTER + al256(2 * 256 * 4);
constexpr size_t OFF_WOUT = OFF_WIN + al256((size_t)2 * INWP * 1024 * 2);
constexpr size_t OFF_WR = OFF_WOUT + al256((size_t)2 * 1024 * 1024 * 2);
constexpr size_t OFF_WEI = OFF_WR + al256((size_t)2 * 256 * 1024 * 2);
constexpr size_t OFF_WED = OFF_WEI + al256((size_t)2 * NE1 * 512 * 1024 * 2);
constexpr size_t OFF_H = OFF_WED + al256((size_t)2 * NE1 * 1024 * 256 * 2);
constexpr size_t OFF_CAT = OFF_H + al256((size_t)MT * D * 2);
constexpr size_t OFF_H2 = OFF_CAT + al256((size_t)MT * D * 2);
constexpr size_t OFF_PX = OFF_H2 + al256((size_t)MT * D * 2);
constexpr size_t OFF_ACT = OFF_PX + al256((size_t)MT * INW * 2);
constexpr size_t OFF_Y = OFF_ACT + al256((size_t)9 * MT * 256 * 2);
constexpr size_t OFF_XRES = OFF_Y + al256((size_t)9 * MT * D * 2);
constexpr size_t OFF_LOGITS = OFF_XRES + al256((size_t)MT * D * 4);
constexpr size_t OFF_WTS = OFF_LOGITS + al256((size_t)MT * 256 * 4);
constexpr size_t OFF_GKV = OFF_WTS + al256((size_t)MT * 8 * 4);
constexpr size_t OFF_GDEC = OFF_GKV + al256((size_t)NB * 4 * NSLOT * 2 * 2048 * 4);
constexpr size_t OFF_GSIN = OFF_GDEC + al256((size_t)NB * 4 * NSLOT * 2 * 32 * 4);
constexpr size_t OFF_LISTS = OFF_GSIN + al256((size_t)NB * 4 * NSLOT * 2 * 2048 * 4);
constexpr size_t OFF_QH = OFF_LISTS + al256((size_t)NE * CAP * 4);
constexpr size_t HM_LAT = (size_t)NB * 8 * NCTX * 64;
constexpr size_t HM_ELEMS = (size_t)NB * 8 * (NCTX + SEQ) * 64;
constexpr size_t OFF_KH = OFF_QH + al256(HM_ELEMS * 2);
constexpr size_t OFF_VT = OFF_KH + al256(HM_ELEMS * 2);
constexpr size_t HMG_LAT = (size_t)NB * 4 * 64 * NCTX;
constexpr size_t HMG_ELEMS = (size_t)NB * 4 * 64 * (NCTX + SEQ);
constexpr size_t OFF_VTG = OFF_VT + al256(HM_ELEMS * 2);
constexpr size_t OFF_GQK = OFF_VTG + al256(HMG_ELEMS * 2);
constexpr size_t OFF_WPT = OFF_GQK + al256((size_t)NB * 4 * NSLOT * 2 * 2 * 2048 * 2);
constexpr size_t OFF_H2Q = OFF_WPT + al256((size_t)2 * 4 * 4096 * 2);
constexpr size_t WS_TOTAL = OFF_H2Q + al256((size_t)MT * 1024);

struct W {
  char* ws; float* out; const float* x; const float* ctx;
#define WF(T, name, OFF) DI T* name() const { return (T*)(ws + OFF); }
  WF(unsigned, bar, OFF_BAR) WF(int, cnt, OFF_CNT) WF(float, mod, OFF_MOD) WF(float, rope, OFF_ROPE)
  WF(float, g_mix, OFF_GMIX) WF(float, g_ffn, OFF_GFFN) WF(float, g_final, OFF_GFINAL) WF(float, rpb, OFF_RPB)
  WF(float, w_pool, OFF_WPOOL) WF(float, pool_scale, OFF_PSCALE) WF(float, w_gate_f, OFF_WGF) WF(float, w_gate_b, OFF_WGB)
  WF(float, b_gate_f, OFF_BGF) WF(float, b_gate_b, OFF_BGB) WF(float, g_gla, OFF_GGLA) WF(float, b_router, OFF_BROUTER)
  WF(bf16_t, win_t, OFF_WIN) WF(bf16_t, wout_t, OFF_WOUT) WF(bf16_t, wr_t, OFF_WR) WF(bf16_t, wei_t, OFF_WEI) WF(bf16_t, wed_t, OFF_WED)
  WF(bf16_t, h, OFF_H) WF(bf16_t, cat, OFF_CAT) WF(bf16_t, h2, OFF_H2) WF(bf16_t, px, OFF_PX) WF(bf16_t, act, OFF_ACT) WF(bf16_t, y, OFF_Y)
  WF(bf16_t, xres, OFF_XRES) WF(float, logits, OFF_LOGITS) WF(float, wts, OFF_WTS) WF(float, gkv, OFF_GKV) WF(float, gdec, OFF_GDEC)
  WF(float, gsin, OFF_GSIN) WF(int, lists, OFF_LISTS) WF(bf16_t, qh, OFF_QH) WF(bf16_t, kh, OFF_KH) WF(bf16_t, vt, OFF_VT) WF(bf16_t, vtg, OFF_VTG) WF(bf16_t, gqk, OFF_GQK) WF(bf16_t, wpt, OFF_WPT) WF(unsigned char, h2q, OFF_H2Q)
#undef WF
};

DI float bf2f(bf16_t v) { return __uint_as_float(((unsigned)v) << 16); }
DI bf16_t f2bf(float f) { unsigned u = __float_as_uint(f); u += 0x7fffu + ((u >> 16) & 1u); return (bf16_t)(u >> 16); }
typedef float f32x2v __attribute__((ext_vector_type(2)));
typedef __bf16 bf16x2v __attribute__((ext_vector_type(2)));
DI unsigned pack2(float lo, float hi) {
  const f32x2v v = {lo, hi};
  return __builtin_bit_cast(unsigned, __builtin_convertvector(v, bf16x2v));
}
DI int pack_fp8x4(float a, float b, float c, float d) {
  a = __builtin_amdgcn_fmed3f(a, -440.f, 440.f); b = __builtin_amdgcn_fmed3f(b, -440.f, 440.f);
  c = __builtin_amdgcn_fmed3f(c, -440.f, 440.f); d = __builtin_amdgcn_fmed3f(d, -440.f, 440.f);
  int w = __builtin_amdgcn_cvt_pk_fp8_f32(a, b, 0, false);
  return __builtin_amdgcn_cvt_pk_fp8_f32(c, d, w, true);
}
DI float4 unpack4(uint2 v) { return make_float4(__uint_as_float(v.x << 16), __uint_as_float(v.x & 0xffff0000u), __uint_as_float(v.y << 16), __uint_as_float(v.y & 0xffff0000u)); }
DI float wave_sum(float v) { for (int o = 32; o; o >>= 1) v += __shfl_xor(v, o); return v; }
DI float wave_max(float v) { for (int o = 32; o; o >>= 1) v = fmaxf(v, __shfl_xor(v, o)); return v; }
template <int CTRL> DI float dppf(float v) { return __int_as_float(__builtin_amdgcn_update_dpp(__float_as_int(v), __float_as_int(v), CTRL, 0xf, 0xf, false)); }
DI float rlanef(float v, int l) { return __int_as_float(__builtin_amdgcn_readlane(__float_as_int(v), l)); }
DI float wave_max_dpp(float v) {
  v = fmaxf(v, dppf<0xB1>(v));
  v = fmaxf(v, dppf<0x4E>(v));
  v = fmaxf(v, dppf<0x141>(v));
  v = fmaxf(v, dppf<0x140>(v));
  return fmaxf(fmaxf(rlanef(v, 0), rlanef(v, 16)), fmaxf(rlanef(v, 32), rlanef(v, 48)));
}
DI int otid() { int t = threadIdx.x; asm volatile("" : "+v"(t)); return t; }
DI float sigmoidf_(float x) { return 1.f / (1.f + __expf(-x)); }
DI float siluf_(float x) { return x / (1.f + __expf(-x)); }
DI int vbid_of(int bid, int nblk) { (void)nblk; return bid; }
DI int mod_row(int row) { return row < MC ? 8 : ((row - MC) >> 12); }

typedef __attribute__((address_space(1))) char gchar;
typedef __attribute__((address_space(1))) float gfloat;
DI W oq(const W& w) {
  unsigned long long v = (unsigned long long)w.ws;
  asm volatile("" : "+s"(v));
  W r; r.ws = (char*)(gchar*)v; r.out = w.out; r.x = w.x; r.ctx = w.ctx;
  return r;
}

struct NoHook { DI void operator()() const {} };
template <int WM, int WN, int MI, int NI, int BK, int NS, bool SWAP, int NCH, int FLAGS = 0, class FA, class FB, class EPI, class HK = NoHook>
DI void gemm_tile(char* lds, int nk, size_t bstride, size_t bks, FA rowA, FB rowB, EPI epi, const char* ares = nullptr, HK hook = HK()) {
  constexpr int BM = WM * MI * 16, BN = WN * NI * 16;
  constexpr int RB = BK * 2, CPR = RB / 16, RPP = 1024 / RB;
  constexpr bool ARES = (FLAGS & 1) != 0;
  constexpr int PA = ARES ? 0 : BM / RPP / 8, PB = BN / RPP / 8, NP = PA + PB, BOFF = ARES ? 0 : BM * RB, STG = BOFF + BN * RB, KS = BK / 32;
  static_assert(WM * WN == 8, "8 waves");
  static_assert(BK == 32 || BK == 64, "BK");
  const int tid = otid(), wid = tid >> 6, lane = tid & 63, fr = lane & 15, fq = lane >> 4;
  const int wr = wid / WN, wc = wid % WN;
  const int lrow = lane / CPR, pc = lane % CPR;
  const bf16_t* ap[PA > 0 ? PA : 1];
  const bf16_t* bp[PB];
#pragma unroll
  for (int i = 0; i < PA; ++i) {
    const int r = (wid + 8 * i) * RPP + lrow;
    const int sw = BK == 64 ? ((r >> 1) & 7) : ((-(r >> 2)) & 3);
    ap[i] = rowA(r) + ((pc ^ sw) * 8);
  }
#pragma unroll
  for (int i = 0; i < PB; ++i) {
    const int r = (wid + 8 * i) * RPP + lrow;
    const int sw = BK == 64 ? ((r >> 1) & 7) : ((-(r >> 2)) & 3);
    bp[i] = rowB(r) + ((pc ^ sw) * 8);
  }
  char* ldst = lds + wid * 1024 + lane * 16;
  f32x4 acc[MI][NI];
#pragma unroll
  for (int mi = 0; mi < MI; ++mi)
#pragma unroll
    for (int ni = 0; ni < NI; ++ni) acc[mi][ni] = (f32x4){0.f, 0.f, 0.f, 0.f};
  const int swf = BK == 64 ? (fr >> 1) : ((-(fr >> 2)) & 3);
  const int aoff = (wr * MI * 16 + fr) * RB + ((fq ^ swf) * 16);
  const int boff = BOFF + (wc * NI * 16 + fr) * RB + ((fq ^ swf) * 16);
#define GEMM_STAGE(s, t)                                                                                              \
  do {                                                                                                                \
    const int kt_ = NCH == 1 ? (t) : (t) % nk;                                                                        \
    const size_t bo_ = NCH == 1 ? (size_t)0 : (size_t)((t) / nk) * bstride;                                           \
    _Pragma("unroll") for (int i = 0; i < PA; ++i) __builtin_amdgcn_global_load_lds(                                  \
        (const unsigned*)(ap[i] + kt_ * BK), (unsigned*)(ldst + (s) * STG + i * 8192), 16, 0, 0);                     \
    _Pragma("unroll") for (int i = 0; i < PB; ++i) __builtin_amdgcn_global_load_lds(                                  \
        (const unsigned*)(bp[i] + bo_ + kt_ * bks), (unsigned*)(ldst + (s) * STG + BOFF + i * 8192), 16, 0, 0);      \
  } while (0)
  const int ntile = NCH * nk;
  if constexpr ((FLAGS & 64) == 0) {
#pragma unroll
    for (int s = 0; s < NS - 1; ++s)
      if (s < ntile) GEMM_STAGE(s, s);
  }
  int slot = 0, nslot = NS - 1;
  int kin = 0, chunk = 0;
#pragma nounroll
  for (int kt = 0; kt < ntile; ++kt) {
    if (kt + NS - 2 < ntile) asm volatile("s_waitcnt vmcnt(%0)" ::"n"((NS - 2) * NP) : "memory");
    else asm volatile("s_waitcnt vmcnt(0)" ::: "memory");
    __builtin_amdgcn_s_barrier();
    asm volatile("" ::: "memory");
    if (kt + NS - 1 < ntile) GEMM_STAGE(nslot, kt + NS - 1);
    if (kt == ntile - 1) hook();
    const char* sb = lds + slot * STG;
    const char* sa = ARES ? ares + (NCH == 1 ? kt : kin) * (BM * RB) : sb;
    slot = slot + 1 == NS ? 0 : slot + 1;
    nslot = nslot + 1 == NS ? 0 : nslot + 1;
    if constexpr ((FLAGS & 4) != 0) {
      static_assert(BK == 64 && NI % 4 == 0, "fp8 path: 128-byte rows, column tiles in groups of 4");
      typedef int i32x4v __attribute__((ext_vector_type(4)));
      typedef int i32x8v __attribute__((ext_vector_type(8)));
      constexpr int ASC = (FLAGS & 8) ? 0x7b7b7b7b : (FLAGS & 16) ? 0x7c7c7c7c : 0x7f7f7f7f;
      i32x4v a0[MI], a1[MI];
#pragma unroll
      for (int mi = 0; mi < MI; ++mi) {
        a0[mi] = *(const i32x4v*)(sa + (aoff + mi * 16 * RB));
        a1[mi] = *(const i32x4v*)(sa + ((aoff ^ 64) + mi * 16 * RB));
      }
      constexpr int GW = NI > 4 ? 2 : 4, NG8 = NI / GW;
      i32x4v b0[2][GW], b1[2][GW];
#pragma unroll
      for (int nj = 0; nj < GW; ++nj) {
        b0[0][nj] = *(const i32x4v*)(sb + (boff + nj * 16 * RB));
        b1[0][nj] = *(const i32x4v*)(sb + ((boff ^ 64) + nj * 16 * RB));
      }
      __builtin_amdgcn_sched_group_barrier(0x100, 2 * MI + 2 * GW, 0);
#pragma unroll
      for (int g = 0; g < NG8; ++g) {
        const int cur = g & 1, nxt = cur ^ 1;
        if (g + 1 < NG8) {
#pragma unroll
          for (int nj = 0; nj < GW; ++nj) {
            b0[nxt][nj] = *(const i32x4v*)(sb + (boff + ((g + 1) * GW + nj) * 16 * RB));
            b1[nxt][nj] = *(const i32x4v*)(sb + ((boff ^ 64) + ((g + 1) * GW + nj) * 16 * RB));
          }
          __builtin_amdgcn_sched_group_barrier(0x100, 2 * GW, 0);
        }
#pragma unroll
        for (int mi = 0; mi < MI; ++mi)
#pragma unroll
          for (int nj = 0; nj < GW; ++nj) {
            const i32x8v av = __builtin_shufflevector(a0[mi], a1[mi], 0, 1, 2, 3, 4, 5, 6, 7);
            const i32x8v bv = __builtin_shufflevector(b0[cur][nj], b1[cur][nj], 0, 1, 2, 3, 4, 5, 6, 7);
            acc[mi][g * GW + nj] = SWAP ? __builtin_amdgcn_mfma_scale_f32_16x16x128_f8f6f4(av, bv, acc[mi][g * GW + nj], 0, 0, 0, ASC, 0, 0x79797979)
                                        : __builtin_amdgcn_mfma_scale_f32_16x16x128_f8f6f4(bv, av, acc[mi][g * GW + nj], 0, 0, 0, 0x79797979, 0, ASC);
          }
        __builtin_amdgcn_sched_group_barrier(0x008, MI * GW, 0);
      }
    } else {
    constexpr int NG = NI / 4, NGT = KS * NG;
    bf16x8 af[KS][MI], bfr[2][4];
#pragma unroll
    for (int mi = 0; mi < MI; ++mi) af[0][mi] = *(const bf16x8*)(sa + (aoff + mi * 16 * RB));
#pragma unroll
    for (int nj = 0; nj < 4; ++nj) bfr[0][nj] = *(const bf16x8*)(sb + (boff + nj * 16 * RB));
    __builtin_amdgcn_sched_group_barrier(0x100, MI + 4, 0);
#pragma unroll
    for (int gi = 0; gi < NGT; ++gi) {
      const int ks = gi / NG, g = gi % NG, cur = gi & 1, nxt = cur ^ 1;
      if (gi + 1 < NGT) {
        const int ks2 = (gi + 1) / NG, g2 = (gi + 1) % NG;
#pragma unroll
        for (int nj = 0; nj < 4; ++nj) bfr[nxt][nj] = *(const bf16x8*)(sb + ((boff ^ (ks2 * 64)) + (g2 * 4 + nj) * 16 * RB));
        if (ks2 != ks) {
#pragma unroll
          for (int mi = 0; mi < MI; ++mi) af[ks2 % KS][mi] = *(const bf16x8*)(sa + ((aoff ^ (ks2 * 64)) + mi * 16 * RB));
          __builtin_amdgcn_sched_group_barrier(0x100, MI + 4, 0);
        } else {
          __builtin_amdgcn_sched_group_barrier(0x100, 4, 0);
        }
      }
#pragma unroll
      for (int mi = 0; mi < MI; ++mi)
#pragma unroll
        for (int nj = 0; nj < 4; ++nj)
          acc[mi][g * 4 + nj] = SWAP ? __builtin_amdgcn_mfma_f32_16x16x32_bf16(af[ks][mi], bfr[cur][nj], acc[mi][g * 4 + nj], 0, 0, 0)
                                     : __builtin_amdgcn_mfma_f32_16x16x32_bf16(bfr[cur][nj], af[ks][mi], acc[mi][g * 4 + nj], 0, 0, 0);
      __builtin_amdgcn_sched_group_barrier(0x008, MI * 4, 0);
    }
    }
    if (NCH > 1) {
      if (++kin == nk) {
        kin = 0;
        epi(acc, chunk, wr, wc, fr, fq);
        ++chunk;
#pragma unroll
        for (int mi = 0; mi < MI; ++mi)
#pragma unroll
          for (int ni = 0; ni < NI; ++ni) acc[mi][ni] = (f32x4){0.f, 0.f, 0.f, 0.f};
      }
    }
  }
#undef GEMM_STAGE
  if (FLAGS & 2) __syncthreads();
  if (NCH == 1) epi(acc, 0, wr, wc, fr, fq);
  __syncthreads();
}


template <int BN, int NPRE, class FB>
DI void gemm_prestage_b(char* lds, size_t bks, FB rowB) {
  const int tid = otid(), wid = tid >> 6, lane = tid & 63;
  const int lrow = lane >> 3, pc = lane & 7;
  char* ldst = lds + wid * 1024 + lane * 16;
#pragma unroll
  for (int s = 0; s < NPRE; ++s)
#pragma unroll
    for (int i = 0; i < BN / 64; ++i) {
      const int r = (wid + 8 * i) * 8 + lrow;
      const bf16_t* bp = rowB(r) + ((pc ^ ((r >> 1) & 7)) * 8);
      __builtin_amdgcn_global_load_lds((const unsigned*)(bp + s * bks), (unsigned*)(ldst + s * (BN * 128) + i * 8192), 16, 0, 0);
    }
}

template <int WM, int WN, int MI, int NI, bool SWAP, bool NOSTAGE = false, class FA, class FB, class EPI>
DI void gemm_tile_stag(char* lds, int nk, size_t bks, FA rowA, FB rowB, EPI epi) {
  constexpr int BK = 32, BM = WM * MI * 16, BN = WN * NI * 16;
  constexpr int RB = BK * 2, CPR = RB / 16, RPP = 1024 / RB;
  constexpr int PA = BM / RPP / 8, PB = BN / RPP / 8, NP = PA + PB, STG = (BM + BN) * RB;
  const int tid = otid(), wid = tid >> 6, lane = tid & 63, fr = lane & 15, fq = lane >> 4;
  const int wr = wid / WN, wc = wid % WN;
  const int lrow = lane / CPR, pc = lane % CPR;
  const bf16_t* ap[PA];
  const bf16_t* bp[PB];
#pragma unroll
  for (int i = 0; i < PA; ++i) { const int r = (wid + 8 * i) * RPP + lrow; ap[i] = rowA(r) + ((pc ^ ((-(r >> 2)) & 3)) * 8); }
#pragma unroll
  for (int i = 0; i < PB; ++i) { const int r = (wid + 8 * i) * RPP + lrow; bp[i] = rowB(r) + ((pc ^ ((-(r >> 2)) & 3)) * 8); }
  char* ldst = lds + wid * 1024 + lane * 16;
  f32x4 acc[MI][NI];
#pragma unroll
  for (int mi = 0; mi < MI; ++mi)
#pragma unroll
    for (int ni = 0; ni < NI; ++ni) acc[mi][ni] = (f32x4){0.f, 0.f, 0.f, 0.f};
  const int swf = (-(fr >> 2)) & 3;
  const int aoff = (wr * MI * 16 + fr) * RB + ((fq ^ swf) * 16);
  const int boff = BM * RB + (wc * NI * 16 + fr) * RB + ((fq ^ swf) * 16);
#define STAG_STAGE(s, t)                                                                                              \
  do {                                                                                                                \
    _Pragma("unroll") for (int i = 0; i < PA; ++i) __builtin_amdgcn_global_load_lds(                                  \
        (const unsigned*)(ap[i] + (t) * BK), (unsigned*)(ldst + (s) * STG + i * 8192), 16, 0, 0);                     \
    _Pragma("unroll") for (int i = 0; i < PB; ++i) __builtin_amdgcn_global_load_lds(                                  \
        (const unsigned*)(bp[i] + (t) * bks), (unsigned*)(ldst + (s) * STG + BM * RB + i * 8192), 16, 0, 0);          \
  } while (0)
  const int hb = __builtin_amdgcn_readfirstlane(wid >> 2);
  STAG_STAGE(0, 0);
  if (1 < nk) { STAG_STAGE(1, 1); asm volatile("s_waitcnt vmcnt(%0)" ::"n"(NP) : "memory"); }
  else asm volatile("s_waitcnt vmcnt(0)" ::: "memory");
  __builtin_amdgcn_s_barrier();
  asm volatile("" ::: "memory");
  if (hb) { __builtin_amdgcn_s_barrier(); asm volatile("" ::: "memory"); }
  for (int kt = 0; kt < nk; ++kt) {
    const char* sb = lds + (kt & 3) * STG;
    bf16x8 af[MI], bfr[NI];
#pragma unroll
    for (int mi = 0; mi < MI; ++mi) af[mi] = *(const bf16x8*)(sb + (aoff + mi * 16 * RB));
#pragma unroll
    for (int ni = 0; ni < NI; ++ni) bfr[ni] = *(const bf16x8*)(sb + (boff + ni * 16 * RB));
    if (!NOSTAGE && kt + 2 < nk) STAG_STAGE((kt + 2) & 3, kt + 2);
    if (hb) {
      if (kt + 2 < nk) asm volatile("s_waitcnt vmcnt(%0)" ::"n"(NP) : "memory");
      else asm volatile("s_waitcnt vmcnt(0)" ::: "memory");
    }
    __builtin_amdgcn_s_barrier();
    asm volatile("" ::: "memory");
    __builtin_amdgcn_s_setprio(1);
#pragma unroll
    for (int mi = 0; mi < MI; ++mi)
#pragma unroll
      for (int ni = 0; ni < NI; ++ni)
        acc[mi][ni] = SWAP ? __builtin_amdgcn_mfma_f32_16x16x32_bf16(af[mi], bfr[ni], acc[mi][ni], 0, 0, 0)
                           : __builtin_amdgcn_mfma_f32_16x16x32_bf16(bfr[ni], af[mi], acc[mi][ni], 0, 0, 0);
    __builtin_amdgcn_s_setprio(0);
    if (!hb) {
      if (kt + 2 < nk) asm volatile("s_waitcnt vmcnt(%0)" ::"n"(NP) : "memory");
      else asm volatile("s_waitcnt vmcnt(0)" ::: "memory");
    }
    __builtin_amdgcn_s_barrier();
    asm volatile("" ::: "memory");
  }
  if (!hb) { __builtin_amdgcn_s_barrier(); asm volatile("" ::: "memory"); }
#undef STAG_STAGE
  epi(acc, 0, wr, wc, fr, fq);
  __syncthreads();
}

struct ConvT { const float* src; bf16_t* dst; int ldn, N, K, k0, n0, bkl, npad, f8; };
DI ConvT conv_desc(const P& q, int tile) {
  constexpr int nA = 2 * 257 * 128, nB = 2 * 257 * 64, nC = 2 * 16 * 44, nD = 2 * 16 * 16;
  const W w{q.ws, q.out};
  ConvT c;
  c.f8 = 0;
  int t = tile;
  if (t < nA) {
    const int m = t / 128, r = t % 128, l = m / 257, e = m % 257;
    c.src = e < 256 ? q.w_e_in + (size_t)(l * 256 + e) * 1024 * 512 : q.w_sh_in + (size_t)l * 1024 * 512;
    c.dst = (bf16_t*)((char*)w.wei_t() + (size_t)m * 512 * 1024); c.ldn = 512; c.N = 512; c.K = 1024; c.bkl = 128; c.npad = 512; c.k0 = (r / 8) * 64; c.n0 = (r % 8) * 64; c.f8 = 1;
    return c;
  }
  t -= nA;
  if (t < nB) {
    const int m = t / 64, r = t % 64, l = m / 257, e = m % 257;
    c.src = e < 256 ? q.w_e_down + (size_t)(l * 256 + e) * 256 * 1024 : q.w_sh_down + (size_t)l * 256 * 1024;
    c.dst = (bf16_t*)((char*)w.wed_t() + (size_t)m * 1024 * 256); c.ldn = 1024; c.N = 1024; c.K = 256; c.bkl = 128; c.npad = 1024; c.k0 = (r / 16) * 64; c.n0 = (r % 16) * 64; c.f8 = 1;
    return c;
  }
  t -= nB;
  if (t < nC) {
    const int l = t / 704, r = t % 704;
    c.src = q.w_in + (size_t)l * 1024 * INW; c.dst = (bf16_t*)((char*)w.win_t() + (size_t)l * INWP * 1024); c.ldn = INW; c.N = INW; c.K = 1024; c.bkl = 128; c.npad = INWP; c.f8 = 1;
    c.k0 = (r / 44) * 64; c.n0 = (r % 44) * 64;
    return c;
  }
  t -= nC;
  if (t < nD) {
    const int l = t / 256, r = t % 256;
    c.src = q.w_out + (size_t)l * 1024 * 1024; c.dst = (bf16_t*)((char*)w.wout_t() + (size_t)l * 1024 * 1024); c.ldn = 1024; c.N = 1024; c.K = 1024; c.bkl = 128; c.npad = 1024; c.f8 = 1;
    c.k0 = (r / 16) * 64; c.n0 = (r % 16) * 64;
    return c;
  }
  t -= nD;
  {
    const int l = t / 64, r = t % 64;
    c.src = q.w_router + (size_t)l * 1024 * 256; c.dst = w.wr_t() + (size_t)l * 256 * 1024; c.ldn = 256; c.N = 256; c.K = 1024; c.bkl = 32; c.npad = 256;
    c.k0 = (r / 4) * 64; c.n0 = (r % 4) * 64;
  }
  return c;
}

DI void conv_store(const ConvT& c, uint4 v, int rn, int rks) {
  const int kk = c.k0 + rks * 2;
  if (c.f8) {
    const float4 lo = unpack4(make_uint2(v.x, v.y)), hi = unpack4(make_uint2(v.z, v.w));
    const int w0 = pack_fp8x4(lo.x * 64.f, lo.y * 64.f, lo.z * 64.f, lo.w * 64.f);
    const int w1 = pack_fp8x4(hi.x * 64.f, hi.y * 64.f, hi.z * 64.f, hi.w * 64.f);
    char* d8 = (char*)c.dst + (size_t)(kk / c.bkl) * c.npad * c.bkl + (size_t)(c.n0 + rn) * c.bkl + (kk % c.bkl);
    *(uint2*)d8 = make_uint2((unsigned)w0, (unsigned)w1);
  } else {
    *(uint4*)(c.dst + (size_t)(kk / c.bkl) * c.npad * c.bkl + (size_t)(c.n0 + rn) * c.bkl + (kk % c.bkl)) = v;
  }
}

DI void conv_fetch(const P& q, int tile, int nblk, int total, int kp, int ns, float4& a0, float4& b0, float4& a1, float4& b1) {
  const ConvT c0 = conv_desc(q, min(tile, total - 1));
  const ConvT c1 = conv_desc(q, min(tile + nblk, total - 1));
  const int col0 = min(c0.n0 + ns, c0.N - 4), col1 = min(c1.n0 + ns, c1.N - 4);
  a0 = *(const float4*)(c0.src + (size_t)(c0.k0 + 2 * kp) * c0.ldn + col0);
  b0 = *(const float4*)(c0.src + (size_t)(c0.k0 + 2 * kp + 1) * c0.ldn + col0);
  a1 = *(const float4*)(c1.src + (size_t)(c1.k0 + 2 * kp) * c1.ldn + col1);
  b1 = *(const float4*)(c1.src + (size_t)(c1.k0 + 2 * kp + 1) * c1.ldn + col1);
}

DI void phase_convert(const P& q, char* lds, int bid, int nblk) {
  constexpr int total = 2 * 257 * 128 + 2 * 257 * 64 + 2 * 16 * 44 + 2 * 16 * 16 + 2 * 16 * 4;
  const int t = otid();
  const int kp = t >> 4, ns = (t & 15) * 4, rn = t >> 3, rks = (t & 7) * 4;
  int par = 0;
  auto process = [&](int tile, const float4& a0, const float4& b0, const float4& a1, const float4& b1) {
    const bool two = tile + nblk < total;
    const ConvT c0 = conv_desc(q, tile);
    const ConvT c1 = conv_desc(q, two ? tile + nblk : tile);
    unsigned* T0 = (unsigned*)lds + par * (2 * 64 * 33);
    unsigned* T1 = T0 + 64 * 33;
    par ^= 1;
    const unsigned k0m = c0.n0 + ns < c0.N ? 0xffffffffu : 0u, k1m = c1.n0 + ns < c1.N ? 0xffffffffu : 0u;
    T0[(ns + 0) * 33 + kp] = pack2(a0.x, b0.x) & k0m; T0[(ns + 1) * 33 + kp] = pack2(a0.y, b0.y) & k0m;
    T0[(ns + 2) * 33 + kp] = pack2(a0.z, b0.z) & k0m; T0[(ns + 3) * 33 + kp] = pack2(a0.w, b0.w) & k0m;
    T1[(ns + 0) * 33 + kp] = pack2(a1.x, b1.x) & k1m; T1[(ns + 1) * 33 + kp] = pack2(a1.y, b1.y) & k1m;
    T1[(ns + 2) * 33 + kp] = pack2(a1.z, b1.z) & k1m; T1[(ns + 3) * 33 + kp] = pack2(a1.w, b1.w) & k1m;
    __syncthreads();
    uint4 v;
    v.x = T0[rn * 33 + rks]; v.y = T0[rn * 33 + rks + 1]; v.z = T0[rn * 33 + rks + 2]; v.w = T0[rn * 33 + rks + 3];
    conv_store(c0, v, rn, rks);
    if (two) {
      v.x = T1[rn * 33 + rks]; v.y = T1[rn * 33 + rks + 1]; v.z = T1[rn * 33 + rks + 2]; v.w = T1[rn * 33 + rks + 3];
      conv_store(c1, v, rn, rks);
    }
  };
  float4 a0, b0, a1, b1, na0, nb0, na1, nb1, ma0, mb0, ma1, mb1;
  const int step = 2 * nblk;
  conv_fetch(q, bid, nblk, total, kp, ns, a0, b0, a1, b1);
  conv_fetch(q, bid + step, nblk, total, kp, ns, na0, nb0, na1, nb1);
  for (int tile = bid; tile < total; tile += 3 * step) {
    conv_fetch(q, tile + 2 * step, nblk, total, kp, ns, ma0, mb0, ma1, mb1);
    process(tile, a0, b0, a1, b1);
    if (tile + step >= total) break;
    conv_fetch(q, tile + 3 * step, nblk, total, kp, ns, a0, b0, a1, b1);
    process(tile + step, na0, nb0, na1, nb1);
    if (tile + 2 * step >= total) break;
    conv_fetch(q, tile + 4 * step, nblk, total, kp, ns, na0, nb0, na1, nb1);
    process(tile + 2 * step, ma0, mb0, ma1, mb1);
  }
  __syncthreads();
}

DI void phase_mod(const P& q, char* lds, int bid, int nblk) {
  float* sc = (float*)lds;
  float* red = sc + 9 * 1024;
  const int t = otid();
  for (int i = t; i < 9 * 1024; i += NTHR) {
    const int r = i >> 10, k = i & 1023;
    const float v = r < 8 ? q.c[r * 1024 + k] : q.c_ctx[k];
    sc[i] = siluf_(v);
  }
  __syncthreads();
  for (int u = bid; u < 2 * 96; u += nblk) {
    const int l = u / 96, n0 = (u % 96) * 64;
    const int col = t & 63, ksl = t >> 6;
    float a[9];
#pragma unroll
    for (int r = 0; r < 9; ++r) a[r] = 0.f;
    const float* w = q.w_mod + (size_t)l * 1024 * 6144 + n0 + col;
    for (int k = ksl * 128; k < ksl * 128 + 128; ++k) {
      const float wv = w[(size_t)k * 6144];
#pragma unroll
      for (int r = 0; r < 9; ++r) a[r] += sc[r * 1024 + k] * wv;
    }
#pragma unroll
    for (int r = 0; r < 9; ++r) red[(ksl * 9 + r) * 64 + col] = a[r];
    __syncthreads();
    for (int i = t; i < 9 * 64; i += NTHR) {
      const int r = i >> 6, cc = i & 63;
      float s = q.b_mod[l * 6144 + n0 + cc];
#pragma unroll
      for (int q = 0; q < 8; ++q) s += red[(q * 9 + r) * 64 + cc];
      ((W{q.ws, q.out, q.x, q.ctx}).mod())[(size_t)(l * 9 + r) * 6144 + n0 + cc] = s;
    }
    __syncthreads();
  }
  {
    const W w{q.ws, q.out};
    const int gt = bid * NTHR + t, gs = nblk * NTHR;
#define CPY(dst, srcp, n) for (int i = gt; i < (n); i += gs) (dst)[i] = (srcp)[i]
    CPY(w.g_mix(), q.g_mix, 2 * 1024); CPY(w.g_ffn(), q.g_ffn, 2 * 1024); CPY(w.g_final(), q.g_final, 1024);
    CPY(w.rpb(), q.rpb, 2 * 3720); CPY(w.w_pool(), q.w_pool, 2 * 4 * 4096); CPY(w.pool_scale(), q.pool_scale, 2 * 256);
    CPY(w.w_gate_f(), q.w_gate_f, 2 * 16 * 128); CPY(w.w_gate_b(), q.w_gate_b, 2 * 16 * 128);
    CPY(w.b_gate_f(), q.b_gate_f, 2 * 128); CPY(w.b_gate_b(), q.b_gate_b, 2 * 128);
    CPY(w.g_gla(), q.g_gla, 2 * 64); CPY(w.b_router(), q.b_router, 2 * 256);
#undef CPY
    for (int i = gt; i < 2 * 4 * 4096; i += gs) { const int lg = i >> 12, jj = (i >> 6) & 63, ii = i & 63; w.wpt()[i] = f2bf(q.w_pool[lg * 4096 + ii * 64 + jj]); }
  }
  if (bid == 0) {
    for (int i = t; i < 64 * 8; i += NTHR) {
      const int pos = i >> 3, j = i & 7;
      const float inv = powf(10000.f, -(float)j / 8.f);
      const float ang = (float)pos * inv;
      ((W{q.ws, q.out, q.x, q.ctx}).rope())[i * 2] = cosf(ang);
      ((W{q.ws, q.out, q.x, q.ctx}).rope())[i * 2 + 1] = sinf(ang);
    }
  }
}

DI void phase_norm0(const P& q, int bid, int nblk) {
  const W p{q.ws, q.out};
  const int wid = otid() >> 6, lane = otid() & 63;
  for (int row = bid * 8 + wid; row < MT; row += nblk * 8) {
    const float* src = row < MC ? q.ctx + (size_t)row * D : q.x + (size_t)(row - MC) * D;
    const float* m = p.mod() + (size_t)(mod_row(row)) * 6144;
    float4 v[4];
    float ss = 0.f;
#pragma unroll
    for (int i = 0; i < 4; ++i) {
      v[i] = *(const float4*)(src + i * 256 + lane * 4);
      ss += v[i].x * v[i].x + v[i].y * v[i].y + v[i].z * v[i].z + v[i].w * v[i].w;
    }
    ss = wave_sum(ss);
    const float rstd = rsqrtf(ss * (1.f / D) + EPS);
#pragma unroll
    for (int i = 0; i < 4; ++i) {
      const int cidx = i * 256 + lane * 4;
      const float4 gg = *(const float4*)(q.g_mix + cidx);
      const float4 sh = *(const float4*)(m + cidx);
      const float4 scl = *(const float4*)(m + 1024 + cidx);
      const float o0 = v[i].x * rstd * gg.x * (1.f + scl.x) + sh.x;
      const float o1 = v[i].y * rstd * gg.y * (1.f + scl.y) + sh.y;
      const float o2 = v[i].z * rstd * gg.z * (1.f + scl.z) + sh.z;
      const float o3 = v[i].w * rstd * gg.w * (1.f + scl.w) + sh.w;
      const int q8 = pack_fp8x4(o0, o1, o2, o3);
      *(int*)((char*)p.h() + (size_t)row * D + cidx) = q8;
    }
  }
}

DI void phase_norm(const W& p_, int layer, int row_lo, int bid, int nblk) {
  const W p = oq(p_);
  const int wid = otid() >> 6, lane = otid() & 63;
  const float* g = p.g_ffn() + layer * D;
  for (int row = row_lo + bid * 8 + wid; row < MT; row += nblk * 8) {
    const bf16_t* src = p.xres() + (size_t)row * D;
    const float* m = p.mod() + (size_t)(layer * 9 + mod_row(row)) * 6144 + 3072;
    float4 v[4];
    float ss = 0.f;
#pragma unroll
    for (int i = 0; i < 4; ++i) {
      v[i] = unpack4(*(const uint2*)(src + i * 256 + lane * 4));
      ss += v[i].x * v[i].x + v[i].y * v[i].y + v[i].z * v[i].z + v[i].w * v[i].w;
    }
    ss = wave_sum(ss);
    const float rstd = rsqrtf(ss * (1.f / D) + EPS);
#pragma unroll
    for (int i = 0; i < 4; ++i) {
      const int cidx = i * 256 + lane * 4;
      const float4 gg = *(const float4*)(g + cidx);
      const float4 sh = *(const float4*)(m + cidx);
      const float4 scl = *(const float4*)(m + 1024 + cidx);
      const float o0 = v[i].x * rstd * gg.x * (1.f + scl.x) + sh.x;
      const float o1 = v[i].y * rstd * gg.y * (1.f + scl.y) + sh.y;
      const float o2 = v[i].z * rstd * gg.z * (1.f + scl.z) + sh.z;
      const float o3 = v[i].w * rstd * gg.w * (1.f + scl.w) + sh.w;
      uint2 o; o.x = pack2(o0, o1); o.y = pack2(o2, o3);
      *(uint2*)(p.h2() + (size_t)row * D + cidx) = o;
      {
        const int q8 = pack_fp8x4(o0, o1, o2, o3);
        *(int*)(p.h2q() + (size_t)row * D + cidx) = q8;
      }
    }
  }
}

DI size_t hm_off(int row, int h) {
  if (row < MC) return ((size_t)(((row >> 8) * 8 + h) * NCTX + (row & 255))) * 64;
  const int r = row - MC;
  return HM_LAT + ((size_t)(((r >> 12) * 8 + h) * SEQ + (r & 4095))) * 64;
}
DI size_t vt_off(int row, int h, int d) {
  if (row < MC) { const int t = row & 255; return ((size_t)(((row >> 8) * 8 + h) * 4 + (t >> 6))) * 4096 + d * 64 + (t & 63); }
  const int r = row - MC, t = r & 4095;
  return HM_LAT + ((size_t)(((r >> 12) * 8 + h) * 64 + (t >> 6))) * 4096 + d * 64 + (t & 63);
}
DI size_t vtg_off(int row, int h, int v) {
  if (row < MC) { const int t = row & 255; return ((size_t)(((row >> 8) * 4 + h) * 4 + (t >> 6))) * 4096 + v * 64 + (t & 63); }
  const int r = row - MC, t = r & 4095;
  return HMG_LAT + ((size_t)(((r >> 12) * 4 + h) * 64 + (t >> 6))) * 4096 + v * 64 + (t & 63);
}

DI void phase_inproj(const W& p_, int layer, char* lds, int bid, int nblk) {
  const W p = oq(p_);
  constexpr int nM = MT / 256, nN = INWP / 256;
  const char* B8 = (const char*)p.win_t() + (size_t)layer * INWP * 1024;
  for (int u = vbid_of(bid, nblk); u < nM * nN; u += nblk) {
    const int pm = u / nN, pn = u % nN, m0 = pm * 256, n0 = pn * 256;
    auto rowA = [&](int r) { return (const bf16_t*)((const char*)p.h() + (size_t)(m0 + r) * D); };
    auto rowB = [&](int r) { return (const bf16_t*)(B8 + (size_t)(n0 + r) * 128); };
    if (pn == 4 || pn == 5 || pn == 8) {
      auto rowAp = [&](int r) { return rowA((r & ~63) | ((r & 12) << 2) | ((r & 48) >> 2) | (r & 3)); };
      auto epi = [&](const f32x4 (&acc)[4][8], int, int wr, int wc, int fr, int fq) {
        const int row = m0 + wr * 64 + fq * 16;
#pragma unroll
        for (int ni = 0; ni < 8; ++ni) {
          uint4 lo, hi;
          lo.x = pack2(acc[0][ni][0], acc[0][ni][1]); lo.y = pack2(acc[0][ni][2], acc[0][ni][3]);
          lo.z = pack2(acc[1][ni][0], acc[1][ni][1]); lo.w = pack2(acc[1][ni][2], acc[1][ni][3]);
          hi.x = pack2(acc[2][ni][0], acc[2][ni][1]); hi.y = pack2(acc[2][ni][2], acc[2][ni][3]);
          hi.z = pack2(acc[3][ni][0], acc[3][ni][1]); hi.w = pack2(acc[3][ni][2], acc[3][ni][3]);
          bf16_t* dst;
          if (pn == 8) {
            const int col = wc * 128 + ni * 16 + fr;
            dst = p.vtg() + vtg_off(row, col >> 6, col & 63);
          } else {
            const int col = n0 + wc * 128 + ni * 16 + fr - 1024;
            dst = p.vt() + vt_off(row, col >> 6, col & 63);
          }
          *(uint4*)dst = lo; *(uint4*)(dst + 8) = hi;
        }
      };
      gemm_tile<4, 2, 4, 8, 64, 2, true, 1, 4>(lds, 8, 0, (size_t)INWP * 64, rowAp, rowB, epi);
    } else {
      auto rowBp = [&](int r) { return rowB((r & ~127) | ((r & 12) << 3) | ((r & 112) >> 2) | (r & 3)); };
      auto epi = [&](const f32x4 (&acc)[4][8], int, int wr, int wc, int fr, int fq) {
#pragma unroll
        for (int mi = 0; mi < 4; ++mi) {
          const int row = m0 + wr * 64 + mi * 16 + fr;
#pragma unroll
          for (int np = 0; np < 4; ++np) {
            const int col = n0 + wc * 128 + fq * 32 + np * 8;
            const f32x4 v0 = acc[mi][2 * np], v1 = acc[mi][2 * np + 1];
            if (pn < 2) {
              constexpr float QS = 0.125f * 1.4426950408889634f;
              uint4 o; o.x = pack2(v0[0] * QS, v0[1] * QS); o.y = pack2(v0[2] * QS, v0[3] * QS); o.z = pack2(v1[0] * QS, v1[1] * QS); o.w = pack2(v1[2] * QS, v1[3] * QS);
              *(uint4*)(p.qh() + hm_off(row, col >> 6) + (col & 63)) = o;
            } else if (pn < 4) {
              const int c2 = col - 512;
              uint4 o; o.x = pack2(v0[0], v0[1]); o.y = pack2(v0[2], v0[3]); o.z = pack2(v1[0], v1[1]); o.w = pack2(v1[2], v1[3]);
              *(uint4*)(p.kh() + hm_off(row, c2 >> 6) + (c2 & 63)) = o;
            } else if (col < INW) {
              uint4 o; o.x = pack2(v0[0], v0[1]); o.y = pack2(v0[2], v0[3]); o.z = pack2(v1[0], v1[1]); o.w = pack2(v1[2], v1[3]);
              *(uint4*)(p.px() + (size_t)row * INW + col) = o;
            }
          }
        }
      };
      gemm_tile<4, 2, 4, 8, 64, 2, false, 1, 4>(lds, 8, 0, (size_t)INWP * 64, rowA, rowBp, epi);
    }
  }
}


#ifndef PROBE_GEMM
#define PROBE_GEMM 0
#endif
#if PROBE_GEMM
DI void phase_probe_gemm(const W& p_, char* lds, int bid, int nblk) {
  const W p = oq(p_);
  constexpr int nM = MT / 256, nN = INWP / 256;
  const bf16_t* Bt = p.win_t();
  for (int u = bid; u < nM * nN; u += nblk) {
    const int pm = u / nN, pn = u % nN, m0 = pm * 256, n0 = pn * 256;
    auto rowA = [&](int r) { return p.h() + (size_t)(m0 + r) * D; };
    auto rowB = [&](int r) { return Bt + (size_t)(n0 + r) * 32; };
    auto epi = [&](const f32x4 (&acc)[4][8], int, int wr, int wc, int fr, int fq) {
#pragma unroll
      for (int mi = 0; mi < 4; ++mi) {
        const int row = m0 + wr * 64 + mi * 16 + fr;
#pragma unroll
        for (int ni = 0; ni < 8; ++ni) {
          const int col = n0 + wc * 128 + ni * 16 + 4 * fq;
          uint2 o; o.x = pack2(acc[mi][ni][0], acc[mi][ni][1]); o.y = pack2(acc[mi][ni][2], acc[mi][ni][3]);
          *(uint2*)(p.y() + (size_t)row * INWP + col) = o;
        }
      }
    };
#if PROBE_GEMM == 4
    gemm_tile_stag<4, 2, 4, 8, false, true>(lds, 32, (size_t)INWP * 32, rowA, rowB, epi);
#elif PROBE_GEMM == 5
    gemm_tile_stag<4, 2, 4, 8, false, false>(lds, 32, (size_t)INWP * 32, rowA, rowB, epi);
#else
    gemm_tile<4, 2, 4, 8, 32, 4, false, 1>(lds, 32, 0, (size_t)INWP * 32, rowA, rowB, epi);
#endif
  }
}
#endif

template <bool DUMMY>
DI void phase_outproj_t(const W& p_, int layer, char* lds, int row_lo, int bid, int nblk) {
  const W p = oq(p_);
  bf16_t* xres_w = DUMMY ? (bf16_t*)((char*)p.y() + (size_t)9 * MT * 1024) : p.xres();
  const int nM = (MT - row_lo) / 256, nN = 4;
  const char* B8 = (const char*)p.wout_t() + (size_t)layer * 1024 * 1024;
  for (int u = vbid_of(bid, nblk); u < nM * nN; u += nblk) {
    const int pm = u / nN, pn = u % nN, m0 = row_lo + pm * 256, n0 = pn * 256;
    auto rowA = [&](int r) { return (const bf16_t*)((const char*)p.cat() + (size_t)(m0 + r) * D); };
    auto rowB = [&](int r) { return (const bf16_t*)(B8 + (size_t)(n0 + r) * 128); };
    auto rowBp = [&](int r) { return rowB((r & ~127) | ((r & 12) << 3) | ((r & 112) >> 2) | (r & 3)); };
    auto epi = [&](const f32x4 (&acc)[4][8], int, int wr, int wc, int fr, int fq) {
#pragma unroll
      for (int mi = 0; mi < 4; ++mi) {
        const int row = m0 + wr * 64 + mi * 16 + fr;
        const float* xin = row < MC ? p.ctx + (size_t)row * D : p.x + (size_t)(row - MC) * D;
        const float* gate = p.mod() + (size_t)(layer * 9 + mod_row(row)) * 6144 + 2048;
#pragma unroll
        for (int np = 0; np < 4; ++np) {
          const int col = n0 + wc * 128 + fq * 32 + np * 8;
          const f32x4 v0 = acc[mi][2 * np], v1 = acc[mi][2 * np + 1];
          float4 xa, xb;
          if (layer == 0) {
            xa = *(const float4*)(xin + col); xb = *(const float4*)(xin + col + 4);
          } else {
            const uint4 xr = *(const uint4*)(p.xres() + (size_t)row * D + col);
            xa = unpack4(make_uint2(xr.x, xr.y)); xb = unpack4(make_uint2(xr.z, xr.w));
          }
          const float4 ga = *(const float4*)(gate + col), gb = *(const float4*)(gate + col + 4);
          uint4 o;
          o.x = pack2(xa.x + ga.x * v0[0], xa.y + ga.y * v0[1]); o.y = pack2(xa.z + ga.z * v0[2], xa.w + ga.w * v0[3]);
          o.z = pack2(xb.x + gb.x * v1[0], xb.y + gb.y * v1[1]); o.w = pack2(xb.z + gb.z * v1[2], xb.w + gb.w * v1[3]);
          *(uint4*)(xres_w + (size_t)row * D + col) = o;
        }
      }
    };
    gemm_tile<4, 2, 4, 8, 64, 2, false, 1, 4 | 16>(lds, 8, 0, (size_t)1024 * 64, rowA, rowBp, epi);
  }
}
DI void phase_outproj(const W& p, int layer, char* lds, int row_lo, int bid, int nblk) { phase_outproj_t<false>(p, layer, lds, row_lo, bid, nblk); }

DI void moe_unit(const W& p, int layer, char* lds, int e, const int* s_rows);
DI int moe_early_shared(int mrows, int nblk);
DI void phase_router(const W& p_, int layer, char* lds, int row_lo, int bid, int nblk) {
  const W p = oq(p_);
  const int nM = (MT - row_lo) / 256;
  const bf16_t* Bt = p.wr_t() + (size_t)layer * 256 * 1024;
  const int sh0 = moe_early_shared(MT - row_lo, nblk);
  for (int u = vbid_of(bid, nblk); u < nM + sh0; u += nblk) {
    if (u >= nM) {
      int* s_rows = (int*)(lds + 144 * 1024) + 1024;
      __syncthreads();
      if (otid() < 256) s_rows[otid()] = 8 * MT + row_lo + (u - nM) * 256 + otid();
      __syncthreads();
      moe_unit(p, layer, lds, NE, s_rows);
      continue;
    }
    const int m0 = row_lo + u * 256;
    auto rowA = [&](int r) { return p.h2() + (size_t)(m0 + r) * D; };
    auto rowB = [&](int r) { return Bt + (size_t)r * 32; };
    auto epi = [&](const f32x4 (&acc)[4][8], int, int wr, int wc, int fr, int fq) {
#pragma unroll
      for (int mi = 0; mi < 4; ++mi) {
        const int row = m0 + wr * 64 + mi * 16 + fr;
#pragma unroll
        for (int ni = 0; ni < 8; ++ni) {
          const int col = wc * 128 + ni * 16 + 4 * fq;
          *(f32x4*)(p.logits() + (size_t)row * 256 + col) = acc[mi][ni];
        }
      }
    };
    gemm_tile_stag<4, 2, 4, 8, false>(lds, 32, (size_t)256 * 32, rowA, rowB, epi);
  }
}

DI void phase_route(const W& p_, int layer, char* lds, int row_lo, int bid, int nblk) {
  const W p = oq(p_);
  int* lcnt = (int*)lds;
  int* lbase = lcnt + 256;
  int* ent = lbase + 256;
  const int tid = otid(), wid = tid >> 6, lane = tid & 63;
  const int nrows = MT - row_lo;
  const int CHT = (nrows % nblk == 0 && nrows / nblk <= 160) ? nrows / nblk : 128;
  const int nch = nrows / CHT;
  const float NEG = -__builtin_inff();
  for (int ch = bid; ch < nch; ch += nblk) {
    if (tid < 256) lcnt[tid] = 0;
    __syncthreads();
    for (int i = wid; i < CHT; i += 8) {
      const int row = row_lo + ch * CHT + i;
      const float4 lg = *(const float4*)(p.logits() + (size_t)row * 256 + lane * 4);
      const float4 br = *(const float4*)(p.b_router() + layer * 256 + lane * 4);
      float sc[4] = {sigmoidf_(lg.x), sigmoidf_(lg.y), sigmoidf_(lg.z), sigmoidf_(lg.w)};
      float v[4] = {sc[0] + br.x, sc[1] + br.y, sc[2] + br.z, sc[3] + br.w};
      float m1 = NEG, m2 = NEG;
#pragma unroll
      for (int j = 0; j < 4; ++j) { if (v[j] > m1) { m2 = m1; m1 = v[j]; } else if (v[j] > m2) m2 = v[j]; }
      {
        float o1 = dppf<0xB1>(m1), o2 = dppf<0xB1>(m2);
        float n1 = fmaxf(m1, o1), n2 = fmaxf(fminf(m1, o1), fmaxf(m2, o2));
        m1 = n1; m2 = n2;
        o1 = dppf<0x4E>(m1); o2 = dppf<0x4E>(m2);
        n1 = fmaxf(m1, o1); n2 = fmaxf(fminf(m1, o1), fmaxf(m2, o2));
        m1 = n1; m2 = n2;
        o1 = dppf<0x141>(m1); o2 = dppf<0x141>(m2);
        n1 = fmaxf(m1, o1); n2 = fmaxf(fminf(m1, o1), fmaxf(m2, o2));
        m1 = n1; m2 = n2;
      }
      const float gs = m1 + m2;
      const int g = lane >> 3;
      int rank = 0;
#pragma unroll
      for (int gg = 0; gg < 8; ++gg) { const float og = rlanef(gs, gg * 8); rank += (og > gs || (og == gs && gg < g)) ? 1 : 0; }
      if (rank >= 4) { v[0] = NEG; v[1] = NEG; v[2] = NEG; v[3] = NEG; }
      float ssum = 0.f, my_s = 0.f; int my_e = 0;
#pragma unroll
      for (int k = 0; k < 8; ++k) {
        float bv = v[0]; int bj = 0;
#pragma unroll
        for (int j = 1; j < 4; ++j) if (v[j] > bv) { bv = v[j]; bj = j; }
        const float wm = wave_max_dpp(bv);
        const unsigned long long bal = __ballot(bv == wm);
        const int win = __builtin_amdgcn_readfirstlane(__ffsll((long long)bal) - 1);
        const float mysc = bj == 0 ? sc[0] : bj == 1 ? sc[1] : bj == 2 ? sc[2] : sc[3];
        const int ej = __builtin_amdgcn_readlane(bj, win);
        const float su = rlanef(mysc, win);
        if (lane == win) {
#pragma unroll
          for (int j = 0; j < 4; ++j) if (j == bj) v[j] = NEG;
        }
        ssum += su;
        if (lane == k) { my_e = win * 4 + ej; my_s = su; }
      }
      if (lane < 8) {
        const int lpos = atomicAdd(&lcnt[my_e], 1);
        ent[i * 8 + lane] = my_e | (lpos << 8);
        p.wts()[(size_t)row * 8 + lane] = my_s / ssum * 2.5f;
      }
    }
    __syncthreads();
    if (tid < 256) { const int cc = lcnt[tid]; lbase[tid] = cc ? atomicAdd(&p.cnt()[layer * 256 + tid], cc) : 0; }
    __syncthreads();
    for (int j = tid; j < CHT * 8; j += NTHR) {
      const int e = ent[j] & 255, lpos = ent[j] >> 8;
      const int row = row_lo + ch * CHT + (j >> 3);
      p.lists()[(size_t)e * CAP + lbase[e] + lpos] = row * 8 + (j & 7);
    }
    __syncthreads();
  }
}

DI void moe_prefix(const W& p, int layer, int mrows, int* s_pref) {
  int* s_tmp = s_pref + 400;
  const int t = otid();
  __syncthreads();
  if (t < 272) {
    int c = 0;
    if (t < NE) c = (p.cnt()[layer * 256 + t] + 255) >> 8;
    else if (t == NE) c = (mrows + 255) >> 8;
    s_tmp[t] = c;
  }
  __syncthreads();
  int cur = 0;
  for (int off = 1; off < 272; off <<= 1) {
    if (t < 272) s_tmp[(cur ^ 1) * 272 + t] = s_tmp[cur * 272 + t] + (t >= off ? s_tmp[cur * 272 + t - off] : 0);
    cur ^= 1;
    __syncthreads();
  }
  if (t <= NE1) s_pref[t] = t == 0 ? 0 : s_tmp[cur * 272 + t - 1];
  __syncthreads();
}
DI int moe_find(const int* s_pref, int ti) {
  int lo = 0, hi = NE1;
  while (hi - lo > 1) { const int mid = (lo + hi) >> 1; if (s_pref[mid] <= ti) lo = mid; else hi = mid; }
  return lo;
}
DI void moe_rows(const W& p, int layer, int e, int mt, int row_lo, int mrows, int* s_rows) {
  const int t = otid();
  if (t < 128) {
    const int cnt = e < NE ? p.cnt()[layer * 256 + e] : mrows;
    const int r = mt * 128 + t;
    int idx = -1;
    if (r < cnt) idx = e < NE ? p.lists()[(size_t)e * CAP + r] : 8 * MT + row_lo + r;
    s_rows[t] = idx;
  }
  __syncthreads();
}

DI void moe_unit(const W& p, int layer, char* lds, int e, const int* s_rows) {
  const int idx0 = s_rows[0];
  {
    const char* B8 = (const char*)p.wei_t() + (size_t)(layer * NE1 + e) * 512 * 1024;
    auto rowA = [&](int r) {
      int idx = s_rows[r]; if (idx < 0) idx = idx0;
      const int tok = idx < 8 * MT ? (idx >> 3) : idx - 8 * MT;
      return (const bf16_t*)(p.h2q() + (size_t)tok * D);
    };
    auto rowB = [&](int r) {
      const int wq = r >> 7, w = r & 127;
      const int n = w < 64 ? wq * 64 + w : 256 + wq * 64 + (w - 64);
      return (const bf16_t*)(B8 + (size_t)n * 128);
    };
    int stash[4][4];
    auto epi = [&](const f32x4 (&acc)[4][8], int chunk, int wr, int wc, int fr, int fq) {
      int cur[4][4];
#pragma unroll
      for (int mi = 0; mi < 4; ++mi)
#pragma unroll
        for (int ni = 0; ni < 4; ++ni) {
          float o[4];
#pragma unroll
          for (int j = 0; j < 4; ++j) o[j] = siluf_(acc[mi][ni][j]) * acc[mi][ni + 4][j] * 16.f;
          cur[mi][ni] = pack_fp8x4(o[0], o[1], o[2], o[3]);
        }
      if (chunk == 0) {
#pragma unroll
        for (int mi = 0; mi < 4; ++mi)
#pragma unroll
          for (int ni = 0; ni < 4; ++ni) stash[mi][ni] = cur[mi][ni];
      } else {
        __syncthreads();
#pragma unroll
        for (int c2 = 0; c2 < 2; ++c2)
#pragma unroll
          for (int mi = 0; mi < 4; ++mi) {
            const int row = wr * 64 + mi * 16 + fr;
#pragma unroll
            for (int ni = 0; ni < 4; ++ni) {
              const int ch = (wc * 4 + ni) ^ ((row >> 1) & 7);
              *(int*)(lds + c2 * 32768 + row * 128 + ch * 16 + 4 * fq) = c2 == 0 ? stash[mi][ni] : cur[mi][ni];
            }
          }
      }
    };
    gemm_tile<4, 2, 4, 8, 64, 2, false, 2, 4>(lds, 8, (size_t)128 * 64, (size_t)512 * 64, rowA, rowB, epi);
  }
  {
    const char* B8d = (const char*)p.wed_t() + (size_t)(layer * NE1 + e) * 1024 * 256;
    auto rowA = [&](int) { return (const bf16_t*)nullptr; };
    auto rowB2 = [&](int r) { return (const bf16_t*)(B8d + (size_t)((r & ~127) | ((r & 12) << 3) | ((r & 112) >> 2) | (r & 3)) * 128); };
    auto epi = [&](const f32x4 (&acc)[4][8], int nt, int wr, int wc, int fr, int fq) {
#pragma unroll
      for (int mi = 0; mi < 4; ++mi) {
        const int dst = s_rows[wr * 64 + mi * 16 + fr];
        if (dst >= 0) {
          int4 lo, hi;
          lo.x = pack_fp8x4(acc[mi][0][0] * 16.f, acc[mi][0][1] * 16.f, acc[mi][0][2] * 16.f, acc[mi][0][3] * 16.f);
          lo.y = pack_fp8x4(acc[mi][1][0] * 16.f, acc[mi][1][1] * 16.f, acc[mi][1][2] * 16.f, acc[mi][1][3] * 16.f);
          lo.z = pack_fp8x4(acc[mi][2][0] * 16.f, acc[mi][2][1] * 16.f, acc[mi][2][2] * 16.f, acc[mi][2][3] * 16.f);
          lo.w = pack_fp8x4(acc[mi][3][0] * 16.f, acc[mi][3][1] * 16.f, acc[mi][3][2] * 16.f, acc[mi][3][3] * 16.f);
          hi.x = pack_fp8x4(acc[mi][4][0] * 16.f, acc[mi][4][1] * 16.f, acc[mi][4][2] * 16.f, acc[mi][4][3] * 16.f);
          hi.y = pack_fp8x4(acc[mi][5][0] * 16.f, acc[mi][5][1] * 16.f, acc[mi][5][2] * 16.f, acc[mi][5][3] * 16.f);
          hi.z = pack_fp8x4(acc[mi][6][0] * 16.f, acc[mi][6][1] * 16.f, acc[mi][6][2] * 16.f, acc[mi][6][3] * 16.f);
          hi.w = pack_fp8x4(acc[mi][7][0] * 16.f, acc[mi][7][1] * 16.f, acc[mi][7][2] * 16.f, acc[mi][7][3] * 16.f);
          char* yp = (char*)p.y() + (size_t)dst * D + nt * 256 + wc * 128 + fq * 32;
          *(int4*)yp = lo; *(int4*)(yp + 16) = hi;
        }
      }
    };
    gemm_tile<4, 2, 4, 8, 64, 2, false, 4, 1 | 4 | 8>(lds + 65536, 2, (size_t)256 * 64, (size_t)1024 * 64, rowA, rowB2, epi, lds);
  }
}

DI int moe_early_shared(int mrows, int nblk) {
  const int idle = nblk - mrows / 256;
  return idle <= 0 ? 0 : (idle < mrows / 256 ? idle : mrows / 256);
}

DI void phase_moe(const W& p_, int layer, char* lds, int row_lo, int bid, int nblk) {
  const W p = oq(p_);
  int* s_pref = (int*)(lds + 144 * 1024);
  int* s_rows = s_pref + 1024;
  const int mrows = MT - row_lo;
  const int sh0 = moe_early_shared(mrows, nblk);
  moe_prefix(p, layer, mrows - sh0 * 256, s_pref);
  const int total = s_pref[NE1];
  auto fetch_rows = [&](int uu) -> int {
    int idx = -1;
    const int t = otid();
    if (uu < total && t < 256) {
      const int e2 = moe_find(s_pref, uu), mt2 = uu - s_pref[e2];
      if (e2 < NE) {
        const int cnt = p.cnt()[layer * 256 + e2];
        const int r = mt2 * 256 + t;
        if (r < cnt) idx = p.lists()[(size_t)e2 * CAP + r];
      } else {
        idx = 8 * MT + row_lo + (mt2 + sh0) * 256 + t;
      }
    }
    return idx;
  };
  int pre = fetch_rows(vbid_of(bid, nblk));
  for (int u = vbid_of(bid, nblk); u < total; u += nblk) {
    const int e = moe_find(s_pref, u);
    if (otid() < 256) s_rows[otid()] = pre;
    __syncthreads();
    pre = fetch_rows(u + nblk);
    moe_unit(p, layer, lds, e, s_rows);
  }
}

template <bool DUMMY>
DI void phase_combine_t(const W& p_, int layer, int row_lo, int bid, int nblk) {
  const W p = oq(p_);
  char* scratch = (char*)p.y() + (size_t)9 * MT * 1024;
  bf16_t* xres_w = DUMMY ? (bf16_t*)scratch : p.xres();
  bf16_t* h_w = DUMMY ? p.act() : p.h();
  float* out_w = DUMMY ? (float*)(scratch + ((size_t)128 << 20)) : p.out;
  const int wid = otid() >> 6, lane = otid() & 63;
  const bool last = layer == 1;
  for (int row = row_lo + bid * 8 + wid; row < MT; row += nblk * 8) {
    const float* m = p.mod() + (size_t)(layer * 9 + mod_row(row)) * 6144;
    float w[8];
#pragma unroll
    for (int k = 0; k < 8; ++k) w[k] = p.wts()[(size_t)row * 8 + k];
    float xn[16];
    float ss = 0.f;
#pragma unroll
    for (int i = 0; i < 4; ++i) {
      const int cidx = i * 256 + lane * 4;
      float a[4] = {0.f, 0.f, 0.f, 0.f};
#pragma unroll
      for (int k = 0; k < 9; ++k) {
        const size_t yr = k < 8 ? (size_t)row * 8 + k : (size_t)8 * MT + row;
        const int yv = *(const int*)((const char*)p.y() + yr * D + cidx);
        const float wk = (k < 8 ? w[k] : 1.f) * (1.f / 16.f);
        typedef float f32x2_ __attribute__((ext_vector_type(2)));
        const f32x2_ ylo = __builtin_amdgcn_cvt_pk_f32_fp8(yv, false), yhi = __builtin_amdgcn_cvt_pk_f32_fp8(yv, true);
        a[0] += wk * ylo.x; a[1] += wk * ylo.y; a[2] += wk * yhi.x; a[3] += wk * yhi.y;
      }
      const float4 xv = unpack4(*(const uint2*)(p.xres() + (size_t)row * D + cidx));
      const float4 gv = *(const float4*)(m + 5120 + cidx);
      xn[i * 4 + 0] = xv.x + gv.x * a[0]; xn[i * 4 + 1] = xv.y + gv.y * a[1];
      xn[i * 4 + 2] = xv.z + gv.z * a[2]; xn[i * 4 + 3] = xv.w + gv.w * a[3];
#pragma unroll
      for (int j = 0; j < 4; ++j) ss += xn[i * 4 + j] * xn[i * 4 + j];
    }
    ss = wave_sum(ss);
    const float rstd = rsqrtf(ss * (1.f / D) + EPS);
    if (!last) {
      const float* g = p.g_mix() + (layer + 1) * D;
      const float* m2 = p.mod() + (size_t)((layer + 1) * 9 + mod_row(row)) * 6144;
#pragma unroll
      for (int i = 0; i < 4; ++i) {
        const int cidx = i * 256 + lane * 4;
        { uint2 xo; xo.x = pack2(xn[i * 4], xn[i * 4 + 1]); xo.y = pack2(xn[i * 4 + 2], xn[i * 4 + 3]); *(uint2*)(xres_w + (size_t)row * D + cidx) = xo; }
        const float4 gg = *(const float4*)(g + cidx);
        const float4 sh = *(const float4*)(m2 + cidx);
        const float4 scl = *(const float4*)(m2 + 1024 + cidx);
        const float o0 = xn[i * 4 + 0] * rstd * gg.x * (1.f + scl.x) + sh.x;
        const float o1 = xn[i * 4 + 1] * rstd * gg.y * (1.f + scl.y) + sh.y;
        const float o2 = xn[i * 4 + 2] * rstd * gg.z * (1.f + scl.z) + sh.z;
        const float o3 = xn[i * 4 + 3] * rstd * gg.w * (1.f + scl.w) + sh.w;
        const int q8 = pack_fp8x4(o0, o1, o2, o3);
        *(int*)((char*)h_w + (size_t)row * D + cidx) = q8;
      }
    } else {
#pragma unroll
      for (int i = 0; i < 4; ++i) {
        const int cidx = i * 256 + lane * 4;
        const float4 gg = *(const float4*)(p.g_final() + cidx);
        *(float4*)(out_w + (size_t)(row - MC) * D + cidx) =
            make_float4(xn[i * 4] * rstd * gg.x, xn[i * 4 + 1] * rstd * gg.y, xn[i * 4 + 2] * rstd * gg.z, xn[i * 4 + 3] * rstd * gg.w);
      }
    }
  }
}
DI void phase_combine(const W& p, int layer, int row_lo, int bid, int nblk) { phase_combine_t<false>(p, layer, row_lo, bid, nblk); }

typedef unsigned u32x4 __attribute__((ext_vector_type(4)));
typedef unsigned u32x2 __attribute__((ext_vector_type(2)));
DI bf16x8 bl128(__amdgpu_buffer_rsrc_t rs, unsigned voff, unsigned soff) {
  return __builtin_bit_cast(bf16x8, __builtin_amdgcn_raw_buffer_load_b128(rs, voff, soff, 0));
}
DI u32x2 bl64(__amdgpu_buffer_rsrc_t rs, unsigned voff, unsigned soff) { return __builtin_amdgcn_raw_buffer_load_b64(rs, voff, soff, 0); }

template <bool LOCALPASS>
DI void attn_pass(__amdgpu_buffer_rsrc_t rsK, __amdgpu_buffer_rsrc_t rsV, unsigned kbase, unsigned vbase, const char* cK, const char* cV,
                  const float* s_rpb_h, int r, int c0, int kc0, int kr0, int lane, const bf16x8& qf0, const bf16x8& qf1,
                  float& m_out, float& l_out, f32x4 (&O)[4], const bf16x8 (&kfa)[16]) {
  const int fr = lane & 15, fq = lane >> 4;
  const unsigned vK = (8 * (fr >> 2) + (fr & 3)) * 128 + fq * 32;
  f32x4 S[16];
  if (LOCALPASS) {
    bf16x8 kfb[16];
#pragma unroll
    for (int t = 8; t < 16; ++t) {
      const unsigned so = kbase + ((kr0 + (t >> 1)) * 64 + kc0 + (t & 1) * 4) * 128;
      kfb[2 * (t - 8)] = bl128(rsK, vK, so); kfb[2 * (t - 8) + 1] = bl128(rsK, vK + 16, so);
    }
    __builtin_amdgcn_sched_barrier(0);
#pragma unroll
    for (int t = 0; t < 8; ++t) {
      f32x4 s = (f32x4){0.f, 0.f, 0.f, 0.f};
      s = __builtin_amdgcn_mfma_f32_16x16x32_bf16(kfa[2 * t], qf0, s, 0, 0, 0);
      s = __builtin_amdgcn_mfma_f32_16x16x32_bf16(kfa[2 * t + 1], qf1, s, 0, 0, 0);
      S[t] = s;
    }
#pragma unroll
    for (int t = 8; t < 16; ++t) {
      f32x4 s = (f32x4){0.f, 0.f, 0.f, 0.f};
      s = __builtin_amdgcn_mfma_f32_16x16x32_bf16(kfb[2 * (t - 8)], qf0, s, 0, 0, 0);
      s = __builtin_amdgcn_mfma_f32_16x16x32_bf16(kfb[2 * (t - 8) + 1], qf1, s, 0, 0, 0);
      S[t] = s;
    }
    __builtin_amdgcn_sched_barrier(0);
  } else {
#pragma unroll
    for (int t = 0; t < 16; ++t) {
      const bf16x8 k0 = *(const bf16x8*)(cK + (t * 2) * 1024 + lane * 16);
      const bf16x8 k1 = *(const bf16x8*)(cK + (t * 2 + 1) * 1024 + lane * 16);
      f32x4 s = (f32x4){0.f, 0.f, 0.f, 0.f};
      s = __builtin_amdgcn_mfma_f32_16x16x32_bf16(k0, qf0, s, 0, 0, 0);
      s = __builtin_amdgcn_mfma_f32_16x16x32_bf16(k1, qf1, s, 0, 0, 0);
      S[t] = s;
      if ((t & 3) == 3) __builtin_amdgcn_sched_barrier(0);
    }
  }
  const unsigned vV = (fr * 64 + 8 * fq) * 2;
  bf16x8 vfa[16];
  if (LOCALPASS) {
#pragma unroll
    for (int s = 0; s < 4; ++s)
#pragma unroll
      for (int dt = 0; dt < 4; ++dt) vfa[s * 4 + dt] = bl128(rsV, vV, vbase + ((kr0 + s) * 4096 + dt * 1024 + kc0) * 2);
    __builtin_amdgcn_sched_barrier(0);
  }
  const float NEGB = -1e30f;
  float mx = NEGB;
  if (LOCALPASS) {
    const int qc = c0 + fr;
    const int cs = min(max(qc - 8, 0), 48);
    unsigned vmask = 0;
#pragma unroll
    for (int e = 0; e < 8; ++e) {
      const int kc = kc0 + 8 * fq + e;
      vmask |= (kc >= cs && kc < cs + 16) ? (1u << e) : 0u;
    }
    const int dc0 = kc0 + fq * 8 - qc + 15;
#pragma unroll
    for (int t = 0; t < 16; ++t) {
      const float* bp = s_rpb_h + (kr0 + (t >> 1) - r + 7) * 31;
#pragma unroll
      for (int j = 0; j < 4; ++j) {
        const int e = (t & 1) * 4 + j;
        const int dc = min(max(dc0 + e, 0), 30);
        const float v = ((vmask >> e) & 1u) ? S[t][j] + bp[dc] : NEGB;
        S[t][j] = v;
        mx = fmaxf(mx, v);
      }
    }
  } else {
#pragma unroll
    for (int t = 0; t < 16; ++t)
#pragma unroll
      for (int j = 0; j < 4; ++j) mx = fmaxf(mx, S[t][j]);
  }
  mx = fmaxf(mx, __shfl_xor(mx, 16));
  mx = fmaxf(mx, __shfl_xor(mx, 32));
  float l = 0.f;
#pragma unroll
  for (int t = 0; t < 16; ++t)
#pragma unroll
    for (int j = 0; j < 4; ++j) { const float pv = __builtin_amdgcn_exp2f(S[t][j] - mx); S[t][j] = pv; l += pv; }
  l += __shfl_xor(l, 16);
  l += __shfl_xor(l, 32);
  m_out = mx; l_out = l;
#pragma unroll
  for (int dt = 0; dt < 4; ++dt) O[dt] = (f32x4){0.f, 0.f, 0.f, 0.f};
  bf16x8 pf[8];
#pragma unroll
  for (int s = 0; s < 8; ++s) {
    const unsigned p0 = pack2(S[2 * s][0], S[2 * s][1]), p1 = pack2(S[2 * s][2], S[2 * s][3]);
    const unsigned p2 = pack2(S[2 * s + 1][0], S[2 * s + 1][1]), p3 = pack2(S[2 * s + 1][2], S[2 * s + 1][3]);
    pf[s] = __builtin_bit_cast(bf16x8, (u32x4){p0, p1, p2, p3});
  }
  if (LOCALPASS) {
    bf16x8 vfb[16];
    __builtin_amdgcn_sched_barrier(0);
#pragma unroll
    for (int s = 0; s < 4; ++s)
#pragma unroll
      for (int dt = 0; dt < 4; ++dt) vfb[s * 4 + dt] = bl128(rsV, vV, vbase + ((kr0 + 4 + s) * 4096 + dt * 1024 + kc0) * 2);
    __builtin_amdgcn_sched_barrier(0);
#pragma unroll
    for (int s = 0; s < 4; ++s)
#pragma unroll
      for (int dt = 0; dt < 4; ++dt) O[dt] = __builtin_amdgcn_mfma_f32_16x16x32_bf16(vfa[s * 4 + dt], pf[s], O[dt], 0, 0, 0);
    __builtin_amdgcn_sched_barrier(0);
#pragma unroll
    for (int s = 0; s < 4; ++s)
#pragma unroll
      for (int dt = 0; dt < 4; ++dt) O[dt] = __builtin_amdgcn_mfma_f32_16x16x32_bf16(vfb[s * 4 + dt], pf[4 + s], O[dt], 0, 0, 0);
  } else {
#pragma unroll
    for (int s = 0; s < 8; ++s) {
#pragma unroll
      for (int dt = 0; dt < 4; ++dt) {
        const bf16x8 vf = *(const bf16x8*)(cV + (s * 4 + dt) * 1024 + lane * 16);
        O[dt] = __builtin_amdgcn_mfma_f32_16x16x32_bf16(vf, pf[s], O[dt], 0, 0, 0);
      }
      if ((s & 1) == 1) __builtin_amdgcn_sched_barrier(0);
    }
  }
}

DI void attn_stage_ctx(const W& p, char* dst, int bh, int wid, int lane) {
  const int fr = lane & 15, fq = lane >> 4;
  const bf16_t* Kc = p.kh() + (size_t)bh * NCTX * 64;
  const bf16_t* Vc = p.vt() + (size_t)bh * 4 * 4096;
#pragma unroll
  for (int i = 0; i < 8; ++i) {
    const int pc = wid * 8 + i;
    const bf16_t* src;
    if (pc < 32) {
      const int t = pc >> 1, ks = pc & 1, g = t >> 1, T = t & 1;
      src = Kc + (32 * g + 8 * (fr >> 2) + 4 * T + (fr & 3)) * 64 + 16 * fq + 8 * ks;
    } else {
      const int s = (pc - 32) >> 2, dt = (pc - 32) & 3;
      src = Vc + (s >> 1) * 4096 + (16 * dt + fr) * 64 + (s & 1) * 32 + 8 * fq;
    }
    __builtin_amdgcn_global_load_lds((const unsigned*)src, (unsigned*)(dst + pc * 1024 + lane * 16), 16, 0, 0);
  }
}

template <bool LOCAL, bool QPRE = false>
DI void attn_unit(const W& p, __amdgpu_buffer_rsrc_t rsQ, __amdgpu_buffer_rsrc_t rsK, __amdgpu_buffer_rsrc_t rsV, const char* cK, const char* cV,
                  const float* s_rpb, int b, int h, int r, int qb, int lane, char* nxt_dst = nullptr, int nxt_bh = 0, int wid = 0,
                  bf16x8 qp0 = bf16x8{}, bf16x8 qp1 = bf16x8{}) {
  const int fr = lane & 15, fq = lane >> 4;
  const unsigned bh = (unsigned)(b * 8 + h);
  int c0 = 0, kc0 = 0, kr0 = 0, qrow;
  unsigned qso;
  if (LOCAL) {
    c0 = qb * 16; kc0 = qb == 0 ? 0 : qb == 1 ? 8 : qb == 2 ? 24 : 32;
    kr0 = min(max(r - 4, 0), 56);
    qrow = MC + b * SEQ + r * 64 + c0 + fr;
    qso = (unsigned)(HM_LAT * 2) + (bh * SEQ + r * 64 + c0) * 128;
  } else {
    qrow = b * NCTX + qb * 16 + fr;
    qso = (bh * NCTX + qb * 16) * 128;
  }
  const unsigned vQ = fr * 128 + fq * 32;
  const bf16x8 qf0 = QPRE ? qp0 : bl128(rsQ, vQ, qso), qf1 = QPRE ? qp1 : bl128(rsQ, vQ + 16, qso);
  bf16x8 kfa[16];
  if (LOCAL) {
    const unsigned kbase = (unsigned)(HM_LAT * 2) + bh * SEQ * 64 * 2;
    const unsigned vK = (8 * (fr >> 2) + (fr & 3)) * 128 + fq * 32;
#pragma unroll
    for (int t = 0; t < 8; ++t) {
      const unsigned so = kbase + ((kr0 + (t >> 1)) * 64 + kc0 + (t & 1) * 4) * 128;
      kfa[2 * t] = bl128(rsK, vK, so); kfa[2 * t + 1] = bl128(rsK, vK + 16, so);
    }
    __builtin_amdgcn_sched_barrier(0);
  }
  float m2, l2; f32x4 O[4];
  attn_pass<false>(rsK, rsV, 0u, 0u, cK, cV, s_rpb, r, c0, kc0, kr0, lane, qf0, qf1, m2, l2, O, kfa);
  float l = l2;
  if (nxt_dst) attn_stage_ctx(p, nxt_dst, nxt_bh, wid, lane);
  if (LOCAL) {
    float m1, l1; f32x4 O1[4];
    attn_pass<true>(rsK, rsV, (unsigned)(HM_LAT * 2) + bh * SEQ * 64 * 2, (unsigned)(HM_LAT * 2) + bh * 64 * 4096 * 2, cK, cV, s_rpb + h * 465, r, c0,
                    kc0, kr0, lane, qf0, qf1, m1, l1, O1, kfa);
    const float m = fmaxf(m1, m2);
    const float sc1 = __builtin_amdgcn_exp2f(m1 - m), sc2 = __builtin_amdgcn_exp2f(m2 - m);
    l = l1 * sc1 + l2 * sc2;
#pragma unroll
    for (int dt = 0; dt < 4; ++dt)
#pragma unroll
      for (int j = 0; j < 4; ++j) O[dt][j] = O[dt][j] * sc2 + O1[dt][j] * sc1;
  }
  const float inv_l = 1.f / l;
#pragma unroll
  for (int dt = 0; dt < 4; ++dt) {
    const float sc8 = inv_l * 8.f;
    *(int*)((char*)p.cat() + (size_t)qrow * D + h * 64 + dt * 16 + fq * 4) = pack_fp8x4(O[dt][0] * sc8, O[dt][1] * sc8, O[dt][2] * sc8, O[dt][3] * sc8);
  }
}

DI void phase_attn(const W& p_, int layer, char* lds, int bid, int nblk) {
  const W p = oq(p_);
  float* s_rpb = (float*)lds;
  char* cbuf = lds + 16384;
  const int tid = otid(), lane = tid & 63;
  const int wid = __builtin_amdgcn_readfirstlane(tid >> 6);
  for (int i = tid; i < 8 * 15 * 31; i += NTHR) s_rpb[i] = p.rpb()[layer * 3720 + i] * 1.4426950408889634f;
  const __amdgpu_buffer_rsrc_t rsQ = __builtin_amdgcn_make_buffer_rsrc((void*)p.qh(), 0, (int)(HM_ELEMS * 2), 0x00020000);
  const __amdgpu_buffer_rsrc_t rsK = __builtin_amdgcn_make_buffer_rsrc((void*)p.kh(), 0, (int)(HM_ELEMS * 2), 0x00020000);
  const __amdgpu_buffer_rsrc_t rsV = __builtin_amdgcn_make_buffer_rsrc((void*)p.vt(), 0, (int)(HM_ELEMS * 2), 0x00020000);
  const bool fast = nblk == 256;
  const int npair = fast ? 8 : 64;
  const int xg = bid >> 5, lw = (bid & 31) * 8 + wid;
  attn_stage_ctx(p, cbuf, fast ? xg : 0, wid, lane);
  const unsigned vQp = (lane & 15) * 128 + (lane >> 4) * 32;
  auto qso_of = [&](int ph2) { return (unsigned)(HM_LAT * 2) + ((unsigned)ph2 * SEQ + (lw >> 2) * 64 + (lw & 3) * 16) * 128; };
  bf16x8 qn0 = bf16x8{}, qn1 = bf16x8{};
  if (fast) { qn0 = bl128(rsQ, vQp, qso_of(xg)); qn1 = bl128(rsQ, vQp + 16, qso_of(xg)); }
  for (int sl = 0; sl < npair; ++sl) {
    const int ph = fast ? sl * 8 + xg : sl, h = ph & 7, b = ph >> 3;
    asm volatile("s_waitcnt vmcnt(0)" ::: "memory");
    __syncthreads();
    const char* cK = cbuf + (sl & 1) * 65536;
    const char* cV = cK + 32768;
    char* ndst = sl + 1 < npair ? cbuf + ((sl + 1) & 1) * 65536 : nullptr;
    if (fast) {
      const bf16x8 qc0 = qn0, qc1 = qn1;
      if (sl + 1 < npair) { qn0 = bl128(rsQ, vQp, qso_of((sl + 1) * 8 + xg)); qn1 = bl128(rsQ, vQp + 16, qso_of((sl + 1) * 8 + xg)); }
      attn_unit<true, true>(p, rsQ, rsK, rsV, cK, cV, s_rpb, b, h, lw >> 2, lw & 3, lane, ndst, (sl + 1) * 8 + xg, wid, qc0, qc1);
      if (layer == 0 && (lw >> 4) == sl) attn_unit<false>(p, rsQ, rsK, rsV, cK, cV, s_rpb, b, h, 0, lw & 15, lane);
    } else {
      if (ndst) attn_stage_ctx(p, ndst, sl + 1, wid, lane);
      for (int u = bid * 8 + wid; u < 256; u += nblk * 8) attn_unit<true>(p, rsQ, rsK, rsV, cK, cV, s_rpb, b, h, u >> 2, u & 3, lane);
      if (layer == 0)
        for (int u = bid * 8 + wid; u < 16; u += nblk * 8) attn_unit<false>(p, rsQ, rsK, rsV, cK, cV, s_rpb, b, h, 0, u, lane);
    }
  }
  __syncthreads();
}

DI void phase_pool(const W& p_, int layer, char* lds, int bid, int nblk) {
  const W p = oq(p_);
  float* U = (float*)lds;
  bf16_t* dA = (bf16_t*)(lds + 81920);
  bf16_t* WT = (bf16_t*)(lds + 81920 + 33792);
  const int tid = otid(), wid = tid >> 6, lane = tid & 63, fr = lane & 15, fq = lane >> 4;
  for (int i = tid; i < 4 * 64 * 8; i += NTHR) {
    const int rowj = i >> 3, chk = i & 7;
    *(uint4*)(WT + rowj * 72 + chk * 8) = *(const uint4*)(p.wpt() + (size_t)layer * 16384 + rowj * 64 + chk * 8);
  }
  const int nlat = ML / 64, nctx = layer == 0 ? MC / 64 : 0;
  const int gextra = NB * 4 * NSLOT - nblk * 8;
  const int heavy = (gextra > 0 && gextra < nblk * 4) ? (gextra + 7) / 8 : 0;
  const int ptotal = nlat + nctx;
  const int ufirst = bid < heavy ? ptotal - 1 - bid : bid - heavy;
  const int ustep = bid < heavy ? ptotal : nblk - heavy;
  const int ulimit = bid < heavy ? ptotal : ptotal - heavy;
  for (int u = ufirst; u < ulimit; u += ustep) {
    int row0, L, seq0;
    if (u < nlat) { row0 = MC + u * 64; L = SEQ; seq0 = MC + ((u * 64) / SEQ) * SEQ; }
    else { row0 = (u - nlat) * 64; L = NCTX; seq0 = (row0 / NCTX) * NCTX; }
    const int t0 = row0 - seq0;
    __syncthreads();
#pragma unroll
    for (int k = 0; k < 5; ++k) {
      const int c = tid + NTHR * k, rr = c >> 5, chk = c & 31;
      const int tpos = t0 - 8 + rr;
      uint4 v = make_uint4(0u, 0u, 0u, 0u);
      if (tpos >= 0 && tpos < L) v = *(const uint4*)(p.px() + (size_t)(seq0 + tpos) * INW + 1536 + chk * 8);
      float4 lo4, hi4;
      lo4.x = __uint_as_float(v.x << 16); lo4.y = __uint_as_float(v.x & 0xffff0000u); lo4.z = __uint_as_float(v.y << 16); lo4.w = __uint_as_float(v.y & 0xffff0000u);
      hi4.x = __uint_as_float(v.z << 16); hi4.y = __uint_as_float(v.z & 0xffff0000u); hi4.z = __uint_as_float(v.w << 16); hi4.w = __uint_as_float(v.w & 0xffff0000u);
      *(float4*)(U + rr * 256 + chk * 8) = lo4;
      *(float4*)(U + rr * 256 + chk * 8 + 4) = hi4;
    }
    __syncthreads();
    {
      const int ch = tid & 255, hf = tid >> 8, g = ch >> 6, hw = 1 << g;
      const float* Uc = U + ch;
      int tpos = t0 + hf * 32;
      int lo = max(tpos - hw, 0), hi = min(tpos + hw - 1, L - 1);
      float S = 0.f;
      for (int j = lo; j <= hi; ++j) S += Uc[(j - t0 + 8) * 256];
      for (int tt = 0; tt < 32; ++tt) {
        const float dv = S / (float)(hi - lo + 1) - Uc[(tpos - t0 + 8) * 256];
        dA[(hf * 32 + tt) * 264 + ch] = f2bf(dv);
        ++tpos;
        const int nlo = max(tpos - hw, 0), nhi = min(tpos + hw - 1, L - 1);
        if (nlo > lo) { S -= Uc[(lo - t0 + 8) * 256]; lo = nlo; }
        if (nhi > hi) { S += Uc[(nhi - t0 + 8) * 256]; hi = nhi; }
      }
    }
    __syncthreads();
    {
      const int g = wid & 3, th = wid >> 2;
      f32x4 acc[2][4];
#pragma unroll
      for (int mi = 0; mi < 2; ++mi)
#pragma unroll
        for (int ni = 0; ni < 4; ++ni) acc[mi][ni] = (f32x4){0.f, 0.f, 0.f, 0.f};
#pragma unroll
      for (int ks = 0; ks < 2; ++ks) {
        bf16x8 a[2], b[4];
#pragma unroll
        for (int mi = 0; mi < 2; ++mi) a[mi] = *(const bf16x8*)(dA + (th * 32 + mi * 16 + fr) * 264 + g * 64 + 32 * ks + 8 * fq);
#pragma unroll
        for (int ni = 0; ni < 4; ++ni) b[ni] = *(const bf16x8*)(WT + (g * 64 + ni * 16 + fr) * 72 + 32 * ks + 8 * fq);
#pragma unroll
        for (int mi = 0; mi < 2; ++mi)
#pragma unroll
          for (int ni = 0; ni < 4; ++ni) acc[mi][ni] = __builtin_amdgcn_mfma_f32_16x16x32_bf16(b[ni], a[mi], acc[mi][ni], 0, 0, 0);
      }
#pragma unroll
      for (int mi = 0; mi < 2; ++mi) {
        const int row = row0 + th * 32 + mi * 16 + fr;
#pragma unroll
        for (int ni = 0; ni < 4; ++ni) {
          const int j0 = g * 64 + ni * 16 + 4 * fq;
          const float4 sc = *(const float4*)(p.pool_scale() + layer * 256 + j0);
          *(int*)((char*)p.cat() + (size_t)row * D + 512 + j0) =
              pack_fp8x4(acc[mi][ni][0] * sc.x * 8.f, acc[mi][ni][1] * sc.y * 8.f, acc[mi][ni][2] * sc.z * 8.f, acc[mi][ni][3] * sc.w * 8.f);
        }
      }
    }
  }
  __syncthreads();
}

DI int gla_row0(int b, int slot) { return slot < 4 ? b * NCTX + slot * 64 : MC + b * SEQ + (slot - 4) * 64; }
constexpr int KXT_STRIDE = 72;

DI void phase_gla_c1(const W& p_, int layer, char* lds, int bid, int nblk) {
  const W p = oq(p_);
  const int tid = otid(), lane = tid & 63;
  const int wid = __builtin_amdgcn_readfirstlane(tid >> 6);
  constexpr int WREG = 2 * 32 * KXT_STRIDE * 2 + 4096;
  bf16_t* kxt = (bf16_t*)(lds + wid * WREG);
  bf16_t* al = (bf16_t*)(lds + wid * WREG + 2 * 32 * KXT_STRIDE * 2);
  float* s_rope = (float*)(lds + 8 * WREG);
  for (int i = tid; i < 1024; i += NTHR) s_rope[i] = p.rope()[i];
  __syncthreads();
  const int dir = lane >> 5, d = lane & 31, fr = lane & 15, fq = lane >> 4;
  const __amdgpu_buffer_rsrc_t rsV = __builtin_amdgcn_make_buffer_rsrc((void*)p.vtg(), 0, (int)(HMG_ELEMS * 2), 0x00020000);
  const int half = d >> 4, jf = d & 7;
  const float sgn = ((d >> 3) & 1) ? 1.f : -1.f;
  for (int u = bid * 8 + wid; u < NB * 4 * NSLOT; u += nblk * 8) {
    const int slot = u % NSLOT, bh = u / NSLOT, h = bh & 3, b = bh >> 2;
    const int row0 = gla_row0(b, slot);
    const bool latent = slot >= 4;
#pragma unroll
    for (int j = 0; j < 4; ++j) {
      const int rr = j * 16 + (lane >> 2), chk = lane & 3;
      *(uint4*)(al + rr * 32 + chk * 8) = *(const uint4*)(p.px() + (size_t)(row0 + rr) * INW + 2560 + chk * 8);
    }
    float w2[16];
    {
      const float* w2p = (dir ? p.w_gate_b() : p.w_gate_f()) + layer * 2048 + h * 32 + d;
#pragma unroll
      for (int r = 0; r < 16; ++r) w2[r] = w2p[r * 128];
    }
    const float b2 = (dir ? p.b_gate_b() : p.b_gate_f())[layer * 128 + h * 32 + d];
    bf16_t* gq = p.gqk() + ((size_t)u * 2 + dir) * 4096;
    asm volatile("s_waitcnt lgkmcnt(0)" ::: "memory");
    float bsum = 0.f;
    for (int ib = 0; ib < 4; ++ib) {
      bf16_t qo[16], qp[16], ko[16], kp[16];
#pragma unroll
      for (int k = 0; k < 16; ++k) {
        const int ii = ib * 16 + k, i = dir ? 63 - ii : ii;
        const bf16_t* rowp = p.px() + (size_t)(row0 + i) * INW + h * 32;
        qo[k] = rowp[1792 + d]; qp[k] = rowp[1792 + (d ^ 8)]; ko[k] = rowp[1920 + d]; kp[k] = rowp[1920 + (d ^ 8)];
      }
#pragma unroll
      for (int k = 0; k < 16; ++k) {
        const int ii = ib * 16 + k, i = dir ? 63 - ii : ii;
        const uint4 a0 = *(const uint4*)(al + i * 32 + dir * 16), a1 = *(const uint4*)(al + i * 32 + dir * 16 + 8);
        float lg = b2;
        const unsigned aw[8] = {a0.x, a0.y, a0.z, a0.w, a1.x, a1.y, a1.z, a1.w};
#pragma unroll
        for (int r = 0; r < 8; ++r) {
          lg += __uint_as_float(aw[r] << 16) * w2[2 * r];
          lg += __uint_as_float(aw[r] & 0xffff0000u) * w2[2 * r + 1];
        }
        const float ls = fminf(lg, 0.f) - __logf(1.f + __expf(-fabsf(lg)));
        bsum += ls * (1.f / 16.f);
        const float qov = bf2f(qo[k]) * 0.17677669529663687f, qpv = bf2f(qp[k]) * 0.17677669529663687f;
        const float kov = bf2f(ko[k]), kpv = bf2f(kp[k]);
        float qr = qov, kr = kov;
        if (latent) {
          const int pos = half == 0 ? (slot - 4) : i;
          const float2 cs = *(const float2*)(s_rope + (pos * 8 + jf) * 2);
          qr = qov * cs.x + sgn * qpv * cs.y;
          kr = kov * cs.x + sgn * kpv * cs.y;
        }
        const float eb = __expf(bsum);
        const bf16_t qx = f2bf(qr * eb), kx = f2bf(kr / eb);
        gq[i * 32 + d] = qx;
        gq[2048 + i * 32 + d] = kx;
        kxt[(dir * 32 + d) * KXT_STRIDE + i] = kx;
      }
    }
    const float eblast = __expf(bsum);
    p.gdec()[((size_t)u * 2 + dir) * 32 + d] = eblast;
    asm volatile("s_waitcnt lgkmcnt(0)" ::: "memory");
    const unsigned vbase = (unsigned)((latent ? HMG_LAT + (size_t)(bh * 64 + slot - 4) * 4096 : (size_t)(bh * 4 + slot) * 4096) * 2);
    bf16x8 vf[2][4];
#pragma unroll
    for (int ks = 0; ks < 2; ++ks)
#pragma unroll
      for (int mt = 0; mt < 4; ++mt) vf[ks][mt] = bl128(rsV, (unsigned)(((16 * mt + fr) * 64 + 8 * fq) * 2), vbase + ks * 64);
#pragma unroll
    for (int dd = 0; dd < 2; ++dd) {
      f32x4 acc[4][2];
#pragma unroll
      for (int mt = 0; mt < 4; ++mt)
#pragma unroll
        for (int nt = 0; nt < 2; ++nt) acc[mt][nt] = (f32x4){0.f, 0.f, 0.f, 0.f};
#pragma unroll
      for (int ks = 0; ks < 2; ++ks) {
        bf16x8 kf[2];
#pragma unroll
        for (int nt = 0; nt < 2; ++nt) kf[nt] = *(const bf16x8*)(kxt + (dd * 32 + 16 * nt + fr) * KXT_STRIDE + 32 * ks + 8 * fq);
#pragma unroll
        for (int mt = 0; mt < 4; ++mt)
#pragma unroll
          for (int nt = 0; nt < 2; ++nt) acc[mt][nt] = __builtin_amdgcn_mfma_f32_16x16x32_bf16(vf[ks][mt], kf[nt], acc[mt][nt], 0, 0, 0);
      }
      float* kvp = p.gkv() + ((size_t)u * 2 + dd) * 2048;
#pragma unroll
      for (int nt = 0; nt < 2; ++nt) {
        const float sc = __shfl(eblast, dd * 32 + 16 * nt + fr);
#pragma unroll
        for (int mt = 0; mt < 4; ++mt)
#pragma unroll
          for (int j = 0; j < 4; ++j) kvp[(16 * mt + 4 * fq + j) * 32 + 16 * nt + fr] = acc[mt][nt][j] * sc;
      }
    }
    asm volatile("s_waitcnt lgkmcnt(0)" ::: "memory");
  }
  __syncthreads();
}

DI void phase_gla_scan(const W& p_, int bid, int nblk) {
  const W p = oq(p_);
  bf16_t* sin = (bf16_t*)p.gsin();
  const int nthreads = NB * 4 * 2 * 2048;
  for (int gid = bid * NTHR + otid(); gid < nthreads; gid += nblk * NTHR) {
    const int el = gid & 2047, dir = (gid >> 11) & 1, bh = gid >> 12, d = el & 31;
    float S = 0.f;
    for (int st0 = 0; st0 < NSLOT; st0 += 17) {
      float dk[17], kv[17];
#pragma unroll
      for (int j = 0; j < 17; ++j) {
        const int st = st0 + j;
        const int slot = dir == 0 ? st : (st < 4 ? 3 - st : NSLOT + 3 - st);
        const size_t base = ((size_t)(bh * NSLOT + slot)) * 2 + dir;
        dk[j] = p.gdec()[base * 32 + d];
        kv[j] = p.gkv()[base * 2048 + el];
      }
#pragma unroll
      for (int j = 0; j < 17; ++j) {
        const int st = st0 + j;
        const int slot = dir == 0 ? st : (st < 4 ? 3 - st : NSLOT + 3 - st);
        const size_t base = ((size_t)(bh * NSLOT + slot)) * 2 + dir;
        sin[base * 2048 + el] = f2bf(S);
        S = dk[j] * S + kv[j];
      }
    }
  }
}

DI void phase_gla_c3(const W& p_, int layer, char* lds, int bid, int nblk) {
  (void)lds;
  const W p = oq(p_);
  const int tid = otid(), lane = tid & 63;
  const int wid = __builtin_amdgcn_readfirstlane(tid >> 6);
  const int fr = lane & 15, fq = lane >> 4;
  const __amdgpu_buffer_rsrc_t rsV = __builtin_amdgcn_make_buffer_rsrc((void*)p.vtg(), 0, (int)(HMG_ELEMS * 2), 0x00020000);
  const __amdgpu_buffer_rsrc_t rsQ = __builtin_amdgcn_make_buffer_rsrc((void*)p.gqk(), 0, (int)((size_t)NB * 4 * NSLOT * 16384), 0x00020000);
  const __amdgpu_buffer_rsrc_t rsS = __builtin_amdgcn_make_buffer_rsrc((void*)p.gsin(), 0, (int)((size_t)NB * 4 * NSLOT * 2 * 4096), 0x00020000);
  const int slot_lo = layer == 0 ? 0 : 4;
  const int nsl = NSLOT - slot_lo;
  const unsigned vfrag = (unsigned)(fr * 64 + fq * 16);
  for (int uu = bid * 8 + wid; uu < NB * 4 * nsl; uu += nblk * 8) {
    const int slot = slot_lo + uu % nsl, bh = uu / nsl, h = bh & 3, b = bh >> 2;
    const int u = bh * NSLOT + slot;
    const bool latent = slot >= 4;
    const int row0 = gla_row0(b, slot);
    const unsigned qbase = (unsigned)u * 16384u;
    bf16x8 QF[4], QB[4];
#pragma unroll
    for (int ct = 0; ct < 4; ++ct) { QF[ct] = bl128(rsQ, vfrag, qbase + ct * 1024); QB[ct] = bl128(rsQ, vfrag, qbase + 8192 + ct * 1024); }
    f32x4 O[4][4];
#pragma unroll
    for (int mt = 0; mt < 4; ++mt)
#pragma unroll
      for (int ct = 0; ct < 4; ++ct) O[mt][ct] = (f32x4){0.f, 0.f, 0.f, 0.f};
    const unsigned vbase = (unsigned)((latent ? HMG_LAT + (size_t)(bh * 64 + slot - 4) * 4096 : (size_t)(bh * 4 + slot) * 4096) * 2);
    const unsigned vV = (unsigned)((fr * 64 + 4 * fq) * 2);
#pragma unroll
    for (int ks = 0; ks < 2; ++ks) {
      f32x4 Pt[2][4];
#pragma unroll
      for (int t2 = 0; t2 < 2; ++t2) {
        const int st = 2 * ks + t2;
        const bf16x8 KFs = bl128(rsQ, vfrag, qbase + 4096 + st * 1024), KBs = bl128(rsQ, vfrag, qbase + 8192 + 4096 + st * 1024);
#pragma unroll
        for (int ct = 0; ct < 4; ++ct) {
          const f32x4 z = (f32x4){0.f, 0.f, 0.f, 0.f};
          if (st < ct) Pt[t2][ct] = __builtin_amdgcn_mfma_f32_16x16x32_bf16(KFs, QF[ct], z, 0, 0, 0);
          else if (st > ct) Pt[t2][ct] = __builtin_amdgcn_mfma_f32_16x16x32_bf16(KBs, QB[ct], z, 0, 0, 0);
          else {
            const f32x4 f = __builtin_amdgcn_mfma_f32_16x16x32_bf16(KFs, QF[ct], z, 0, 0, 0);
            const f32x4 g = __builtin_amdgcn_mfma_f32_16x16x32_bf16(KBs, QB[ct], z, 0, 0, 0);
#pragma unroll
            for (int j = 0; j < 4; ++j) { const int s = 4 * fq + j; Pt[t2][ct][j] = (s <= fr ? f[j] : 0.f) + (s >= fr ? g[j] : 0.f); }
          }
        }
      }
      bf16x8 pf[4];
#pragma unroll
      for (int ct = 0; ct < 4; ++ct)
        pf[ct] = __builtin_bit_cast(bf16x8, (u32x4){pack2(Pt[0][ct][0], Pt[0][ct][1]), pack2(Pt[0][ct][2], Pt[0][ct][3]),
                                                     pack2(Pt[1][ct][0], Pt[1][ct][1]), pack2(Pt[1][ct][2], Pt[1][ct][3])});
#pragma unroll
      for (int mt = 0; mt < 4; ++mt) {
        const unsigned so = vbase + (unsigned)((mt * 16 * 64 + 32 * ks) * 2);
        const u32x2 v0 = bl64(rsV, vV, so), v1 = bl64(rsV, vV + 32, so);
        const bf16x8 vf = __builtin_bit_cast(bf16x8, (u32x4){v0.x, v0.y, v1.x, v1.y});
#pragma unroll
        for (int ct = 0; ct < 4; ++ct) O[mt][ct] = __builtin_amdgcn_mfma_f32_16x16x32_bf16(vf, pf[ct], O[mt][ct], 0, 0, 0);
      }
    }
    const unsigned sbase = (unsigned)u * 8192u;
#pragma unroll
    for (int mt = 0; mt < 4; ++mt) {
      const bf16x8 sf = bl128(rsS, vfrag, sbase + mt * 1024), sb = bl128(rsS, vfrag, sbase + 4096 + mt * 1024);
#pragma unroll
      for (int ct = 0; ct < 4; ++ct) {
        O[mt][ct] = __builtin_amdgcn_mfma_f32_16x16x32_bf16(sf, QF[ct], O[mt][ct], 0, 0, 0);
        O[mt][ct] = __builtin_amdgcn_mfma_f32_16x16x32_bf16(sb, QB[ct], O[mt][ct], 0, 0, 0);
      }
    }
#pragma unroll
    for (int ct = 0; ct < 4; ++ct) {
      float ss = 0.f;
#pragma unroll
      for (int mt = 0; mt < 4; ++mt)
#pragma unroll
        for (int j = 0; j < 4; ++j) ss += O[mt][ct][j] * O[mt][ct][j];
      ss += __shfl_xor(ss, 16); ss += __shfl_xor(ss, 32);
      const float rstd = rsqrtf(ss * (1.f / 64.f) + EPS);
      const int row = row0 + 16 * ct + fr;
#pragma unroll
      for (int mt = 0; mt < 4; ++mt) {
        const int v0 = 16 * mt + 4 * fq;
        const uint2 rv = *(const uint2*)(p.px() + (size_t)row * INW + 2304 + h * 64 + v0);
        const float4 gg = *(const float4*)(p.g_gla() + layer * 64 + v0);
        const float r0 = O[mt][ct][0] * rstd * gg.x * siluf_(__uint_as_float(rv.x << 16));
        const float r1 = O[mt][ct][1] * rstd * gg.y * siluf_(__uint_as_float(rv.x & 0xffff0000u));
        const float r2 = O[mt][ct][2] * rstd * gg.z * siluf_(__uint_as_float(rv.y << 16));
        const float r3 = O[mt][ct][3] * rstd * gg.w * siluf_(__uint_as_float(rv.y & 0xffff0000u));
        *(int*)((char*)p.cat() + (size_t)row * D + 768 + h * 64 + v0) = pack_fp8x4(r0 * 8.f, r1 * 8.f, r2 * 8.f, r3 * 8.f);
      }
    }
  }
}

#define XB_TMO      128
#define XB_XCNT(j)  (256  + 64 * (j))
#define XB_XSUB(j)  (1280 + 64 * (j))
#define XB_XGEN(j)  (2304 + 64 * (j))
#define XB_TOP      3328
#define XB_TOPGEN   3392
#define XCD_BAR_WORDS 3456
#define XB_SPIN_CAP (1u << 18)
#define LAS __attribute__((address_space(3)))

__device__ __forceinline__ unsigned xb_ld(unsigned* p)              { return __hip_atomic_load(p, __ATOMIC_RELAXED, __HIP_MEMORY_SCOPE_AGENT); }
__device__ __forceinline__ unsigned xb_add(unsigned* p, unsigned v) { return __hip_atomic_fetch_add(p, v, __ATOMIC_RELAXED, __HIP_MEMORY_SCOPE_AGENT); }
__device__ __forceinline__ unsigned xb_xcc_id() { return (unsigned)__builtin_amdgcn_s_getreg((3 << 11) | 20) & 0xFu; }
#define XB_SPIN(cond, bar) do { unsigned _sp = 0; while (cond) { __builtin_amdgcn_s_sleep(1); \
    if ((++_sp & 255u) == 0u) { if (xb_ld(&(bar)[XB_TMO])) break; if (_sp > XB_SPIN_CAP) { atomicAdd(&(bar)[XB_TMO], 1u); break; } } } } while (0)

struct XcdBarrier { unsigned* bar; unsigned x; volatile LAS unsigned* st; };

__device__ __forceinline__ XcdBarrier xcd_barrier_post(unsigned* bar, volatile LAS unsigned* st) {
    XcdBarrier b; b.bar = bar; b.x = xb_xcc_id(); b.st = st;
    if (threadIdx.x == 0) (void)xb_add(&bar[XB_XCNT(b.x)], 1u);
    return b;
}
__device__ __forceinline__ void xcd_barrier_complete(unsigned* bar, unsigned x, unsigned& nloc, unsigned& nx) {
    const unsigned G = gridDim.x * gridDim.y * gridDim.z;
    unsigned sum, cnt, mine, sp = 0u;
    for (;;) {
        sum = 0u; cnt = 0u; mine = 0u;
#pragma unroll
        for (unsigned j = 0; j < 16; ++j) { const unsigned c = xb_ld(&bar[XB_XCNT(j)]); sum += c; cnt += (c > 0u) ? 1u : 0u; mine = (j == x) ? c : mine; }
        if (sum == G) break;
        __builtin_amdgcn_s_sleep(1);
        if ((++sp & 255u) == 0u) { if (xb_ld(&bar[XB_TMO])) break; if (sp > XB_SPIN_CAP) { atomicAdd(&bar[XB_TMO], 1u); break; } }
    }
    nloc = mine > 0u ? mine : 1u; nx = cnt > 0u ? cnt : 1u;
}
__device__ __forceinline__ void xcd_barrier(const XcdBarrier& b) {
    asm volatile("s_waitcnt vmcnt(0)" ::: "memory");
    __syncthreads();
    if (threadIdx.x == 0) {
        unsigned long long bv = (unsigned long long)b.bar; unsigned bx = b.x;
        asm volatile("" : "+s"(bv), "+s"(bx));
        unsigned* bar = (unsigned*)(__attribute__((address_space(1))) unsigned*)bv;
        __builtin_amdgcn_s_waitcnt(0);
        unsigned nloc = b.st[0], nx = b.st[1];
        if (nloc == 0u) { xcd_barrier_complete(bar, bx, nloc, nx); b.st[0] = nloc; b.st[1] = nx; }
        const unsigned old = xb_add(&bar[XB_XSUB(bx)], 1u);
        const unsigned gen = old / nloc;
        if (old + 1u == (gen + 1u) * nloc) {
            __builtin_amdgcn_fence(__ATOMIC_RELEASE, "agent");
            asm volatile("s_waitcnt vmcnt(0)" ::: "memory");
            const unsigned og = xb_add(&bar[XB_TOP], 1u);
            const unsigned tg = og / nx;
            if (og + 1u == (tg + 1u) * nx) xb_add(&bar[XB_TOPGEN], 1u);
            else XB_SPIN(xb_ld(&bar[XB_TOPGEN]) == tg, bar);
            __builtin_amdgcn_fence(__ATOMIC_ACQUIRE, "agent");
            xb_add(&bar[XB_XGEN(bx)], 1u);
            asm volatile("s_waitcnt vmcnt(0)" ::: "memory");
        } else {
            XB_SPIN(xb_ld(&bar[XB_XGEN(bx)]) == gen, bar);
            __builtin_amdgcn_fence(__ATOMIC_ACQUIRE, "agent");
            asm volatile("s_waitcnt vmcnt(0)" ::: "memory");
        }
    }
    __syncthreads();
}

__global__ void __launch_bounds__(NTHR, 2) k_fwd(P q) {
  extern __shared__ __attribute__((aligned(16))) char lds[];
  const int bid = blockIdx.x, nblk = gridDim.x;
  if (threadIdx.x < 4) ((unsigned*)(lds + LDS_BYTES - 16))[threadIdx.x] = 0u;
  __syncthreads();
  XcdBarrier bar = xcd_barrier_post((unsigned*)(q.ws + OFF_BAR), (volatile LAS unsigned*)(lds + LDS_BYTES - 16));
  int* s_vb = (int*)(lds + LDS_BYTES - 32);
  if (threadIdx.x == 0) {
    const int xcc = (int)xb_xcc_id();
    s_vb[1] = xcc;
    s_vb[2] = (int)__hip_atomic_fetch_add((unsigned*)(q.ws + OFF_CNT) + 768 + xcc, 1u, __ATOMIC_RELAXED, __HIP_MEMORY_SCOPE_AGENT);
  }
#define GB() xcd_barrier(bar)
#ifndef PROBE_DUP
#define PROBE_DUP 0
#endif
#if PROBE_DUP == 1
#define DUP1(x) x
#else
#define DUP1(x) (void)0
#endif
#if PROBE_DUP == 2
#define DUP2(x) x
#else
#define DUP2(x) (void)0
#endif
#if PROBE_DUP == 3
#define DUP3(x) x
#else
#define DUP3(x) (void)0
#endif
#if PROBE_DUP == 4
#define DUP4(x) x
#else
#define DUP4(x) (void)0
#endif
#if PROBE_DUP == 5
#define DUP5(x) x
#else
#define DUP5(x) (void)0
#endif
#if PROBE_DUP == 6
#define DUP6(x) x
#else
#define DUP6(x) (void)0
#endif
#if PROBE_DUP == 7
#define DUP7(x) x
#else
#define DUP7(x) (void)0
#endif
#if PROBE_DUP == 8
#define DUP8(x) x
#else
#define DUP8(x) (void)0
#endif
#if PROBE_DUP == 9
#define DUP9(x) x
#else
#define DUP9(x) (void)0
#endif
  phase_convert(q, lds, bid, nblk);
  phase_mod(q, lds, bid, nblk);
  DUP3(phase_convert(q, lds, bid, nblk)); DUP3(phase_mod(q, lds, bid, nblk));
  GB();
  if (threadIdx.x == 0) {
    const unsigned* rc = (const unsigned*)(q.ws + OFF_CNT) + 768;
    const int per = nblk >> 3;
    bool ok = (nblk & 7) == 0;
    for (int j = 0; j < 16; ++j) {
      const int c = (int)__hip_atomic_load(rc + j, __ATOMIC_RELAXED, __HIP_MEMORY_SCOPE_AGENT);
      ok = ok && (j < 8 ? c == per : c == 0);
    }
    s_vb[0] = ok ? s_vb[1] * per + s_vb[2] : ((nblk & 7) == 0 ? (bid & 7) * per + (bid >> 3) : bid);
  }
  __syncthreads();
  const int vb = __builtin_amdgcn_readfirstlane(s_vb[0]);
  phase_norm0(q, bid, nblk);
  DUP3(phase_norm0(q, bid, nblk));
  GB();
  const W p{q.ws, q.out, q.x, q.ctx};
#define LAYER(layer, row_lo, LASTGB)                          \
  do {                                                        \
    phase_inproj(p, layer, lds, vb, nblk);                   \
    DUP7(phase_inproj(p, layer, lds, vb, nblk));             \
    GB();                                                     \
    phase_gla_c1(p, layer, lds, vb, nblk);                   \
    phase_pool(p, layer, lds, vb, nblk);                     \
    DUP6(phase_gla_c1(p, layer, lds, vb, nblk)); DUP5(phase_pool(p, layer, lds, vb, nblk)); \
    GB();                                                     \
    phase_gla_scan(p, vb, nblk);                             \
    phase_attn(p, layer, lds, vb, nblk);                     \
    DUP6(phase_gla_scan(p, vb, nblk)); DUP4(phase_attn(p, layer, lds, vb, nblk)); \
    GB();                                                     \
    phase_gla_c3(p, layer, lds, vb, nblk);                   \
    DUP6(phase_gla_c3(p, layer, lds, vb, nblk));             \
    GB();                                                     \
    DUP2(phase_outproj_t<true>(p, layer, lds, row_lo, vb, nblk)); \
    phase_outproj(p, layer, lds, row_lo, vb, nblk);          \
    GB();                                                     \
    phase_norm(p, layer, row_lo, vb, nblk);                  \
    DUP3(phase_norm(p, layer, row_lo, vb, nblk));            \
    GB();                                                     \
    phase_router(p, layer, lds, row_lo, vb, nblk);           \
    DUP1(phase_router(p, layer, lds, row_lo, vb, nblk));     \
    GB();                                                     \
    phase_route(p, layer, lds, row_lo, vb, nblk);            \
    GB();                                                     \
    phase_moe(p, layer, lds, row_lo, vb, nblk);              \
    DUP8(phase_moe(p, layer, lds, row_lo, vb, nblk));        \
    GB();                                                     \
    DUP9(phase_combine_t<true>(p, layer, row_lo, vb, nblk)); \
    phase_combine(p, layer, row_lo, vb, nblk);               \
    LASTGB;                                                   \
  } while (0)
#if PROBE_GEMM
  phase_probe_gemm(p, lds, vb, nblk);
  GB();
#endif
  LAYER(0, 0, GB());
  LAYER(1, MC, (void)0);
#undef LAYER
#undef GB
}

}

extern "C" void kernel_launch(void* const* d_in, const int* in_sizes, int n_in, void* d_out, int out_size, void* d_ws,
                              size_t ws_size, hipStream_t stream) {
  (void)in_sizes; (void)n_in; (void)out_size;
  P p{};
  const float* const* in = (const float* const*)d_in;
  p.x = in[0]; p.c = in[1]; p.ctx = in[2]; p.c_ctx = in[3]; p.w_mod = in[4]; p.b_mod = in[5]; p.g_mix = in[6]; p.w_in = in[7];
  p.rpb = in[8]; p.w_pool = in[9]; p.pool_scale = in[10]; p.w_gate_f = in[11]; p.b_gate_f = in[12]; p.w_gate_b = in[13];
  p.b_gate_b = in[14]; p.g_gla = in[15]; p.w_out = in[16]; p.g_ffn = in[17]; p.w_router = in[18]; p.b_router = in[19];
  p.w_e_in = in[20]; p.w_e_down = in[21]; p.w_sh_in = in[22]; p.w_sh_down = in[23]; p.g_final = in[24];
  p.out = (float*)d_out;
  p.ws = (char*)d_ws;
  char* ws = (char*)d_ws;
  if (ws_size < WS_TOTAL) { fprintf(stderr, "workspace too small: %zu < %zu\n", ws_size, (size_t)WS_TOTAL); }
  static int grid = 0;
  if (!grid) {
    (void)hipFuncSetAttribute((const void*)k_fwd, hipFuncAttributeMaxDynamicSharedMemorySize, LDS_BYTES);
    int dev = 0, cus = 0, per_cu = 0;
    (void)hipGetDevice(&dev);
    (void)hipDeviceGetAttribute(&cus, hipDeviceAttributeMultiprocessorCount, dev);
    (void)hipOccupancyMaxActiveBlocksPerMultiprocessor(&per_cu, (const void*)k_fwd, NTHR, LDS_BYTES);
    if (per_cu < 1) { fprintf(stderr, "k_fwd: occupancy query says 0 blocks per CU\n"); per_cu = 1; }
    grid = cus > 0 ? cus : 256;
  }
  (void)hipMemsetAsync(ws, 0, ZERO_BYTES, stream);
  hipLaunchKernelGGL(k_fwd, dim3(grid), dim3(NTHR), LDS_BYTES, stream, p);
}
```

```cpp
#include <hip/hip_runtime.h>
#include <stdint.h>
#include <stdio.h>

#define DI __device__ __forceinline__
typedef unsigned short bf16_t;
typedef short bf16x8 __attribute__((ext_vector_type(8)));
typedef short bf16x4 __attribute__((ext_vector_type(4)));
typedef float f32x4 __attribute__((ext_vector_type(4)));

namespace {
constexpr int D = 1024, NB = 8, SEQ = 4096, NCTX = 256;
constexpr int MC = NB * NCTX, ML = NB * SEQ, MT = MC + ML;
constexpr int INW = 2592, INWP = 2816;
constexpr int NE = 256, NE1 = 257;
constexpr int NTHR = 512;
constexpr int LDS_BYTES = 152 * 1024;
constexpr int CAP = MT;
constexpr int NSLOT = 68;
constexpr float EPS = 1e-6f;

struct P {
  const float *x, *c, *ctx, *c_ctx, *w_mod, *b_mod, *g_mix, *w_in, *rpb, *w_pool, *pool_scale,
      *w_gate_f, *b_gate_f, *w_gate_b, *b_gate_b, *g_gla, *w_out, *g_ffn, *w_router, *b_router,
      *w_e_in, *w_e_down, *w_sh_in, *w_sh_down, *g_final;
  float* out;
  char* ws;
};

constexpr size_t al256(size_t x) { return (x + 255) & ~(size_t)255; }
constexpr size_t OFF_BAR = 0;
constexpr size_t OFF_CNT = OFF_BAR + 16384;
constexpr size_t ZERO_BYTES = 16384 + 4096;
constexpr size_t OFF_MOD = OFF_CNT + 4096;
constexpr size_t OFF_ROPE = OFF_MOD + al256((size_t)2 * 9 * 6144 * 4);
constexpr size_t OFF_GMIX = OFF_ROPE + al256(64 * 8 * 2 * 4);
constexpr size_t OFF_GFFN = OFF_GMIX + al256(2 * 1024 * 4);
constexpr size_t OFF_GFINAL = OFF_GFFN + al256(2 * 1024 * 4);
constexpr size_t OFF_RPB = OFF_GFINAL + al256(1024 * 4);
constexpr size_t OFF_WPOOL = OFF_RPB + al256(2 * 3720 * 4);
constexpr size_t OFF_PSCALE = OFF_WPOOL + al256(2 * 4 * 4096 * 4);
constexpr size_t OFF_WGF = OFF_PSCALE + al256(2 * 256 * 4);
constexpr size_t OFF_WGB = OFF_WGF + al256(2 * 16 * 128 * 4);
constexpr size_t OFF_BGF = OFF_WGB + al256(2 * 16 * 128 * 4);
constexpr size_t OFF_BGB = OFF_BGF + al256(2 * 128 * 4);
constexpr size_t OFF_GGLA = OFF_BGB + al256(2 * 128 * 4);
constexpr size_t OFF_BROUTER = OFF_GGLA + al256(2 * 64 * 4);
constexpr size_t OFF_WIN = OFF_BROUTER + al256(2 * 256 * 4);
constexpr size_t OFF_WOUT = OFF_WIN + al256((size_t)2 * INWP * 1024 * 2);
constexpr size_t OFF_WR = OFF_WOUT + al256((size_t)2 * 1024 * 1024 * 2);
constexpr size_t OFF_WEI = OFF_WR + al256((size_t)2 * 256 * 1024 * 2);
constexpr size_t OFF_WED = OFF_WEI + al256((size_t)2 * NE1 * 512 * 1024 * 2);
constexpr size_t OFF_H = OFF_WED + al256((size_t)2 * NE1 * 1024 * 256 * 2);
constexpr size_t OFF_CAT = OFF_H + al256((size_t)MT * D * 2);
constexpr size_t OFF_H2 = OFF_CAT + al256((size_t)MT * D * 2);
constexpr size_t OFF_PX = OFF_H2 + al256((size_t)MT * D * 2);
constexpr size_t OFF_ACT = OFF_PX + al256((size_t)MT * INW * 2);
constexpr size_t OFF_Y = OFF_ACT + al256((size_t)9 * MT * 256 * 2);
constexpr size_t OFF_XRES = OFF_Y + al256((size_t)9 * MT * D * 2);
constexpr size_t OFF_LOGITS = OFF_XRES + al256((size_t)MT * D * 4);
constexpr size_t OFF_WTS = OFF_LOGITS + al256((size_t)MT * 256 * 4);
constexpr size_t OFF_GKV = OFF_WTS + al256((size_t)MT * 8 * 4);
constexpr size_t OFF_GDEC = OFF_GKV + al256((size_t)NB * 4 * NSLOT * 2 * 2048 * 4);
constexpr size_t OFF_GSIN = OFF_GDEC + al256((size_t)NB * 4 * NSLOT * 2 * 32 * 4);
constexpr size_t OFF_LISTS = OFF_GSIN + al256((size_t)NB * 4 * NSLOT * 2 * 2048 * 4);
constexpr size_t OFF_QH = OFF_LISTS + al256((size_t)NE * CAP * 4);
constexpr size_t HM_LAT = (size_t)NB * 8 * NCTX * 64;
constexpr size_t HM_ELEMS = (size_t)NB * 8 * (NCTX + SEQ) * 64;
constexpr size_t OFF_KH = OFF_QH + al256(HM_ELEMS * 2);
constexpr size_t OFF_VT = OFF_KH + al256(HM_ELEMS * 2);
constexpr size_t HMG_LAT = (size_t)NB * 4 * 64 * NCTX;
constexpr size_t HMG_ELEMS = (size_t)NB * 4 * 64 * (NCTX + SEQ);
constexpr size_t OFF_VTG = OFF_VT + al256(HM_ELEMS * 2);
constexpr size_t OFF_GQK = OFF_VTG + al256(HMG_ELEMS * 2);
constexpr size_t OFF_WPT = OFF_GQK + al256((size_t)NB * 4 * NSLOT * 2 * 2 * 2048 * 2);
constexpr size_t OFF_H2Q = OFF_WPT + al256((size_t)2 * 4 * 4096 * 2);
constexpr size_t WS_TOTAL = OFF_H2Q + al256((size_t)MT * 1024);

struct W {
  char* ws; float* out; const float* x; const float* ctx;
#define WF(T, name, OFF) DI T* name() const { return (T*)(ws + OFF); }
  WF(unsigned, bar, OFF_BAR) WF(int, cnt, OFF_CNT) WF(float, mod, OFF_MOD) WF(float, rope, OFF_ROPE)
  WF(float, g_mix, OFF_GMIX) WF(float, g_ffn, OFF_GFFN) WF(float, g_final, OFF_GFINAL) WF(float, rpb, OFF_RPB)
  WF(float, w_pool, OFF_WPOOL) WF(float, pool_scale, OFF_PSCALE) WF(float, w_gate_f, OFF_WGF) WF(float, w_gate_b, OFF_WGB)
  WF(float, b_gate_f, OFF_BGF) WF(float, b_gate_b, OFF_BGB) WF(float, g_gla, OFF_GGLA) WF(float, b_router, OFF_BROUTER)
  WF(bf16_t, win_t, OFF_WIN) WF(bf16_t, wout_t, OFF_WOUT) WF(bf16_t, wr_t, OFF_WR) WF(bf16_t, wei_t, OFF_WEI) WF(bf16_t, wed_t, OFF_WED)
  WF(bf16_t, h, OFF_H) WF(bf16_t, cat, OFF_CAT) WF(bf16_t, h2, OFF_H2) WF(bf16_t, px, OFF_PX) WF(bf16_t, act, OFF_ACT) WF(bf16_t, y, OFF_Y)
  WF(bf16_t, xres, OFF_XRES) WF(float, logits, OFF_LOGITS) WF(float, wts, OFF_WTS) WF(float, gkv, OFF_GKV) WF(float, gdec, OFF_GDEC)
  WF(float, gsin, OFF_GSIN) WF(int, lists, OFF_LISTS) WF(bf16_t, qh, OFF_QH) WF(bf16_t, kh, OFF_KH) WF(bf16_t, vt, OFF_VT) WF(bf16_t, vtg, OFF_VTG) WF(bf16_t, gqk, OFF_GQK) WF(bf16_t, wpt, OFF_WPT) WF(unsigned char, h2q, OFF_H2Q)
#undef WF
};

DI float bf2f(bf16_t v) { return __uint_as_float(((unsigned)v) << 16); }
DI bf16_t f2bf(float f) { unsigned u = __float_as_uint(f); u += 0x7fffu + ((u >> 16) & 1u); return (bf16_t)(u >> 16); }
typedef float f32x2v __attribute__((ext_vector_type(2)));
typedef __bf16 bf16x2v __attribute__((ext_vector_type(2)));
DI unsigned pack2(float lo, float hi) {
  const f32x2v v = {lo, hi};
  return __builtin_bit_cast(unsigned, __builtin_convertvector(v, bf16x2v));
}
DI int pack_fp8x4(float a, float b, float c, float d) {
  a = __builtin_amdgcn_fmed3f(a, -440.f, 440.f); b = __builtin_amdgcn_fmed3f(b, -440.f, 440.f);
  c = __builtin_amdgcn_fmed3f(c, -440.f, 440.f); d = __builtin_amdgcn_fmed3f(d, -440.f, 440.f);
  int w = __builtin_amdgcn_cvt_pk_fp8_f32(a, b, 0, false);
  return __builtin_amdgcn_cvt_pk_fp8_f32(c, d, w, true);
}
DI float4 unpack4(uint2 v) { return make_float4(__uint_as_float(v.x << 16), __uint_as_float(v.x & 0xffff0000u), __uint_as_float(v.y << 16), __uint_as_float(v.y & 0xffff0000u)); }
DI float wave_sum(float v) { for (int o = 32; o; o >>= 1) v += __shfl_xor(v, o); return v; }
DI float wave_max(float v) { for (int o = 32; o; o >>= 1) v = fmaxf(v, __shfl_xor(v, o)); return v; }
template <int CTRL> DI float dppf(float v) { return __int_as_float(__builtin_amdgcn_update_dpp(__float_as_int(v), __float_as_int(v), CTRL, 0xf, 0xf, false)); }
DI float rlanef(float v, int l) { return __int_as_float(__builtin_amdgcn_readlane(__float_as_int(v), l)); }
DI float wave_max_dpp(float v) {
  v = fmaxf(v, dppf<0xB1>(v));
  v = fmaxf(v, dppf<0x4E>(v));
  v = fmaxf(v, dppf<0x141>(v));
  v = fmaxf(v, dppf<0x140>(v));
  return fmaxf(fmaxf(rlanef(v, 0), rlanef(v, 16)), fmaxf(rlanef(v, 32), rlanef(v, 48)));
}
DI int otid() { int t = threadIdx.x; asm volatile("" : "+v"(t)); return t; }
DI float sigmoidf_(float x) { return 1.f / (1.f + __expf(-x)); }
DI float siluf_(float x) { return x / (1.f + __expf(-x)); }
DI int vbid_of(int bid, int nblk) { (void)nblk; return bid; }
DI int mod_row(int row) { return row < MC ? 8 : ((row - MC) >> 12); }

typedef __attribute__((address_space(1))) char gchar;
typedef __attribute__((address_space(1))) float gfloat;
DI W oq(const W& w) {
  unsigned long long v = (unsigned long long)w.ws;
  asm volatile("" : "+s"(v));
  W r; r.ws = (char*)(gchar*)v; r.out = w.out; r.x = w.x; r.ctx = w.ctx;
  return r;
}

struct NoHook { DI void operator()() const {} };
template <int WM, int WN, int MI, int NI, int BK, int NS, bool SWAP, int NCH, int FLAGS = 0, class FA, class FB, class EPI, class HK = NoHook>
DI void gemm_tile(char* lds, int nk, size_t bstride, size_t bks, FA rowA, FB rowB, EPI epi, const char* ares = nullptr, HK hook = HK()) {
  constexpr int BM = WM * MI * 16, BN = WN * NI * 16;
  constexpr int RB = BK * 2, CPR = RB / 16, RPP = 1024 / RB;
  constexpr bool ARES = (FLAGS & 1) != 0;
  constexpr int PA = ARES ? 0 : BM / RPP / 8, PB = BN / RPP / 8, NP = PA + PB, BOFF = ARES ? 0 : BM * RB, STG = BOFF + BN * RB, KS = BK / 32;
  static_assert(WM * WN == 8, "8 waves");
  static_assert(BK == 32 || BK == 64, "BK");
  const int tid = otid(), wid = tid >> 6, lane = tid & 63, fr = lane & 15, fq = lane >> 4;
  const int wr = wid / WN, wc = wid % WN;
  const int lrow = lane / CPR, pc = lane % CPR;
  const bf16_t* ap[PA > 0 ? PA : 1];
  const bf16_t* bp[PB];
#pragma unroll
  for (int i = 0; i < PA; ++i) {
    const int r = (wid + 8 * i) * RPP + lrow;
    const int sw = BK == 64 ? ((r >> 1) & 7) : ((-(r >> 2)) & 3);
    ap[i] = rowA(r) + ((pc ^ sw) * 8);
  }
#pragma unroll
  for (int i = 0; i < PB; ++i) {
    const int r = (wid + 8 * i) * RPP + lrow;
    const int sw = BK == 64 ? ((r >> 1) & 7) : ((-(r >> 2)) & 3);
    bp[i] = rowB(r) + ((pc ^ sw) * 8);
  }
  char* ldst = lds + wid * 1024 + lane * 16;
  f32x4 acc[MI][NI];
#pragma unroll
  for (int mi = 0; mi < MI; ++mi)
#pragma unroll
    for (int ni = 0; ni < NI; ++ni) acc[mi][ni] = (f32x4){0.f, 0.f, 0.f, 0.f};
  const int swf = BK == 64 ? (fr >> 1) : ((-(fr >> 2)) & 3);
  const int aoff = (wr * MI * 16 + fr) * RB + ((fq ^ swf) * 16);
  const int boff = BOFF + (wc * NI * 16 + fr) * RB + ((fq ^ swf) * 16);
#define GEMM_STAGE(s, t)                                                                                              \
  do {                                                                                                                \
    const int kt_ = NCH == 1 ? (t) : (t) % nk;                                                                        \
    const size_t bo_ = NCH == 1 ? (size_t)0 : (size_t)((t) / nk) * bstride;                                           \
    _Pragma("unroll") for (int i = 0; i < PA; ++i) __builtin_amdgcn_global_load_lds(                                  \
        (const unsigned*)(ap[i] + kt_ * BK), (unsigned*)(ldst + (s) * STG + i * 8192), 16, 0, 0);                     \
    _Pragma("unroll") for (int i = 0; i < PB; ++i) __builtin_amdgcn_global_load_lds(                                  \
        (const unsigned*)(bp[i] + bo_ + kt_ * bks), (unsigned*)(ldst + (s) * STG + BOFF + i * 8192), 16, 0, 0);      \
  } while (0)
  const int ntile = NCH * nk;
  if constexpr ((FLAGS & 64) == 0) {
#pragma unroll
    for (int s = 0; s < NS - 1; ++s)
      if (s < ntile) GEMM_STAGE(s, s);
  }
  int slot = 0, nslot = NS - 1;
  int kin = 0, chunk = 0;
#pragma nounroll
  for (int kt = 0; kt < ntile; ++kt) {
    if constexpr ((FLAGS & 32) != 0) {
      static_assert(NS == 2 && NCH > 1, "store-aware wait: 2-slot ring, chunked stream");
      if (kin == 0 && kt > 0) asm volatile("s_waitcnt vmcnt(8)" ::: "memory");
      else asm volatile("s_waitcnt vmcnt(0)" ::: "memory");
    } else {
      if (kt + NS - 2 < ntile) asm volatile("s_waitcnt vmcnt(%0)" ::"n"((NS - 2) * NP) : "memory");
      else asm volatile("s_waitcnt vmcnt(0)" ::: "memory");
    }
    __builtin_amdgcn_s_barrier();
    asm volatile("" ::: "memory");
    if (kt + NS - 1 < ntile) GEMM_STAGE(nslot, kt + NS - 1);
    if (kt == ntile - 1) hook();
    const char* sb = lds + slot * STG;
    const char* sa = ARES ? ares + (NCH == 1 ? kt : kin) * (BM * RB) : sb;
    slot = slot + 1 == NS ? 0 : slot + 1;
    nslot = nslot + 1 == NS ? 0 : nslot + 1;
    if constexpr ((FLAGS & 4) != 0) {
      static_assert(BK == 64 && NI % 4 == 0, "fp8 path: 128-byte rows, column tiles in groups of 4");
      typedef int i32x4v __attribute__((ext_vector_type(4)));
      typedef int i32x8v __attribute__((ext_vector_type(8)));
      constexpr int ASC = (FLAGS & 8) ? 0x7b7b7b7b : (FLAGS & 16) ? 0x7c7c7c7c : 0x7f7f7f7f;
      i32x4v a0[MI], a1[MI];
#pragma unroll
      for (int mi = 0; mi < MI; ++mi) {
        a0[mi] = *(const i32x4v*)(sa + (aoff + mi * 16 * RB));
        a1[mi] = *(const i32x4v*)(sa + ((aoff ^ 64) + mi * 16 * RB));
      }
      constexpr int GW = NI > 4 ? 2 : 4, NG8 = NI / GW;
      i32x4v b0[2][GW], b1[2][GW];
#pragma unroll
      for (int nj = 0; nj < GW; ++nj) {
        b0[0][nj] = *(const i32x4v*)(sb + (boff + nj * 16 * RB));
        b1[0][nj] = *(const i32x4v*)(sb + ((boff ^ 64) + nj * 16 * RB));
      }
      __builtin_amdgcn_sched_group_barrier(0x100, 2 * MI + 2 * GW, 0);
#pragma unroll
      for (int g = 0; g < NG8; ++g) {
        const int cur = g & 1, nxt = cur ^ 1;
        if (g + 1 < NG8) {
#pragma unroll
          for (int nj = 0; nj < GW; ++nj) {
            b0[nxt][nj] = *(const i32x4v*)(sb + (boff + ((g + 1) * GW + nj) * 16 * RB));
            b1[nxt][nj] = *(const i32x4v*)(sb + ((boff ^ 64) + ((g + 1) * GW + nj) * 16 * RB));
          }
          __builtin_amdgcn_sched_group_barrier(0x100, 2 * GW, 0);
        }
#pragma unroll
        for (int mi = 0; mi < MI; ++mi)
#pragma unroll
          for (int nj = 0; nj < GW; ++nj) {
            const i32x8v av = __builtin_shufflevector(a0[mi], a1[mi], 0, 1, 2, 3, 4, 5, 6, 7);
            const i32x8v bv = __builtin_shufflevector(b0[cur][nj], b1[cur][nj], 0, 1, 2, 3, 4, 5, 6, 7);
            acc[mi][g * GW + nj] = SWAP ? __builtin_amdgcn_mfma_scale_f32_16x16x128_f8f6f4(av, bv, acc[mi][g * GW + nj], 0, 0, 0, ASC, 0, 0x79797979)
                                        : __builtin_amdgcn_mfma_scale_f32_16x16x128_f8f6f4(bv, av, acc[mi][g * GW + nj], 0, 0, 0, 0x79797979, 0, ASC);
          }
        __builtin_amdgcn_sched_group_barrier(0x008, MI * GW, 0);
      }
    } else {
    constexpr int NG = NI / 4, NGT = KS * NG;
    bf16x8 af[KS][MI], bfr[2][4];
#pragma unroll
    for (int mi = 0; mi < MI; ++mi) af[0][mi] = *(const bf16x8*)(sa + (aoff + mi * 16 * RB));
#pragma unroll
    for (int nj = 0; nj < 4; ++nj) bfr[0][nj] = *(const bf16x8*)(sb + (boff + nj * 16 * RB));
    __builtin_amdgcn_sched_group_barrier(0x100, MI + 4, 0);
#pragma unroll
    for (int gi = 0; gi < NGT; ++gi) {
      const int ks = gi / NG, g = gi % NG, cur = gi & 1, nxt = cur ^ 1;
      if (gi + 1 < NGT) {
        const int ks2 = (gi + 1) / NG, g2 = (gi + 1) % NG;
#pragma unroll
        for (int nj = 0; nj < 4; ++nj) bfr[nxt][nj] = *(const bf16x8*)(sb + ((boff ^ (ks2 * 64)) + (g2 * 4 + nj) * 16 * RB));
        if (ks2 != ks) {
#pragma unroll
          for (int mi = 0; mi < MI; ++mi) af[ks2 % KS][mi] = *(const bf16x8*)(sa + ((aoff ^ (ks2 * 64)) + mi * 16 * RB));
          __builtin_amdgcn_sched_group_barrier(0x100, MI + 4, 0);
        } else {
          __builtin_amdgcn_sched_group_barrier(0x100, 4, 0);
        }
      }
#pragma unroll
      for (int mi = 0; mi < MI; ++mi)
#pragma unroll
        for (int nj = 0; nj < 4; ++nj)
          acc[mi][g * 4 + nj] = SWAP ? __builtin_amdgcn_mfma_f32_16x16x32_bf16(af[ks][mi], bfr[cur][nj], acc[mi][g * 4 + nj], 0, 0, 0)
                                     : __builtin_amdgcn_mfma_f32_16x16x32_bf16(bfr[cur][nj], af[ks][mi], acc[mi][g * 4 + nj], 0, 0, 0);
      __builtin_amdgcn_sched_group_barrier(0x008, MI * 4, 0);
    }
    }
    if (NCH > 1) {
      if (++kin == nk) {
        kin = 0;
        epi(acc, chunk, wr, wc, fr, fq);
        ++chunk;
#pragma unroll
        for (int mi = 0; mi < MI; ++mi)
#pragma unroll
          for (int ni = 0; ni < NI; ++ni) acc[mi][ni] = (f32x4){0.f, 0.f, 0.f, 0.f};
      }
    }
  }
#undef GEMM_STAGE
  if (FLAGS & 2) __syncthreads();
  if (NCH == 1) epi(acc, 0, wr, wc, fr, fq);
  __syncthreads();
}


template <int BN, int NPRE, class FB>
DI void gemm_prestage_b(char* lds, size_t bks, FB rowB) {
  const int tid = otid(), wid = tid >> 6, lane = tid & 63;
  const int lrow = lane >> 3, pc = lane & 7;
  char* ldst = lds + wid * 1024 + lane * 16;
#pragma unroll
  for (int s = 0; s < NPRE; ++s)
#pragma unroll
    for (int i = 0; i < BN / 64; ++i) {
      const int r = (wid + 8 * i) * 8 + lrow;
      const bf16_t* bp = rowB(r) + ((pc ^ ((r >> 1) & 7)) * 8);
      __builtin_amdgcn_global_load_lds((const unsigned*)(bp + s * bks), (unsigned*)(ldst + s * (BN * 128) + i * 8192), 16, 0, 0);
    }
}

template <int WM, int WN, int MI, int NI, bool SWAP, bool NOSTAGE = false, class FA, class FB, class EPI>
DI void gemm_tile_stag(char* lds, int nk, size_t bks, FA rowA, FB rowB, EPI epi) {
  constexpr int BK = 32, BM = WM * MI * 16, BN = WN * NI * 16;
  constexpr int RB = BK * 2, CPR = RB / 16, RPP = 1024 / RB;
  constexpr int PA = BM / RPP / 8, PB = BN / RPP / 8, NP = PA + PB, STG = (BM + BN) * RB;
  const int tid = otid(), wid = tid >> 6, lane = tid & 63, fr = lane & 15, fq = lane >> 4;
  const int wr = wid / WN, wc = wid % WN;
  const int lrow = lane / CPR, pc = lane % CPR;
  const bf16_t* ap[PA];
  const bf16_t* bp[PB];
#pragma unroll
  for (int i = 0; i < PA; ++i) { const int r = (wid + 8 * i) * RPP + lrow; ap[i] = rowA(r) + ((pc ^ ((-(r >> 2)) & 3)) * 8); }
#pragma unroll
  for (int i = 0; i < PB; ++i) { const int r = (wid + 8 * i) * RPP + lrow; bp[i] = rowB(r) + ((pc ^ ((-(r >> 2)) & 3)) * 8); }
  char* ldst = lds + wid * 1024 + lane * 16;
  f32x4 acc[MI][NI];
#pragma unroll
  for (int mi = 0; mi < MI; ++mi)
#pragma unroll
    for (int ni = 0; ni < NI; ++ni) acc[mi][ni] = (f32x4){0.f, 0.f, 0.f, 0.f};
  const int swf = (-(fr >> 2)) & 3;
  const int aoff = (wr * MI * 16 + fr) * RB + ((fq ^ swf) * 16);
  const int boff = BM * RB + (wc * NI * 16 + fr) * RB + ((fq ^ swf) * 16);
#define STAG_STAGE(s, t)                                                                                              \
  do {                                                                                                                \
    _Pragma("unroll") for (int i = 0; i < PA; ++i) __builtin_amdgcn_global_load_lds(                                  \
        (const unsigned*)(ap[i] + (t) * BK), (unsigned*)(ldst + (s) * STG + i * 8192), 16, 0, 0);                     \
    _Pragma("unroll") for (int i = 0; i < PB; ++i) __builtin_amdgcn_global_load_lds(                                  \
        (const unsigned*)(bp[i] + (t) * bks), (unsigned*)(ldst + (s) * STG + BM * RB + i * 8192), 16, 0, 0);          \
  } while (0)
  const int hb = __builtin_amdgcn_readfirstlane(wid >> 2);
  STAG_STAGE(0, 0);
  if (1 < nk) { STAG_STAGE(1, 1); asm volatile("s_waitcnt vmcnt(%0)" ::"n"(NP) : "memory"); }
  else asm volatile("s_waitcnt vmcnt(0)" ::: "memory");
  __builtin_amdgcn_s_barrier();
  asm volatile("" ::: "memory");
  if (hb) { __builtin_amdgcn_s_barrier(); asm volatile("" ::: "memory"); }
  for (int kt = 0; kt < nk; ++kt) {
    const char* sb = lds + (kt & 3) * STG;
    bf16x8 af[MI], bfr[NI];
#pragma unroll
    for (int mi = 0; mi < MI; ++mi) af[mi] = *(const bf16x8*)(sb + (aoff + mi * 16 * RB));
#pragma unroll
    for (int ni = 0; ni < NI; ++ni) bfr[ni] = *(const bf16x8*)(sb + (boff + ni * 16 * RB));
    if (!NOSTAGE && kt + 2 < nk) STAG_STAGE((kt + 2) & 3, kt + 2);
    if (hb) {
      if (kt + 2 < nk) asm volatile("s_waitcnt vmcnt(%0)" ::"n"(NP) : "memory");
      else asm volatile("s_waitcnt vmcnt(0)" ::: "memory");
    }
    __builtin_amdgcn_s_barrier();
    asm volatile("" ::: "memory");
    __builtin_amdgcn_s_setprio(1);
#pragma unroll
    for (int mi = 0; mi < MI; ++mi)
#pragma unroll
      for (int ni = 0; ni < NI; ++ni)
        acc[mi][ni] = SWAP ? __builtin_amdgcn_mfma_f32_16x16x32_bf16(af[mi], bfr[ni], acc[mi][ni], 0, 0, 0)
                           : __builtin_amdgcn_mfma_f32_16x16x32_bf16(bfr[ni], af[mi], acc[mi][ni], 0, 0, 0);
    __builtin_amdgcn_s_setprio(0);
    if (!hb) {
      if (kt + 2 < nk) asm volatile("s_waitcnt vmcnt(%0)" ::"n"(NP) : "memory");
      else asm volatile("s_waitcnt vmcnt(0)" ::: "memory");
    }
    __builtin_amdgcn_s_barrier();
    asm volatile("" ::: "memory");
  }
  if (!hb) { __builtin_amdgcn_s_barrier(); asm volatile("" ::: "memory"); }
#undef STAG_STAGE
  epi(acc, 0, wr, wc, fr, fq);
  __syncthreads();
}

struct ConvT { const float* src; bf16_t* dst; int ldn, N, K, k0, n0, bkl, npad, f8; };
DI ConvT conv_desc(const P& q, int tile) {
  constexpr int nA = 2 * 257 * 128, nB = 2 * 257 * 64, nC = 2 * 16 * 44, nD = 2 * 16 * 16;
  const W w{q.ws, q.out};
  ConvT c;
  c.f8 = 0;
  int t = tile;
  if (t < nA) {
    const int m = t / 128, r = t % 128, l = m / 257, e = m % 257;
    c.src = e < 256 ? q.w_e_in + (size_t)(l * 256 + e) * 1024 * 512 : q.w_sh_in + (size_t)l * 1024 * 512;
    c.dst = (bf16_t*)((char*)w.wei_t() + (size_t)m * 512 * 1024); c.ldn = 512; c.N = 512; c.K = 1024; c.bkl = 128; c.npad = 512; c.k0 = (r / 8) * 64; c.n0 = (r % 8) * 64; c.f8 = 1;
    return c;
  }
  t -= nA;
  if (t < nB) {
    const int m = t / 64, r = t % 64, l = m / 257, e = m % 257;
    c.src = e < 256 ? q.w_e_down + (size_t)(l * 256 + e) * 256 * 1024 : q.w_sh_down + (size_t)l * 256 * 1024;
    c.dst = (bf16_t*)((char*)w.wed_t() + (size_t)m * 1024 * 256); c.ldn = 1024; c.N = 1024; c.K = 256; c.bkl = 128; c.npad = 1024; c.k0 = (r / 16) * 64; c.n0 = (r % 16) * 64; c.f8 = 1;
    return c;
  }
  t -= nB;
  if (t < nC) {
    const int l = t / 704, r = t % 704;
    c.src = q.w_in + (size_t)l * 1024 * INW; c.dst = (bf16_t*)((char*)w.win_t() + (size_t)l * INWP * 1024); c.ldn = INW; c.N = INW; c.K = 1024; c.bkl = 128; c.npad = INWP; c.f8 = 1;
    c.k0 = (r / 44) * 64; c.n0 = (r % 44) * 64;
    return c;
  }
  t -= nC;
  if (t < nD) {
    const int l = t / 256, r = t % 256;
    c.src = q.w_out + (size_t)l * 1024 * 1024; c.dst = (bf16_t*)((char*)w.wout_t() + (size_t)l * 1024 * 1024); c.ldn = 1024; c.N = 1024; c.K = 1024; c.bkl = 128; c.npad = 1024; c.f8 = 1;
    c.k0 = (r / 16) * 64; c.n0 = (r % 16) * 64;
    return c;
  }
  t -= nD;
  {
    const int l = t / 64, r = t % 64;
    c.src = q.w_router + (size_t)l * 1024 * 256; c.dst = w.wr_t() + (size_t)l * 256 * 1024; c.ldn = 256; c.N = 256; c.K = 1024; c.bkl = 32; c.npad = 256;
    c.k0 = (r / 4) * 64; c.n0 = (r % 4) * 64;
  }
  return c;
}

DI void conv_store(const ConvT& c, uint4 v, int rn, int rks) {
  const int kk = c.k0 + rks * 2;
  if (c.f8) {
    const float4 lo = unpack4(make_uint2(v.x, v.y)), hi = unpack4(make_uint2(v.z, v.w));
    const int w0 = pack_fp8x4(lo.x * 64.f, lo.y * 64.f, lo.z * 64.f, lo.w * 64.f);
    const int w1 = pack_fp8x4(hi.x * 64.f, hi.y * 64.f, hi.z * 64.f, hi.w * 64.f);
    char* d8 = (char*)c.dst + (size_t)(kk / c.bkl) * c.npad * c.bkl + (size_t)(c.n0 + rn) * c.bkl + (kk % c.bkl);
    *(uint2*)d8 = make_uint2((unsigned)w0, (unsigned)w1);
  } else {
    *(uint4*)(c.dst + (size_t)(kk / c.bkl) * c.npad * c.bkl + (size_t)(c.n0 + rn) * c.bkl + (kk % c.bkl)) = v;
  }
}

DI void conv_fetch(const P& q, int tile, int nblk, int total, int kp, int ns, float4& a0, float4& b0, float4& a1, float4& b1) {
  const ConvT c0 = conv_desc(q, min(tile, total - 1));
  const ConvT c1 = conv_desc(q, min(tile + nblk, total - 1));
  const int col0 = min(c0.n0 + ns, c0.N - 4), col1 = min(c1.n0 + ns, c1.N - 4);
  a0 = *(const float4*)(c0.src + (size_t)(c0.k0 + 2 * kp) * c0.ldn + col0);
  b0 = *(const float4*)(c0.src + (size_t)(c0.k0 + 2 * kp + 1) * c0.ldn + col0);
  a1 = *(const float4*)(c1.src + (size_t)(c1.k0 + 2 * kp) * c1.ldn + col1);
  b1 = *(const float4*)(c1.src + (size_t)(c1.k0 + 2 * kp + 1) * c1.ldn + col1);
}

DI void phase_convert(const P& q, char* lds, int bid, int nblk) {
  constexpr int total = 2 * 257 * 128 + 2 * 257 * 64 + 2 * 16 * 44 + 2 * 16 * 16 + 2 * 16 * 4;
  const int t = otid();
  const int kp = t >> 4, ns = (t & 15) * 4, rn = t >> 3, rks = (t & 7) * 4;
  int par = 0;
  auto process = [&](int tile, const float4& a0, const float4& b0, const float4& a1, const float4& b1) {
    const bool two = tile + nblk < total;
    const ConvT c0 = conv_desc(q, tile);
    const ConvT c1 = conv_desc(q, two ? tile + nblk : tile);
    unsigned* T0 = (unsigned*)lds + par * (2 * 64 * 33);
    unsigned* T1 = T0 + 64 * 33;
    par ^= 1;
    const unsigned k0m = c0.n0 + ns < c0.N ? 0xffffffffu : 0u, k1m = c1.n0 + ns < c1.N ? 0xffffffffu : 0u;
    T0[(ns + 0) * 33 + kp] = pack2(a0.x, b0.x) & k0m; T0[(ns + 1) * 33 + kp] = pack2(a0.y, b0.y) & k0m;
    T0[(ns + 2) * 33 + kp] = pack2(a0.z, b0.z) & k0m; T0[(ns + 3) * 33 + kp] = pack2(a0.w, b0.w) & k0m;
    T1[(ns + 0) * 33 + kp] = pack2(a1.x, b1.x) & k1m; T1[(ns + 1) * 33 + kp] = pack2(a1.y, b1.y) & k1m;
    T1[(ns + 2) * 33 + kp] = pack2(a1.z, b1.z) & k1m; T1[(ns + 3) * 33 + kp] = pack2(a1.w, b1.w) & k1m;
    __syncthreads();
    uint4 v;
    v.x = T0[rn * 33 + rks]; v.y = T0[rn * 33 + rks + 1]; v.z = T0[rn * 33 + rks + 2]; v.w = T0[rn * 33 + rks + 3];
    conv_store(c0, v, rn, rks);
    if (two) {
      v.x = T1[rn * 33 + rks]; v.y = T1[rn * 33 + rks + 1]; v.z = T1[rn * 33 + rks + 2]; v.w = T1[rn * 33 + rks + 3];
      conv_store(c1, v, rn, rks);
    }
  };
  float4 a0, b0, a1, b1, na0, nb0, na1, nb1, ma0, mb0, ma1, mb1;
  const int step = 2 * nblk;
  conv_fetch(q, bid, nblk, total, kp, ns, a0, b0, a1, b1);
  conv_fetch(q, bid + step, nblk, total, kp, ns, na0, nb0, na1, nb1);
  for (int tile = bid; tile < total; tile += 3 * step) {
    conv_fetch(q, tile + 2 * step, nblk, total, kp, ns, ma0, mb0, ma1, mb1);
    process(tile, a0, b0, a1, b1);
    if (tile + step >= total) break;
    conv_fetch(q, tile + 3 * step, nblk, total, kp, ns, a0, b0, a1, b1);
    process(tile + step, na0, nb0, na1, nb1);
    if (tile + 2 * step >= total) break;
    conv_fetch(q, tile + 4 * step, nblk, total, kp, ns, na0, nb0, na1, nb1);
    process(tile + 2 * step, ma0, mb0, ma1, mb1);
  }
  __syncthreads();
}

DI void phase_mod(const P& q, char* lds, int bid, int nblk) {
  float* sc = (float*)lds;
  float* red = sc + 9 * 1024;
  const int t = otid();
  for (int i = t; i < 9 * 1024; i += NTHR) {
    const int r = i >> 10, k = i & 1023;
    const float v = r < 8 ? q.c[r * 1024 + k] : q.c_ctx[k];
    sc[i] = siluf_(v);
  }
  __syncthreads();
  for (int u = bid; u < 2 * 96; u += nblk) {
    const int l = u / 96, n0 = (u % 96) * 64;
    const int col = t & 63, ksl = t >> 6;
    float a[9];
#pragma unroll
    for (int r = 0; r < 9; ++r) a[r] = 0.f;
    const float* w = q.w_mod + (size_t)l * 1024 * 6144 + n0 + col;
    for (int k = ksl * 128; k < ksl * 128 + 128; ++k) {
      const float wv = w[(size_t)k * 6144];
#pragma unroll
      for (int r = 0; r < 9; ++r) a[r] += sc[r * 1024 + k] * wv;
    }
#pragma unroll
    for (int r = 0; r < 9; ++r) red[(ksl * 9 + r) * 64 + col] = a[r];
    __syncthreads();
    for (int i = t; i < 9 * 64; i += NTHR) {
      const int r = i >> 6, cc = i & 63;
      float s = q.b_mod[l * 6144 + n0 + cc];
#pragma unroll
      for (int q = 0; q < 8; ++q) s += red[(q * 9 + r) * 64 + cc];
      ((W{q.ws, q.out, q.x, q.ctx}).mod())[(size_t)(l * 9 + r) * 6144 + n0 + cc] = s;
    }
    __syncthreads();
  }
  {
    const W w{q.ws, q.out};
    const int gt = bid * NTHR + t, gs = nblk * NTHR;
#define CPY(dst, srcp, n) for (int i = gt; i < (n); i += gs) (dst)[i] = (srcp)[i]
    CPY(w.g_mix(), q.g_mix, 2 * 1024); CPY(w.g_ffn(), q.g_ffn, 2 * 1024); CPY(w.g_final(), q.g_final, 1024);
    CPY(w.rpb(), q.rpb, 2 * 3720); CPY(w.w_pool(), q.w_pool, 2 * 4 * 4096); CPY(w.pool_scale(), q.pool_scale, 2 * 256);
    CPY(w.w_gate_f(), q.w_gate_f, 2 * 16 * 128); CPY(w.w_gate_b(), q.w_gate_b, 2 * 16 * 128);
    CPY(w.b_gate_f(), q.b_gate_f, 2 * 128); CPY(w.b_gate_b(), q.b_gate_b, 2 * 128);
    CPY(w.g_gla(), q.g_gla, 2 * 64); CPY(w.b_router(), q.b_router, 2 * 256);
#undef CPY
    for (int i = gt; i < 2 * 4 * 4096; i += gs) { const int lg = i >> 12, jj = (i >> 6) & 63, ii = i & 63; w.wpt()[i] = f2bf(q.w_pool[lg * 4096 + ii * 64 + jj]); }
  }
  if (bid == 0) {
    for (int i = t; i < 64 * 8; i += NTHR) {
      const int pos = i >> 3, j = i & 7;
      const float inv = powf(10000.f, -(float)j / 8.f);
      const float ang = (float)pos * inv;
      ((W{q.ws, q.out, q.x, q.ctx}).rope())[i * 2] = cosf(ang);
      ((W{q.ws, q.out, q.x, q.ctx}).rope())[i * 2 + 1] = sinf(ang);
    }
  }
}

DI void phase_norm0(const P& q, int bid, int nblk) {
  const W p{q.ws, q.out};
  const int wid = otid() >> 6, lane = otid() & 63;
  for (int row = bid * 8 + wid; row < MT; row += nblk * 8) {
    const float* src = row < MC ? q.ctx + (size_t)row * D : q.x + (size_t)(row - MC) * D;
    const float* m = p.mod() + (size_t)(mod_row(row)) * 6144;
    float4 v[4];
    float ss = 0.f;
#pragma unroll
    for (int i = 0; i < 4; ++i) {
      v[i] = *(const float4*)(src + i * 256 + lane * 4);
      ss += v[i].x * v[i].x + v[i].y * v[i].y + v[i].z * v[i].z + v[i].w * v[i].w;
    }
    ss = wave_sum(ss);
    const float rstd = rsqrtf(ss * (1.f / D) + EPS);
#pragma unroll
    for (int i = 0; i < 4; ++i) {
      const int cidx = i * 256 + lane * 4;
      const float4 gg = *(const float4*)(q.g_mix + cidx);
      const float4 sh = *(const float4*)(m + cidx);
      const float4 scl = *(const float4*)(m + 1024 + cidx);
      const float o0 = v[i].x * rstd * gg.x * (1.f + scl.x) + sh.x;
      const float o1 = v[i].y * rstd * gg.y * (1.f + scl.y) + sh.y;
      const float o2 = v[i].z * rstd * gg.z * (1.f + scl.z) + sh.z;
      const float o3 = v[i].w * rstd * gg.w * (1.f + scl.w) + sh.w;
      const int q8 = pack_fp8x4(o0, o1, o2, o3);
      *(int*)((char*)p.h() + (size_t)row * D + cidx) = q8;
    }
  }
}

DI void phase_norm(const W& p_, int layer, int row_lo, int bid, int nblk) {
  const W p = oq(p_);
  const int wid = otid() >> 6, lane = otid() & 63;
  const float* g = p.g_ffn() + layer * D;
  for (int row = row_lo + bid * 8 + wid; row < MT; row += nblk * 8) {
    const bf16_t* src = p.xres() + (size_t)row * D;
    const float* m = p.mod() + (size_t)(layer * 9 + mod_row(row)) * 6144 + 3072;
    float4 v[4];
    float ss = 0.f;
#pragma unroll
    for (int i = 0; i < 4; ++i) {
      v[i] = unpack4(*(const uint2*)(src + i * 256 + lane * 4));
      ss += v[i].x * v[i].x + v[i].y * v[i].y + v[i].z * v[i].z + v[i].w * v[i].w;
    }
    ss = wave_sum(ss);
    const float rstd = rsqrtf(ss * (1.f / D) + EPS);
#pragma unroll
    for (int i = 0; i < 4; ++i) {
      const int cidx = i * 256 + lane * 4;
      const float4 gg = *(const float4*)(g + cidx);
      const float4 sh = *(const float4*)(m + cidx);
      const float4 scl = *(const float4*)(m + 1024 + cidx);
      const float o0 = v[i].x * rstd * gg.x * (1.f + scl.x) + sh.x;
      const float o1 = v[i].y * rstd * gg.y * (1.f + scl.y) + sh.y;
      const float o2 = v[i].z * rstd * gg.z * (1.f + scl.z) + sh.z;
      const float o3 = v[i].w * rstd * gg.w * (1.f + scl.w) + sh.w;
      uint2 o; o.x = pack2(o0, o1); o.y = pack2(o2, o3);
      *(uint2*)(p.h2() + (size_t)row * D + cidx) = o;
      {
        const int q8 = pack_fp8x4(o0, o1, o2, o3);
        *(int*)(p.h2q() + (size_t)row * D + cidx) = q8;
      }
    }
  }
}

DI size_t hm_off(int row, int h) {
  if (row < MC) return ((size_t)(((row >> 8) * 8 + h) * NCTX + (row & 255))) * 64;
  const int r = row - MC;
  return HM_LAT + ((size_t)(((r >> 12) * 8 + h) * SEQ + (r & 4095))) * 64;
}
DI size_t vt_off(int row, int h, int d) {
  if (row < MC) { const int t = row & 255; return ((size_t)(((row >> 8) * 8 + h) * 4 + (t >> 6))) * 4096 + d * 64 + (t & 63); }
  const int r = row - MC, t = r & 4095;
  return HM_LAT + ((size_t)(((r >> 12) * 8 + h) * 64 + (t >> 6))) * 4096 + d * 64 + (t & 63);
}
DI size_t vtg_off(int row, int h, int v) {
  if (row < MC) { const int t = row & 255; return ((size_t)(((row >> 8) * 4 + h) * 4 + (t >> 6))) * 4096 + v * 64 + (t & 63); }
  const int r = row - MC, t = r & 4095;
  return HMG_LAT + ((size_t)(((r >> 12) * 4 + h) * 64 + (t >> 6))) * 4096 + v * 64 + (t & 63);
}

DI void phase_inproj(const W& p_, int layer, char* lds, int bid, int nblk) {
  const W p = oq(p_);
  constexpr int nM = MT / 256, nN = INWP / 256;
  const char* B8 = (const char*)p.win_t() + (size_t)layer * INWP * 1024;
  for (int u = vbid_of(bid, nblk); u < nM * nN; u += nblk) {
    const int pm = u / nN, pn = u % nN, m0 = pm * 256, n0 = pn * 256;
    auto rowA = [&](int r) { return (const bf16_t*)((const char*)p.h() + (size_t)(m0 + r) * D); };
    auto rowB = [&](int r) { return (const bf16_t*)(B8 + (size_t)(n0 + r) * 128); };
    if (pn == 4 || pn == 5 || pn == 8) {
      auto rowAp = [&](int r) { return rowA((r & ~63) | ((r & 12) << 2) | ((r & 48) >> 2) | (r & 3)); };
      auto epi = [&](const f32x4 (&acc)[4][8], int, int wr, int wc, int fr, int fq) {
        const int row = m0 + wr * 64 + fq * 16;
#pragma unroll
        for (int ni = 0; ni < 8; ++ni) {
          uint4 lo, hi;
          lo.x = pack2(acc[0][ni][0], acc[0][ni][1]); lo.y = pack2(acc[0][ni][2], acc[0][ni][3]);
          lo.z = pack2(acc[1][ni][0], acc[1][ni][1]); lo.w = pack2(acc[1][ni][2], acc[1][ni][3]);
          hi.x = pack2(acc[2][ni][0], acc[2][ni][1]); hi.y = pack2(acc[2][ni][2], acc[2][ni][3]);
          hi.z = pack2(acc[3][ni][0], acc[3][ni][1]); hi.w = pack2(acc[3][ni][2], acc[3][ni][3]);
          bf16_t* dst;
          if (pn == 8) {
            const int col = wc * 128 + ni * 16 + fr;
            dst = p.vtg() + vtg_off(row, col >> 6, col & 63);
          } else {
            const int col = n0 + wc * 128 + ni * 16 + fr - 1024;
            dst = p.vt() + vt_off(row, col >> 6, col & 63);
          }
          *(uint4*)dst = lo; *(uint4*)(dst + 8) = hi;
        }
      };
      gemm_tile<4, 2, 4, 8, 64, 2, true, 1, 4>(lds, 8, 0, (size_t)INWP * 64, rowAp, rowB, epi);
    } else {
      auto rowBp = [&](int r) { return rowB((r & ~127) | ((r & 12) << 3) | ((r & 112) >> 2) | (r & 3)); };
      auto epi = [&](const f32x4 (&acc)[4][8], int, int wr, int wc, int fr, int fq) {
#pragma unroll
        for (int mi = 0; mi < 4; ++mi) {
          const int row = m0 + wr * 64 + mi * 16 + fr;
#pragma unroll
          for (int np = 0; np < 4; ++np) {
            const int col = n0 + wc * 128 + fq * 32 + np * 8;
            const f32x4 v0 = acc[mi][2 * np], v1 = acc[mi][2 * np + 1];
            if (pn < 2) {
              constexpr float QS = 0.125f * 1.4426950408889634f;
              uint4 o; o.x = pack2(v0[0] * QS, v0[1] * QS); o.y = pack2(v0[2] * QS, v0[3] * QS); o.z = pack2(v1[0] * QS, v1[1] * QS); o.w = pack2(v1[2] * QS, v1[3] * QS);
              *(uint4*)(p.qh() + hm_off(row, col >> 6) + (col & 63)) = o;
            } else if (pn < 4) {
              const int c2 = col - 512;
              uint4 o; o.x = pack2(v0[0], v0[1]); o.y = pack2(v0[2], v0[3]); o.z = pack2(v1[0], v1[1]); o.w = pack2(v1[2], v1[3]);
              *(uint4*)(p.kh() + hm_off(row, c2 >> 6) + (c2 & 63)) = o;
            } else if (col < INW) {
              uint4 o; o.x = pack2(v0[0], v0[1]); o.y = pack2(v0[2], v0[3]); o.z = pack2(v1[0], v1[1]); o.w = pack2(v1[2], v1[3]);
              *(uint4*)(p.px() + (size_t)row * INW + col) = o;
            }
          }
        }
      };
      gemm_tile<4, 2, 4, 8, 64, 2, false, 1, 4>(lds, 8, 0, (size_t)INWP * 64, rowA, rowBp, epi);
    }
  }
}


#ifndef PROBE_GEMM
#define PROBE_GEMM 0
#endif
#if PROBE_GEMM
DI void phase_probe_gemm(const W& p_, char* lds, int bid, int nblk) {
  const W p = oq(p_);
  constexpr int nM = MT / 256, nN = INWP / 256;
  const bf16_t* Bt = p.win_t();
  for (int u = bid; u < nM * nN; u += nblk) {
    const int pm = u / nN, pn = u % nN, m0 = pm * 256, n0 = pn * 256;
    auto rowA = [&](int r) { return p.h() + (size_t)(m0 + r) * D; };
    auto rowB = [&](int r) { return Bt + (size_t)(n0 + r) * 32; };
    auto epi = [&](const f32x4 (&acc)[4][8], int, int wr, int wc, int fr, int fq) {
#pragma unroll
      for (int mi = 0; mi < 4; ++mi) {
        const int row = m0 + wr * 64 + mi * 16 + fr;
#pragma unroll
        for (int ni = 0; ni < 8; ++ni) {
          const int col = n0 + wc * 128 + ni * 16 + 4 * fq;
          uint2 o; o.x = pack2(acc[mi][ni][0], acc[mi][ni][1]); o.y = pack2(acc[mi][ni][2], acc[mi][ni][3]);
          *(uint2*)(p.y() + (size_t)row * INWP + col) = o;
        }
      }
    };
#if PROBE_GEMM == 4
    gemm_tile_stag<4, 2, 4, 8, false, true>(lds, 32, (size_t)INWP * 32, rowA, rowB, epi);
#elif PROBE_GEMM == 5
    gemm_tile_stag<4, 2, 4, 8, false, false>(lds, 32, (size_t)INWP * 32, rowA, rowB, epi);
#else
    gemm_tile<4, 2, 4, 8, 32, 4, false, 1>(lds, 32, 0, (size_t)INWP * 32, rowA, rowB, epi);
#endif
  }
}
#endif

template <bool DUMMY>
DI void phase_outproj_t(const W& p_, int layer, char* lds, int row_lo, int bid, int nblk) {
  const W p = oq(p_);
  bf16_t* xres_w = DUMMY ? (bf16_t*)((char*)p.y() + (size_t)9 * MT * 1024) : p.xres();
  const int nM = (MT - row_lo) / 256, nN = 4;
  const char* B8 = (const char*)p.wout_t() + (size_t)layer * 1024 * 1024;
  for (int u = vbid_of(bid, nblk); u < nM * nN; u += nblk) {
    const int pm = u / nN, pn = u % nN, m0 = row_lo + pm * 256, n0 = pn * 256;
    auto rowA = [&](int r) { return (const bf16_t*)((const char*)p.cat() + (size_t)(m0 + r) * D); };
    auto rowB = [&](int r) { return (const bf16_t*)(B8 + (size_t)(n0 + r) * 128); };
    auto rowBp = [&](int r) { return rowB((r & ~127) | ((r & 12) << 3) | ((r & 112) >> 2) | (r & 3)); };
    auto epi = [&](const f32x4 (&acc)[4][8], int, int wr, int wc, int fr, int fq) {
#pragma unroll
      for (int mi = 0; mi < 4; ++mi) {
        const int row = m0 + wr * 64 + mi * 16 + fr;
        const float* xin = row < MC ? p.ctx + (size_t)row * D : p.x + (size_t)(row - MC) * D;
        const float* gate = p.mod() + (size_t)(layer * 9 + mod_row(row)) * 6144 + 2048;
#pragma unroll
        for (int np = 0; np < 4; ++np) {
          const int col = n0 + wc * 128 + fq * 32 + np * 8;
          const f32x4 v0 = acc[mi][2 * np], v1 = acc[mi][2 * np + 1];
          float4 xa, xb;
          if (layer == 0) {
            xa = *(const float4*)(xin + col); xb = *(const float4*)(xin + col + 4);
          } else {
            const uint4 xr = *(const uint4*)(p.xres() + (size_t)row * D + col);
            xa = unpack4(make_uint2(xr.x, xr.y)); xb = unpack4(make_uint2(xr.z, xr.w));
          }
          const float4 ga = *(const float4*)(gate + col), gb = *(const float4*)(gate + col + 4);
          uint4 o;
          o.x = pack2(xa.x + ga.x * v0[0], xa.y + ga.y * v0[1]); o.y = pack2(xa.z + ga.z * v0[2], xa.w + ga.w * v0[3]);
          o.z = pack2(xb.x + gb.x * v1[0], xb.y + gb.y * v1[1]); o.w = pack2(xb.z + gb.z * v1[2], xb.w + gb.w * v1[3]);
          *(uint4*)(xres_w + (size_t)row * D + col) = o;
        }
      }
    };
    gemm_tile<4, 2, 4, 8, 64, 2, false, 1, 4 | 16>(lds, 8, 0, (size_t)1024 * 64, rowA, rowBp, epi);
  }
}
DI void phase_outproj(const W& p, int layer, char* lds, int row_lo, int bid, int nblk) { phase_outproj_t<false>(p, layer, lds, row_lo, bid, nblk); }

DI void moe_unit(const W& p, int layer, char* lds, int e, const int* s_rows);
DI int moe_early_shared(int mrows, int nblk);
DI void phase_router(const W& p_, int layer, char* lds, int row_lo, int bid, int nblk) {
  const W p = oq(p_);
  const int nM = (MT - row_lo) / 256;
  const bf16_t* Bt = p.wr_t() + (size_t)layer * 256 * 1024;
  const int sh0 = moe_early_shared(MT - row_lo, nblk);
  for (int u = vbid_of(bid, nblk); u < nM + sh0; u += nblk) {
    if (u >= nM) {
      int* s_rows = (int*)(lds + 144 * 1024) + 1024;
      __syncthreads();
      if (otid() < 256) s_rows[otid()] = 8 * MT + row_lo + (u - nM) * 256 + otid();
      __syncthreads();
      moe_unit(p, layer, lds, NE, s_rows);
      continue;
    }
    const int m0 = row_lo + u * 256;
    auto rowA = [&](int r) { return p.h2() + (size_t)(m0 + r) * D; };
    auto rowB = [&](int r) { return Bt + (size_t)r * 32; };
    auto epi = [&](const f32x4 (&acc)[4][8], int, int wr, int wc, int fr, int fq) {
#pragma unroll
      for (int mi = 0; mi < 4; ++mi) {
        const int row = m0 + wr * 64 + mi * 16 + fr;
#pragma unroll
        for (int ni = 0; ni < 8; ++ni) {
          const int col = wc * 128 + ni * 16 + 4 * fq;
          *(f32x4*)(p.logits() + (size_t)row * 256 + col) = acc[mi][ni];
        }
      }
    };
    gemm_tile_stag<4, 2, 4, 8, false>(lds, 32, (size_t)256 * 32, rowA, rowB, epi);
  }
}

DI void phase_route(const W& p_, int layer, char* lds, int row_lo, int bid, int nblk) {
  const W p = oq(p_);
  int* lcnt = (int*)lds;
  int* lbase = lcnt + 256;
  int* ent = lbase + 256;
  const int tid = otid(), wid = tid >> 6, lane = tid & 63;
  const int nrows = MT - row_lo;
  const int CHT = (nrows % nblk == 0 && nrows / nblk <= 160) ? nrows / nblk : 128;
  const int nch = nrows / CHT;
  const float NEG = -__builtin_inff();
  for (int ch = bid; ch < nch; ch += nblk) {
    if (tid < 256) lcnt[tid] = 0;
    __syncthreads();
    for (int i = wid; i < CHT; i += 8) {
      const int row = row_lo + ch * CHT + i;
      const float4 lg = *(const float4*)(p.logits() + (size_t)row * 256 + lane * 4);
      const float4 br = *(const float4*)(p.b_router() + layer * 256 + lane * 4);
      float sc[4] = {sigmoidf_(lg.x), sigmoidf_(lg.y), sigmoidf_(lg.z), sigmoidf_(lg.w)};
      float v[4] = {sc[0] + br.x, sc[1] + br.y, sc[2] + br.z, sc[3] + br.w};
      float m1 = NEG, m2 = NEG;
#pragma unroll
      for (int j = 0; j < 4; ++j) { if (v[j] > m1) { m2 = m1; m1 = v[j]; } else if (v[j] > m2) m2 = v[j]; }
      {
        float o1 = dppf<0xB1>(m1), o2 = dppf<0xB1>(m2);
        float n1 = fmaxf(m1, o1), n2 = fmaxf(fminf(m1, o1), fmaxf(m2, o2));
        m1 = n1; m2 = n2;
        o1 = dppf<0x4E>(m1); o2 = dppf<0x4E>(m2);
        n1 = fmaxf(m1, o1); n2 = fmaxf(fminf(m1, o1), fmaxf(m2, o2));
        m1 = n1; m2 = n2;
        o1 = dppf<0x141>(m1); o2 = dppf<0x141>(m2);
        n1 = fmaxf(m1, o1); n2 = fmaxf(fminf(m1, o1), fmaxf(m2, o2));
        m1 = n1; m2 = n2;
      }
      const float gs = m1 + m2;
      const int g = lane >> 3;
      int rank = 0;
#pragma unroll
      for (int gg = 0; gg < 8; ++gg) { const float og = rlanef(gs, gg * 8); rank += (og > gs || (og == gs && gg < g)) ? 1 : 0; }
      if (rank >= 4) { v[0] = NEG; v[1] = NEG; v[2] = NEG; v[3] = NEG; }
      float ssum = 0.f, my_s = 0.f; int my_e = 0;
#pragma unroll
      for (int k = 0; k < 8; ++k) {
        float bv = v[0]; int bj = 0;
#pragma unroll
        for (int j = 1; j < 4; ++j) if (v[j] > bv) { bv = v[j]; bj = j; }
        const float wm = wave_max_dpp(bv);
        const unsigned long long bal = __ballot(bv == wm);
        const int win = __builtin_amdgcn_readfirstlane(__ffsll((long long)bal) - 1);
        const float mysc = bj == 0 ? sc[0] : bj == 1 ? sc[1] : bj == 2 ? sc[2] : sc[3];
        const int ej = __builtin_amdgcn_readlane(bj, win);
        const float su = rlanef(mysc, win);
        if (lane == win) {
#pragma unroll
          for (int j = 0; j < 4; ++j) if (j == bj) v[j] = NEG;
        }
        ssum += su;
        if (lane == k) { my_e = win * 4 + ej; my_s = su; }
      }
      if (lane < 8) {
        const int lpos = atomicAdd(&lcnt[my_e], 1);
        ent[i * 8 + lane] = my_e | (lpos << 8);
        p.wts()[(size_t)row * 8 + lane] = my_s / ssum * 2.5f;
      }
    }
    __syncthreads();
    if (tid < 256) { const int cc = lcnt[tid]; lbase[tid] = cc ? atomicAdd(&p.cnt()[layer * 256 + tid], cc) : 0; }
    __syncthreads();
    for (int j = tid; j < CHT * 8; j += NTHR) {
      const int e = ent[j] & 255, lpos = ent[j] >> 8;
      const int row = row_lo + ch * CHT + (j >> 3);
      p.lists()[(size_t)e * CAP + lbase[e] + lpos] = row * 8 + (j & 7);
    }
    __syncthreads();
  }
}

DI void moe_prefix(const W& p, int layer, int mrows, int* s_pref) {
  int* s_tmp = s_pref + 400;
  const int t = otid();
  __syncthreads();
  if (t < 272) {
    int c = 0;
    if (t < NE) c = (p.cnt()[layer * 256 + t] + 255) >> 8;
    else if (t == NE) c = (mrows + 255) >> 8;
    s_tmp[t] = c;
  }
  __syncthreads();
  int cur = 0;
  for (int off = 1; off < 272; off <<= 1) {
    if (t < 272) s_tmp[(cur ^ 1) * 272 + t] = s_tmp[cur * 272 + t] + (t >= off ? s_tmp[cur * 272 + t - off] : 0);
    cur ^= 1;
    __syncthreads();
  }
  if (t <= NE1) s_pref[t] = t == 0 ? 0 : s_tmp[cur * 272 + t - 1];
  __syncthreads();
}
DI int moe_find(const int* s_pref, int ti) {
  int lo = 0, hi = NE1;
  while (hi - lo > 1) { const int mid = (lo + hi) >> 1; if (s_pref[mid] <= ti) lo = mid; else hi = mid; }
  return lo;
}
DI void moe_rows(const W& p, int layer, int e, int mt, int row_lo, int mrows, int* s_rows) {
  const int t = otid();
  if (t < 128) {
    const int cnt = e < NE ? p.cnt()[layer * 256 + e] : mrows;
    const int r = mt * 128 + t;
    int idx = -1;
    if (r < cnt) idx = e < NE ? p.lists()[(size_t)e * CAP + r] : 8 * MT + row_lo + r;
    s_rows[t] = idx;
  }
  __syncthreads();
}

DI void moe_unit(const W& p, int layer, char* lds, int e, const int* s_rows) {
  const int idx0 = s_rows[0];
  {
    const char* B8 = (const char*)p.wei_t() + (size_t)(layer * NE1 + e) * 512 * 1024;
    auto rowA = [&](int r) {
      int idx = s_rows[r]; if (idx < 0) idx = idx0;
      const int tok = idx < 8 * MT ? (idx >> 3) : idx - 8 * MT;
      return (const bf16_t*)(p.h2q() + (size_t)tok * D);
    };
    auto rowB = [&](int r) {
      const int wq = r >> 7, w = r & 127;
      const int n = w < 64 ? wq * 64 + w : 256 + wq * 64 + (w - 64);
      return (const bf16_t*)(B8 + (size_t)n * 128);
    };
    int stash[4][4];
    auto epi = [&](const f32x4 (&acc)[4][8], int chunk, int wr, int wc, int fr, int fq) {
      int cur[4][4];
#pragma unroll
      for (int mi = 0; mi < 4; ++mi)
#pragma unroll
        for (int ni = 0; ni < 4; ++ni) {
          float o[4];
#pragma unroll
          for (int j = 0; j < 4; ++j) o[j] = siluf_(acc[mi][ni][j]) * acc[mi][ni + 4][j] * 16.f;
          cur[mi][ni] = pack_fp8x4(o[0], o[1], o[2], o[3]);
        }
      if (chunk == 0) {
#pragma unroll
        for (int mi = 0; mi < 4; ++mi)
#pragma unroll
          for (int ni = 0; ni < 4; ++ni) stash[mi][ni] = cur[mi][ni];
      } else {
        __syncthreads();
#pragma unroll
        for (int c2 = 0; c2 < 2; ++c2)
#pragma unroll
          for (int mi = 0; mi < 4; ++mi) {
            const int row = wr * 64 + mi * 16 + fr;
#pragma unroll
            for (int ni = 0; ni < 4; ++ni) {
              const int ch = (wc * 4 + ni) ^ ((row >> 1) & 7);
              *(int*)(lds + c2 * 32768 + row * 128 + ch * 16 + 4 * fq) = c2 == 0 ? stash[mi][ni] : cur[mi][ni];
            }
          }
      }
    };
    gemm_tile<4, 2, 4, 8, 64, 2, false, 2, 4>(lds, 8, (size_t)128 * 64, (size_t)512 * 64, rowA, rowB, epi);
  }
  {
    const char* B8d = (const char*)p.wed_t() + (size_t)(layer * NE1 + e) * 1024 * 256;
    auto rowA = [&](int) { return (const bf16_t*)nullptr; };
    auto rowB2 = [&](int r) { return (const bf16_t*)(B8d + (size_t)((r & ~63) | ((r & 12) << 2) | ((r & 48) >> 2) | (r & 3)) * 128); };
    auto epi = [&](const f32x4 (&acc)[4][8], int nt, int wr, int wc, int fr, int fq) {
#pragma unroll
      for (int mi = 0; mi < 4; ++mi) {
        int dst = s_rows[wr * 64 + mi * 16 + fr];
        if (dst < 0) dst = 9 * MT + (int)blockIdx.x;
        {
          int4 lo, hi;
          lo.x = pack_fp8x4(acc[mi][0][0] * 16.f, acc[mi][0][1] * 16.f, acc[mi][0][2] * 16.f, acc[mi][0][3] * 16.f);
          lo.y = pack_fp8x4(acc[mi][1][0] * 16.f, acc[mi][1][1] * 16.f, acc[mi][1][2] * 16.f, acc[mi][1][3] * 16.f);
          lo.z = pack_fp8x4(acc[mi][2][0] * 16.f, acc[mi][2][1] * 16.f, acc[mi][2][2] * 16.f, acc[mi][2][3] * 16.f);
          lo.w = pack_fp8x4(acc[mi][3][0] * 16.f, acc[mi][3][1] * 16.f, acc[mi][3][2] * 16.f, acc[mi][3][3] * 16.f);
          hi.x = pack_fp8x4(acc[mi][4][0] * 16.f, acc[mi][4][1] * 16.f, acc[mi][4][2] * 16.f, acc[mi][4][3] * 16.f);
          hi.y = pack_fp8x4(acc[mi][5][0] * 16.f, acc[mi][5][1] * 16.f, acc[mi][5][2] * 16.f, acc[mi][5][3] * 16.f);
          hi.z = pack_fp8x4(acc[mi][6][0] * 16.f, acc[mi][6][1] * 16.f, acc[mi][6][2] * 16.f, acc[mi][6][3] * 16.f);
          hi.w = pack_fp8x4(acc[mi][7][0] * 16.f, acc[mi][7][1] * 16.f, acc[mi][7][2] * 16.f, acc[mi][7][3] * 16.f);
          char* yp = (char*)p.y() + (size_t)dst * D + nt * 256 + wc * 128 + fq * 16;
          *(int4*)yp = lo; *(int4*)(yp + 64) = hi;
        }
      }
    };
    gemm_tile<4, 2, 4, 8, 64, 2, false, 4, 1 | 4 | 8 | 32>(lds + 65536, 2, (size_t)256 * 64, (size_t)1024 * 64, rowA, rowB2, epi, lds);
  }
}

DI int moe_early_shared(int mrows, int nblk) {
  const int idle = nblk - mrows / 256;
  return idle <= 0 ? 0 : (idle < mrows / 256 ? idle : mrows / 256);
}

DI void phase_moe(const W& p_, int layer, char* lds, int row_lo, int bid, int nblk) {
  const W p = oq(p_);
  int* s_pref = (int*)(lds + 144 * 1024);
  int* s_rows = s_pref + 1024;
  const int mrows = MT - row_lo;
  const int sh0 = moe_early_shared(mrows, nblk);
  moe_prefix(p, layer, mrows - sh0 * 256, s_pref);
  const int total = s_pref[NE1];
  auto fetch_rows = [&](int uu) -> int {
    int idx = -1;
    const int t = otid();
    if (uu < total && t < 256) {
      const int e2 = moe_find(s_pref, uu), mt2 = uu - s_pref[e2];
      if (e2 < NE) {
        const int cnt = p.cnt()[layer * 256 + e2];
        const int r = mt2 * 256 + t;
        if (r < cnt) idx = p.lists()[(size_t)e2 * CAP + r];
      } else {
        idx = 8 * MT + row_lo + (mt2 + sh0) * 256 + t;
      }
    }
    return idx;
  };
  int pre = fetch_rows(vbid_of(bid, nblk));
  for (int u = vbid_of(bid, nblk); u < total; u += nblk) {
    const int e = moe_find(s_pref, u);
    if (otid() < 256) s_rows[otid()] = pre;
    __syncthreads();
    pre = fetch_rows(u + nblk);
    moe_unit(p, layer, lds, e, s_rows);
  }
}

template <bool DUMMY>
DI void phase_combine_t(const W& p_, int layer, int row_lo, int bid, int nblk) {
  const W p = oq(p_);
  char* scratch = (char*)p.y() + (size_t)9 * MT * 1024;
  bf16_t* xres_w = DUMMY ? (bf16_t*)scratch : p.xres();
  bf16_t* h_w = DUMMY ? p.act() : p.h();
  float* out_w = DUMMY ? (float*)(scratch + ((size_t)128 << 20)) : p.out;
  const int wid = otid() >> 6, lane = otid() & 63;
  const bool last = layer == 1;
  for (int row = row_lo + bid * 8 + wid; row < MT; row += nblk * 8) {
    const float* m = p.mod() + (size_t)(layer * 9 + mod_row(row)) * 6144;
    float w[8];
#pragma unroll
    for (int k = 0; k < 8; ++k) w[k] = p.wts()[(size_t)row * 8 + k];
    float xn[16];
    float ss = 0.f;
#pragma unroll
    for (int i = 0; i < 4; ++i) {
      const int cidx = i * 256 + lane * 4;
      float a[4] = {0.f, 0.f, 0.f, 0.f};
#pragma unroll
      for (int k = 0; k < 9; ++k) {
        const size_t yr = k < 8 ? (size_t)row * 8 + k : (size_t)8 * MT + row;
        const int yv = *(const int*)((const char*)p.y() + yr * D + cidx);
        const float wk = (k < 8 ? w[k] : 1.f) * (1.f / 16.f);
        typedef float f32x2_ __attribute__((ext_vector_type(2)));
        const f32x2_ ylo = __builtin_amdgcn_cvt_pk_f32_fp8(yv, false), yhi = __builtin_amdgcn_cvt_pk_f32_fp8(yv, true);
        a[0] += wk * ylo.x; a[1] += wk * ylo.y; a[2] += wk * yhi.x; a[3] += wk * yhi.y;
      }
      const float4 xv = unpack4(*(const uint2*)(p.xres() + (size_t)row * D + cidx));
      const float4 gv = *(const float4*)(m + 5120 + cidx);
      xn[i * 4 + 0] = xv.x + gv.x * a[0]; xn[i * 4 + 1] = xv.y + gv.y * a[1];
      xn[i * 4 + 2] = xv.z + gv.z * a[2]; xn[i * 4 + 3] = xv.w + gv.w * a[3];
#pragma unroll
      for (int j = 0; j < 4; ++j) ss += xn[i * 4 + j] * xn[i * 4 + j];
    }
    ss = wave_sum(ss);
    const float rstd = rsqrtf(ss * (1.f / D) + EPS);
    if (!last) {
      const float* g = p.g_mix() + (layer + 1) * D;
      const float* m2 = p.mod() + (size_t)((layer + 1) * 9 + mod_row(row)) * 6144;
#pragma unroll
      for (int i = 0; i < 4; ++i) {
        const int cidx = i * 256 + lane * 4;
        { uint2 xo; xo.x = pack2(xn[i * 4], xn[i * 4 + 1]); xo.y = pack2(xn[i * 4 + 2], xn[i * 4 + 3]); *(uint2*)(xres_w + (size_t)row * D + cidx) = xo; }
        const float4 gg = *(const float4*)(g + cidx);
        const float4 sh = *(const float4*)(m2 + cidx);
        const float4 scl = *(const float4*)(m2 + 1024 + cidx);
        const float o0 = xn[i * 4 + 0] * rstd * gg.x * (1.f + scl.x) + sh.x;
        const float o1 = xn[i * 4 + 1] * rstd * gg.y * (1.f + scl.y) + sh.y;
        const float o2 = xn[i * 4 + 2] * rstd * gg.z * (1.f + scl.z) + sh.z;
        const float o3 = xn[i * 4 + 3] * rstd * gg.w * (1.f + scl.w) + sh.w;
        const int q8 = pack_fp8x4(o0, o1, o2, o3);
        *(int*)((char*)h_w + (size_t)row * D + cidx) = q8;
      }
    } else {
#pragma unroll
      for (int i = 0; i < 4; ++i) {
        const int cidx = i * 256 + lane * 4;
        const float4 gg = *(const float4*)(p.g_final() + cidx);
        *(float4*)(out_w + (size_t)(row - MC) * D + cidx) =
            make_float4(xn[i * 4] * rstd * gg.x, xn[i * 4 + 1] * rstd * gg.y, xn[i * 4 + 2] * rstd * gg.z, xn[i * 4 + 3] * rstd * gg.w);
      }
    }
  }
}
DI void phase_combine(const W& p, int layer, int row_lo, int bid, int nblk) { phase_combine_t<false>(p, layer, row_lo, bid, nblk); }

typedef unsigned u32x4 __attribute__((ext_vector_type(4)));
typedef unsigned u32x2 __attribute__((ext_vector_type(2)));
DI bf16x8 bl128(__amdgpu_buffer_rsrc_t rs, unsigned voff, unsigned soff) {
  return __builtin_bit_cast(bf16x8, __builtin_amdgcn_raw_buffer_load_b128(rs, voff, soff, 0));
}
DI u32x2 bl64(__amdgpu_buffer_rsrc_t rs, unsigned voff, unsigned soff) { return __builtin_amdgcn_raw_buffer_load_b64(rs, voff, soff, 0); }

template <bool LOCALPASS>
DI void attn_pass(__amdgpu_buffer_rsrc_t rsK, __amdgpu_buffer_rsrc_t rsV, unsigned kbase, unsigned vbase, const char* cK, const char* cV,
                  const float* s_rpb_h, int r, int c0, int kc0, int kr0, int lane, const bf16x8& qf0, const bf16x8& qf1,
                  float& m_out, float& l_out, f32x4 (&O)[4], const bf16x8 (&kfa)[16]) {
  const int fr = lane & 15, fq = lane >> 4;
  const unsigned vK = (8 * (fr >> 2) + (fr & 3)) * 128 + fq * 32;
  f32x4 S[16];
  if (LOCALPASS) {
    bf16x8 kfb[16];
#pragma unroll
    for (int t = 8; t < 16; ++t) {
      const unsigned so = kbase + ((kr0 + (t >> 1)) * 64 + kc0 + (t & 1) * 4) * 128;
      kfb[2 * (t - 8)] = bl128(rsK, vK, so); kfb[2 * (t - 8) + 1] = bl128(rsK, vK + 16, so);
    }
    __builtin_amdgcn_sched_barrier(0);
#pragma unroll
    for (int t = 0; t < 8; ++t) {
      f32x4 s = (f32x4){0.f, 0.f, 0.f, 0.f};
      s = __builtin_amdgcn_mfma_f32_16x16x32_bf16(kfa[2 * t], qf0, s, 0, 0, 0);
      s = __builtin_amdgcn_mfma_f32_16x16x32_bf16(kfa[2 * t + 1], qf1, s, 0, 0, 0);
      S[t] = s;
    }
#pragma unroll
    for (int t = 8; t < 16; ++t) {
      f32x4 s = (f32x4){0.f, 0.f, 0.f, 0.f};
      s = __builtin_amdgcn_mfma_f32_16x16x32_bf16(kfb[2 * (t - 8)], qf0, s, 0, 0, 0);
      s = __builtin_amdgcn_mfma_f32_16x16x32_bf16(kfb[2 * (t - 8) + 1], qf1, s, 0, 0, 0);
      S[t] = s;
    }
    __builtin_amdgcn_sched_barrier(0);
  } else {
#pragma unroll
    for (int t = 0; t < 16; ++t) {
      const bf16x8 k0 = *(const bf16x8*)(cK + (t * 2) * 1024 + lane * 16);
      const bf16x8 k1 = *(const bf16x8*)(cK + (t * 2 + 1) * 1024 + lane * 16);
      f32x4 s = (f32x4){0.f, 0.f, 0.f, 0.f};
      s = __builtin_amdgcn_mfma_f32_16x16x32_bf16(k0, qf0, s, 0, 0, 0);
      s = __builtin_amdgcn_mfma_f32_16x16x32_bf16(k1, qf1, s, 0, 0, 0);
      S[t] = s;
      if ((t & 3) == 3) __builtin_amdgcn_sched_barrier(0);
    }
  }
  const unsigned vV = (fr * 64 + 8 * fq) * 2;
  bf16x8 vfa[16];
  if (LOCALPASS) {
#pragma unroll
    for (int s = 0; s < 4; ++s)
#pragma unroll
      for (int dt = 0; dt < 4; ++dt) vfa[s * 4 + dt] = bl128(rsV, vV, vbase + ((kr0 + s) * 4096 + dt * 1024 + kc0) * 2);
    __builtin_amdgcn_sched_barrier(0);
  }
  const float NEGB = -1e30f;
  float mx = NEGB;
  if (LOCALPASS) {
    const int qc = c0 + fr;
    const int cs = min(max(qc - 8, 0), 48);
    unsigned vmask = 0;
#pragma unroll
    for (int e = 0; e < 8; ++e) {
      const int kc = kc0 + 8 * fq + e;
      vmask |= (kc >= cs && kc < cs + 16) ? (1u << e) : 0u;
    }
    const int dc0 = kc0 + fq * 8 - qc + 15;
#pragma unroll
    for (int t = 0; t < 16; ++t) {
      const float* bp = s_rpb_h + (kr0 + (t >> 1) - r + 7) * 31;
#pragma unroll
      for (int j = 0; j < 4; ++j) {
        const int e = (t & 1) * 4 + j;
        const int dc = min(max(dc0 + e, 0), 30);
        const float v = ((vmask >> e) & 1u) ? S[t][j] + bp[dc] : NEGB;
        S[t][j] = v;
        mx = fmaxf(mx, v);
      }
    }
  } else {
#pragma unroll
    for (int t = 0; t < 16; ++t)
#pragma unroll
      for (int j = 0; j < 4; ++j) mx = fmaxf(mx, S[t][j]);
  }
  mx = fmaxf(mx, __shfl_xor(mx, 16));
  mx = fmaxf(mx, __shfl_xor(mx, 32));
  float l = 0.f;
#pragma unroll
  for (int t = 0; t < 16; ++t)
#pragma unroll
    for (int j = 0; j < 4; ++j) { const float pv = __builtin_amdgcn_exp2f(S[t][j] - mx); S[t][j] = pv; l += pv; }
  l += __shfl_xor(l, 16);
  l += __shfl_xor(l, 32);
  m_out = mx; l_out = l;
#pragma unroll
  for (int dt = 0; dt < 4; ++dt) O[dt] = (f32x4){0.f, 0.f, 0.f, 0.f};
  bf16x8 pf[8];
#pragma unroll
  for (int s = 0; s < 8; ++s) {
    const unsigned p0 = pack2(S[2 * s][0], S[2 * s][1]), p1 = pack2(S[2 * s][2], S[2 * s][3]);
    const unsigned p2 = pack2(S[2 * s + 1][0], S[2 * s + 1][1]), p3 = pack2(S[2 * s + 1][2], S[2 * s + 1][3]);
    pf[s] = __builtin_bit_cast(bf16x8, (u32x4){p0, p1, p2, p3});
  }
  if (LOCALPASS) {
    bf16x8 vfb[16];
    __builtin_amdgcn_sched_barrier(0);
#pragma unroll
    for (int s = 0; s < 4; ++s)
#pragma unroll
      for (int dt = 0; dt < 4; ++dt) vfb[s * 4 + dt] = bl128(rsV, vV, vbase + ((kr0 + 4 + s) * 4096 + dt * 1024 + kc0) * 2);
    __builtin_amdgcn_sched_barrier(0);
#pragma unroll
    for (int s = 0; s < 4; ++s)
#pragma unroll
      for (int dt = 0; dt < 4; ++dt) O[dt] = __builtin_amdgcn_mfma_f32_16x16x32_bf16(vfa[s * 4 + dt], pf[s], O[dt], 0, 0, 0);
    __builtin_amdgcn_sched_barrier(0);
#pragma unroll
    for (int s = 0; s < 4; ++s)
#pragma unroll
      for (int dt = 0; dt < 4; ++dt) O[dt] = __builtin_amdgcn_mfma_f32_16x16x32_bf16(vfb[s * 4 + dt], pf[4 + s], O[dt], 0, 0, 0);
  } else {
#pragma unroll
    for (int s = 0; s < 8; ++s) {
#pragma unroll
      for (int dt = 0; dt < 4; ++dt) {
        const bf16x8 vf = *(const bf16x8*)(cV + (s * 4 + dt) * 1024 + lane * 16);
        O[dt] = __builtin_amdgcn_mfma_f32_16x16x32_bf16(vf, pf[s], O[dt], 0, 0, 0);
      }
      if ((s & 1) == 1) __builtin_amdgcn_sched_barrier(0);
    }
  }
}

DI void attn_stage_ctx(const W& p, char* dst, int bh, int wid, int lane) {
  const int fr = lane & 15, fq = lane >> 4;
  const bf16_t* Kc = p.kh() + (size_t)bh * NCTX * 64;
  const bf16_t* Vc = p.vt() + (size_t)bh * 4 * 4096;
#pragma unroll
  for (int i = 0; i < 8; ++i) {
    const int pc = wid * 8 + i;
    const bf16_t* src;
    if (pc < 32) {
      const int t = pc >> 1, ks = pc & 1, g = t >> 1, T = t & 1;
      src = Kc + (32 * g + 8 * (fr >> 2) + 4 * T + (fr & 3)) * 64 + 16 * fq + 8 * ks;
    } else {
      const int s = (pc - 32) >> 2, dt = (pc - 32) & 3;
      src = Vc + (s >> 1) * 4096 + (16 * dt + fr) * 64 + (s & 1) * 32 + 8 * fq;
    }
    __builtin_amdgcn_global_load_lds((const unsigned*)src, (unsigned*)(dst + pc * 1024 + lane * 16), 16, 0, 0);
  }
}

template <bool LOCAL, bool QPRE = false>
DI void attn_unit(const W& p, __amdgpu_buffer_rsrc_t rsQ, __amdgpu_buffer_rsrc_t rsK, __amdgpu_buffer_rsrc_t rsV, const char* cK, const char* cV,
                  const float* s_rpb, int b, int h, int r, int qb, int lane, char* nxt_dst = nullptr, int nxt_bh = 0, int wid = 0,
                  bf16x8 qp0 = bf16x8{}, bf16x8 qp1 = bf16x8{}) {
  const int fr = lane & 15, fq = lane >> 4;
  const unsigned bh = (unsigned)(b * 8 + h);
  int c0 = 0, kc0 = 0, kr0 = 0, qrow;
  unsigned qso;
  if (LOCAL) {
    c0 = qb * 16; kc0 = qb == 0 ? 0 : qb == 1 ? 8 : qb == 2 ? 24 : 32;
    kr0 = min(max(r - 4, 0), 56);
    qrow = MC + b * SEQ + r * 64 + c0 + fr;
    qso = (unsigned)(HM_LAT * 2) + (bh * SEQ + r * 64 + c0) * 128;
  } else {
    qrow = b * NCTX + qb * 16 + fr;
    qso = (bh * NCTX + qb * 16) * 128;
  }
  const unsigned vQ = fr * 128 + fq * 32;
  const bf16x8 qf0 = QPRE ? qp0 : bl128(rsQ, vQ, qso), qf1 = QPRE ? qp1 : bl128(rsQ, vQ + 16, qso);
  bf16x8 kfa[16];
  if (LOCAL) {
    const unsigned kbase = (unsigned)(HM_LAT * 2) + bh * SEQ * 64 * 2;
    const unsigned vK = (8 * (fr >> 2) + (fr & 3)) * 128 + fq * 32;
#pragma unroll
    for (int t = 0; t < 8; ++t) {
      const unsigned so = kbase + ((kr0 + (t >> 1)) * 64 + kc0 + (t & 1) * 4) * 128;
      kfa[2 * t] = bl128(rsK, vK, so); kfa[2 * t + 1] = bl128(rsK, vK + 16, so);
    }
    __builtin_amdgcn_sched_barrier(0);
  }
  float m2, l2; f32x4 O[4];
  attn_pass<false>(rsK, rsV, 0u, 0u, cK, cV, s_rpb, r, c0, kc0, kr0, lane, qf0, qf1, m2, l2, O, kfa);
  float l = l2;
  if (nxt_dst) attn_stage_ctx(p, nxt_dst, nxt_bh, wid, lane);
  if (LOCAL) {
    float m1, l1; f32x4 O1[4];
    attn_pass<true>(rsK, rsV, (unsigned)(HM_LAT * 2) + bh * SEQ * 64 * 2, (unsigned)(HM_LAT * 2) + bh * 64 * 4096 * 2, cK, cV, s_rpb + h * 465, r, c0,
                    kc0, kr0, lane, qf0, qf1, m1, l1, O1, kfa);
    const float m = fmaxf(m1, m2);
    const float sc1 = __builtin_amdgcn_exp2f(m1 - m), sc2 = __builtin_amdgcn_exp2f(m2 - m);
    l = l1 * sc1 + l2 * sc2;
#pragma unroll
    for (int dt = 0; dt < 4; ++dt)
#pragma unroll
      for (int j = 0; j < 4; ++j) O[dt][j] = O[dt][j] * sc2 + O1[dt][j] * sc1;
  }
  const float inv_l = 1.f / l;
#pragma unroll
  for (int dt = 0; dt < 4; ++dt) {
    const float sc8 = inv_l * 8.f;
    *(int*)((char*)p.cat() + (size_t)qrow * D + h * 64 + dt * 16 + fq * 4) = pack_fp8x4(O[dt][0] * sc8, O[dt][1] * sc8, O[dt][2] * sc8, O[dt][3] * sc8);
  }
}

DI void phase_attn(const W& p_, int layer, char* lds, int bid, int nblk) {
  const W p = oq(p_);
  float* s_rpb = (float*)lds;
  char* cbuf = lds + 16384;
  const int tid = otid(), lane = tid & 63;
  const int wid = __builtin_amdgcn_readfirstlane(tid >> 6);
  for (int i = tid; i < 8 * 15 * 31; i += NTHR) s_rpb[i] = p.rpb()[layer * 3720 + i] * 1.4426950408889634f;
  const __amdgpu_buffer_rsrc_t rsQ = __builtin_amdgcn_make_buffer_rsrc((void*)p.qh(), 0, (int)(HM_ELEMS * 2), 0x00020000);
  const __amdgpu_buffer_rsrc_t rsK = __builtin_amdgcn_make_buffer_rsrc((void*)p.kh(), 0, (int)(HM_ELEMS * 2), 0x00020000);
  const __amdgpu_buffer_rsrc_t rsV = __builtin_amdgcn_make_buffer_rsrc((void*)p.vt(), 0, (int)(HM_ELEMS * 2), 0x00020000);
  const bool fast = nblk == 256;
  const int npair = fast ? 8 : 64;
  const int xg = bid >> 5, lw = (bid & 31) * 8 + wid;
  attn_stage_ctx(p, cbuf, fast ? xg : 0, wid, lane);
  const unsigned vQp = (lane & 15) * 128 + (lane >> 4) * 32;
  auto qso_of = [&](int ph2) { return (unsigned)(HM_LAT * 2) + ((unsigned)ph2 * SEQ + (lw >> 2) * 64 + (lw & 3) * 16) * 128; };
  bf16x8 qn0 = bf16x8{}, qn1 = bf16x8{};
  if (fast) { qn0 = bl128(rsQ, vQp, qso_of(xg)); qn1 = bl128(rsQ, vQp + 16, qso_of(xg)); }
  for (int sl = 0; sl < npair; ++sl) {
    const int ph = fast ? sl * 8 + xg : sl, h = ph & 7, b = ph >> 3;
    asm volatile("s_waitcnt vmcnt(0)" ::: "memory");
    __syncthreads();
    const char* cK = cbuf + (sl & 1) * 65536;
    const char* cV = cK + 32768;
    char* ndst = sl + 1 < npair ? cbuf + ((sl + 1) & 1) * 65536 : nullptr;
    if (fast) {
      const bf16x8 qc0 = qn0, qc1 = qn1;
      if (sl + 1 < npair) { qn0 = bl128(rsQ, vQp, qso_of((sl + 1) * 8 + xg)); qn1 = bl128(rsQ, vQp + 16, qso_of((sl + 1) * 8 + xg)); }
      attn_unit<true, true>(p, rsQ, rsK, rsV, cK, cV, s_rpb, b, h, lw >> 2, lw & 3, lane, ndst, (sl + 1) * 8 + xg, wid, qc0, qc1);
      if (layer == 0 && (lw >> 4) == sl) attn_unit<false>(p, rsQ, rsK, rsV, cK, cV, s_rpb, b, h, 0, lw & 15, lane);
    } else {
      if (ndst) attn_stage_ctx(p, ndst, sl + 1, wid, lane);
      for (int u = bid * 8 + wid; u < 256; u += nblk * 8) attn_unit<true>(p, rsQ, rsK, rsV, cK, cV, s_rpb, b, h, u >> 2, u & 3, lane);
      if (layer == 0)
        for (int u = bid * 8 + wid; u < 16; u += nblk * 8) attn_unit<false>(p, rsQ, rsK, rsV, cK, cV, s_rpb, b, h, 0, u, lane);
    }
  }
  __syncthreads();
}

DI void phase_pool(const W& p_, int layer, char* lds, int bid, int nblk) {
  const W p = oq(p_);
  float* U = (float*)lds;
  bf16_t* dA = (bf16_t*)(lds + 81920);
  bf16_t* WT = (bf16_t*)(lds + 81920 + 33792);
  const int tid = otid(), wid = tid >> 6, lane = tid & 63, fr = lane & 15, fq = lane >> 4;
  for (int i = tid; i < 4 * 64 * 8; i += NTHR) {
    const int rowj = i >> 3, chk = i & 7;
    *(uint4*)(WT + rowj * 72 + chk * 8) = *(const uint4*)(p.wpt() + (size_t)layer * 16384 + rowj * 64 + chk * 8);
  }
  const int nlat = ML / 64, nctx = layer == 0 ? MC / 64 : 0;
  const int gextra = NB * 4 * NSLOT - nblk * 8;
  const int heavy = (gextra > 0 && gextra < nblk * 4) ? (gextra + 7) / 8 : 0;
  const int ptotal = nlat + nctx;
  const int ufirst = bid < heavy ? ptotal - 1 - bid : bid - heavy;
  const int ustep = bid < heavy ? ptotal : nblk - heavy;
  const int ulimit = bid < heavy ? ptotal : ptotal - heavy;
  for (int u = ufirst; u < ulimit; u += ustep) {
    int row0, L, seq0;
    if (u < nlat) { row0 = MC + u * 64; L = SEQ; seq0 = MC + ((u * 64) / SEQ) * SEQ; }
    else { row0 = (u - nlat) * 64; L = NCTX; seq0 = (row0 / NCTX) * NCTX; }
    const int t0 = row0 - seq0;
    __syncthreads();
#pragma unroll
    for (int k = 0; k < 5; ++k) {
      const int c = tid + NTHR * k, rr = c >> 5, chk = c & 31;
      const int tpos = t0 - 8 + rr;
      uint4 v = make_uint4(0u, 0u, 0u, 0u);
      if (tpos >= 0 && tpos < L) v = *(const uint4*)(p.px() + (size_t)(seq0 + tpos) * INW + 1536 + chk * 8);
      float4 lo4, hi4;
      lo4.x = __uint_as_float(v.x << 16); lo4.y = __uint_as_float(v.x & 0xffff0000u); lo4.z = __uint_as_float(v.y << 16); lo4.w = __uint_as_float(v.y & 0xffff0000u);
      hi4.x = __uint_as_float(v.z << 16); hi4.y = __uint_as_float(v.z & 0xffff0000u); hi4.z = __uint_as_float(v.w << 16); hi4.w = __uint_as_float(v.w & 0xffff0000u);
      *(float4*)(U + rr * 256 + chk * 8) = lo4;
      *(float4*)(U + rr * 256 + chk * 8 + 4) = hi4;
    }
    __syncthreads();
    {
      const int ch = tid & 255, hf = tid >> 8, g = ch >> 6, hw = 1 << g;
      const float* Uc = U + ch;
      int tpos = t0 + hf * 32;
      int lo = max(tpos - hw, 0), hi = min(tpos + hw - 1, L - 1);
      float S = 0.f;
      for (int j = lo; j <= hi; ++j) S += Uc[(j - t0 + 8) * 256];
      for (int tt = 0; tt < 32; ++tt) {
        const float dv = S / (float)(hi - lo + 1) - Uc[(tpos - t0 + 8) * 256];
        dA[(hf * 32 + tt) * 264 + ch] = f2bf(dv);
        ++tpos;
        const int nlo = max(tpos - hw, 0), nhi = min(tpos + hw - 1, L - 1);
        if (nlo > lo) { S -= Uc[(lo - t0 + 8) * 256]; lo = nlo; }
        if (nhi > hi) { S += Uc[(nhi - t0 + 8) * 256]; hi = nhi; }
      }
    }
    __syncthreads();
    {
      const int g = wid & 3, th = wid >> 2;
      f32x4 acc[2][4];
#pragma unroll
      for (int mi = 0; mi < 2; ++mi)
#pragma unroll
        for (int ni = 0; ni < 4; ++ni) acc[mi][ni] = (f32x4){0.f, 0.f, 0.f, 0.f};
#pragma unroll
      for (int ks = 0; ks < 2; ++ks) {
        bf16x8 a[2], b[4];
#pragma unroll
        for (int mi = 0; mi < 2; ++mi) a[mi] = *(const bf16x8*)(dA + (th * 32 + mi * 16 + fr) * 264 + g * 64 + 32 * ks + 8 * fq);
#pragma unroll
        for (int ni = 0; ni < 4; ++ni) b[ni] = *(const bf16x8*)(WT + (g * 64 + ni * 16 + fr) * 72 + 32 * ks + 8 * fq);
#pragma unroll
        for (int mi = 0; mi < 2; ++mi)
#pragma unroll
          for (int ni = 0; ni < 4; ++ni) acc[mi][ni] = __builtin_amdgcn_mfma_f32_16x16x32_bf16(b[ni], a[mi], acc[mi][ni], 0, 0, 0);
      }
#pragma unroll
      for (int mi = 0; mi < 2; ++mi) {
        const int row = row0 + th * 32 + mi * 16 + fr;
#pragma unroll
        for (int ni = 0; ni < 4; ++ni) {
          const int j0 = g * 64 + ni * 16 + 4 * fq;
          const float4 sc = *(const float4*)(p.pool_scale() + layer * 256 + j0);
          *(int*)((char*)p.cat() + (size_t)row * D + 512 + j0) =
              pack_fp8x4(acc[mi][ni][0] * sc.x * 8.f, acc[mi][ni][1] * sc.y * 8.f, acc[mi][ni][2] * sc.z * 8.f, acc[mi][ni][3] * sc.w * 8.f);
        }
      }
    }
  }
  __syncthreads();
}

DI int gla_row0(int b, int slot) { return slot < 4 ? b * NCTX + slot * 64 : MC + b * SEQ + (slot - 4) * 64; }
constexpr int KXT_STRIDE = 72;

DI void phase_gla_c1(const W& p_, int layer, char* lds, int bid, int nblk) {
  const W p = oq(p_);
  const int tid = otid(), lane = tid & 63;
  const int wid = __builtin_amdgcn_readfirstlane(tid >> 6);
  constexpr int WREG = 2 * 32 * KXT_STRIDE * 2 + 4096;
  bf16_t* kxt = (bf16_t*)(lds + wid * WREG);
  bf16_t* al = (bf16_t*)(lds + wid * WREG + 2 * 32 * KXT_STRIDE * 2);
  float* s_rope = (float*)(lds + 8 * WREG);
  for (int i = tid; i < 1024; i += NTHR) s_rope[i] = p.rope()[i];
  __syncthreads();
  const int dir = lane >> 5, d = lane & 31, fr = lane & 15, fq = lane >> 4;
  const __amdgpu_buffer_rsrc_t rsV = __builtin_amdgcn_make_buffer_rsrc((void*)p.vtg(), 0, (int)(HMG_ELEMS * 2), 0x00020000);
  const int half = d >> 4, jf = d & 7;
  const float sgn = ((d >> 3) & 1) ? 1.f : -1.f;
  for (int u = bid * 8 + wid; u < NB * 4 * NSLOT; u += nblk * 8) {
    const int slot = u % NSLOT, bh = u / NSLOT, h = bh & 3, b = bh >> 2;
    const int row0 = gla_row0(b, slot);
    const bool latent = slot >= 4;
#pragma unroll
    for (int j = 0; j < 4; ++j) {
      const int rr = j * 16 + (lane >> 2), chk = lane & 3;
      *(uint4*)(al + rr * 32 + chk * 8) = *(const uint4*)(p.px() + (size_t)(row0 + rr) * INW + 2560 + chk * 8);
    }
    float w2[16];
    {
      const float* w2p = (dir ? p.w_gate_b() : p.w_gate_f()) + layer * 2048 + h * 32 + d;
#pragma unroll
      for (int r = 0; r < 16; ++r) w2[r] = w2p[r * 128];
    }
    const float b2 = (dir ? p.b_gate_b() : p.b_gate_f())[layer * 128 + h * 32 + d];
    bf16_t* gq = p.gqk() + ((size_t)u * 2 + dir) * 4096;
    asm volatile("s_waitcnt lgkmcnt(0)" ::: "memory");
    float bsum = 0.f;
    for (int ib = 0; ib < 4; ++ib) {
      bf16_t qo[16], qp[16], ko[16], kp[16];
#pragma unroll
      for (int k = 0; k < 16; ++k) {
        const int ii = ib * 16 + k, i = dir ? 63 - ii : ii;
        const bf16_t* rowp = p.px() + (size_t)(row0 + i) * INW + h * 32;
        qo[k] = rowp[1792 + d]; qp[k] = rowp[1792 + (d ^ 8)]; ko[k] = rowp[1920 + d]; kp[k] = rowp[1920 + (d ^ 8)];
      }
#pragma unroll
      for (int k = 0; k < 16; ++k) {
        const int ii = ib * 16 + k, i = dir ? 63 - ii : ii;
        const uint4 a0 = *(const uint4*)(al + i * 32 + dir * 16), a1 = *(const uint4*)(al + i * 32 + dir * 16 + 8);
        float lg = b2;
        const unsigned aw[8] = {a0.x, a0.y, a0.z, a0.w, a1.x, a1.y, a1.z, a1.w};
#pragma unroll
        for (int r = 0; r < 8; ++r) {
          lg += __uint_as_float(aw[r] << 16) * w2[2 * r];
          lg += __uint_as_float(aw[r] & 0xffff0000u) * w2[2 * r + 1];
        }
        const float ls = fminf(lg, 0.f) - __logf(1.f + __expf(-fabsf(lg)));
        bsum += ls * (1.f / 16.f);
        const float qov = bf2f(qo[k]) * 0.17677669529663687f, qpv = bf2f(qp[k]) * 0.17677669529663687f;
        const float kov = bf2f(ko[k]), kpv = bf2f(kp[k]);
        float qr = qov, kr = kov;
        if (latent) {
          const int pos = half == 0 ? (slot - 4) : i;
          const float2 cs = *(const float2*)(s_rope + (pos * 8 + jf) * 2);
          qr = qov * cs.x + sgn * qpv * cs.y;
          kr = kov * cs.x + sgn * kpv * cs.y;
        }
        const float eb = __expf(bsum);
        const bf16_t qx = f2bf(qr * eb), kx = f2bf(kr / eb);
        gq[i * 32 + d] = qx;
        gq[2048 + i * 32 + d] = kx;
        kxt[(dir * 32 + d) * KXT_STRIDE + i] = kx;
      }
    }
    const float eblast = __expf(bsum);
    p.gdec()[((size_t)u * 2 + dir) * 32 + d] = eblast;
    asm volatile("s_waitcnt lgkmcnt(0)" ::: "memory");
    const unsigned vbase = (unsigned)((latent ? HMG_LAT + (size_t)(bh * 64 + slot - 4) * 4096 : (size_t)(bh * 4 + slot) * 4096) * 2);
    bf16x8 vf[2][4];
#pragma unroll
    for (int ks = 0; ks < 2; ++ks)
#pragma unroll
      for (int mt = 0; mt < 4; ++mt) vf[ks][mt] = bl128(rsV, (unsigned)(((16 * mt + fr) * 64 + 8 * fq) * 2), vbase + ks * 64);
#pragma unroll
    for (int dd = 0; dd < 2; ++dd) {
      f32x4 acc[4][2];
#pragma unroll
      for (int mt = 0; mt < 4; ++mt)
#pragma unroll
        for (int nt = 0; nt < 2; ++nt) acc[mt][nt] = (f32x4){0.f, 0.f, 0.f, 0.f};
#pragma unroll
      for (int ks = 0; ks < 2; ++ks) {
        bf16x8 kf[2];
#pragma unroll
        for (int nt = 0; nt < 2; ++nt) kf[nt] = *(const bf16x8*)(kxt + (dd * 32 + 16 * nt + fr) * KXT_STRIDE + 32 * ks + 8 * fq);
#pragma unroll
        for (int mt = 0; mt < 4; ++mt)
#pragma unroll
          for (int nt = 0; nt < 2; ++nt) acc[mt][nt] = __builtin_amdgcn_mfma_f32_16x16x32_bf16(vf[ks][mt], kf[nt], acc[mt][nt], 0, 0, 0);
      }
      float* kvp = p.gkv() + ((size_t)u * 2 + dd) * 2048;
#pragma unroll
      for (int nt = 0; nt < 2; ++nt) {
        const float sc = __shfl(eblast, dd * 32 + 16 * nt + fr);
#pragma unroll
        for (int mt = 0; mt < 4; ++mt)
#pragma unroll
          for (int j = 0; j < 4; ++j) kvp[(16 * mt + 4 * fq + j) * 32 + 16 * nt + fr] = acc[mt][nt][j] * sc;
      }
    }
    asm volatile("s_waitcnt lgkmcnt(0)" ::: "memory");
  }
  __syncthreads();
}

DI void phase_gla_scan(const W& p_, int bid, int nblk) {
  const W p = oq(p_);
  bf16_t* sin = (bf16_t*)p.gsin();
  const int nthreads = NB * 4 * 2 * 2048;
  for (int gid = bid * NTHR + otid(); gid < nthreads; gid += nblk * NTHR) {
    const int el = gid & 2047, dir = (gid >> 11) & 1, bh = gid >> 12, d = el & 31;
    float S = 0.f;
    for (int st0 = 0; st0 < NSLOT; st0 += 17) {
      float dk[17], kv[17];
#pragma unroll
      for (int j = 0; j < 17; ++j) {
        const int st = st0 + j;
        const int slot = dir == 0 ? st : (st < 4 ? 3 - st : NSLOT + 3 - st);
        const size_t base = ((size_t)(bh * NSLOT + slot)) * 2 + dir;
        dk[j] = p.gdec()[base * 32 + d];
        kv[j] = p.gkv()[base * 2048 + el];
      }
#pragma unroll
      for (int j = 0; j < 17; ++j) {
        const int st = st0 + j;
        const int slot = dir == 0 ? st : (st < 4 ? 3 - st : NSLOT + 3 - st);
        const size_t base = ((size_t)(bh * NSLOT + slot)) * 2 + dir;
        sin[base * 2048 + el] = f2bf(S);
        S = dk[j] * S + kv[j];
      }
    }
  }
}

DI void phase_gla_c3(const W& p_, int layer, char* lds, int bid, int nblk) {
  (void)lds;
  const W p = oq(p_);
  const int tid = otid(), lane = tid & 63;
  const int wid = __builtin_amdgcn_readfirstlane(tid >> 6);
  const int fr = lane & 15, fq = lane >> 4;
  const __amdgpu_buffer_rsrc_t rsV = __builtin_amdgcn_make_buffer_rsrc((void*)p.vtg(), 0, (int)(HMG_ELEMS * 2), 0x00020000);
  const __amdgpu_buffer_rsrc_t rsQ = __builtin_amdgcn_make_buffer_rsrc((void*)p.gqk(), 0, (int)((size_t)NB * 4 * NSLOT * 16384), 0x00020000);
  const __amdgpu_buffer_rsrc_t rsS = __builtin_amdgcn_make_buffer_rsrc((void*)p.gsin(), 0, (int)((size_t)NB * 4 * NSLOT * 2 * 4096), 0x00020000);
  const int slot_lo = layer == 0 ? 0 : 4;
  const int nsl = NSLOT - slot_lo;
  const unsigned vfrag = (unsigned)(fr * 64 + fq * 16);
  for (int uu = bid * 8 + wid; uu < NB * 4 * nsl; uu += nblk * 8) {
    const int slot = slot_lo + uu % nsl, bh = uu / nsl, h = bh & 3, b = bh >> 2;
    const int u = bh * NSLOT + slot;
    const bool latent = slot >= 4;
    const int row0 = gla_row0(b, slot);
    const unsigned qbase = (unsigned)u * 16384u;
    bf16x8 QF[4], QB[4];
#pragma unroll
    for (int ct = 0; ct < 4; ++ct) { QF[ct] = bl128(rsQ, vfrag, qbase + ct * 1024); QB[ct] = bl128(rsQ, vfrag, qbase + 8192 + ct * 1024); }
    f32x4 O[4][4];
#pragma unroll
    for (int mt = 0; mt < 4; ++mt)
#pragma unroll
      for (int ct = 0; ct < 4; ++ct) O[mt][ct] = (f32x4){0.f, 0.f, 0.f, 0.f};
    const unsigned vbase = (unsigned)((latent ? HMG_LAT + (size_t)(bh * 64 + slot - 4) * 4096 : (size_t)(bh * 4 + slot) * 4096) * 2);
    const unsigned vV = (unsigned)((fr * 64 + 4 * fq) * 2);
#pragma unroll
    for (int ks = 0; ks < 2; ++ks) {
      f32x4 Pt[2][4];
#pragma unroll
      for (int t2 = 0; t2 < 2; ++t2) {
        const int st = 2 * ks + t2;
        const bf16x8 KFs = bl128(rsQ, vfrag, qbase + 4096 + st * 1024), KBs = bl128(rsQ, vfrag, qbase + 8192 + 4096 + st * 1024);
#pragma unroll
        for (int ct = 0; ct < 4; ++ct) {
          const f32x4 z = (f32x4){0.f, 0.f, 0.f, 0.f};
          if (st < ct) Pt[t2][ct] = __builtin_amdgcn_mfma_f32_16x16x32_bf16(KFs, QF[ct], z, 0, 0, 0);
          else if (st > ct) Pt[t2][ct] = __builtin_amdgcn_mfma_f32_16x16x32_bf16(KBs, QB[ct], z, 0, 0, 0);
          else {
            const f32x4 f = __builtin_amdgcn_mfma_f32_16x16x32_bf16(KFs, QF[ct], z, 0, 0, 0);
            const f32x4 g = __builtin_amdgcn_mfma_f32_16x16x32_bf16(KBs, QB[ct], z, 0, 0, 0);
#pragma unroll
            for (int j = 0; j < 4; ++j) { const int s = 4 * fq + j; Pt[t2][ct][j] = (s <= fr ? f[j] : 0.f) + (s >= fr ? g[j] : 0.f); }
          }
        }
      }
      bf16x8 pf[4];
#pragma unroll
      for (int ct = 0; ct < 4; ++ct)
        pf[ct] = __builtin_bit_cast(bf16x8, (u32x4){pack2(Pt[0][ct][0], Pt[0][ct][1]), pack2(Pt[0][ct][2], Pt[0][ct][3]),
                                                     pack2(Pt[1][ct][0], Pt[1][ct][1]), pack2(Pt[1][ct][2], Pt[1][ct][3])});
#pragma unroll
      for (int mt = 0; mt < 4; ++mt) {
        const unsigned so = vbase + (unsigned)((mt * 16 * 64 + 32 * ks) * 2);
        const u32x2 v0 = bl64(rsV, vV, so), v1 = bl64(rsV, vV + 32, so);
        const bf16x8 vf = __builtin_bit_cast(bf16x8, (u32x4){v0.x, v0.y, v1.x, v1.y});
#pragma unroll
        for (int ct = 0; ct < 4; ++ct) O[mt][ct] = __builtin_amdgcn_mfma_f32_16x16x32_bf16(vf, pf[ct], O[mt][ct], 0, 0, 0);
      }
    }
    const unsigned sbase = (unsigned)u * 8192u;
#pragma unroll
    for (int mt = 0; mt < 4; ++mt) {
      const bf16x8 sf = bl128(rsS, vfrag, sbase + mt * 1024), sb = bl128(rsS, vfrag, sbase + 4096 + mt * 1024);
#pragma unroll
      for (int ct = 0; ct < 4; ++ct) {
        O[mt][ct] = __builtin_amdgcn_mfma_f32_16x16x32_bf16(sf, QF[ct], O[mt][ct], 0, 0, 0);
        O[mt][ct] = __builtin_amdgcn_mfma_f32_16x16x32_bf16(sb, QB[ct], O[mt][ct], 0, 0, 0);
      }
    }
#pragma unroll
    for (int ct = 0; ct < 4; ++ct) {
      float ss = 0.f;
#pragma unroll
      for (int mt = 0; mt < 4; ++mt)
#pragma unroll
        for (int j = 0; j < 4; ++j) ss += O[mt][ct][j] * O[mt][ct][j];
      ss += __shfl_xor(ss, 16); ss += __shfl_xor(ss, 32);
      const float rstd = rsqrtf(ss * (1.f / 64.f) + EPS);
      const int row = row0 + 16 * ct + fr;
#pragma unroll
      for (int mt = 0; mt < 4; ++mt) {
        const int v0 = 16 * mt + 4 * fq;
        const uint2 rv = *(const uint2*)(p.px() + (size_t)row * INW + 2304 + h * 64 + v0);
        const float4 gg = *(const float4*)(p.g_gla() + layer * 64 + v0);
        const float r0 = O[mt][ct][0] * rstd * gg.x * siluf_(__uint_as_float(rv.x << 16));
        const float r1 = O[mt][ct][1] * rstd * gg.y * siluf_(__uint_as_float(rv.x & 0xffff0000u));
        const float r2 = O[mt][ct][2] * rstd * gg.z * siluf_(__uint_as_float(rv.y << 16));
        const float r3 = O[mt][ct][3] * rstd * gg.w * siluf_(__uint_as_float(rv.y & 0xffff0000u));
        *(int*)((char*)p.cat() + (size_t)row * D + 768 + h * 64 + v0) = pack_fp8x4(r0 * 8.f, r1 * 8.f, r2 * 8.f, r3 * 8.f);
      }
    }
  }
}

#define XB_TMO      128
#define XB_XCNT(j)  (256  + 64 * (j))
#define XB_XSUB(j)  (1280 + 64 * (j))
#define XB_XGEN(j)  (2304 + 64 * (j))
#define XB_TOP      3328
#define XB_TOPGEN   3392
#define XCD_BAR_WORDS 3456
#define XB_SPIN_CAP (1u << 18)
#define LAS __attribute__((address_space(3)))

__device__ __forceinline__ unsigned xb_ld(unsigned* p)              { return __hip_atomic_load(p, __ATOMIC_RELAXED, __HIP_MEMORY_SCOPE_AGENT); }
__device__ __forceinline__ unsigned xb_add(unsigned* p, unsigned v) { return __hip_atomic_fetch_add(p, v, __ATOMIC_RELAXED, __HIP_MEMORY_SCOPE_AGENT); }
__device__ __forceinline__ unsigned xb_xcc_id() { return (unsigned)__builtin_amdgcn_s_getreg((3 << 11) | 20) & 0xFu; }
#define XB_SPIN(cond, bar) do { unsigned _sp = 0; while (cond) { __builtin_amdgcn_s_sleep(1); \
    if ((++_sp & 255u) == 0u) { if (xb_ld(&(bar)[XB_TMO])) break; if (_sp > XB_SPIN_CAP) { atomicAdd(&(bar)[XB_TMO], 1u); break; } } } } while (0)

struct XcdBarrier { unsigned* bar; unsigned x; volatile LAS unsigned* st; };

__device__ __forceinline__ XcdBarrier xcd_barrier_post(unsigned* bar, volatile LAS unsigned* st) {
    XcdBarrier b; b.bar = bar; b.x = xb_xcc_id(); b.st = st;
    if (threadIdx.x == 0) (void)xb_add(&bar[XB_XCNT(b.x)], 1u);
    return b;
}
__device__ __forceinline__ void xcd_barrier_complete(unsigned* bar, unsigned x, unsigned& nloc, unsigned& nx) {
    const unsigned G = gridDim.x * gridDim.y * gridDim.z;
    unsigned sum, cnt, mine, sp = 0u;
    for (;;) {
        sum = 0u; cnt = 0u; mine = 0u;
#pragma unroll
        for (unsigned j = 0; j < 16; ++j) { const unsigned c = xb_ld(&bar[XB_XCNT(j)]); sum += c; cnt += (c > 0u) ? 1u : 0u; mine = (j == x) ? c : mine; }
        if (sum == G) break;
        __builtin_amdgcn_s_sleep(1);
        if ((++sp & 255u) == 0u) { if (xb_ld(&bar[XB_TMO])) break; if (sp > XB_SPIN_CAP) { atomicAdd(&bar[XB_TMO], 1u); break; } }
    }
    nloc = mine > 0u ? mine : 1u; nx = cnt > 0u ? cnt : 1u;
}
__device__ __forceinline__ void xcd_barrier(const XcdBarrier& b) {
    asm volatile("s_waitcnt vmcnt(0)" ::: "memory");
    __syncthreads();
    if (threadIdx.x == 0) {
        unsigned long long bv = (unsigned long long)b.bar; unsigned bx = b.x;
        asm volatile("" : "+s"(bv), "+s"(bx));
        unsigned* bar = (unsigned*)(__attribute__((address_space(1))) unsigned*)bv;
        __builtin_amdgcn_s_waitcnt(0);
        unsigned nloc = b.st[0], nx = b.st[1];
        if (nloc == 0u) { xcd_barrier_complete(bar, bx, nloc, nx); b.st[0] = nloc; b.st[1] = nx; }
        const unsigned old = xb_add(&bar[XB_XSUB(bx)], 1u);
        const unsigned gen = old / nloc;
        if (old + 1u == (gen + 1u) * nloc) {
            __builtin_amdgcn_fence(__ATOMIC_RELEASE, "agent");
            asm volatile("s_waitcnt vmcnt(0)" ::: "memory");
            const unsigned og = xb_add(&bar[XB_TOP], 1u);
            const unsigned tg = og / nx;
            if (og + 1u == (tg + 1u) * nx) xb_add(&bar[XB_TOPGEN], 1u);
            else XB_SPIN(xb_ld(&bar[XB_TOPGEN]) == tg, bar);
            __builtin_amdgcn_fence(__ATOMIC_ACQUIRE, "agent");
            xb_add(&bar[XB_XGEN(bx)], 1u);
            asm volatile("s_waitcnt vmcnt(0)" ::: "memory");
        } else {
            XB_SPIN(xb_ld(&bar[XB_XGEN(bx)]) == gen, bar);
            __builtin_amdgcn_fence(__ATOMIC_ACQUIRE, "agent");
            asm volatile("s_waitcnt vmcnt(0)" ::: "memory");
        }
    }
    __syncthreads();
}

__global__ void __launch_bounds__(NTHR, 2) k_fwd(P q) {
  extern __shared__ __attribute__((aligned(16))) char lds[];
  const int bid = blockIdx.x, nblk = gridDim.x;
  if (threadIdx.x < 4) ((unsigned*)(lds + LDS_BYTES - 16))[threadIdx.x] = 0u;
  __syncthreads();
  XcdBarrier bar = xcd_barrier_post((unsigned*)(q.ws + OFF_BAR), (volatile LAS unsigned*)(lds + LDS_BYTES - 16));
  int* s_vb = (int*)(lds + LDS_BYTES - 32);
  if (threadIdx.x == 0) {
    const int xcc = (int)xb_xcc_id();
    s_vb[1] = xcc;
    s_vb[2] = (int)__hip_atomic_fetch_add((unsigned*)(q.ws + OFF_CNT) + 768 + xcc, 1u, __ATOMIC_RELAXED, __HIP_MEMORY_SCOPE_AGENT);
  }
#define GB() xcd_barrier(bar)
#ifndef PROBE_DUP
#define PROBE_DUP 0
#endif
#if PROBE_DUP == 1
#define DUP1(x) x
#else
#define DUP1(x) (void)0
#endif
#if PROBE_DUP == 2
#define DUP2(x) x
#else
#define DUP2(x) (void)0
#endif
#if PROBE_DUP == 3
#define DUP3(x) x
#else
#define DUP3(x) (void)0
#endif
#if PROBE_DUP == 4
#define DUP4(x) x
#else
#define DUP4(x) (void)0
#endif
#if PROBE_DUP == 5
#define DUP5(x) x
#else
#define DUP5(x) (void)0
#endif
#if PROBE_DUP == 6
#define DUP6(x) x
#else
#define DUP6(x) (void)0
#endif
#if PROBE_DUP == 7
#define DUP7(x) x
#else
#define DUP7(x) (void)0
#endif
#if PROBE_DUP == 8
#define DUP8(x) x
#else
#define DUP8(x) (void)0
#endif
#if PROBE_DUP == 9
#define DUP9(x) x
#else
#define DUP9(x) (void)0
#endif
  phase_convert(q, lds, bid, nblk);
  phase_mod(q, lds, bid, nblk);
  DUP3(phase_convert(q, lds, bid, nblk)); DUP3(phase_mod(q, lds, bid, nblk));
  GB();
  if (threadIdx.x == 0) {
    const unsigned* rc = (const unsigned*)(q.ws + OFF_CNT) + 768;
    const int per = nblk >> 3;
    bool ok = (nblk & 7) == 0;
    for (int j = 0; j < 16; ++j) {
      const int c = (int)__hip_atomic_load(rc + j, __ATOMIC_RELAXED, __HIP_MEMORY_SCOPE_AGENT);
      ok = ok && (j < 8 ? c == per : c == 0);
    }
    s_vb[0] = ok ? s_vb[1] * per + s_vb[2] : ((nblk & 7) == 0 ? (bid & 7) * per + (bid >> 3) : bid);
  }
  __syncthreads();
  const int vb = __builtin_amdgcn_readfirstlane(s_vb[0]);
  phase_norm0(q, bid, nblk);
  DUP3(phase_norm0(q, bid, nblk));
  GB();
  const W p{q.ws, q.out, q.x, q.ctx};
#define LAYER(layer, row_lo, LASTGB)                          \
  do {                                                        \
    phase_inproj(p, layer, lds, vb, nblk);                   \
    DUP7(phase_inproj(p, layer, lds, vb, nblk));             \
    GB();                                                     \
    phase_gla_c1(p, layer, lds, vb, nblk);                   \
    phase_pool(p, layer, lds, vb, nblk);                     \
    DUP6(phase_gla_c1(p, layer, lds, vb, nblk)); DUP5(phase_pool(p, layer, lds, vb, nblk)); \
    GB();                                                     \
    phase_gla_scan(p, vb, nblk);                             \
    phase_attn(p, layer, lds, vb, nblk);                     \
    DUP6(phase_gla_scan(p, vb, nblk)); DUP4(phase_attn(p, layer, lds, vb, nblk)); \
    GB();                                                     \
    phase_gla_c3(p, layer, lds, vb, nblk);                   \
    DUP6(phase_gla_c3(p, layer, lds, vb, nblk));             \
    GB();                                                     \
    DUP2(phase_outproj_t<true>(p, layer, lds, row_lo, vb, nblk)); \
    phase_outproj(p, layer, lds, row_lo, vb, nblk);          \
    GB();                                                     \
    phase_norm(p, layer, row_lo, vb, nblk);                  \
    DUP3(phase_norm(p, layer, row_lo, vb, nblk));            \
    GB();                                                     \
    phase_router(p, layer, lds, row_lo, vb, nblk);           \
    DUP1(phase_router(p, layer, lds, row_lo, vb, nblk));     \
    GB();                                                     \
    phase_route(p, layer, lds, row_lo, vb, nblk);            \
    GB();                                                     \
    phase_moe(p, layer, lds, row_lo, vb, nblk);              \
    DUP8(phase_moe(p, layer, lds, row_lo, vb, nblk));        \
    GB();                                                     \
    DUP9(phase_combine_t<true>(p, layer, row_lo, vb, nblk)); \
    phase_combine(p, layer, row_lo, vb, nblk);               \
    LASTGB;                                                   \
  } while (0)
#if PROBE_GEMM
  phase_probe_gemm(p, lds, vb, nblk);
  GB();
#endif
  LAYER(0, 0, GB());
  LAYER(1, MC, (void)0);
#undef LAYER
#undef GB
}

}

extern "C" void kernel_launch(void* const* d_in, const int* in_sizes, int n_in, void* d_out, int out_size, void* d_ws,
                              size_t ws_size, hipStream_t stream) {
  (void)in_sizes; (void)n_in; (void)out_size;
  P p{};
  const float* const* in = (const float* const*)d_in;
  p.x = in[0]; p.c = in[1]; p.ctx = in[2]; p.c_ctx = in[3]; p.w_mod = in[4]; p.b_mod = in[5]; p.g_mix = in[6]; p.w_in = in[7];
  p.rpb = in[8]; p.w_pool = in[9]; p.pool_scale = in[10]; p.w_gate_f = in[11]; p.b_gate_f = in[12]; p.w_gate_b = in[13];
  p.b_gate_b = in[14]; p.g_gla = in[15]; p.w_out = in[16]; p.g_ffn = in[17]; p.w_router = in[18]; p.b_router = in[19];
  p.w_e_in = in[20]; p.w_e_down = in[21]; p.w_sh_in = in[22]; p.w_sh_down = in[23]; p.g_final = in[24];
  p.out = (float*)d_out;
  p.ws = (char*)d_ws;
  char* ws = (char*)d_ws;
  if (ws_size < WS_TOTAL) { fprintf(stderr, "workspace too small: %zu < %zu\n", ws_size, (size_t)WS_TOTAL); }
  static int grid = 0;
  if (!grid) {
    (void)hipFuncSetAttribute((const void*)k_fwd, hipFuncAttributeMaxDynamicSharedMemorySize, LDS_BYTES);
    int dev = 0, cus = 0, per_cu = 0;
    (void)hipGetDevice(&dev);
    (void)hipDeviceGetAttribute(&cus, hipDeviceAttributeMultiprocessorCount, dev);
    (void)hipOccupancyMaxActiveBlocksPerMultiprocessor(&per_cu, (const void*)k_fwd, NTHR, LDS_BYTES);
    if (per_cu < 1) { fprintf(stderr, "k_fwd: occupancy query says 0 blocks per CU\n"); per_cu = 1; }
    grid = cus > 0 ? cus : 256;
  }
  (void)hipMemsetAsync(ws, 0, ZERO_BYTES, stream);
  hipLaunchKernelGGL(k_fwd, dim3(grid), dim3(NTHR), LDS_BYTES, stream, p);
}
```

```cpp
#include <hip/hip_runtime.h>
#include <stdint.h>
#include <stdio.h>

#define DI __device__ __forceinline__
typedef unsigned short bf16_t;
typedef short bf16x8 __attribute__((ext_vector_type(8)));
typedef short bf16x4 __attribute__((ext_vector_type(4)));
typedef float f32x4 __attribute__((ext_vector_type(4)));

namespace {
constexpr int D = 1024, NB = 8, SEQ = 4096, NCTX = 256;
constexpr int MC = NB * NCTX, ML = NB * SEQ, MT = MC + ML;
constexpr int INW = 2592, INWP = 2816;
constexpr int NE = 256, NE1 = 257;
constexpr int NTHR = 512;
constexpr int LDS_BYTES = 152 * 1024;
constexpr int CAP = MT;
constexpr int NSLOT = 68;
constexpr float EPS = 1e-6f;

struct P {
  const float *x, *c, *ctx, *c_ctx, *w_mod, *b_mod, *g_mix, *w_in, *rpb, *w_pool, *pool_scale,
      *w_gate_f, *b_gate_f, *w_gate_b, *b_gate_b, *g_gla, *w_out, *g_ffn, *w_router, *b_router,
      *w_e_in, *w_e_down, *w_sh_in, *w_sh_down, *g_final;
  float* out;
  char* ws;
};

constexpr size_t al256(size_t x) { return (x + 255) & ~(size_t)255; }
constexpr size_t OFF_BAR = 0;
constexpr size_t OFF_CNT = OFF_BAR + 16384;
constexpr size_t ZERO_BYTES = 16384 + 4096;
constexpr size_t OFF_MOD = OFF_CNT + 4096;
constexpr size_t OFF_ROPE = OFF_MOD + al256((size_t)2 * 9 * 6144 * 4);
constexpr size_t OFF_GMIX = OFF_ROPE + al256(64 * 8 * 2 * 4);
constexpr size_t OFF_GFFN = OFF_GMIX + al256(2 * 1024 * 4);
constexpr size_t OFF_GFINAL = OFF_GFFN + al256(2 * 1024 * 4);
constexpr size_t OFF_RPB = OFF_GFINAL + al256(1024 * 4);
constexpr size_t OFF_WPOOL = OFF_RPB + al256(2 * 3720 * 4);
constexpr size_t OFF_PSCALE = OFF_WPOOL + al256(2 * 4 * 4096 * 4);
constexpr size_t OFF_WGF = OFF_PSCALE + al256(2 * 256 * 4);
constexpr size_t OFF_WGB = OFF_WGF + al256(2 * 16 * 128 * 4);
constexpr size_t OFF_BGF = OFF_WGB + al256(2 * 16 * 128 * 4);
constexpr size_t OFF_BGB = OFF_BGF + al256(2 * 128 * 4);
constexpr size_t OFF_GGLA = OFF_BGB + al256(2 * 128 * 4);
constexpr size_t OFF_BROUTER = OFF_GGLA + al256(2 * 64 * 4);
constexpr size_t OFF_WIN = OFF_BROUTER + al256(2 * 256 * 4);
constexpr size_t OFF_WOUT = OFF_WIN + al256((size_t)2 * INWP * 1024 * 2);
constexpr size_t OFF_WR = OFF_WOUT + al256((size_t)2 * 1024 * 1024 * 2);
constexpr size_t OFF_WEI = OFF_WR + al256((size_t)2 * 256 * 1024 * 2);
constexpr size_t OFF_WED = OFF_WEI + al256((size_t)2 * NE1 * 512 * 1024 * 2);
constexpr size_t OFF_H = OFF_WED + al256((size_t)2 * NE1 * 1024 * 256 * 2);
constexpr size_t OFF_CAT = OFF_H + al256((size_t)MT * D * 2);
constexpr size_t OFF_H2 = OFF_CAT + al256((size_t)MT * D * 2);
constexpr size_t OFF_PX = OFF_H2 + al256((size_t)MT * D * 2);
constexpr size_t OFF_ACT = OFF_PX + al256((size_t)MT * INW * 2);
constexpr size_t OFF_Y = OFF_ACT + al256((size_t)9 * MT * 256 * 2);
constexpr size_t OFF_XRES = OFF_Y + al256((size_t)9 * MT * D * 2);
constexpr size_t OFF_LOGITS = OFF_XRES + al256((size_t)MT * D * 4);
constexpr size_t OFF_WTS = OFF_LOGITS + al256((size_t)MT * 256 * 4);
constexpr size_t OFF_GKV = OFF_WTS + al256((size_t)MT * 8 * 4);
constexpr size_t OFF_GDEC = OFF_GKV + al256((size_t)NB * 4 * NSLOT * 2 * 2048 * 4);
constexpr size_t OFF_GSIN = OFF_GDEC + al256((size_t)NB * 4 * NSLOT * 2 * 32 * 4);
constexpr size_t OFF_LISTS = OFF_GSIN + al256((size_t)NB * 4 * NSLOT * 2 * 2048 * 4);
constexpr size_t OFF_QH = OFF_LISTS + al256((size_t)NE * CAP * 4);
constexpr size_t HM_LAT = (size_t)NB * 8 * NCTX * 64;
constexpr size_t HM_ELEMS = (size_t)NB * 8 * (NCTX + SEQ) * 64;
constexpr size_t OFF_KH = OFF_QH + al256(HM_ELEMS * 2);
constexpr size_t OFF_VT = OFF_KH + al256(HM_ELEMS * 2);
constexpr size_t HMG_LAT = (size_t)NB * 4 * 64 * NCTX;
constexpr size_t HMG_ELEMS = (size_t)NB * 4 * 64 * (NCTX + SEQ);
constexpr size_t OFF_VTG = OFF_VT + al256(HM_ELEMS * 2);
constexpr size_t OFF_GQK = OFF_VTG + al256(HMG_ELEMS * 2);
constexpr size_t OFF_WPT = OFF_GQK + al256((size_t)NB * 4 * NSLOT * 2 * 2 * 2048 * 2);
constexpr size_t OFF_H2Q = OFF_WPT + al256((size_t)2 * 4 * 4096 * 2);
constexpr size_t WS_TOTAL = OFF_H2Q + al256((size_t)MT * 1024);

struct W {
  char* ws; float* out; const float* x; const float* ctx;
#define WF(T, name, OFF) DI T* name() const { return (T*)(ws + OFF); }
  WF(unsigned, bar, OFF_BAR) WF(int, cnt, OFF_CNT) WF(float, mod, OFF_MOD) WF(float, rope, OFF_ROPE)
  WF(float, g_mix, OFF_GMIX) WF(float, g_ffn, OFF_GFFN) WF(float, g_final, OFF_GFINAL) WF(float, rpb, OFF_RPB)
  WF(float, w_pool, OFF_WPOOL) WF(float, pool_scale, OFF_PSCALE) WF(float, w_gate_f, OFF_WGF) WF(float, w_gate_b, OFF_WGB)
  WF(float, b_gate_f, OFF_BGF) WF(float, b_gate_b, OFF_BGB) WF(float, g_gla, OFF_GGLA) WF(float, b_router, OFF_BROUTER)
  WF(bf16_t, win_t, OFF_WIN) WF(bf16_t, wout_t, OFF_WOUT) WF(bf16_t, wr_t, OFF_WR) WF(bf16_t, wei_t, OFF_WEI) WF(bf16_t, wed_t, OFF_WED)
  WF(bf16_t, h, OFF_H) WF(bf16_t, cat, OFF_CAT) WF(bf16_t, h2, OFF_H2) WF(bf16_t, px, OFF_PX) WF(bf16_t, act, OFF_ACT) WF(bf16_t, y, OFF_Y)
  WF(bf16_t, xres, OFF_XRES) WF(float, logits, OFF_LOGITS) WF(float, wts, OFF_WTS) WF(float, gkv, OFF_GKV) WF(float, gdec, OFF_GDEC)
  WF(float, gsin, OFF_GSIN) WF(int, lists, OFF_LISTS) WF(bf16_t, qh, OFF_QH) WF(bf16_t, kh, OFF_KH) WF(bf16_t, vt, OFF_VT) WF(bf16_t, vtg, OFF_VTG) WF(bf16_t, gqk, OFF_GQK) WF(bf16_t, wpt, OFF_WPT) WF(unsigned char, h2q, OFF_H2Q)
#undef WF
};

DI float bf2f(bf16_t v) { return __uint_as_float(((unsigned)v) << 16); }
DI bf16_t f2bf(float f) { unsigned u = __float_as_uint(f); u += 0x7fffu + ((u >> 16) & 1u); return (bf16_t)(u >> 16); }
typedef float f32x2v __attribute__((ext_vector_type(2)));
typedef __bf16 bf16x2v __attribute__((ext_vector_type(2)));
DI unsigned pack2(float lo, float hi) {
  const f32x2v v = {lo, hi};
  return __builtin_bit_cast(unsigned, __builtin_convertvector(v, bf16x2v));
}
DI int pack_fp8x4(float a, float b, float c, float d) {
  a = __builtin_amdgcn_fmed3f(a, -440.f, 440.f); b = __builtin_amdgcn_fmed3f(b, -440.f, 440.f);
  c = __builtin_amdgcn_fmed3f(c, -440.f, 440.f); d = __builtin_amdgcn_fmed3f(d, -440.f, 440.f);
  int w = __builtin_amdgcn_cvt_pk_fp8_f32(a, b, 0, false);
  return __builtin_amdgcn_cvt_pk_fp8_f32(c, d, w, true);
}
DI float4 unpack4(uint2 v) { return make_float4(__uint_as_float(v.x << 16), __uint_as_float(v.x & 0xffff0000u), __uint_as_float(v.y << 16), __uint_as_float(v.y & 0xffff0000u)); }
DI float wave_sum(float v) { for (int o = 32; o; o >>= 1) v += __shfl_xor(v, o); return v; }
DI float wave_max(float v) { for (int o = 32; o; o >>= 1) v = fmaxf(v, __shfl_xor(v, o)); return v; }
template <int CTRL> DI float dppf(float v) { return __int_as_float(__builtin_amdgcn_update_dpp(__float_as_int(v), __float_as_int(v), CTRL, 0xf, 0xf, false)); }
DI float rlanef(float v, int l) { return __int_as_float(__builtin_amdgcn_readlane(__float_as_int(v), l)); }
DI float wave_max_dpp(float v) {
  v = fmaxf(v, dppf<0xB1>(v));
  v = fmaxf(v, dppf<0x4E>(v));
  v = fmaxf(v, dppf<0x141>(v));
  v = fmaxf(v, dppf<0x140>(v));
  return fmaxf(fmaxf(rlanef(v, 0), rlanef(v, 16)), fmaxf(rlanef(v, 32), rlanef(v, 48)));
}
DI int otid() { int t = threadIdx.x; asm volatile("" : "+v"(t)); return t; }
DI float sigmoidf_(float x) { return 1.f / (1.f + __expf(-x)); }
DI float siluf_(float x) { return x / (1.f + __expf(-x)); }
DI int vbid_of(int bid, int nblk) { (void)nblk; return bid; }
DI int mod_row(int row) { return row < MC ? 8 : ((row - MC) >> 12); }

typedef __attribute__((address_space(1))) char gchar;
typedef __attribute__((address_space(1))) float gfloat;
DI W oq(const W& w) {
  unsigned long long v = (unsigned long long)w.ws;
  asm volatile("" : "+s"(v));
  W r; r.ws = (char*)(gchar*)v; r.out = w.out; r.x = w.x; r.ctx = w.ctx;
  return r;
}

struct NoHook { DI void operator()() const {} };
template <int WM, int WN, int MI, int NI, int BK, int NS, bool SWAP, int NCH, int FLAGS = 0, class FA, class FB, class EPI, class HK = NoHook>
DI void gemm_tile(char* lds, int nk, size_t bstride, size_t bks, FA rowA, FB rowB, EPI epi, const char* ares = nullptr, HK hook = HK()) {
  constexpr int BM = WM * MI * 16, BN = WN * NI * 16;
  constexpr int RB = BK * 2, CPR = RB / 16, RPP = 1024 / RB;
  constexpr bool ARES = (FLAGS & 1) != 0;
  constexpr int PA = ARES ? 0 : BM / RPP / 8, PB = BN / RPP / 8, NP = PA + PB, BOFF = ARES ? 0 : BM * RB, STG = BOFF + BN * RB, KS = BK / 32;
  static_assert(WM * WN == 8, "8 waves");
  static_assert(BK == 32 || BK == 64, "BK");
  const int tid = otid(), wid = tid >> 6, lane = tid & 63, fr = lane & 15, fq = lane >> 4;
  const int wr = wid / WN, wc = wid % WN;
  const int lrow = lane / CPR, pc = lane % CPR;
  const bf16_t* ap[PA > 0 ? PA : 1];
  const bf16_t* bp[PB];
#pragma unroll
  for (int i = 0; i < PA; ++i) {
    const int r = (wid + 8 * i) * RPP + lrow;
    const int sw = BK == 64 ? ((r >> 1) & 7) : ((-(r >> 2)) & 3);
    ap[i] = rowA(r) + ((pc ^ sw) * 8);
  }
#pragma unroll
  for (int i = 0; i < PB; ++i) {
    const int r = (wid + 8 * i) * RPP + lrow;
    const int sw = BK == 64 ? ((r >> 1) & 7) : ((-(r >> 2)) & 3);
    bp[i] = rowB(r) + ((pc ^ sw) * 8);
  }
  char* ldst = lds + wid * 1024 + lane * 16;
  f32x4 acc[MI][NI];
#pragma unroll
  for (int mi = 0; mi < MI; ++mi)
#pragma unroll
    for (int ni = 0; ni < NI; ++ni) acc[mi][ni] = (f32x4){0.f, 0.f, 0.f, 0.f};
  const int swf = BK == 64 ? (fr >> 1) : ((-(fr >> 2)) & 3);
  const int aoff = (wr * MI * 16 + fr) * RB + ((fq ^ swf) * 16);
  const int boff = BOFF + (wc * NI * 16 + fr) * RB + ((fq ^ swf) * 16);
#define GEMM_STAGE(s, t)                                                                                              \
  do {                                                                                                                \
    const int kt_ = NCH == 1 ? (t) : (t) % nk;                                                                        \
    const size_t bo_ = NCH == 1 ? (size_t)0 : (size_t)((t) / nk) * bstride;                                           \
    _Pragma("unroll") for (int i = 0; i < PA; ++i) __builtin_amdgcn_global_load_lds(                                  \
        (const unsigned*)(ap[i] + kt_ * BK), (unsigned*)(ldst + (s) * STG + i * 8192), 16, 0, 0);                     \
    _Pragma("unroll") for (int i = 0; i < PB; ++i) __builtin_amdgcn_global_load_lds(                                  \
        (const unsigned*)(bp[i] + bo_ + kt_ * bks), (unsigned*)(ldst + (s) * STG + BOFF + i * 8192), 16, 0, 0);      \
  } while (0)
  const int ntile = NCH * nk;
  if constexpr ((FLAGS & 64) == 0) {
#pragma unroll
    for (int s = 0; s < NS - 1; ++s)
      if (s < ntile) GEMM_STAGE(s, s);
  }
  int slot = 0, nslot = NS - 1;
  int kin = 0, chunk = 0;
#pragma nounroll
  for (int kt = 0; kt < ntile; ++kt) {
    if constexpr ((FLAGS & 32) != 0) {
      static_assert(NS == 2 && NCH > 1, "store-aware wait: 2-slot ring, chunked stream");
      if (kin == 0 && kt > 0) asm volatile("s_waitcnt vmcnt(8)" ::: "memory");
      else asm volatile("s_waitcnt vmcnt(0)" ::: "memory");
    } else {
      if (kt + NS - 2 < ntile) asm volatile("s_waitcnt vmcnt(%0)" ::"n"((NS - 2) * NP) : "memory");
      else asm volatile("s_waitcnt vmcnt(0)" ::: "memory");
    }
    __builtin_amdgcn_s_barrier();
    asm volatile("" ::: "memory");
    if (kt + NS - 1 < ntile) GEMM_STAGE(nslot, kt + NS - 1);
    if (kt == ntile - 1) hook();
    const char* sb = lds + slot * STG;
    const char* sa = ARES ? ares + (NCH == 1 ? kt : kin) * (BM * RB) : sb;
    slot = slot + 1 == NS ? 0 : slot + 1;
    nslot = nslot + 1 == NS ? 0 : nslot + 1;
    if constexpr ((FLAGS & 4) != 0) {
      static_assert(BK == 64 && NI % 4 == 0, "fp8 path: 128-byte rows, column tiles in groups of 4");
      typedef int i32x4v __attribute__((ext_vector_type(4)));
      typedef int i32x8v __attribute__((ext_vector_type(8)));
      constexpr int ASC = (FLAGS & 8) ? 0x7b7b7b7b : (FLAGS & 16) ? 0x7c7c7c7c : 0x7f7f7f7f;
      i32x4v a0[MI], a1[MI];
#pragma unroll
      for (int mi = 0; mi < MI; ++mi) {
        a0[mi] = *(const i32x4v*)(sa + (aoff + mi * 16 * RB));
        a1[mi] = *(const i32x4v*)(sa + ((aoff ^ 64) + mi * 16 * RB));
      }
      constexpr int GW = NI > 4 ? 2 : 4, NG8 = NI / GW;
      i32x4v b0[2][GW], b1[2][GW];
#pragma unroll
      for (int nj = 0; nj < GW; ++nj) {
        b0[0][nj] = *(const i32x4v*)(sb + (boff + nj * 16 * RB));
        b1[0][nj] = *(const i32x4v*)(sb + ((boff ^ 64) + nj * 16 * RB));
      }
      __builtin_amdgcn_sched_group_barrier(0x100, 2 * MI + 2 * GW, 0);
#pragma unroll
      for (int g = 0; g < NG8; ++g) {
        const int cur = g & 1, nxt = cur ^ 1;
        if (g + 1 < NG8) {
#pragma unroll
          for (int nj = 0; nj < GW; ++nj) {
            b0[nxt][nj] = *(const i32x4v*)(sb + (boff + ((g + 1) * GW + nj) * 16 * RB));
            b1[nxt][nj] = *(const i32x4v*)(sb + ((boff ^ 64) + ((g + 1) * GW + nj) * 16 * RB));
          }
          __builtin_amdgcn_sched_group_barrier(0x100, 2 * GW, 0);
        }
#pragma unroll
        for (int mi = 0; mi < MI; ++mi)
#pragma unroll
          for (int nj = 0; nj < GW; ++nj) {
            const i32x8v av = __builtin_shufflevector(a0[mi], a1[mi], 0, 1, 2, 3, 4, 5, 6, 7);
            const i32x8v bv = __builtin_shufflevector(b0[cur][nj], b1[cur][nj], 0, 1, 2, 3, 4, 5, 6, 7);
            acc[mi][g * GW + nj] = SWAP ? __builtin_amdgcn_mfma_scale_f32_16x16x128_f8f6f4(av, bv, acc[mi][g * GW + nj], 0, 0, 0, ASC, 0, 0x79797979)
                                        : __builtin_amdgcn_mfma_scale_f32_16x16x128_f8f6f4(bv, av, acc[mi][g * GW + nj], 0, 0, 0, 0x79797979, 0, ASC);
          }
        __builtin_amdgcn_sched_group_barrier(0x008, MI * GW, 0);
      }
    } else {
    constexpr int NG = NI / 4, NGT = KS * NG;
    bf16x8 af[KS][MI], bfr[2][4];
#pragma unroll
    for (int mi = 0; mi < MI; ++mi) af[0][mi] = *(const bf16x8*)(sa + (aoff + mi * 16 * RB));
#pragma unroll
    for (int nj = 0; nj < 4; ++nj) bfr[0][nj] = *(const bf16x8*)(sb + (boff + nj * 16 * RB));
    __builtin_amdgcn_sched_group_barrier(0x100, MI + 4, 0);
#pragma unroll
    for (int gi = 0; gi < NGT; ++gi) {
      const int ks = gi / NG, g = gi % NG, cur = gi & 1, nxt = cur ^ 1;
      if (gi + 1 < NGT) {
        const int ks2 = (gi + 1) / NG, g2 = (gi + 1) % NG;
#pragma unroll
        for (int nj = 0; nj < 4; ++nj) bfr[nxt][nj] = *(const bf16x8*)(sb + ((boff ^ (ks2 * 64)) + (g2 * 4 + nj) * 16 * RB));
        if (ks2 != ks) {
#pragma unroll
          for (int mi = 0; mi < MI; ++mi) af[ks2 % KS][mi] = *(const bf16x8*)(sa + ((aoff ^ (ks2 * 64)) + mi * 16 * RB));
          __builtin_amdgcn_sched_group_barrier(0x100, MI + 4, 0);
        } else {
          __builtin_amdgcn_sched_group_barrier(0x100, 4, 0);
        }
      }
#pragma unroll
      for (int mi = 0; mi < MI; ++mi)
#pragma unroll
        for (int nj = 0; nj < 4; ++nj)
          acc[mi][g * 4 + nj] = SWAP ? __builtin_amdgcn_mfma_f32_16x16x32_bf16(af[ks][mi], bfr[cur][nj], acc[mi][g * 4 + nj], 0, 0, 0)
                                     : __builtin_amdgcn_mfma_f32_16x16x32_bf16(bfr[cur][nj], af[ks][mi], acc[mi][g * 4 + nj], 0, 0, 0);
      __builtin_amdgcn_sched_group_barrier(0x008, MI * 4, 0);
    }
    }
    if (NCH > 1) {
      if (++kin == nk) {
        kin = 0;
        epi(acc, chunk, wr, wc, fr, fq);
        ++chunk;
#pragma unroll
        for (int mi = 0; mi < MI; ++mi)
#pragma unroll
          for (int ni = 0; ni < NI; ++ni) acc[mi][ni] = (f32x4){0.f, 0.f, 0.f, 0.f};
      }
    }
  }
#undef GEMM_STAGE
  if (FLAGS & 2) __syncthreads();
  if (NCH == 1) epi(acc, 0, wr, wc, fr, fq);
  __syncthreads();
}


template <int BN, int NPRE, class FB>
DI void gemm_prestage_b(char* lds, size_t bks, FB rowB) {
  const int tid = otid(), wid = tid >> 6, lane = tid & 63;
  const int lrow = lane >> 3, pc = lane & 7;
  char* ldst = lds + wid * 1024 + lane * 16;
#pragma unroll
  for (int s = 0; s < NPRE; ++s)
#pragma unroll
    for (int i = 0; i < BN / 64; ++i) {
      const int r = (wid + 8 * i) * 8 + lrow;
      const bf16_t* bp = rowB(r) + ((pc ^ ((r >> 1) & 7)) * 8);
      __builtin_amdgcn_global_load_lds((const unsigned*)(bp + s * bks), (unsigned*)(ldst + s * (BN * 128) + i * 8192), 16, 0, 0);
    }
}

template <int WM, int WN, int MI, int NI, bool SWAP, bool NOSTAGE = false, class FA, class FB, class EPI>
DI void gemm_tile_stag(char* lds, int nk, size_t bks, FA rowA, FB rowB, EPI epi) {
  constexpr int BK = 32, BM = WM * MI * 16, BN = WN * NI * 16;
  constexpr int RB = BK * 2, CPR = RB / 16, RPP = 1024 / RB;
  constexpr int PA = BM / RPP / 8, PB = BN / RPP / 8, NP = PA + PB, STG = (BM + BN) * RB;
  const int tid = otid(), wid = tid >> 6, lane = tid & 63, fr = lane & 15, fq = lane >> 4;
  const int wr = wid / WN, wc = wid % WN;
  const int lrow = lane / CPR, pc = lane % CPR;
  const bf16_t* ap[PA];
  const bf16_t* bp[PB];
#pragma unroll
  for (int i = 0; i < PA; ++i) { const int r = (wid + 8 * i) * RPP + lrow; ap[i] = rowA(r) + ((pc ^ ((-(r >> 2)) & 3)) * 8); }
#pragma unroll
  for (int i = 0; i < PB; ++i) { const int r = (wid + 8 * i) * RPP + lrow; bp[i] = rowB(r) + ((pc ^ ((-(r >> 2)) & 3)) * 8); }
  char* ldst = lds + wid * 1024 + lane * 16;
  f32x4 acc[MI][NI];
#pragma unroll
  for (int mi = 0; mi < MI; ++mi)
#pragma unroll
    for (int ni = 0; ni < NI; ++ni) acc[mi][ni] = (f32x4){0.f, 0.f, 0.f, 0.f};
  const int swf = (-(fr >> 2)) & 3;
  const int aoff = (wr * MI * 16 + fr) * RB + ((fq ^ swf) * 16);
  const int boff = BM * RB + (wc * NI * 16 + fr) * RB + ((fq ^ swf) * 16);
#define STAG_STAGE(s, t)                                                                                              \
  do {                                                                                                                \
    _Pragma("unroll") for (int i = 0; i < PA; ++i) __builtin_amdgcn_global_load_lds(                                  \
        (const unsigned*)(ap[i] + (t) * BK), (unsigned*)(ldst + (s) * STG + i * 8192), 16, 0, 0);                     \
    _Pragma("unroll") for (int i = 0; i < PB; ++i) __builtin_amdgcn_global_load_lds(                                  \
        (const unsigned*)(bp[i] + (t) * bks), (unsigned*)(ldst + (s) * STG + BM * RB + i * 8192), 16, 0, 0);          \
  } while (0)
  const int hb = __builtin_amdgcn_readfirstlane(wid >> 2);
  STAG_STAGE(0, 0);
  if (1 < nk) { STAG_STAGE(1, 1); asm volatile("s_waitcnt vmcnt(%0)" ::"n"(NP) : "memory"); }
  else asm volatile("s_waitcnt vmcnt(0)" ::: "memory");
  __builtin_amdgcn_s_barrier();
  asm volatile("" ::: "memory");
  if (hb) { __builtin_amdgcn_s_barrier(); asm volatile("" ::: "memory"); }
  for (int kt = 0; kt < nk; ++kt) {
    const char* sb = lds + (kt & 3) * STG;
    bf16x8 af[MI], bfr[NI];
#pragma unroll
    for (int mi = 0; mi < MI; ++mi) af[mi] = *(const bf16x8*)(sb + (aoff + mi * 16 * RB));
#pragma unroll
    for (int ni = 0; ni < NI; ++ni) bfr[ni] = *(const bf16x8*)(sb + (boff + ni * 16 * RB));
    if (!NOSTAGE && kt + 2 < nk) STAG_STAGE((kt + 2) & 3, kt + 2);
    if (hb) {
      if (kt + 2 < nk) asm volatile("s_waitcnt vmcnt(%0)" ::"n"(NP) : "memory");
      else asm volatile("s_waitcnt vmcnt(0)" ::: "memory");
    }
    __builtin_amdgcn_s_barrier();
    asm volatile("" ::: "memory");
    __builtin_amdgcn_s_setprio(1);
#pragma unroll
    for (int mi = 0; mi < MI; ++mi)
#pragma unroll
      for (int ni = 0; ni < NI; ++ni)
        acc[mi][ni] = SWAP ? __builtin_amdgcn_mfma_f32_16x16x32_bf16(af[mi], bfr[ni], acc[mi][ni], 0, 0, 0)
                           : __builtin_amdgcn_mfma_f32_16x16x32_bf16(bfr[ni], af[mi], acc[mi][ni], 0, 0, 0);
    __builtin_amdgcn_s_setprio(0);
    if (!hb) {
      if (kt + 2 < nk) asm volatile("s_waitcnt vmcnt(%0)" ::"n"(NP) : "memory");
      else asm volatile("s_waitcnt vmcnt(0)" ::: "memory");
    }
    __builtin_amdgcn_s_barrier();
    asm volatile("" ::: "memory");
  }
  if (!hb) { __builtin_amdgcn_s_barrier(); asm volatile("" ::: "memory"); }
#undef STAG_STAGE
  epi(acc, 0, wr, wc, fr, fq);
  __syncthreads();
}

struct ConvT { const float* src; bf16_t* dst; int ldn, N, K, k0, n0, bkl, npad, f8; };
DI ConvT conv_desc(const P& q, int tile) {
  constexpr int nA = 2 * 257 * 128, nB = 2 * 257 * 64, nC = 2 * 16 * 44, nD = 2 * 16 * 16;
  const W w{q.ws, q.out};
  ConvT c;
  c.f8 = 0;
  int t = tile;
  if (t < nA) {
    const int m = t / 128, r = t % 128, l = m / 257, e = m % 257;
    c.src = e < 256 ? q.w_e_in + (size_t)(l * 256 + e) * 1024 * 512 : q.w_sh_in + (size_t)l * 1024 * 512;
    c.dst = (bf16_t*)((char*)w.wei_t() + (size_t)m * 512 * 1024); c.ldn = 512; c.N = 512; c.K = 1024; c.bkl = 128; c.npad = 512; c.k0 = (r / 8) * 64; c.n0 = (r % 8) * 64; c.f8 = 1;
    return c;
  }
  t -= nA;
  if (t < nB) {
    const int m = t / 64, r = t % 64, l = m / 257, e = m % 257;
    c.src = e < 256 ? q.w_e_down + (size_t)(l * 256 + e) * 256 * 1024 : q.w_sh_down + (size_t)l * 256 * 1024;
    c.dst = (bf16_t*)((char*)w.wed_t() + (size_t)m * 1024 * 256); c.ldn = 1024; c.N = 1024; c.K = 256; c.bkl = 128; c.npad = 1024; c.k0 = (r / 16) * 64; c.n0 = (r % 16) * 64; c.f8 = 1;
    return c;
  }
  t -= nB;
  if (t < nC) {
    const int l = t / 704, r = t % 704;
    c.src = q.w_in + (size_t)l * 1024 * INW; c.dst = (bf16_t*)((char*)w.win_t() + (size_t)l * INWP * 1024); c.ldn = INW; c.N = INW; c.K = 1024; c.bkl = 128; c.npad = INWP; c.f8 = 1;
    c.k0 = (r / 44) * 64; c.n0 = (r % 44) * 64;
    return c;
  }
  t -= nC;
  if (t < nD) {
    const int l = t / 256, r = t % 256;
    c.src = q.w_out + (size_t)l * 1024 * 1024; c.dst = (bf16_t*)((char*)w.wout_t() + (size_t)l * 1024 * 1024); c.ldn = 1024; c.N = 1024; c.K = 1024; c.bkl = 128; c.npad = 1024; c.f8 = 1;
    c.k0 = (r / 16) * 64; c.n0 = (r % 16) * 64;
    return c;
  }
  t -= nD;
  {
    const int l = t / 64, r = t % 64;
    c.src = q.w_router + (size_t)l * 1024 * 256; c.dst = w.wr_t() + (size_t)l * 256 * 1024; c.ldn = 256; c.N = 256; c.K = 1024; c.bkl = 32; c.npad = 256;
    c.k0 = (r / 4) * 64; c.n0 = (r % 4) * 64;
  }
  return c;
}

DI void conv_store(const ConvT& c, uint4 v, int rn, int rks) {
  const int kk = c.k0 + rks * 2;
  if (c.f8) {
    const float4 lo = unpack4(make_uint2(v.x, v.y)), hi = unpack4(make_uint2(v.z, v.w));
    const int w0 = pack_fp8x4(lo.x * 64.f, lo.y * 64.f, lo.z * 64.f, lo.w * 64.f);
    const int w1 = pack_fp8x4(hi.x * 64.f, hi.y * 64.f, hi.z * 64.f, hi.w * 64.f);
    char* d8 = (char*)c.dst + (size_t)(kk / c.bkl) * c.npad * c.bkl + (size_t)(c.n0 + rn) * c.bkl + (kk % c.bkl);
    *(uint2*)d8 = make_uint2((unsigned)w0, (unsigned)w1);
  } else {
    *(uint4*)(c.dst + (size_t)(kk / c.bkl) * c.npad * c.bkl + (size_t)(c.n0 + rn) * c.bkl + (kk % c.bkl)) = v;
  }
}

DI void conv_fetch(const P& q, int tile, int nblk, int total, int kp, int ns, float4& a0, float4& b0, float4& a1, float4& b1) {
  const ConvT c0 = conv_desc(q, min(tile, total - 1));
  const ConvT c1 = conv_desc(q, min(tile + nblk, total - 1));
  const int col0 = min(c0.n0 + ns, c0.N - 4), col1 = min(c1.n0 + ns, c1.N - 4);
  a0 = *(const float4*)(c0.src + (size_t)(c0.k0 + 2 * kp) * c0.ldn + col0);
  b0 = *(const float4*)(c0.src + (size_t)(c0.k0 + 2 * kp + 1) * c0.ldn + col0);
  a1 = *(const float4*)(c1.src + (size_t)(c1.k0 + 2 * kp) * c1.ldn + col1);
  b1 = *(const float4*)(c1.src + (size_t)(c1.k0 + 2 * kp + 1) * c1.ldn + col1);
}

DI void phase_convert(const P& q, char* lds, int bid, int nblk) {
  constexpr int total = 2 * 257 * 128 + 2 * 257 * 64 + 2 * 16 * 44 + 2 * 16 * 16 + 2 * 16 * 4;
  const int t = otid();
  const int kp = t >> 4, ns = (t & 15) * 4, rn = t >> 3, rks = (t & 7) * 4;
  int par = 0;
  auto process = [&](int tile, const float4& a0, const float4& b0, const float4& a1, const float4& b1) {
    const bool two = tile + 1 < total;
    const ConvT c0 = conv_desc(q, tile);
    const ConvT c1 = conv_desc(q, two ? tile + 1 : tile);
    unsigned* T0 = (unsigned*)lds + par * (2 * 64 * 33);
    unsigned* T1 = T0 + 64 * 33;
    par ^= 1;
    const unsigned k0m = c0.n0 + ns < c0.N ? 0xffffffffu : 0u, k1m = c1.n0 + ns < c1.N ? 0xffffffffu : 0u;
    T0[(ns + 0) * 33 + kp] = pack2(a0.x, b0.x) & k0m; T0[(ns + 1) * 33 + kp] = pack2(a0.y, b0.y) & k0m;
    T0[(ns + 2) * 33 + kp] = pack2(a0.z, b0.z) & k0m; T0[(ns + 3) * 33 + kp] = pack2(a0.w, b0.w) & k0m;
    T1[(ns + 0) * 33 + kp] = pack2(a1.x, b1.x) & k1m; T1[(ns + 1) * 33 + kp] = pack2(a1.y, b1.y) & k1m;
    T1[(ns + 2) * 33 + kp] = pack2(a1.z, b1.z) & k1m; T1[(ns + 3) * 33 + kp] = pack2(a1.w, b1.w) & k1m;
    __syncthreads();
    uint4 v;
    v.x = T0[rn * 33 + rks]; v.y = T0[rn * 33 + rks + 1]; v.z = T0[rn * 33 + rks + 2]; v.w = T0[rn * 33 + rks + 3];
    conv_store(c0, v, rn, rks);
    if (two) {
      v.x = T1[rn * 33 + rks]; v.y = T1[rn * 33 + rks + 1]; v.z = T1[rn * 33 + rks + 2]; v.w = T1[rn * 33 + rks + 3];
      conv_store(c1, v, rn, rks);
    }
  };
  float4 a0, b0, a1, b1, na0, nb0, na1, nb1, ma0, mb0, ma1, mb1;
  const int step = 2 * nblk;
  conv_fetch(q, 2 * bid, 1, total, kp, ns, a0, b0, a1, b1);
  conv_fetch(q, 2 * bid + step, 1, total, kp, ns, na0, nb0, na1, nb1);
  for (int tile = 2 * bid; tile < total; tile += 3 * step) {
    conv_fetch(q, tile + 2 * step, 1, total, kp, ns, ma0, mb0, ma1, mb1);
    process(tile, a0, b0, a1, b1);
    if (tile + step >= total) break;
    conv_fetch(q, tile + 3 * step, 1, total, kp, ns, a0, b0, a1, b1);
    process(tile + step, na0, nb0, na1, nb1);
    if (tile + 2 * step >= total) break;
    conv_fetch(q, tile + 4 * step, 1, total, kp, ns, na0, nb0, na1, nb1);
    process(tile + 2 * step, ma0, mb0, ma1, mb1);
  }
  __syncthreads();
}

DI void phase_mod(const P& q, char* lds, int bid, int nblk) {
  float* sc = (float*)lds;
  float* red = sc + 9 * 1024;
  const int t = otid();
  for (int i = t; i < 9 * 1024; i += NTHR) {
    const int r = i >> 10, k = i & 1023;
    const float v = r < 8 ? q.c[r * 1024 + k] : q.c_ctx[k];
    sc[i] = siluf_(v);
  }
  __syncthreads();
  for (int u = bid; u < 2 * 96; u += nblk) {
    const int l = u / 96, n0 = (u % 96) * 64;
    const int col = t & 63, ksl = t >> 6;
    float a[9];
#pragma unroll
    for (int r = 0; r < 9; ++r) a[r] = 0.f;
    const float* w = q.w_mod + (size_t)l * 1024 * 6144 + n0 + col;
    for (int k = ksl * 128; k < ksl * 128 + 128; ++k) {
      const float wv = w[(size_t)k * 6144];
#pragma unroll
      for (int r = 0; r < 9; ++r) a[r] += sc[r * 1024 + k] * wv;
    }
#pragma unroll
    for (int r = 0; r < 9; ++r) red[(ksl * 9 + r) * 64 + col] = a[r];
    __syncthreads();
    for (int i = t; i < 9 * 64; i += NTHR) {
      const int r = i >> 6, cc = i & 63;
      float s = q.b_mod[l * 6144 + n0 + cc];
#pragma unroll
      for (int q = 0; q < 8; ++q) s += red[(q * 9 + r) * 64 + cc];
      ((W{q.ws, q.out, q.x, q.ctx}).mod())[(size_t)(l * 9 + r) * 6144 + n0 + cc] = s;
    }
    __syncthreads();
  }
  {
    const W w{q.ws, q.out};
    const int gt = bid * NTHR + t, gs = nblk * NTHR;
#define CPY(dst, srcp, n) for (int i = gt; i < (n); i += gs) (dst)[i] = (srcp)[i]
    CPY(w.g_mix(), q.g_mix, 2 * 1024); CPY(w.g_ffn(), q.g_ffn, 2 * 1024); CPY(w.g_final(), q.g_final, 1024);
    CPY(w.rpb(), q.rpb, 2 * 3720); CPY(w.w_pool(), q.w_pool, 2 * 4 * 4096); CPY(w.pool_scale(), q.pool_scale, 2 * 256);
    CPY(w.w_gate_f(), q.w_gate_f, 2 * 16 * 128); CPY(w.w_gate_b(), q.w_gate_b, 2 * 16 * 128);
    CPY(w.b_gate_f(), q.b_gate_f, 2 * 128); CPY(w.b_gate_b(), q.b_gate_b, 2 * 128);
    CPY(w.g_gla(), q.g_gla, 2 * 64); CPY(w.b_router(), q.b_router, 2 * 256);
#undef CPY
    for (int i = gt; i < 2 * 4 * 4096; i += gs) { const int lg = i >> 12, jj = (i >> 6) & 63, ii = i & 63; w.wpt()[i] = f2bf(q.w_pool[lg * 4096 + ii * 64 + jj]); }
  }
  if (bid == 0) {
    for (int i = t; i < 64 * 8; i += NTHR) {
      const int pos = i >> 3, j = i & 7;
      const float inv = powf(10000.f, -(float)j / 8.f);
      const float ang = (float)pos * inv;
      ((W{q.ws, q.out, q.x, q.ctx}).rope())[i * 2] = cosf(ang);
      ((W{q.ws, q.out, q.x, q.ctx}).rope())[i * 2 + 1] = sinf(ang);
    }
  }
}

DI void phase_norm0(const P& q, int bid, int nblk) {
  const W p{q.ws, q.out};
  const int wid = otid() >> 6, lane = otid() & 63;
  for (int row = bid * 8 + wid; row < MT; row += nblk * 8) {
    const float* src = row < MC ? q.ctx + (size_t)row * D : q.x + (size_t)(row - MC) * D;
    const float* m = p.mod() + (size_t)(mod_row(row)) * 6144;
    float4 v[4];
    float ss = 0.f;
#pragma unroll
    for (int i = 0; i < 4; ++i) {
      v[i] = *(const float4*)(src + i * 256 + lane * 4);
      ss += v[i].x * v[i].x + v[i].y * v[i].y + v[i].z * v[i].z + v[i].w * v[i].w;
    }
    ss = wave_sum(ss);
    const float rstd = rsqrtf(ss * (1.f / D) + EPS);
#pragma unroll
    for (int i = 0; i < 4; ++i) {
      const int cidx = i * 256 + lane * 4;
      const float4 gg = *(const float4*)(q.g_mix + cidx);
      const float4 sh = *(const float4*)(m + cidx);
      const float4 scl = *(const float4*)(m + 1024 + cidx);
      const float o0 = v[i].x * rstd * gg.x * (1.f + scl.x) + sh.x;
      const float o1 = v[i].y * rstd * gg.y * (1.f + scl.y) + sh.y;
      const float o2 = v[i].z * rstd * gg.z * (1.f + scl.z) + sh.z;
      const float o3 = v[i].w * rstd * gg.w * (1.f + scl.w) + sh.w;
      const int q8 = pack_fp8x4(o0, o1, o2, o3);
      *(int*)((char*)p.h() + (size_t)row * D + cidx) = q8;
    }
  }
}

DI void phase_norm(const W& p_, int layer, int row_lo, int bid, int nblk) {
  const W p = oq(p_);
  const int wid = otid() >> 6, lane = otid() & 63;
  const float* g = p.g_ffn() + layer * D;
  for (int row = row_lo + bid * 8 + wid; row < MT; row += nblk * 8) {
    const bf16_t* src = p.xres() + (size_t)row * D;
    const float* m = p.mod() + (size_t)(layer * 9 + mod_row(row)) * 6144 + 3072;
    float4 v[4];
    float ss = 0.f;
#pragma unroll
    for (int i = 0; i < 4; ++i) {
      v[i] = unpack4(*(const uint2*)(src + i * 256 + lane * 4));
      ss += v[i].x * v[i].x + v[i].y * v[i].y + v[i].z * v[i].z + v[i].w * v[i].w;
    }
    ss = wave_sum(ss);
    const float rstd = rsqrtf(ss * (1.f / D) + EPS);
#pragma unroll
    for (int i = 0; i < 4; ++i) {
      const int cidx = i * 256 + lane * 4;
      const float4 gg = *(const float4*)(g + cidx);
      const float4 sh = *(const float4*)(m + cidx);
      const float4 scl = *(const float4*)(m + 1024 + cidx);
      const float o0 = v[i].x * rstd * gg.x * (1.f + scl.x) + sh.x;
      const float o1 = v[i].y * rstd * gg.y * (1.f + scl.y) + sh.y;
      const float o2 = v[i].z * rstd * gg.z * (1.f + scl.z) + sh.z;
      const float o3 = v[i].w * rstd * gg.w * (1.f + scl.w) + sh.w;
      uint2 o; o.x = pack2(o0, o1); o.y = pack2(o2, o3);
      *(uint2*)(p.h2() + (size_t)row * D + cidx) = o;
      {
        const int q8 = pack_fp8x4(o0, o1, o2, o3);
        *(int*)(p.h2q() + (size_t)row * D + cidx) = q8;
      }
    }
  }
}

DI size_t hm_off(int row, int h) {
  if (row < MC) return ((size_t)(((row >> 8) * 8 + h) * NCTX + (row & 255))) * 64;
  const int r = row - MC;
  return HM_LAT + ((size_t)(((r >> 12) * 8 + h) * SEQ + (r & 4095))) * 64;
}
DI size_t vt_off(int row, int h, int d) {
  if (row < MC) { const int t = row & 255; return ((size_t)(((row >> 8) * 8 + h) * 4 + (t >> 6))) * 4096 + d * 64 + (t & 63); }
  const int r = row - MC, t = r & 4095;
  return HM_LAT + ((size_t)(((r >> 12) * 8 + h) * 64 + (t >> 6))) * 4096 + d * 64 + (t & 63);
}
DI size_t vtg_off(int row, int h, int v) {
  if (row < MC) { const int t = row & 255; return ((size_t)(((row >> 8) * 4 + h) * 4 + (t >> 6))) * 4096 + v * 64 + (t & 63); }
  const int r = row - MC, t = r & 4095;
  return HMG_LAT + ((size_t)(((r >> 12) * 4 + h) * 64 + (t >> 6))) * 4096 + v * 64 + (t & 63);
}

DI void phase_inproj(const W& p_, int layer, char* lds, int bid, int nblk) {
  const W p = oq(p_);
  constexpr int nM = MT / 256, nN = INWP / 256;
  const char* B8 = (const char*)p.win_t() + (size_t)layer * INWP * 1024;
  for (int u = vbid_of(bid, nblk); u < nM * nN; u += nblk) {
    const int pm = u / nN, pn = u % nN, m0 = pm * 256, n0 = pn * 256;
    auto rowA = [&](int r) { return (const bf16_t*)((const char*)p.h() + (size_t)(m0 + r) * D); };
    auto rowB = [&](int r) { return (const bf16_t*)(B8 + (size_t)(n0 + r) * 128); };
    if (pn == 4 || pn == 5 || pn == 8) {
      auto rowAp = [&](int r) { return rowA((r & ~63) | ((r & 12) << 2) | ((r & 48) >> 2) | (r & 3)); };
      auto epi = [&](const f32x4 (&acc)[4][8], int, int wr, int wc, int fr, int fq) {
        const int row = m0 + wr * 64 + fq * 16;
#pragma unroll
        for (int ni = 0; ni < 8; ++ni) {
          uint4 lo, hi;
          lo.x = pack2(acc[0][ni][0], acc[0][ni][1]); lo.y = pack2(acc[0][ni][2], acc[0][ni][3]);
          lo.z = pack2(acc[1][ni][0], acc[1][ni][1]); lo.w = pack2(acc[1][ni][2], acc[1][ni][3]);
          hi.x = pack2(acc[2][ni][0], acc[2][ni][1]); hi.y = pack2(acc[2][ni][2], acc[2][ni][3]);
          hi.z = pack2(acc[3][ni][0], acc[3][ni][1]); hi.w = pack2(acc[3][ni][2], acc[3][ni][3]);
          bf16_t* dst;
          if (pn == 8) {
            const int col = wc * 128 + ni * 16 + fr;
            dst = p.vtg() + vtg_off(row, col >> 6, col & 63);
          } else {
            const int col = n0 + wc * 128 + ni * 16 + fr - 1024;
            dst = p.vt() + vt_off(row, col >> 6, col & 63);
          }
          *(uint4*)dst = lo; *(uint4*)(dst + 8) = hi;
        }
      };
      gemm_tile<4, 2, 4, 8, 64, 2, true, 1, 4>(lds, 8, 0, (size_t)INWP * 64, rowAp, rowB, epi);
    } else {
      auto rowBp = [&](int r) { return rowB((r & ~127) | ((r & 12) << 3) | ((r & 112) >> 2) | (r & 3)); };
      auto epi = [&](const f32x4 (&acc)[4][8], int, int wr, int wc, int fr, int fq) {
#pragma unroll
        for (int mi = 0; mi < 4; ++mi) {
          const int row = m0 + wr * 64 + mi * 16 + fr;
#pragma unroll
          for (int np = 0; np < 4; ++np) {
            const int col = n0 + wc * 128 + fq * 32 + np * 8;
            const f32x4 v0 = acc[mi][2 * np], v1 = acc[mi][2 * np + 1];
            if (pn < 2) {
              constexpr float QS = 0.125f * 1.4426950408889634f;
              uint4 o; o.x = pack2(v0[0] * QS, v0[1] * QS); o.y = pack2(v0[2] * QS, v0[3] * QS); o.z = pack2(v1[0] * QS, v1[1] * QS); o.w = pack2(v1[2] * QS, v1[3] * QS);
              *(uint4*)(p.qh() + hm_off(row, col >> 6) + (col & 63)) = o;
            } else if (pn < 4) {
              const int c2 = col - 512;
              uint4 o; o.x = pack2(v0[0], v0[1]); o.y = pack2(v0[2], v0[3]); o.z = pack2(v1[0], v1[1]); o.w = pack2(v1[2], v1[3]);
              *(uint4*)(p.kh() + hm_off(row, c2 >> 6) + (c2 & 63)) = o;
            } else if (col < INW) {
              uint4 o; o.x = pack2(v0[0], v0[1]); o.y = pack2(v0[2], v0[3]); o.z = pack2(v1[0], v1[1]); o.w = pack2(v1[2], v1[3]);
              *(uint4*)(p.px() + (size_t)row * INW + col) = o;
            }
          }
        }
      };
      gemm_tile<4, 2, 4, 8, 64, 2, false, 1, 4>(lds, 8, 0, (size_t)INWP * 64, rowA, rowBp, epi);
    }
  }
}


#ifndef PROBE_GEMM
#define PROBE_GEMM 0
#endif
#if PROBE_GEMM
DI void phase_probe_gemm(const W& p_, char* lds, int bid, int nblk) {
  const W p = oq(p_);
  constexpr int nM = MT / 256, nN = INWP / 256;
  const bf16_t* Bt = p.win_t();
  for (int u = bid; u < nM * nN; u += nblk) {
    const int pm = u / nN, pn = u % nN, m0 = pm * 256, n0 = pn * 256;
    auto rowA = [&](int r) { return p.h() + (size_t)(m0 + r) * D; };
    auto rowB = [&](int r) { return Bt + (size_t)(n0 + r) * 32; };
    auto epi = [&](const f32x4 (&acc)[4][8], int, int wr, int wc, int fr, int fq) {
#pragma unroll
      for (int mi = 0; mi < 4; ++mi) {
        const int row = m0 + wr * 64 + mi * 16 + fr;
#pragma unroll
        for (int ni = 0; ni < 8; ++ni) {
          const int col = n0 + wc * 128 + ni * 16 + 4 * fq;
          uint2 o; o.x = pack2(acc[mi][ni][0], acc[mi][ni][1]); o.y = pack2(acc[mi][ni][2], acc[mi][ni][3]);
          *(uint2*)(p.y() + (size_t)row * INWP + col) = o;
        }
      }
    };
#if PROBE_GEMM == 4
    gemm_tile_stag<4, 2, 4, 8, false, true>(lds, 32, (size_t)INWP * 32, rowA, rowB, epi);
#elif PROBE_GEMM == 5
    gemm_tile_stag<4, 2, 4, 8, false, false>(lds, 32, (size_t)INWP * 32, rowA, rowB, epi);
#else
    gemm_tile<4, 2, 4, 8, 32, 4, false, 1>(lds, 32, 0, (size_t)INWP * 32, rowA, rowB, epi);
#endif
  }
}
#endif

template <bool DUMMY>
DI void phase_outproj_t(const W& p_, int layer, char* lds, int row_lo, int bid, int nblk) {
  const W p = oq(p_);
  bf16_t* xres_w = DUMMY ? (bf16_t*)((char*)p.y() + (size_t)9 * MT * 1024) : p.xres();
  const int nM = (MT - row_lo) / 256, nN = 4;
  const char* B8 = (const char*)p.wout_t() + (size_t)layer * 1024 * 1024;
  for (int u = vbid_of(bid, nblk); u < nM * nN; u += nblk) {
    const int pm = u / nN, pn = u % nN, m0 = row_lo + pm * 256, n0 = pn * 256;
    auto rowA = [&](int r) { return (const bf16_t*)((const char*)p.cat() + (size_t)(m0 + r) * D); };
    auto rowB = [&](int r) { return (const bf16_t*)(B8 + (size_t)(n0 + r) * 128); };
    auto rowBp = [&](int r) { return rowB((r & ~127) | ((r & 12) << 3) | ((r & 112) >> 2) | (r & 3)); };
    auto epi = [&](const f32x4 (&acc)[4][8], int, int wr, int wc, int fr, int fq) {
#pragma unroll
      for (int mi = 0; mi < 4; ++mi) {
        const int row = m0 + wr * 64 + mi * 16 + fr;
        const float* xin = row < MC ? p.ctx + (size_t)row * D : p.x + (size_t)(row - MC) * D;
        const float* gate = p.mod() + (size_t)(layer * 9 + mod_row(row)) * 6144 + 2048;
#pragma unroll
        for (int np = 0; np < 4; ++np) {
          const int col = n0 + wc * 128 + fq * 32 + np * 8;
          const f32x4 v0 = acc[mi][2 * np], v1 = acc[mi][2 * np + 1];
          float4 xa, xb;
          if (layer == 0) {
            xa = *(const float4*)(xin + col); xb = *(const float4*)(xin + col + 4);
          } else {
            const uint4 xr = *(const uint4*)(p.xres() + (size_t)row * D + col);
            xa = unpack4(make_uint2(xr.x, xr.y)); xb = unpack4(make_uint2(xr.z, xr.w));
          }
          const float4 ga = *(const float4*)(gate + col), gb = *(const float4*)(gate + col + 4);
          uint4 o;
          o.x = pack2(xa.x + ga.x * v0[0], xa.y + ga.y * v0[1]); o.y = pack2(xa.z + ga.z * v0[2], xa.w + ga.w * v0[3]);
          o.z = pack2(xb.x + gb.x * v1[0], xb.y + gb.y * v1[1]); o.w = pack2(xb.z + gb.z * v1[2], xb.w + gb.w * v1[3]);
          *(uint4*)(xres_w + (size_t)row * D + col) = o;
        }
      }
    };
    gemm_tile<4, 2, 4, 8, 64, 2, false, 1, 4 | 16>(lds, 8, 0, (size_t)1024 * 64, rowA, rowBp, epi);
  }
}
DI void phase_outproj(const W& p, int layer, char* lds, int row_lo, int bid, int nblk) { phase_outproj_t<false>(p, layer, lds, row_lo, bid, nblk); }

DI void moe_unit(const W& p, int layer, char* lds, int e, const int* s_rows);
DI int moe_early_shared(int mrows, int nblk);
DI void phase_router(const W& p_, int layer, char* lds, int row_lo, int bid, int nblk) {
  const W p = oq(p_);
  const int nM = (MT - row_lo) / 256;
  const bf16_t* Bt = p.wr_t() + (size_t)layer * 256 * 1024;
  const int sh0 = moe_early_shared(MT - row_lo, nblk);
  for (int u = vbid_of(bid, nblk); u < nM + sh0; u += nblk) {
    if (u >= nM) {
      int* s_rows = (int*)(lds + 144 * 1024) + 1024;
      __syncthreads();
      if (otid() < 256) s_rows[otid()] = 8 * MT + row_lo + (u - nM) * 256 + otid();
      __syncthreads();
      moe_unit(p, layer, lds, NE, s_rows);
      continue;
    }
    const int m0 = row_lo + u * 256;
    auto rowA = [&](int r) { return p.h2() + (size_t)(m0 + r) * D; };
    auto rowB = [&](int r) { return Bt + (size_t)r * 32; };
    auto epi = [&](const f32x4 (&acc)[4][8], int, int wr, int wc, int fr, int fq) {
#pragma unroll
      for (int mi = 0; mi < 4; ++mi) {
        const int row = m0 + wr * 64 + mi * 16 + fr;
#pragma unroll
        for (int ni = 0; ni < 8; ++ni) {
          const int col = wc * 128 + ni * 16 + 4 * fq;
          *(f32x4*)(p.logits() + (size_t)row * 256 + col) = acc[mi][ni];
        }
      }
    };
    gemm_tile_stag<4, 2, 4, 8, false>(lds, 32, (size_t)256 * 32, rowA, rowB, epi);
  }
}

DI void phase_route(const W& p_, int layer, char* lds, int row_lo, int bid, int nblk) {
  const W p = oq(p_);
  int* lcnt = (int*)lds;
  int* lbase = lcnt + 256;
  int* ent = lbase + 256;
  const int tid = otid(), wid = tid >> 6, lane = tid & 63;
  const int nrows = MT - row_lo;
  const int CHT = (nrows % nblk == 0 && nrows / nblk <= 160) ? nrows / nblk : 128;
  const int nch = nrows / CHT;
  const float NEG = -__builtin_inff();
  for (int ch = bid; ch < nch; ch += nblk) {
    if (tid < 256) lcnt[tid] = 0;
    __syncthreads();
    for (int i = wid; i < CHT; i += 8) {
      const int row = row_lo + ch * CHT + i;
      const float4 lg = *(const float4*)(p.logits() + (size_t)row * 256 + lane * 4);
      const float4 br = *(const float4*)(p.b_router() + layer * 256 + lane * 4);
      float sc[4] = {sigmoidf_(lg.x), sigmoidf_(lg.y), sigmoidf_(lg.z), sigmoidf_(lg.w)};
      float v[4] = {sc[0] + br.x, sc[1] + br.y, sc[2] + br.z, sc[3] + br.w};
      float m1 = NEG, m2 = NEG;
#pragma unroll
      for (int j = 0; j < 4; ++j) { if (v[j] > m1) { m2 = m1; m1 = v[j]; } else if (v[j] > m2) m2 = v[j]; }
      {
        float o1 = dppf<0xB1>(m1), o2 = dppf<0xB1>(m2);
        float n1 = fmaxf(m1, o1), n2 = fmaxf(fminf(m1, o1), fmaxf(m2, o2));
        m1 = n1; m2 = n2;
        o1 = dppf<0x4E>(m1); o2 = dppf<0x4E>(m2);
        n1 = fmaxf(m1, o1); n2 = fmaxf(fminf(m1, o1), fmaxf(m2, o2));
        m1 = n1; m2 = n2;
        o1 = dppf<0x141>(m1); o2 = dppf<0x141>(m2);
        n1 = fmaxf(m1, o1); n2 = fmaxf(fminf(m1, o1), fmaxf(m2, o2));
        m1 = n1; m2 = n2;
      }
      const float gs = m1 + m2;
      const int g = lane >> 3;
      int rank = 0;
#pragma unroll
      for (int gg = 0; gg < 8; ++gg) { const float og = rlanef(gs, gg * 8); rank += (og > gs || (og == gs && gg < g)) ? 1 : 0; }
      if (rank >= 4) { v[0] = NEG; v[1] = NEG; v[2] = NEG; v[3] = NEG; }
      float ssum = 0.f, my_s = 0.f; int my_e = 0;
#pragma unroll
      for (int k = 0; k < 8; ++k) {
        float bv = v[0]; int bj = 0;
#pragma unroll
        for (int j = 1; j < 4; ++j) if (v[j] > bv) { bv = v[j]; bj = j; }
        const float wm = wave_max_dpp(bv);
        const unsigned long long bal = __ballot(bv == wm);
        const int win = __builtin_amdgcn_readfirstlane(__ffsll((long long)bal) - 1);
        const float mysc = bj == 0 ? sc[0] : bj == 1 ? sc[1] : bj == 2 ? sc[2] : sc[3];
        const int ej = __builtin_amdgcn_readlane(bj, win);
        const float su = rlanef(mysc, win);
        if (lane == win) {
#pragma unroll
          for (int j = 0; j < 4; ++j) if (j == bj) v[j] = NEG;
        }
        ssum += su;
        if (lane == k) { my_e = win * 4 + ej; my_s = su; }
      }
      if (lane < 8) {
        const int lpos = atomicAdd(&lcnt[my_e], 1);
        ent[i * 8 + lane] = my_e | (lpos << 8);
        p.wts()[(size_t)row * 8 + lane] = my_s / ssum * 2.5f;
      }
    }
    __syncthreads();
    if (tid < 256) { const int cc = lcnt[tid]; lbase[tid] = cc ? atomicAdd(&p.cnt()[layer * 256 + tid], cc) : 0; }
    __syncthreads();
    for (int j = tid; j < CHT * 8; j += NTHR) {
      const int e = ent[j] & 255, lpos = ent[j] >> 8;
      const int row = row_lo + ch * CHT + (j >> 3);
      p.lists()[(size_t)e * CAP + lbase[e] + lpos] = row * 8 + (j & 7);
    }
    __syncthreads();
  }
}

DI void moe_prefix(const W& p, int layer, int mrows, int* s_pref) {
  int* s_tmp = s_pref + 400;
  const int t = otid();
  __syncthreads();
  if (t < 272) {
    int c = 0;
    if (t < NE) c = (p.cnt()[layer * 256 + t] + 255) >> 8;
    else if (t == NE) c = (mrows + 255) >> 8;
    s_tmp[t] = c;
  }
  __syncthreads();
  int cur = 0;
  for (int off = 1; off < 272; off <<= 1) {
    if (t < 272) s_tmp[(cur ^ 1) * 272 + t] = s_tmp[cur * 272 + t] + (t >= off ? s_tmp[cur * 272 + t - off] : 0);
    cur ^= 1;
    __syncthreads();
  }
  if (t <= NE1) s_pref[t] = t == 0 ? 0 : s_tmp[cur * 272 + t - 1];
  __syncthreads();
}
DI int moe_find(const int* s_pref, int ti) {
  int lo = 0, hi = NE1;
  while (hi - lo > 1) { const int mid = (lo + hi) >> 1; if (s_pref[mid] <= ti) lo = mid; else hi = mid; }
  return lo;
}
DI void moe_rows(const W& p, int layer, int e, int mt, int row_lo, int mrows, int* s_rows) {
  const int t = otid();
  if (t < 128) {
    const int cnt = e < NE ? p.cnt()[layer * 256 + e] : mrows;
    const int r = mt * 128 + t;
    int idx = -1;
    if (r < cnt) idx = e < NE ? p.lists()[(size_t)e * CAP + r] : 8 * MT + row_lo + r;
    s_rows[t] = idx;
  }
  __syncthreads();
}

DI void moe_unit(const W& p, int layer, char* lds, int e, const int* s_rows) {
  const int idx0 = s_rows[0];
  {
    const char* B8 = (const char*)p.wei_t() + (size_t)(layer * NE1 + e) * 512 * 1024;
    auto rowA = [&](int r) {
      int idx = s_rows[r]; if (idx < 0) idx = idx0;
      const int tok = idx < 8 * MT ? (idx >> 3) : idx - 8 * MT;
      return (const bf16_t*)(p.h2q() + (size_t)tok * D);
    };
    auto rowB = [&](int r) {
      const int wq = r >> 7, w = r & 127;
      const int n = w < 64 ? wq * 64 + w : 256 + wq * 64 + (w - 64);
      return (const bf16_t*)(B8 + (size_t)n * 128);
    };
    int stash[4][4];
    auto epi = [&](const f32x4 (&acc)[4][8], int chunk, int wr, int wc, int fr, int fq) {
      int cur[4][4];
#pragma unroll
      for (int mi = 0; mi < 4; ++mi)
#pragma unroll
        for (int ni = 0; ni < 4; ++ni) {
          float o[4];
#pragma unroll
          for (int j = 0; j < 4; ++j) o[j] = siluf_(acc[mi][ni][j]) * acc[mi][ni + 4][j] * 16.f;
          cur[mi][ni] = pack_fp8x4(o[0], o[1], o[2], o[3]);
        }
      if (chunk == 0) {
#pragma unroll
        for (int mi = 0; mi < 4; ++mi)
#pragma unroll
          for (int ni = 0; ni < 4; ++ni) stash[mi][ni] = cur[mi][ni];
      } else {
        __syncthreads();
#pragma unroll
        for (int c2 = 0; c2 < 2; ++c2)
#pragma unroll
          for (int mi = 0; mi < 4; ++mi) {
            const int row = wr * 64 + mi * 16 + fr;
#pragma unroll
            for (int ni = 0; ni < 4; ++ni) {
              const int ch = (wc * 4 + ni) ^ ((row >> 1) & 7);
              *(int*)(lds + c2 * 32768 + row * 128 + ch * 16 + 4 * fq) = c2 == 0 ? stash[mi][ni] : cur[mi][ni];
            }
          }
      }
    };
    gemm_tile<4, 2, 4, 8, 64, 2, false, 2, 4>(lds, 8, (size_t)128 * 64, (size_t)512 * 64, rowA, rowB, epi);
  }
  {
    const char* B8d = (const char*)p.wed_t() + (size_t)(layer * NE1 + e) * 1024 * 256;
    auto rowA = [&](int) { return (const bf16_t*)nullptr; };
    auto rowB2 = [&](int r) { return (const bf16_t*)(B8d + (size_t)((r & ~63) | ((r & 12) << 2) | ((r & 48) >> 2) | (r & 3)) * 128); };
    auto epi = [&](const f32x4 (&acc)[4][8], int nt, int wr, int wc, int fr, int fq) {
#pragma unroll
      for (int mi = 0; mi < 4; ++mi) {
        int dst = s_rows[wr * 64 + mi * 16 + fr];
        if (dst < 0) dst = 9 * MT + (int)blockIdx.x;
        {
          int4 lo, hi;
          lo.x = pack_fp8x4(acc[mi][0][0] * 16.f, acc[mi][0][1] * 16.f, acc[mi][0][2] * 16.f, acc[mi][0][3] * 16.f);
          lo.y = pack_fp8x4(acc[mi][1][0] * 16.f, acc[mi][1][1] * 16.f, acc[mi][1][2] * 16.f, acc[mi][1][3] * 16.f);
          lo.z = pack_fp8x4(acc[mi][2][0] * 16.f, acc[mi][2][1] * 16.f, acc[mi][2][2] * 16.f, acc[mi][2][3] * 16.f);
          lo.w = pack_fp8x4(acc[mi][3][0] * 16.f, acc[mi][3][1] * 16.f, acc[mi][3][2] * 16.f, acc[mi][3][3] * 16.f);
          hi.x = pack_fp8x4(acc[mi][4][0] * 16.f, acc[mi][4][1] * 16.f, acc[mi][4][2] * 16.f, acc[mi][4][3] * 16.f);
          hi.y = pack_fp8x4(acc[mi][5][0] * 16.f, acc[mi][5][1] * 16.f, acc[mi][5][2] * 16.f, acc[mi][5][3] * 16.f);
          hi.z = pack_fp8x4(acc[mi][6][0] * 16.f, acc[mi][6][1] * 16.f, acc[mi][6][2] * 16.f, acc[mi][6][3] * 16.f);
          hi.w = pack_fp8x4(acc[mi][7][0] * 16.f, acc[mi][7][1] * 16.f, acc[mi][7][2] * 16.f, acc[mi][7][3] * 16.f);
          char* yp = (char*)p.y() + (size_t)dst * D + nt * 256 + wc * 128 + fq * 16;
          *(int4*)yp = lo; *(int4*)(yp + 64) = hi;
        }
      }
    };
    gemm_tile<4, 2, 4, 8, 64, 2, false, 4, 1 | 4 | 8 | 32>(lds + 65536, 2, (size_t)256 * 64, (size_t)1024 * 64, rowA, rowB2, epi, lds);
  }
}

DI int moe_early_shared(int mrows, int nblk) {
  const int idle = nblk - mrows / 256;
  return idle <= 0 ? 0 : (idle < mrows / 256 ? idle : mrows / 256);
}

DI void phase_moe(const W& p_, int layer, char* lds, int row_lo, int bid, int nblk) {
  const W p = oq(p_);
  int* s_pref = (int*)(lds + 144 * 1024);
  int* s_rows = s_pref + 1024;
  const int mrows = MT - row_lo;
  const int sh0 = moe_early_shared(mrows, nblk);
  moe_prefix(p, layer, mrows - sh0 * 256, s_pref);
  const int total = s_pref[NE1];
  auto fetch_rows = [&](int uu) -> int {
    int idx = -1;
    const int t = otid();
    if (uu < total && t < 256) {
      const int e2 = moe_find(s_pref, uu), mt2 = uu - s_pref[e2];
      if (e2 < NE) {
        const int cnt = p.cnt()[layer * 256 + e2];
        const int r = mt2 * 256 + t;
        if (r < cnt) idx = p.lists()[(size_t)e2 * CAP + r];
      } else {
        idx = 8 * MT + row_lo + (mt2 + sh0) * 256 + t;
      }
    }
    return idx;
  };
  int pre = fetch_rows(vbid_of(bid, nblk));
  for (int u = vbid_of(bid, nblk); u < total; u += nblk) {
    const int e = moe_find(s_pref, u);
    if (otid() < 256) s_rows[otid()] = pre;
    __syncthreads();
    pre = fetch_rows(u + nblk);
    moe_unit(p, layer, lds, e, s_rows);
  }
}

template <bool DUMMY>
DI void phase_combine_t(const W& p_, int layer, int row_lo, int bid, int nblk) {
  const W p = oq(p_);
  char* scratch = (char*)p.y() + (size_t)9 * MT * 1024;
  bf16_t* xres_w = DUMMY ? (bf16_t*)scratch : p.xres();
  bf16_t* h_w = DUMMY ? p.act() : p.h();
  float* out_w = DUMMY ? (float*)(scratch + ((size_t)128 << 20)) : p.out;
  const int wid = otid() >> 6, lane = otid() & 63;
  const bool last = layer == 1;
  for (int row = row_lo + bid * 8 + wid; row < MT; row += nblk * 8) {
    const float* m = p.mod() + (size_t)(layer * 9 + mod_row(row)) * 6144;
    float w[8];
#pragma unroll
    for (int k = 0; k < 8; ++k) w[k] = p.wts()[(size_t)row * 8 + k];
    float xn[16];
    float ss = 0.f;
#pragma unroll
    for (int i = 0; i < 4; ++i) {
      const int cidx = i * 256 + lane * 4;
      float a[4] = {0.f, 0.f, 0.f, 0.f};
#pragma unroll
      for (int k = 0; k < 9; ++k) {
        const size_t yr = k < 8 ? (size_t)row * 8 + k : (size_t)8 * MT + row;
        const int yv = *(const int*)((const char*)p.y() + yr * D + cidx);
        const float wk = (k < 8 ? w[k] : 1.f) * (1.f / 16.f);
        typedef float f32x2_ __attribute__((ext_vector_type(2)));
        const f32x2_ ylo = __builtin_amdgcn_cvt_pk_f32_fp8(yv, false), yhi = __builtin_amdgcn_cvt_pk_f32_fp8(yv, true);
        a[0] += wk * ylo.x; a[1] += wk * ylo.y; a[2] += wk * yhi.x; a[3] += wk * yhi.y;
      }
      const float4 xv = unpack4(*(const uint2*)(p.xres() + (size_t)row * D + cidx));
      const float4 gv = *(const float4*)(m + 5120 + cidx);
      xn[i * 4 + 0] = xv.x + gv.x * a[0]; xn[i * 4 + 1] = xv.y + gv.y * a[1];
      xn[i * 4 + 2] = xv.z + gv.z * a[2]; xn[i * 4 + 3] = xv.w + gv.w * a[3];
#pragma unroll
      for (int j = 0; j < 4; ++j) ss += xn[i * 4 + j] * xn[i * 4 + j];
    }
    ss = wave_sum(ss);
    const float rstd = rsqrtf(ss * (1.f / D) + EPS);
    if (!last) {
      const float* g = p.g_mix() + (layer + 1) * D;
      const float* m2 = p.mod() + (size_t)((layer + 1) * 9 + mod_row(row)) * 6144;
#pragma unroll
      for (int i = 0; i < 4; ++i) {
        const int cidx = i * 256 + lane * 4;
        { uint2 xo; xo.x = pack2(xn[i * 4], xn[i * 4 + 1]); xo.y = pack2(xn[i * 4 + 2], xn[i * 4 + 3]); *(uint2*)(xres_w + (size_t)row * D + cidx) = xo; }
        const float4 gg = *(const float4*)(g + cidx);
        const float4 sh = *(const float4*)(m2 + cidx);
        const float4 scl = *(const float4*)(m2 + 1024 + cidx);
        const float o0 = xn[i * 4 + 0] * rstd * gg.x * (1.f + scl.x) + sh.x;
        const float o1 = xn[i * 4 + 1] * rstd * gg.y * (1.f + scl.y) + sh.y;
        const float o2 = xn[i * 4 + 2] * rstd * gg.z * (1.f + scl.z) + sh.z;
        const float o3 = xn[i * 4 + 3] * rstd * gg.w * (1.f + scl.w) + sh.w;
        const int q8 = pack_fp8x4(o0, o1, o2, o3);
        *(int*)((char*)h_w + (size_t)row * D + cidx) = q8;
      }
    } else {
#pragma unroll
      for (int i = 0; i < 4; ++i) {
        const int cidx = i * 256 + lane * 4;
        const float4 gg = *(const float4*)(p.g_final() + cidx);
        *(float4*)(out_w + (size_t)(row - MC) * D + cidx) =
            make_float4(xn[i * 4] * rstd * gg.x, xn[i * 4 + 1] * rstd * gg.y, xn[i * 4 + 2] * rstd * gg.z, xn[i * 4 + 3] * rstd * gg.w);
      }
    }
  }
}
DI void phase_combine(const W& p, int layer, int row_lo, int bid, int nblk) { phase_combine_t<false>(p, layer, row_lo, bid, nblk); }

typedef unsigned u32x4 __attribute__((ext_vector_type(4)));
typedef unsigned u32x2 __attribute__((ext_vector_type(2)));
DI bf16x8 bl128(__amdgpu_buffer_rsrc_t rs, unsigned voff, unsigned soff) {
  return __builtin_bit_cast(bf16x8, __builtin_amdgcn_raw_buffer_load_b128(rs, voff, soff, 0));
}
DI u32x2 bl64(__amdgpu_buffer_rsrc_t rs, unsigned voff, unsigned soff) { return __builtin_amdgcn_raw_buffer_load_b64(rs, voff, soff, 0); }

template <bool LOCALPASS>
DI void attn_pass(__amdgpu_buffer_rsrc_t rsK, __amdgpu_buffer_rsrc_t rsV, unsigned kbase, unsigned vbase, const char* cK, const char* cV,
                  const float* s_rpb_h, int r, int c0, int kc0, int kr0, int lane, const bf16x8& qf0, const bf16x8& qf1,
                  float& m_out, float& l_out, f32x4 (&O)[4], const bf16x8 (&kfa)[16]) {
  const int fr = lane & 15, fq = lane >> 4;
  const unsigned vK = (8 * (fr >> 2) + (fr & 3)) * 128 + fq * 32;
  f32x4 S[16];
  if (LOCALPASS) {
    bf16x8 kfb[16];
#pragma unroll
    for (int t = 8; t < 16; ++t) {
      const unsigned so = kbase + ((kr0 + (t >> 1)) * 64 + kc0 + (t & 1) * 4) * 128;
      kfb[2 * (t - 8)] = bl128(rsK, vK, so); kfb[2 * (t - 8) + 1] = bl128(rsK, vK + 16, so);
    }
    __builtin_amdgcn_sched_barrier(0);
#pragma unroll
    for (int t = 0; t < 8; ++t) {
      f32x4 s = (f32x4){0.f, 0.f, 0.f, 0.f};
      s = __builtin_amdgcn_mfma_f32_16x16x32_bf16(kfa[2 * t], qf0, s, 0, 0, 0);
      s = __builtin_amdgcn_mfma_f32_16x16x32_bf16(kfa[2 * t + 1], qf1, s, 0, 0, 0);
      S[t] = s;
    }
#pragma unroll
    for (int t = 8; t < 16; ++t) {
      f32x4 s = (f32x4){0.f, 0.f, 0.f, 0.f};
      s = __builtin_amdgcn_mfma_f32_16x16x32_bf16(kfb[2 * (t - 8)], qf0, s, 0, 0, 0);
      s = __builtin_amdgcn_mfma_f32_16x16x32_bf16(kfb[2 * (t - 8) + 1], qf1, s, 0, 0, 0);
      S[t] = s;
    }
    __builtin_amdgcn_sched_barrier(0);
  } else {
#pragma unroll
    for (int t = 0; t < 16; ++t) {
      const bf16x8 k0 = *(const bf16x8*)(cK + (t * 2) * 1024 + lane * 16);
      const bf16x8 k1 = *(const bf16x8*)(cK + (t * 2 + 1) * 1024 + lane * 16);
      f32x4 s = (f32x4){0.f, 0.f, 0.f, 0.f};
      s = __builtin_amdgcn_mfma_f32_16x16x32_bf16(k0, qf0, s, 0, 0, 0);
      s = __builtin_amdgcn_mfma_f32_16x16x32_bf16(k1, qf1, s, 0, 0, 0);
      S[t] = s;
      if ((t & 3) == 3) __builtin_amdgcn_sched_barrier(0);
    }
  }
  const unsigned vV = (fr * 64 + 8 * fq) * 2;
  bf16x8 vfa[16];
  if (LOCALPASS) {
#pragma unroll
    for (int s = 0; s < 4; ++s)
#pragma unroll
      for (int dt = 0; dt < 4; ++dt) vfa[s * 4 + dt] = bl128(rsV, vV, vbase + ((kr0 + s) * 4096 + dt * 1024 + kc0) * 2);
    __builtin_amdgcn_sched_barrier(0);
  }
  const float NEGB = -1e30f;
  float mx = NEGB;
  if (LOCALPASS) {
    const int qc = c0 + fr;
    const int cs = min(max(qc - 8, 0), 48);
    unsigned vmask = 0;
#pragma unroll
    for (int e = 0; e < 8; ++e) {
      const int kc = kc0 + 8 * fq + e;
      vmask |= (kc >= cs && kc < cs + 16) ? (1u << e) : 0u;
    }
    const int dc0 = kc0 + fq * 8 - qc + 15;
#pragma unroll
    for (int t = 0; t < 16; ++t) {
      const float* bp = s_rpb_h + (kr0 + (t >> 1) - r + 7) * 31;
#pragma unroll
      for (int j = 0; j < 4; ++j) {
        const int e = (t & 1) * 4 + j;
        const int dc = min(max(dc0 + e, 0), 30);
        const float v = ((vmask >> e) & 1u) ? S[t][j] + bp[dc] : NEGB;
        S[t][j] = v;
        mx = fmaxf(mx, v);
      }
    }
  } else {
#pragma unroll
    for (int t = 0; t < 16; ++t)
#pragma unroll
      for (int j = 0; j < 4; ++j) mx = fmaxf(mx, S[t][j]);
  }
  mx = fmaxf(mx, __shfl_xor(mx, 16));
  mx = fmaxf(mx, __shfl_xor(mx, 32));
  float l = 0.f;
#pragma unroll
  for (int t = 0; t < 16; ++t)
#pragma unroll
    for (int j = 0; j < 4; ++j) { const float pv = __builtin_amdgcn_exp2f(S[t][j] - mx); S[t][j] = pv; l += pv; }
  l += __shfl_xor(l, 16);
  l += __shfl_xor(l, 32);
  m_out = mx; l_out = l;
#pragma unroll
  for (int dt = 0; dt < 4; ++dt) O[dt] = (f32x4){0.f, 0.f, 0.f, 0.f};
  bf16x8 pf[8];
#pragma unroll
  for (int s = 0; s < 8; ++s) {
    const unsigned p0 = pack2(S[2 * s][0], S[2 * s][1]), p1 = pack2(S[2 * s][2], S[2 * s][3]);
    const unsigned p2 = pack2(S[2 * s + 1][0], S[2 * s + 1][1]), p3 = pack2(S[2 * s + 1][2], S[2 * s + 1][3]);
    pf[s] = __builtin_bit_cast(bf16x8, (u32x4){p0, p1, p2, p3});
  }
  if (LOCALPASS) {
    bf16x8 vfb[16];
    __builtin_amdgcn_sched_barrier(0);
#pragma unroll
    for (int s = 0; s < 4; ++s)
#pragma unroll
      for (int dt = 0; dt < 4; ++dt) vfb[s * 4 + dt] = bl128(rsV, vV, vbase + ((kr0 + 4 + s) * 4096 + dt * 1024 + kc0) * 2);
    __builtin_amdgcn_sched_barrier(0);
#pragma unroll
    for (int s = 0; s < 4; ++s)
#pragma unroll
      for (int dt = 0; dt < 4; ++dt) O[dt] = __builtin_amdgcn_mfma_f32_16x16x32_bf16(vfa[s * 4 + dt], pf[s], O[dt], 0, 0, 0);
    __builtin_amdgcn_sched_barrier(0);
#pragma unroll
    for (int s = 0; s < 4; ++s)
#pragma unroll
      for (int dt = 0; dt < 4; ++dt) O[dt] = __builtin_amdgcn_mfma_f32_16x16x32_bf16(vfb[s * 4 + dt], pf[4 + s], O[dt], 0, 0, 0);
  } else {
#pragma unroll
    for (int s = 0; s < 8; ++s) {
#pragma unroll
      for (int dt = 0; dt < 4; ++dt) {
        const bf16x8 vf = *(const bf16x8*)(cV + (s * 4 + dt) * 1024 + lane * 16);
        O[dt] = __builtin_amdgcn_mfma_f32_16x16x32_bf16(vf, pf[s], O[dt], 0, 0, 0);
      }
      if ((s & 1) == 1) __builtin_amdgcn_sched_barrier(0);
    }
  }
}

DI void attn_stage_ctx(const W& p, char* dst, int bh, int wid, int lane) {
  const int fr = lane & 15, fq = lane >> 4;
  const bf16_t* Kc = p.kh() + (size_t)bh * NCTX * 64;
  const bf16_t* Vc = p.vt() + (size_t)bh * 4 * 4096;
#pragma unroll
  for (int i = 0; i < 8; ++i) {
    const int pc = wid * 8 + i;
    const bf16_t* src;
    if (pc < 32) {
      const int t = pc >> 1, ks = pc & 1, g = t >> 1, T = t & 1;
      src = Kc + (32 * g + 8 * (fr >> 2) + 4 * T + (fr & 3)) * 64 + 16 * fq + 8 * ks;
    } else {
      const int s = (pc - 32) >> 2, dt = (pc - 32) & 3;
      src = Vc + (s >> 1) * 4096 + (16 * dt + fr) * 64 + (s & 1) * 32 + 8 * fq;
    }
    __builtin_amdgcn_global_load_lds((const unsigned*)src, (unsigned*)(dst + pc * 1024 + lane * 16), 16, 0, 0);
  }
}

template <bool LOCAL, bool QPRE = false>
DI void attn_unit(const W& p, __amdgpu_buffer_rsrc_t rsQ, __amdgpu_buffer_rsrc_t rsK, __amdgpu_buffer_rsrc_t rsV, const char* cK, const char* cV,
                  const float* s_rpb, int b, int h, int r, int qb, int lane, char* nxt_dst = nullptr, int nxt_bh = 0, int wid = 0,
                  bf16x8 qp0 = bf16x8{}, bf16x8 qp1 = bf16x8{}) {
  const int fr = lane & 15, fq = lane >> 4;
  const unsigned bh = (unsigned)(b * 8 + h);
  int c0 = 0, kc0 = 0, kr0 = 0, qrow;
  unsigned qso;
  if (LOCAL) {
    c0 = qb * 16; kc0 = qb == 0 ? 0 : qb == 1 ? 8 : qb == 2 ? 24 : 32;
    kr0 = min(max(r - 4, 0), 56);
    qrow = MC + b * SEQ + r * 64 + c0 + fr;
    qso = (unsigned)(HM_LAT * 2) + (bh * SEQ + r * 64 + c0) * 128;
  } else {
    qrow = b * NCTX + qb * 16 + fr;
    qso = (bh * NCTX + qb * 16) * 128;
  }
  const unsigned vQ = fr * 128 + fq * 32;
  const bf16x8 qf0 = QPRE ? qp0 : bl128(rsQ, vQ, qso), qf1 = QPRE ? qp1 : bl128(rsQ, vQ + 16, qso);
  bf16x8 kfa[16];
  if (LOCAL) {
    const unsigned kbase = (unsigned)(HM_LAT * 2) + bh * SEQ * 64 * 2;
    const unsigned vK = (8 * (fr >> 2) + (fr & 3)) * 128 + fq * 32;
#pragma unroll
    for (int t = 0; t < 8; ++t) {
      const unsigned so = kbase + ((kr0 + (t >> 1)) * 64 + kc0 + (t & 1) * 4) * 128;
      kfa[2 * t] = bl128(rsK, vK, so); kfa[2 * t + 1] = bl128(rsK, vK + 16, so);
    }
    __builtin_amdgcn_sched_barrier(0);
  }
  float m2, l2; f32x4 O[4];
  attn_pass<false>(rsK, rsV, 0u, 0u, cK, cV, s_rpb, r, c0, kc0, kr0, lane, qf0, qf1, m2, l2, O, kfa);
  float l = l2;
  if (nxt_dst) attn_stage_ctx(p, nxt_dst, nxt_bh, wid, lane);
  if (LOCAL) {
    float m1, l1; f32x4 O1[4];
    attn_pass<true>(rsK, rsV, (unsigned)(HM_LAT * 2) + bh * SEQ * 64 * 2, (unsigned)(HM_LAT * 2) + bh * 64 * 4096 * 2, cK, cV, s_rpb + h * 465, r, c0,
                    kc0, kr0, lane, qf0, qf1, m1, l1, O1, kfa);
    const float m = fmaxf(m1, m2);
    const float sc1 = __builtin_amdgcn_exp2f(m1 - m), sc2 = __builtin_amdgcn_exp2f(m2 - m);
    l = l1 * sc1 + l2 * sc2;
#pragma unroll
    for (int dt = 0; dt < 4; ++dt)
#pragma unroll
      for (int j = 0; j < 4; ++j) O[dt][j] = O[dt][j] * sc2 + O1[dt][j] * sc1;
  }
  const float inv_l = 1.f / l;
#pragma unroll
  for (int dt = 0; dt < 4; ++dt) {
    const float sc8 = inv_l * 8.f;
    *(int*)((char*)p.cat() + (size_t)qrow * D + h * 64 + dt * 16 + fq * 4) = pack_fp8x4(O[dt][0] * sc8, O[dt][1] * sc8, O[dt][2] * sc8, O[dt][3] * sc8);
  }
}

DI void phase_attn(const W& p_, int layer, char* lds, int bid, int nblk) {
  const W p = oq(p_);
  float* s_rpb = (float*)lds;
  char* cbuf = lds + 16384;
  const int tid = otid(), lane = tid & 63;
  const int wid = __builtin_amdgcn_readfirstlane(tid >> 6);
  for (int i = tid; i < 8 * 15 * 31; i += NTHR) s_rpb[i] = p.rpb()[layer * 3720 + i] * 1.4426950408889634f;
  const __amdgpu_buffer_rsrc_t rsQ = __builtin_amdgcn_make_buffer_rsrc((void*)p.qh(), 0, (int)(HM_ELEMS * 2), 0x00020000);
  const __amdgpu_buffer_rsrc_t rsK = __builtin_amdgcn_make_buffer_rsrc((void*)p.kh(), 0, (int)(HM_ELEMS * 2), 0x00020000);
  const __amdgpu_buffer_rsrc_t rsV = __builtin_amdgcn_make_buffer_rsrc((void*)p.vt(), 0, (int)(HM_ELEMS * 2), 0x00020000);
  const bool fast = nblk == 256;
  const int npair = fast ? 8 : 64;
  const int xg = bid >> 5, lw = (bid & 31) * 8 + wid;
  attn_stage_ctx(p, cbuf, fast ? xg : 0, wid, lane);
  const unsigned vQp = (lane & 15) * 128 + (lane >> 4) * 32;
  auto qso_of = [&](int ph2) { return (unsigned)(HM_LAT * 2) + ((unsigned)ph2 * SEQ + (lw >> 2) * 64 + (lw & 3) * 16) * 128; };
  bf16x8 qn0 = bf16x8{}, qn1 = bf16x8{};
  if (fast) { qn0 = bl128(rsQ, vQp, qso_of(xg)); qn1 = bl128(rsQ, vQp + 16, qso_of(xg)); }
  for (int sl = 0; sl < npair; ++sl) {
    const int ph = fast ? sl * 8 + xg : sl, h = ph & 7, b = ph >> 3;
    asm volatile("s_waitcnt vmcnt(0)" ::: "memory");
    __syncthreads();
    const char* cK = cbuf + (sl & 1) * 65536;
    const char* cV = cK + 32768;
    char* ndst = sl + 1 < npair ? cbuf + ((sl + 1) & 1) * 65536 : nullptr;
    if (fast) {
      const bf16x8 qc0 = qn0, qc1 = qn1;
      if (sl + 1 < npair) { qn0 = bl128(rsQ, vQp, qso_of((sl + 1) * 8 + xg)); qn1 = bl128(rsQ, vQp + 16, qso_of((sl + 1) * 8 + xg)); }
      attn_unit<true, true>(p, rsQ, rsK, rsV, cK, cV, s_rpb, b, h, lw >> 2, lw & 3, lane, ndst, (sl + 1) * 8 + xg, wid, qc0, qc1);
      if (layer == 0 && (lw >> 4) == sl) attn_unit<false>(p, rsQ, rsK, rsV, cK, cV, s_rpb, b, h, 0, lw & 15, lane);
    } else {
      if (ndst) attn_stage_ctx(p, ndst, sl + 1, wid, lane);
      for (int u = bid * 8 + wid; u < 256; u += nblk * 8) attn_unit<true>(p, rsQ, rsK, rsV, cK, cV, s_rpb, b, h, u >> 2, u & 3, lane);
      if (layer == 0)
        for (int u = bid * 8 + wid; u < 16; u += nblk * 8) attn_unit<false>(p, rsQ, rsK, rsV, cK, cV, s_rpb, b, h, 0, u, lane);
    }
  }
  __syncthreads();
}

DI void phase_pool(const W& p_, int layer, char* lds, int bid, int nblk) {
  const W p = oq(p_);
  float* U = (float*)lds;
  bf16_t* dA = (bf16_t*)(lds + 81920);
  bf16_t* WT = (bf16_t*)(lds + 81920 + 33792);
  const int tid = otid(), wid = tid >> 6, lane = tid & 63, fr = lane & 15, fq = lane >> 4;
  for (int i = tid; i < 4 * 64 * 8; i += NTHR) {
    const int rowj = i >> 3, chk = i & 7;
    *(uint4*)(WT + rowj * 72 + chk * 8) = *(const uint4*)(p.wpt() + (size_t)layer * 16384 + rowj * 64 + chk * 8);
  }
  const int nlat = ML / 64, nctx = layer == 0 ? MC / 64 : 0;
  const int gextra = NB * 4 * NSLOT - nblk * 8;
  const int heavy = (gextra > 0 && gextra < nblk * 4) ? (gextra + 7) / 8 : 0;
  const int ptotal = nlat + nctx;
  const int ufirst = bid < heavy ? ptotal - 1 - bid : bid - heavy;
  const int ustep = bid < heavy ? ptotal : nblk - heavy;
  const int ulimit = bid < heavy ? ptotal : ptotal - heavy;
  for (int u = ufirst; u < ulimit; u += ustep) {
    int row0, L, seq0;
    if (u < nlat) { row0 = MC + u * 64; L = SEQ; seq0 = MC + ((u * 64) / SEQ) * SEQ; }
    else { row0 = (u - nlat) * 64; L = NCTX; seq0 = (row0 / NCTX) * NCTX; }
    const int t0 = row0 - seq0;
    __syncthreads();
#pragma unroll
    for (int k = 0; k < 5; ++k) {
      const int c = tid + NTHR * k, rr = c >> 5, chk = c & 31;
      const int tpos = t0 - 8 + rr;
      uint4 v = make_uint4(0u, 0u, 0u, 0u);
      if (tpos >= 0 && tpos < L) v = *(const uint4*)(p.px() + (size_t)(seq0 + tpos) * INW + 1536 + chk * 8);
      float4 lo4, hi4;
      lo4.x = __uint_as_float(v.x << 16); lo4.y = __uint_as_float(v.x & 0xffff0000u); lo4.z = __uint_as_float(v.y << 16); lo4.w = __uint_as_float(v.y & 0xffff0000u);
      hi4.x = __uint_as_float(v.z << 16); hi4.y = __uint_as_float(v.z & 0xffff0000u); hi4.z = __uint_as_float(v.w << 16); hi4.w = __uint_as_float(v.w & 0xffff0000u);
      *(float4*)(U + rr * 256 + chk * 8) = lo4;
      *(float4*)(U + rr * 256 + chk * 8 + 4) = hi4;
    }
    __syncthreads();
    {
      const int ch = tid & 255, hf = tid >> 8, g = ch >> 6, hw = 1 << g;
      const float* Uc = U + ch;
      int tpos = t0 + hf * 32;
      int lo = max(tpos - hw, 0), hi = min(tpos + hw - 1, L - 1);
      float S = 0.f;
      for (int j = lo; j <= hi; ++j) S += Uc[(j - t0 + 8) * 256];
      for (int tt = 0; tt < 32; ++tt) {
        const float dv = S / (float)(hi - lo + 1) - Uc[(tpos - t0 + 8) * 256];
        dA[(hf * 32 + tt) * 264 + ch] = f2bf(dv);
        ++tpos;
        const int nlo = max(tpos - hw, 0), nhi = min(tpos + hw - 1, L - 1);
        if (nlo > lo) { S -= Uc[(lo - t0 + 8) * 256]; lo = nlo; }
        if (nhi > hi) { S += Uc[(nhi - t0 + 8) * 256]; hi = nhi; }
      }
    }
    __syncthreads();
    {
      const int g = wid & 3, th = wid >> 2;
      f32x4 acc[2][4];
#pragma unroll
      for (int mi = 0; mi < 2; ++mi)
#pragma unroll
        for (int ni = 0; ni < 4; ++ni) acc[mi][ni] = (f32x4){0.f, 0.f, 0.f, 0.f};
#pragma unroll
      for (int ks = 0; ks < 2; ++ks) {
        bf16x8 a[2], b[4];
#pragma unroll
        for (int mi = 0; mi < 2; ++mi) a[mi] = *(const bf16x8*)(dA + (th * 32 + mi * 16 + fr) * 264 + g * 64 + 32 * ks + 8 * fq);
#pragma unroll
        for (int ni = 0; ni < 4; ++ni) b[ni] = *(const bf16x8*)(WT + (g * 64 + ni * 16 + fr) * 72 + 32 * ks + 8 * fq);
#pragma unroll
        for (int mi = 0; mi < 2; ++mi)
#pragma unroll
          for (int ni = 0; ni < 4; ++ni) acc[mi][ni] = __builtin_amdgcn_mfma_f32_16x16x32_bf16(b[ni], a[mi], acc[mi][ni], 0, 0, 0);
      }
#pragma unroll
      for (int mi = 0; mi < 2; ++mi) {
        const int row = row0 + th * 32 + mi * 16 + fr;
#pragma unroll
        for (int ni = 0; ni < 4; ++ni) {
          const int j0 = g * 64 + ni * 16 + 4 * fq;
          const float4 sc = *(const float4*)(p.pool_scale() + layer * 256 + j0);
          *(int*)((char*)p.cat() + (size_t)row * D + 512 + j0) =
              pack_fp8x4(acc[mi][ni][0] * sc.x * 8.f, acc[mi][ni][1] * sc.y * 8.f, acc[mi][ni][2] * sc.z * 8.f, acc[mi][ni][3] * sc.w * 8.f);
        }
      }
    }
  }
  __syncthreads();
}

DI int gla_row0(int b, int slot) { return slot < 4 ? b * NCTX + slot * 64 : MC + b * SEQ + (slot - 4) * 64; }
constexpr int KXT_STRIDE = 72;

DI void phase_gla_c1(const W& p_, int layer, char* lds, int bid, int nblk) {
  const W p = oq(p_);
  const int tid = otid(), lane = tid & 63;
  const int wid = __builtin_amdgcn_readfirstlane(tid >> 6);
  constexpr int WREG = 2 * 32 * KXT_STRIDE * 2 + 4096;
  bf16_t* kxt = (bf16_t*)(lds + wid * WREG);
  bf16_t* al = (bf16_t*)(lds + wid * WREG + 2 * 32 * KXT_STRIDE * 2);
  float* s_rope = (float*)(lds + 8 * WREG);
  for (int i = tid; i < 1024; i += NTHR) s_rope[i] = p.rope()[i];
  __syncthreads();
  const int dir = lane >> 5, d = lane & 31, fr = lane & 15, fq = lane >> 4;
  const __amdgpu_buffer_rsrc_t rsV = __builtin_amdgcn_make_buffer_rsrc((void*)p.vtg(), 0, (int)(HMG_ELEMS * 2), 0x00020000);
  const int half = d >> 4, jf = d & 7;
  const float sgn = ((d >> 3) & 1) ? 1.f : -1.f;
  for (int u = bid * 8 + wid; u < NB * 4 * NSLOT; u += nblk * 8) {
    const int slot = u % NSLOT, bh = u / NSLOT, h = bh & 3, b = bh >> 2;
    const int row0 = gla_row0(b, slot);
    const bool latent = slot >= 4;
#pragma unroll
    for (int j = 0; j < 4; ++j) {
      const int rr = j * 16 + (lane >> 2), chk = lane & 3;
      *(uint4*)(al + rr * 32 + chk * 8) = *(const uint4*)(p.px() + (size_t)(row0 + rr) * INW + 2560 + chk * 8);
    }
    float w2[16];
    {
      const float* w2p = (dir ? p.w_gate_b() : p.w_gate_f()) + layer * 2048 + h * 32 + d;
#pragma unroll
      for (int r = 0; r < 16; ++r) w2[r] = w2p[r * 128];
    }
    const float b2 = (dir ? p.b_gate_b() : p.b_gate_f())[layer * 128 + h * 32 + d];
    bf16_t* gq = p.gqk() + ((size_t)u * 2 + dir) * 4096;
    asm volatile("s_waitcnt lgkmcnt(0)" ::: "memory");
    float bsum = 0.f;
    for (int ib = 0; ib < 4; ++ib) {
      bf16_t qo[16], qp[16], ko[16], kp[16];
#pragma unroll
      for (int k = 0; k < 16; ++k) {
        const int ii = ib * 16 + k, i = dir ? 63 - ii : ii;
        const bf16_t* rowp = p.px() + (size_t)(row0 + i) * INW + h * 32;
        qo[k] = rowp[1792 + d]; qp[k] = rowp[1792 + (d ^ 8)]; ko[k] = rowp[1920 + d]; kp[k] = rowp[1920 + (d ^ 8)];
      }
#pragma unroll
      for (int k = 0; k < 16; ++k) {
        const int ii = ib * 16 + k, i = dir ? 63 - ii : ii;
        const uint4 a0 = *(const uint4*)(al + i * 32 + dir * 16), a1 = *(const uint4*)(al + i * 32 + dir * 16 + 8);
        float lg = b2;
        const unsigned aw[8] = {a0.x, a0.y, a0.z, a0.w, a1.x, a1.y, a1.z, a1.w};
#pragma unroll
        for (int r = 0; r < 8; ++r) {
          lg += __uint_as_float(aw[r] << 16) * w2[2 * r];
          lg += __uint_as_float(aw[r] & 0xffff0000u) * w2[2 * r + 1];
        }
        const float ls = fminf(lg, 0.f) - __logf(1.f + __expf(-fabsf(lg)));
        bsum += ls * (1.f / 16.f);
        const float qov = bf2f(qo[k]) * 0.17677669529663687f, qpv = bf2f(qp[k]) * 0.17677669529663687f;
        const float kov = bf2f(ko[k]), kpv = bf2f(kp[k]);
        float qr = qov, kr = kov;
        if (latent) {
          const int pos = half == 0 ? (slot - 4) : i;
          const float2 cs = *(const float2*)(s_rope + (pos * 8 + jf) * 2);
          qr = qov * cs.x + sgn * qpv * cs.y;
          kr = kov * cs.x + sgn * kpv * cs.y;
        }
        const float eb = __expf(bsum);
        const bf16_t qx = f2bf(qr * eb), kx = f2bf(kr / eb);
        gq[i * 32 + d] = qx;
        gq[2048 + i * 32 + d] = kx;
        kxt[(dir * 32 + d) * KXT_STRIDE + i] = kx;
      }
    }
    const float eblast = __expf(bsum);
    p.gdec()[((size_t)u * 2 + dir) * 32 + d] = eblast;
    asm volatile("s_waitcnt lgkmcnt(0)" ::: "memory");
    const unsigned vbase = (unsigned)((latent ? HMG_LAT + (size_t)(bh * 64 + slot - 4) * 4096 : (size_t)(bh * 4 + slot) * 4096) * 2);
    bf16x8 vf[2][4];
#pragma unroll
    for (int ks = 0; ks < 2; ++ks)
#pragma unroll
      for (int mt = 0; mt < 4; ++mt) vf[ks][mt] = bl128(rsV, (unsigned)(((16 * mt + fr) * 64 + 8 * fq) * 2), vbase + ks * 64);
#pragma unroll
    for (int dd = 0; dd < 2; ++dd) {
      f32x4 acc[4][2];
#pragma unroll
      for (int mt = 0; mt < 4; ++mt)
#pragma unroll
        for (int nt = 0; nt < 2; ++nt) acc[mt][nt] = (f32x4){0.f, 0.f, 0.f, 0.f};
#pragma unroll
      for (int ks = 0; ks < 2; ++ks) {
        bf16x8 kf[2];
#pragma unroll
        for (int nt = 0; nt < 2; ++nt) kf[nt] = *(const bf16x8*)(kxt + (dd * 32 + 16 * nt + fr) * KXT_STRIDE + 32 * ks + 8 * fq);
#pragma unroll
        for (int mt = 0; mt < 4; ++mt)
#pragma unroll
          for (int nt = 0; nt < 2; ++nt) acc[mt][nt] = __builtin_amdgcn_mfma_f32_16x16x32_bf16(vf[ks][mt], kf[nt], acc[mt][nt], 0, 0, 0);
      }
      float* kvp = p.gkv() + ((size_t)u * 2 + dd) * 2048;
#pragma unroll
      for (int nt = 0; nt < 2; ++nt) {
        const float sc = __shfl(eblast, dd * 32 + 16 * nt + fr);
#pragma unroll
        for (int mt = 0; mt < 4; ++mt)
#pragma unroll
          for (int j = 0; j < 4; ++j) kvp[(16 * mt + 4 * fq + j) * 32 + 16 * nt + fr] = acc[mt][nt][j] * sc;
      }
    }
    asm volatile("s_waitcnt lgkmcnt(0)" ::: "memory");
  }
  __syncthreads();
}

DI void phase_gla_scan(const W& p_, int bid, int nblk) {
  const W p = oq(p_);
  bf16_t* sin = (bf16_t*)p.gsin();
  const int nthreads = NB * 4 * 2 * 2048;
  for (int gid = bid * NTHR + otid(); gid < nthreads; gid += nblk * NTHR) {
    const int el = gid & 2047, dir = (gid >> 11) & 1, bh = gid >> 12, d = el & 31;
    float S = 0.f;
    for (int st0 = 0; st0 < NSLOT; st0 += 17) {
      float dk[17], kv[17];
#pragma unroll
      for (int j = 0; j < 17; ++j) {
        const int st = st0 + j;
        const int slot = dir == 0 ? st : (st < 4 ? 3 - st : NSLOT + 3 - st);
        const size_t base = ((size_t)(bh * NSLOT + slot)) * 2 + dir;
        dk[j] = p.gdec()[base * 32 + d];
        kv[j] = p.gkv()[base * 2048 + el];
      }
#pragma unroll
      for (int j = 0; j < 17; ++j) {
        const int st = st0 + j;
        const int slot = dir == 0 ? st : (st < 4 ? 3 - st : NSLOT + 3 - st);
        const size_t base = ((size_t)(bh * NSLOT + slot)) * 2 + dir;
        sin[base * 2048 + el] = f2bf(S);
        S = dk[j] * S + kv[j];
      }
    }
  }
}

DI void phase_gla_c3(const W& p_, int layer, char* lds, int bid, int nblk) {
  (void)lds;
  const W p = oq(p_);
  const int tid = otid(), lane = tid & 63;
  const int wid = __builtin_amdgcn_readfirstlane(tid >> 6);
  const int fr = lane & 15, fq = lane >> 4;
  const __amdgpu_buffer_rsrc_t rsV = __builtin_amdgcn_make_buffer_rsrc((void*)p.vtg(), 0, (int)(HMG_ELEMS * 2), 0x00020000);
  const __amdgpu_buffer_rsrc_t rsQ = __builtin_amdgcn_make_buffer_rsrc((void*)p.gqk(), 0, (int)((size_t)NB * 4 * NSLOT * 16384), 0x00020000);
  const __amdgpu_buffer_rsrc_t rsS = __builtin_amdgcn_make_buffer_rsrc((void*)p.gsin(), 0, (int)((size_t)NB * 4 * NSLOT * 2 * 4096), 0x00020000);
  const int slot_lo = layer == 0 ? 0 : 4;
  const int nsl = NSLOT - slot_lo;
  const unsigned vfrag = (unsigned)(fr * 64 + fq * 16);
  for (int uu = bid * 8 + wid; uu < NB * 4 * nsl; uu += nblk * 8) {
    const int slot = slot_lo + uu % nsl, bh = uu / nsl, h = bh & 3, b = bh >> 2;
    const int u = bh * NSLOT + slot;
    const bool latent = slot >= 4;
    const int row0 = gla_row0(b, slot);
    const unsigned qbase = (unsigned)u * 16384u;
    bf16x8 QF[4], QB[4];
#pragma unroll
    for (int ct = 0; ct < 4; ++ct) { QF[ct] = bl128(rsQ, vfrag, qbase + ct * 1024); QB[ct] = bl128(rsQ, vfrag, qbase + 8192 + ct * 1024); }
    f32x4 O[4][4];
#pragma unroll
    for (int mt = 0; mt < 4; ++mt)
#pragma unroll
      for (int ct = 0; ct < 4; ++ct) O[mt][ct] = (f32x4){0.f, 0.f, 0.f, 0.f};
    const unsigned vbase = (unsigned)((latent ? HMG_LAT + (size_t)(bh * 64 + slot - 4) * 4096 : (size_t)(bh * 4 + slot) * 4096) * 2);
    const unsigned vV = (unsigned)((fr * 64 + 4 * fq) * 2);
#pragma unroll
    for (int ks = 0; ks < 2; ++ks) {
      f32x4 Pt[2][4];
#pragma unroll
      for (int t2 = 0; t2 < 2; ++t2) {
        const int st = 2 * ks + t2;
        const bf16x8 KFs = bl128(rsQ, vfrag, qbase + 4096 + st * 1024), KBs = bl128(rsQ, vfrag, qbase + 8192 + 4096 + st * 1024);
#pragma unroll
        for (int ct = 0; ct < 4; ++ct) {
          const f32x4 z = (f32x4){0.f, 0.f, 0.f, 0.f};
          if (st < ct) Pt[t2][ct] = __builtin_amdgcn_mfma_f32_16x16x32_bf16(KFs, QF[ct], z, 0, 0, 0);
          else if (st > ct) Pt[t2][ct] = __builtin_amdgcn_mfma_f32_16x16x32_bf16(KBs, QB[ct], z, 0, 0, 0);
          else {
            const f32x4 f = __builtin_amdgcn_mfma_f32_16x16x32_bf16(KFs, QF[ct], z, 0, 0, 0);
            const f32x4 g = __builtin_amdgcn_mfma_f32_16x16x32_bf16(KBs, QB[ct], z, 0, 0, 0);
#pragma unroll
            for (int j = 0; j < 4; ++j) { const int s = 4 * fq + j; Pt[t2][ct][j] = (s <= fr ? f[j] : 0.f) + (s >= fr ? g[j] : 0.f); }
          }
        }
      }
      bf16x8 pf[4];
#pragma unroll
      for (int ct = 0; ct < 4; ++ct)
        pf[ct] = __builtin_bit_cast(bf16x8, (u32x4){pack2(Pt[0][ct][0], Pt[0][ct][1]), pack2(Pt[0][ct][2], Pt[0][ct][3]),
                                                     pack2(Pt[1][ct][0], Pt[1][ct][1]), pack2(Pt[1][ct][2], Pt[1][ct][3])});
#pragma unroll
      for (int mt = 0; mt < 4; ++mt) {
        const unsigned so = vbase + (unsigned)((mt * 16 * 64 + 32 * ks) * 2);
        const u32x2 v0 = bl64(rsV, vV, so), v1 = bl64(rsV, vV + 32, so);
        const bf16x8 vf = __builtin_bit_cast(bf16x8, (u32x4){v0.x, v0.y, v1.x, v1.y});
#pragma unroll
        for (int ct = 0; ct < 4; ++ct) O[mt][ct] = __builtin_amdgcn_mfma_f32_16x16x32_bf16(vf, pf[ct], O[mt][ct], 0, 0, 0);
      }
    }
    const unsigned sbase = (unsigned)u * 8192u;
#pragma unroll
    for (int mt = 0; mt < 4; ++mt) {
      const bf16x8 sf = bl128(rsS, vfrag, sbase + mt * 1024), sb = bl128(rsS, vfrag, sbase + 4096 + mt * 1024);
#pragma unroll
      for (int ct = 0; ct < 4; ++ct) {
        O[mt][ct] = __builtin_amdgcn_mfma_f32_16x16x32_bf16(sf, QF[ct], O[mt][ct], 0, 0, 0);
        O[mt][ct] = __builtin_amdgcn_mfma_f32_16x16x32_bf16(sb, QB[ct], O[mt][ct], 0, 0, 0);
      }
    }
#pragma unroll
    for (int ct = 0; ct < 4; ++ct) {
      float ss = 0.f;
#pragma unroll
      for (int mt = 0; mt < 4; ++mt)
#pragma unroll
        for (int j = 0; j < 4; ++j) ss += O[mt][ct][j] * O[mt][ct][j];
      ss += __shfl_xor(ss, 16); ss += __shfl_xor(ss, 32);
      const float rstd = rsqrtf(ss * (1.f / 64.f) + EPS);
      const int row = row0 + 16 * ct + fr;
#pragma unroll
      for (int mt = 0; mt < 4; ++mt) {
        const int v0 = 16 * mt + 4 * fq;
        const uint2 rv = *(const uint2*)(p.px() + (size_t)row * INW + 2304 + h * 64 + v0);
        const float4 gg = *(const float4*)(p.g_gla() + layer * 64 + v0);
        const float r0 = O[mt][ct][0] * rstd * gg.x * siluf_(__uint_as_float(rv.x << 16));
        const float r1 = O[mt][ct][1] * rstd * gg.y * siluf_(__uint_as_float(rv.x & 0xffff0000u));
        const float r2 = O[mt][ct][2] * rstd * gg.z * siluf_(__uint_as_float(rv.y << 16));
        const float r3 = O[mt][ct][3] * rstd * gg.w * siluf_(__uint_as_float(rv.y & 0xffff0000u));
        *(int*)((char*)p.cat() + (size_t)row * D + 768 + h * 64 + v0) = pack_fp8x4(r0 * 8.f, r1 * 8.f, r2 * 8.f, r3 * 8.f);
      }
    }
  }
}

#define XB_TMO      128
#define XB_XCNT(j)  (256  + 64 * (j))
#define XB_XSUB(j)  (1280 + 64 * (j))
#define XB_XGEN(j)  (2304 + 64 * (j))
#define XB_TOP      3328
#define XB_TOPGEN   3392
#define XCD_BAR_WORDS 3456
#define XB_SPIN_CAP (1u << 18)
#define LAS __attribute__((address_space(3)))

__device__ __forceinline__ unsigned xb_ld(unsigned* p)              { return __hip_atomic_load(p, __ATOMIC_RELAXED, __HIP_MEMORY_SCOPE_AGENT); }
__device__ __forceinline__ unsigned xb_add(unsigned* p, unsigned v) { return __hip_atomic_fetch_add(p, v, __ATOMIC_RELAXED, __HIP_MEMORY_SCOPE_AGENT); }
__device__ __forceinline__ unsigned xb_xcc_id() { return (unsigned)__builtin_amdgcn_s_getreg((3 << 11) | 20) & 0xFu; }
#define XB_SPIN(cond, bar) do { unsigned _sp = 0; while (cond) { __builtin_amdgcn_s_sleep(1); \
    if ((++_sp & 255u) == 0u) { if (xb_ld(&(bar)[XB_TMO])) break; if (_sp > XB_SPIN_CAP) { atomicAdd(&(bar)[XB_TMO], 1u); break; } } } } while (0)

struct XcdBarrier { unsigned* bar; unsigned x; volatile LAS unsigned* st; };

__device__ __forceinline__ XcdBarrier xcd_barrier_post(unsigned* bar, volatile LAS unsigned* st) {
    XcdBarrier b; b.bar = bar; b.x = xb_xcc_id(); b.st = st;
    if (threadIdx.x == 0) (void)xb_add(&bar[XB_XCNT(b.x)], 1u);
    return b;
}
__device__ __forceinline__ void xcd_barrier_complete(unsigned* bar, unsigned x, unsigned& nloc, unsigned& nx) {
    const unsigned G = gridDim.x * gridDim.y * gridDim.z;
    unsigned sum, cnt, mine, sp = 0u;
    for (;;) {
        sum = 0u; cnt = 0u; mine = 0u;
#pragma unroll
        for (unsigned j = 0; j < 16; ++j) { const unsigned c = xb_ld(&bar[XB_XCNT(j)]); sum += c; cnt += (c > 0u) ? 1u : 0u; mine = (j == x) ? c : mine; }
        if (sum == G) break;
        __builtin_amdgcn_s_sleep(1);
        if ((++sp & 255u) == 0u) { if (xb_ld(&bar[XB_TMO])) break; if (sp > XB_SPIN_CAP) { atomicAdd(&bar[XB_TMO], 1u); break; } }
    }
    nloc = mine > 0u ? mine : 1u; nx = cnt > 0u ? cnt : 1u;
}
__device__ __forceinline__ void xcd_barrier(const XcdBarrier& b) {
    asm volatile("s_waitcnt vmcnt(0)" ::: "memory");
    __syncthreads();
    if (threadIdx.x == 0) {
        unsigned long long bv = (unsigned long long)b.bar; unsigned bx = b.x;
        asm volatile("" : "+s"(bv), "+s"(bx));
        unsigned* bar = (unsigned*)(__attribute__((address_space(1))) unsigned*)bv;
        __builtin_amdgcn_s_waitcnt(0);
        unsigned nloc = b.st[0], nx = b.st[1];
        if (nloc == 0u) { xcd_barrier_complete(bar, bx, nloc, nx); b.st[0] = nloc; b.st[1] = nx; }
        const unsigned old = xb_add(&bar[XB_XSUB(bx)], 1u);
        const unsigned gen = old / nloc;
        if (old + 1u == (gen + 1u) * nloc) {
            __builtin_amdgcn_fence(__ATOMIC_RELEASE, "agent");
            asm volatile("s_waitcnt vmcnt(0)" ::: "memory");
            const unsigned og = xb_add(&bar[XB_TOP], 1u);
            const unsigned tg = og / nx;
            if (og + 1u == (tg + 1u) * nx) xb_add(&bar[XB_TOPGEN], 1u);
            else XB_SPIN(xb_ld(&bar[XB_TOPGEN]) == tg, bar);
            __builtin_amdgcn_fence(__ATOMIC_ACQUIRE, "agent");
            xb_add(&bar[XB_XGEN(bx)], 1u);
            asm volatile("s_waitcnt vmcnt(0)" ::: "memory");
        } else {
            XB_SPIN(xb_ld(&bar[XB_XGEN(bx)]) == gen, bar);
            __builtin_amdgcn_fence(__ATOMIC_ACQUIRE, "agent");
            asm volatile("s_waitcnt vmcnt(0)" ::: "memory");
        }
    }
    __syncthreads();
}

__global__ void __launch_bounds__(NTHR, 2) k_fwd(P q) {
  extern __shared__ __attribute__((aligned(16))) char lds[];
  const int bid = blockIdx.x, nblk = gridDim.x;
  if (threadIdx.x < 4) ((unsigned*)(lds + LDS_BYTES - 16))[threadIdx.x] = 0u;
  __syncthreads();
  XcdBarrier bar = xcd_barrier_post((unsigned*)(q.ws + OFF_BAR), (volatile LAS unsigned*)(lds + LDS_BYTES - 16));
  int* s_vb = (int*)(lds + LDS_BYTES - 32);
  if (threadIdx.x == 0) {
    const int xcc = (int)xb_xcc_id();
    s_vb[1] = xcc;
    s_vb[2] = (int)__hip_atomic_fetch_add((unsigned*)(q.ws + OFF_CNT) + 768 + xcc, 1u, __ATOMIC_RELAXED, __HIP_MEMORY_SCOPE_AGENT);
  }
#define GB() xcd_barrier(bar)
#ifndef PROBE_DUP
#define PROBE_DUP 0
#endif
#if PROBE_DUP == 1
#define DUP1(x) x
#else
#define DUP1(x) (void)0
#endif
#if PROBE_DUP == 2
#define DUP2(x) x
#else
#define DUP2(x) (void)0
#endif
#if PROBE_DUP == 3
#define DUP3(x) x
#else
#define DUP3(x) (void)0
#endif
#if PROBE_DUP == 4
#define DUP4(x) x
#else
#define DUP4(x) (void)0
#endif
#if PROBE_DUP == 5
#define DUP5(x) x
#else
#define DUP5(x) (void)0
#endif
#if PROBE_DUP == 6
#define DUP6(x) x
#else
#define DUP6(x) (void)0
#endif
#if PROBE_DUP == 7
#define DUP7(x) x
#else
#define DUP7(x) (void)0
#endif
#if PROBE_DUP == 8
#define DUP8(x) x
#else
#define DUP8(x) (void)0
#endif
#if PROBE_DUP == 9
#define DUP9(x) x
#else
#define DUP9(x) (void)0
#endif
  phase_convert(q, lds, bid, nblk);
  phase_mod(q, lds, bid, nblk);
  DUP3(phase_convert(q, lds, bid, nblk)); DUP3(phase_mod(q, lds, bid, nblk));
  GB();
  if (threadIdx.x == 0) {
    const unsigned* rc = (const unsigned*)(q.ws + OFF_CNT) + 768;
    const int per = nblk >> 3;
    bool ok = (nblk & 7) == 0;
    for (int j = 0; j < 16; ++j) {
      const int c = (int)__hip_atomic_load(rc + j, __ATOMIC_RELAXED, __HIP_MEMORY_SCOPE_AGENT);
      ok = ok && (j < 8 ? c == per : c == 0);
    }
    s_vb[0] = ok ? s_vb[1] * per + s_vb[2] : ((nblk & 7) == 0 ? (bid & 7) * per + (bid >> 3) : bid);
  }
  __syncthreads();
  const int vb = __builtin_amdgcn_readfirstlane(s_vb[0]);
  phase_norm0(q, bid, nblk);
  DUP3(phase_norm0(q, bid, nblk));
  GB();
  const W p{q.ws, q.out, q.x, q.ctx};
#define LAYER(layer, row_lo, LASTGB)                          \
  do {                                                        \
    phase_inproj(p, layer, lds, vb, nblk);                   \
    DUP7(phase_inproj(p, layer, lds, vb, nblk));             \
    GB();                                                     \
    phase_gla_c1(p, layer, lds, vb, nblk);                   \
    phase_pool(p, layer, lds, vb, nblk);                     \
    DUP6(phase_gla_c1(p, layer, lds, vb, nblk)); DUP5(phase_pool(p, layer, lds, vb, nblk)); \
    GB();                                                     \
    phase_gla_scan(p, vb, nblk);                             \
    phase_attn(p, layer, lds, vb, nblk);                     \
    DUP6(phase_gla_scan(p, vb, nblk)); DUP4(phase_attn(p, layer, lds, vb, nblk)); \
    GB();                                                     \
    phase_gla_c3(p, layer, lds, vb, nblk);                   \
    DUP6(phase_gla_c3(p, layer, lds, vb, nblk));             \
    GB();                                                     \
    DUP2(phase_outproj_t<true>(p, layer, lds, row_lo, vb, nblk)); \
    phase_outproj(p, layer, lds, row_lo, vb, nblk);          \
    GB();                                                     \
    phase_norm(p, layer, row_lo, vb, nblk);                  \
    DUP3(phase_norm(p, layer, row_lo, vb, nblk));            \
    GB();                                                     \
    phase_router(p, layer, lds, row_lo, vb, nblk);           \
    DUP1(phase_router(p, layer, lds, row_lo, vb, nblk));     \
    GB();                                                     \
    phase_route(p, layer, lds, row_lo, vb, nblk);            \
    GB();                                                     \
    phase_moe(p, layer, lds, row_lo, vb, nblk);              \
    DUP8(phase_moe(p, layer, lds, row_lo, vb, nblk));        \
    GB();                                                     \
    DUP9(phase_combine_t<true>(p, layer, row_lo, vb, nblk)); \
    phase_combine(p, layer, row_lo, vb, nblk);               \
    LASTGB;                                                   \
  } while (0)
#if PROBE_GEMM
  phase_probe_gemm(p, lds, vb, nblk);
  GB();
#endif
  LAYER(0, 0, GB());
  LAYER(1, MC, (void)0);
#undef LAYER
#undef GB
}

}

extern "C" void kernel_launch(void* const* d_in, const int* in_sizes, int n_in, void* d_out, int out_size, void* d_ws,
                              size_t ws_size, hipStream_t stream) {
  (void)in_sizes; (void)n_in; (void)out_size;
  P p{};
  const float* const* in = (const float* const*)d_in;
  p.x = in[0]; p.c = in[1]; p.ctx = in[2]; p.c_ctx = in[3]; p.w_mod = in[4]; p.b_mod = in[5]; p.g_mix = in[6]; p.w_in = in[7];
  p.rpb = in[8]; p.w_pool = in[9]; p.pool_scale = in[10]; p.w_gate_f = in[11]; p.b_gate_f = in[12]; p.w_gate_b = in[13];
  p.b_gate_b = in[14]; p.g_gla = in[15]; p.w_out = in[16]; p.g_ffn = in[17]; p.w_router = in[18]; p.b_router = in[19];
  p.w_e_in = in[20]; p.w_e_down = in[21]; p.w_sh_in = in[22]; p.w_sh_down = in[23]; p.g_final = in[24];
  p.out = (float*)d_out;
  p.ws = (char*)d_ws;
  char* ws = (char*)d_ws;
  if (ws_size < WS_TOTAL) { fprintf(stderr, "workspace too small: %zu < %zu\n", ws_size, (size_t)WS_TOTAL); }
  static int grid = 0;
  if (!grid) {
    (void)hipFuncSetAttribute((const void*)k_fwd, hipFuncAttributeMaxDynamicSharedMemorySize, LDS_BYTES);
    int dev = 0, cus = 0, per_cu = 0;
    (void)hipGetDevice(&dev);
    (void)hipDeviceGetAttribute(&cus, hipDeviceAttributeMultiprocessorCount, dev);
    (void)hipOccupancyMaxActiveBlocksPerMultiprocessor(&per_cu, (const void*)k_fwd, NTHR, LDS_BYTES);
    if (per_cu < 1) { fprintf(stderr, "k_fwd: occupancy query says 0 blocks per CU\n"); per_cu = 1; }
    grid = cus > 0 ? cus : 256;
  }
  (void)hipMemsetAsync(ws, 0, ZERO_BYTES, stream);
  hipLaunchKernelGGL(k_fwd, dim3(grid), dim3(NTHR), LDS_BYTES, stream, p);
}
```

```cpp
#include <hip/hip_runtime.h>
#include <stdint.h>
#include <stdio.h>

#define DI __device__ __forceinline__
typedef unsigned short bf16_t;
typedef short bf16x8 __attribute__((ext_vector_type(8)));
typedef short bf16x4 __attribute__((ext_vector_type(4)));
typedef float f32x4 __attribute__((ext_vector_type(4)));

namespace {
constexpr int D = 1024, NB = 8, SEQ = 4096, NCTX = 256;
constexpr int MC = NB * NCTX, ML = NB * SEQ, MT = MC + ML;
constexpr int INW = 2592, INWP = 2816;
constexpr int NE = 256, NE1 = 257;
constexpr int NTHR = 512;
constexpr int LDS_BYTES = 152 * 1024;
constexpr int CAP = MT;
constexpr int NSLOT = 68;
constexpr float EPS = 1e-6f;

struct P {
  const float *x, *c, *ctx, *c_ctx, *w_mod, *b_mod, *g_mix, *w_in, *rpb, *w_pool, *pool_scale,
      *w_gate_f, *b_gate_f, *w_gate_b, *b_gate_b, *g_gla, *w_out, *g_ffn, *w_router, *b_router,
      *w_e_in, *w_e_down, *w_sh_in, *w_sh_down, *g_final;
  float* out;
  char* ws;
};

constexpr size_t al256(size_t x) { return (x + 255) & ~(size_t)255; }
constexpr size_t OFF_BAR = 0;
constexpr size_t OFF_CNT = OFF_BAR + 16384;
constexpr size_t ZERO_BYTES = 16384 + 4096;
constexpr size_t OFF_MOD = OFF_CNT + 4096;
constexpr size_t OFF_ROPE = OFF_MOD + al256((size_t)2 * 9 * 6144 * 4);
constexpr size_t OFF_GMIX = OFF_ROPE + al256(64 * 8 * 2 * 4);
constexpr size_t OFF_GFFN = OFF_GMIX + al256(2 * 1024 * 4);
constexpr size_t OFF_GFINAL = OFF_GFFN + al256(2 * 1024 * 4);
constexpr size_t OFF_RPB = OFF_GFINAL + al256(1024 * 4);
constexpr size_t OFF_WPOOL = OFF_RPB + al256(2 * 3720 * 4);
constexpr size_t OFF_PSCALE = OFF_WPOOL + al256(2 * 4 * 4096 * 4);
constexpr size_t OFF_WGF = OFF_PSCALE + al256(2 * 256 * 4);
constexpr size_t OFF_WGB = OFF_WGF + al256(2 * 16 * 128 * 4);
constexpr size_t OFF_BGF = OFF_WGB + al256(2 * 16 * 128 * 4);
constexpr size_t OFF_BGB = OFF_BGF + al256(2 * 128 * 4);
constexpr size_t OFF_GGLA = OFF_BGB + al256(2 * 128 * 4);
constexpr size_t OFF_BROUTER = OFF_GGLA + al256(2 * 64 * 4);
constexpr size_t OFF_WIN = OFF_BROUTER + al256(2 * 256 * 4);
constexpr size_t OFF_WOUT = OFF_WIN + al256((size_t)2 * INWP * 1024 * 2);
constexpr size_t OFF_WR = OFF_WOUT + al256((size_t)2 * 1024 * 1024 * 2);
constexpr size_t OFF_WEI = OFF_WR + al256((size_t)2 * 256 * 1024 * 2);
constexpr size_t OFF_WED = OFF_WEI + al256((size_t)2 * NE1 * 512 * 1024 * 2);
constexpr size_t OFF_H = OFF_WED + al256((size_t)2 * NE1 * 1024 * 256 * 2);
constexpr size_t OFF_CAT = OFF_H + al256((size_t)MT * D * 2);
constexpr size_t OFF_H2 = OFF_CAT + al256((size_t)MT * D * 2);
constexpr size_t OFF_PX = OFF_H2 + al256((size_t)MT * D * 2);
constexpr size_t OFF_ACT = OFF_PX + al256((size_t)MT * INW * 2);
constexpr size_t OFF_Y = OFF_ACT + al256((size_t)9 * MT * 256 * 2);
constexpr size_t OFF_XRES = OFF_Y + al256((size_t)9 * MT * D * 2);
constexpr size_t OFF_LOGITS = OFF_XRES + al256((size_t)MT * D * 4);
constexpr size_t OFF_WTS = OFF_LOGITS + al256((size_t)MT * 256 * 4);
constexpr size_t OFF_GKV = OFF_WTS + al256((size_t)MT * 8 * 4);
constexpr size_t OFF_GDEC = OFF_GKV + al256((size_t)NB * 4 * NSLOT * 2 * 2048 * 4);
constexpr size_t OFF_GSIN = OFF_GDEC + al256((size_t)NB * 4 * NSLOT * 2 * 32 * 4);
constexpr size_t OFF_LISTS = OFF_GSIN + al256((size_t)NB * 4 * NSLOT * 2 * 2048 * 4);
constexpr size_t OFF_QH = OFF_LISTS + al256((size_t)NE * CAP * 4);
constexpr size_t HM_LAT = (size_t)NB * 8 * NCTX * 64;
constexpr size_t HM_ELEMS = (size_t)NB * 8 * (NCTX + SEQ) * 64;
constexpr size_t OFF_KH = OFF_QH + al256(HM_ELEMS * 2);
constexpr size_t OFF_VT = OFF_KH + al256(HM_ELEMS * 2);
constexpr size_t HMG_LAT = (size_t)NB * 4 * 64 * NCTX;
constexpr size_t HMG_ELEMS = (size_t)NB * 4 * 64 * (NCTX + SEQ);
constexpr size_t OFF_VTG = OFF_VT + al256(HM_ELEMS * 2);
constexpr size_t OFF_GQK = OFF_VTG + al256(HMG_ELEMS * 2);
constexpr size_t OFF_WPT = OFF_GQK + al256((size_t)NB * 4 * NSLOT * 2 * 2 * 2048 * 2);
constexpr size_t OFF_H2Q = OFF_WPT + al256((size_t)2 * 4 * 4096 * 2);
constexpr size_t WS_TOTAL = OFF_H2Q + al256((size_t)MT * 1024);

struct W {
  char* ws; float* out; const float* x; const float* ctx;
#define WF(T, name, OFF) DI T* name() const { return (T*)(ws + OFF); }
  WF(unsigned, bar, OFF_BAR) WF(int, cnt, OFF_CNT) WF(float, mod, OFF_MOD) WF(float, rope, OFF_ROPE)
  WF(float, g_mix, OFF_GMIX) WF(float, g_ffn, OFF_GFFN) WF(float, g_final, OFF_GFINAL) WF(float, rpb, OFF_RPB)
  WF(float, w_pool, OFF_WPOOL) WF(float, pool_scale, OFF_PSCALE) WF(float, w_gate_f, OFF_WGF) WF(float, w_gate_b, OFF_WGB)
  WF(float, b_gate_f, OFF_BGF) WF(float, b_gate_b, OFF_BGB) WF(float, g_gla, OFF_GGLA) WF(float, b_router, OFF_BROUTER)
  WF(bf16_t, win_t, OFF_WIN) WF(bf16_t, wout_t, OFF_WOUT) WF(bf16_t, wr_t, OFF_WR) WF(bf16_t, wei_t, OFF_WEI) WF(bf16_t, wed_t, OFF_WED)
  WF(bf16_t, h, OFF_H) WF(bf16_t, cat, OFF_CAT) WF(bf16_t, h2, OFF_H2) WF(bf16_t, px, OFF_PX) WF(bf16_t, act, OFF_ACT) WF(bf16_t, y, OFF_Y)
  WF(bf16_t, xres, OFF_XRES) WF(float, logits, OFF_LOGITS) WF(float, wts, OFF_WTS) WF(float, gkv, OFF_GKV) WF(float, gdec, OFF_GDEC)
  WF(float, gsin, OFF_GSIN) WF(int, lists, OFF_LISTS) WF(bf16_t, qh, OFF_QH) WF(bf16_t, kh, OFF_KH) WF(bf16_t, vt, OFF_VT) WF(bf16_t, vtg, OFF_VTG) WF(bf16_t, gqk, OFF_GQK) WF(bf16_t, wpt, OFF_WPT) WF(unsigned char, h2q, OFF_H2Q)
#undef WF
};

DI float bf2f(bf16_t v) { return __uint_as_float(((unsigned)v) << 16); }
DI bf16_t f2bf(float f) { unsigned u = __float_as_uint(f); u += 0x7fffu + ((u >> 16) & 1u); return (bf16_t)(u >> 16); }
typedef float f32x2v __attribute__((ext_vector_type(2)));
typedef __bf16 bf16x2v __attribute__((ext_vector_type(2)));
DI unsigned pack2(float lo, float hi) {
  const f32x2v v = {lo, hi};
  return __builtin_bit_cast(unsigned, __builtin_convertvector(v, bf16x2v));
}
DI int pack_fp8x4(float a, float b, float c, float d) {
  a = __builtin_amdgcn_fmed3f(a, -440.f, 440.f); b = __builtin_amdgcn_fmed3f(b, -440.f, 440.f);
  c = __builtin_amdgcn_fmed3f(c, -440.f, 440.f); d = __builtin_amdgcn_fmed3f(d, -440.f, 440.f);
  int w = __builtin_amdgcn_cvt_pk_fp8_f32(a, b, 0, false);
  return __builtin_amdgcn_cvt_pk_fp8_f32(c, d, w, true);
}
DI float4 unpack4(uint2 v) { return make_float4(__uint_as_float(v.x << 16), __uint_as_float(v.x & 0xffff0000u), __uint_as_float(v.y << 16), __uint_as_float(v.y & 0xffff0000u)); }
DI float wave_sum(float v) { for (int o = 32; o; o >>= 1) v += __shfl_xor(v, o); return v; }
DI float wave_max(float v) { for (int o = 32; o; o >>= 1) v = fmaxf(v, __shfl_xor(v, o)); return v; }
template <int CTRL> DI float dppf(float v) { return __int_as_float(__builtin_amdgcn_update_dpp(__float_as_int(v), __float_as_int(v), CTRL, 0xf, 0xf, false)); }
DI float rlanef(float v, int l) { return __int_as_float(__builtin_amdgcn_readlane(__float_as_int(v), l)); }
DI float wave_max_dpp(float v) {
  v = fmaxf(v, dppf<0xB1>(v));
  v = fmaxf(v, dppf<0x4E>(v));
  v = fmaxf(v, dppf<0x141>(v));
  v = fmaxf(v, dppf<0x140>(v));
  return fmaxf(fmaxf(rlanef(v, 0), rlanef(v, 16)), fmaxf(rlanef(v, 32), rlanef(v, 48)));
}
DI int otid() { int t = threadIdx.x; asm volatile("" : "+v"(t)); return t; }
DI float sigmoidf_(float x) { return 1.f / (1.f + __expf(-x)); }
DI float siluf_(float x) { return x / (1.f + __expf(-x)); }
DI int vbid_of(int bid, int nblk) { (void)nblk; return bid; }
DI int mod_row(int row) { return row < MC ? 8 : ((row - MC) >> 12); }

typedef __attribute__((address_space(1))) char gchar;
typedef __attribute__((address_space(1))) float gfloat;
DI W oq(const W& w) {
  unsigned long long v = (unsigned long long)w.ws;
  asm volatile("" : "+s"(v));
  W r; r.ws = (char*)(gchar*)v; r.out = w.out; r.x = w.x; r.ctx = w.ctx;
  return r;
}

struct NoHook { DI void operator()() const {} };
template <int WM, int WN, int MI, int NI, int BK, int NS, bool SWAP, int NCH, int FLAGS = 0, class FA, class FB, class EPI, class HK = NoHook>
DI void gemm_tile(char* lds, int nk, size_t bstride, size_t bks, FA rowA, FB rowB, EPI epi, const char* ares = nullptr, HK hook = HK()) {
  constexpr int BM = WM * MI * 16, BN = WN * NI * 16;
  constexpr int RB = BK * 2, CPR = RB / 16, RPP = 1024 / RB;
  constexpr bool ARES = (FLAGS & 1) != 0;
  constexpr int PA = ARES ? 0 : BM / RPP / 8, PB = BN / RPP / 8, NP = PA + PB, BOFF = ARES ? 0 : BM * RB, STG = BOFF + BN * RB, KS = BK / 32;
  static_assert(WM * WN == 8, "8 waves");
  static_assert(BK == 32 || BK == 64, "BK");
  const int tid = otid(), wid = tid >> 6, lane = tid & 63, fr = lane & 15, fq = lane >> 4;
  const int wr = wid / WN, wc = wid % WN;
  const int lrow = lane / CPR, pc = lane % CPR;
  const bf16_t* ap[PA > 0 ? PA : 1];
  const bf16_t* bp[PB];
#pragma unroll
  for (int i = 0; i < PA; ++i) {
    const int r = (wid + 8 * i) * RPP + lrow;
    const int sw = BK == 64 ? ((r >> 1) & 7) : ((-(r >> 2)) & 3);
    ap[i] = rowA(r) + ((pc ^ sw) * 8);
  }
#pragma unroll
  for (int i = 0; i < PB; ++i) {
    const int r = (wid + 8 * i) * RPP + lrow;
    const int sw = BK == 64 ? ((r >> 1) & 7) : ((-(r >> 2)) & 3);
    bp[i] = rowB(r) + ((pc ^ sw) * 8);
  }
  char* ldst = lds + wid * 1024 + lane * 16;
  f32x4 acc[MI][NI];
#pragma unroll
  for (int mi = 0; mi < MI; ++mi)
#pragma unroll
    for (int ni = 0; ni < NI; ++ni) acc[mi][ni] = (f32x4){0.f, 0.f, 0.f, 0.f};
  const int swf = BK == 64 ? (fr >> 1) : ((-(fr >> 2)) & 3);
  const int aoff = (wr * MI * 16 + fr) * RB + ((fq ^ swf) * 16);
  const int boff = BOFF + (wc * NI * 16 + fr) * RB + ((fq ^ swf) * 16);
#define GEMM_STAGE(s, t)                                                                                              \
  do {                                                                                                                \
    const int kt_ = NCH == 1 ? (t) : (t) % nk;                                                                        \
    const size_t bo_ = NCH == 1 ? (size_t)0 : (size_t)((t) / nk) * bstride;                                           \
    _Pragma("unroll") for (int i = 0; i < PA; ++i) __builtin_amdgcn_global_load_lds(                                  \
        (const unsigned*)(ap[i] + kt_ * BK), (unsigned*)(ldst + (s) * STG + i * 8192), 16, 0, 0);                     \
    _Pragma("unroll") for (int i = 0; i < PB; ++i) __builtin_amdgcn_global_load_lds(                                  \
        (const unsigned*)(bp[i] + bo_ + kt_ * bks), (unsigned*)(ldst + (s) * STG + BOFF + i * 8192), 16, 0, 0);      \
  } while (0)
  const int ntile = NCH * nk;
  if constexpr ((FLAGS & 64) == 0) {
#pragma unroll
    for (int s = 0; s < NS - 1; ++s)
      if (s < ntile) GEMM_STAGE(s, s);
  }
  int slot = 0, nslot = NS - 1;
  int kin = 0, chunk = 0;
#pragma nounroll
  for (int kt = 0; kt < ntile; ++kt) {
    if constexpr ((FLAGS & 32) != 0) {
      static_assert(NS == 2 && NCH > 1, "store-aware wait: 2-slot ring, chunked stream");
      if (kin == 0 && kt > 0) asm volatile("s_waitcnt vmcnt(8)" ::: "memory");
      else asm volatile("s_waitcnt vmcnt(0)" ::: "memory");
    } else {
      if (kt + NS - 2 < ntile) asm volatile("s_waitcnt vmcnt(%0)" ::"n"((NS - 2) * NP) : "memory");
      else asm volatile("s_waitcnt vmcnt(0)" ::: "memory");
    }
    __builtin_amdgcn_s_barrier();
    asm volatile("" ::: "memory");
    if (kt + NS - 1 < ntile) GEMM_STAGE(nslot, kt + NS - 1);
    if (kt == ntile - 1) hook();
    const char* sb = lds + slot * STG;
    const char* sa = ARES ? ares + (NCH == 1 ? kt : kin) * (BM * RB) : sb;
    slot = slot + 1 == NS ? 0 : slot + 1;
    nslot = nslot + 1 == NS ? 0 : nslot + 1;
    if constexpr ((FLAGS & 4) != 0) {
      static_assert(BK == 64 && NI % 4 == 0, "fp8 path: 128-byte rows, column tiles in groups of 4");
      typedef int i32x4v __attribute__((ext_vector_type(4)));
      typedef int i32x8v __attribute__((ext_vector_type(8)));
      constexpr int ASC = (FLAGS & 8) ? 0x7b7b7b7b : (FLAGS & 16) ? 0x7c7c7c7c : 0x7f7f7f7f;
      i32x4v a0[MI], a1[MI];
#pragma unroll
      for (int mi = 0; mi < MI; ++mi) {
        a0[mi] = *(const i32x4v*)(sa + (aoff + mi * 16 * RB));
        a1[mi] = *(const i32x4v*)(sa + ((aoff ^ 64) + mi * 16 * RB));
      }
      constexpr int GW = NI > 4 ? 2 : 4, NG8 = NI / GW;
      i32x4v b0[2][GW], b1[2][GW];
#pragma unroll
      for (int nj = 0; nj < GW; ++nj) {
        b0[0][nj] = *(const i32x4v*)(sb + (boff + nj * 16 * RB));
        b1[0][nj] = *(const i32x4v*)(sb + ((boff ^ 64) + nj * 16 * RB));
      }
      __builtin_amdgcn_sched_group_barrier(0x100, 2 * MI + 2 * GW, 0);
#pragma unroll
      for (int g = 0; g < NG8; ++g) {
        const int cur = g & 1, nxt = cur ^ 1;
        if (g + 1 < NG8) {
#pragma unroll
          for (int nj = 0; nj < GW; ++nj) {
            b0[nxt][nj] = *(const i32x4v*)(sb + (boff + ((g + 1) * GW + nj) * 16 * RB));
            b1[nxt][nj] = *(const i32x4v*)(sb + ((boff ^ 64) + ((g + 1) * GW + nj) * 16 * RB));
          }
          __builtin_amdgcn_sched_group_barrier(0x100, 2 * GW, 0);
        }
#pragma unroll
        for (int mi = 0; mi < MI; ++mi)
#pragma unroll
          for (int nj = 0; nj < GW; ++nj) {
            const i32x8v av = __builtin_shufflevector(a0[mi], a1[mi], 0, 1, 2, 3, 4, 5, 6, 7);
            const i32x8v bv = __builtin_shufflevector(b0[cur][nj], b1[cur][nj], 0, 1, 2, 3, 4, 5, 6, 7);
            acc[mi][g * GW + nj] = SWAP ? __builtin_amdgcn_mfma_scale_f32_16x16x128_f8f6f4(av, bv, acc[mi][g * GW + nj], 0, 0, 0, ASC, 0, 0x79797979)
                                        : __builtin_amdgcn_mfma_scale_f32_16x16x128_f8f6f4(bv, av, acc[mi][g * GW + nj], 0, 0, 0, 0x79797979, 0, ASC);
          }
        __builtin_amdgcn_sched_group_barrier(0x008, MI * GW, 0);
      }
    } else {
    constexpr int NG = NI / 4, NGT = KS * NG;
    bf16x8 af[KS][MI], bfr[2][4];
#pragma unroll
    for (int mi = 0; mi < MI; ++mi) af[0][mi] = *(const bf16x8*)(sa + (aoff + mi * 16 * RB));
#pragma unroll
    for (int nj = 0; nj < 4; ++nj) bfr[0][nj] = *(const bf16x8*)(sb + (boff + nj * 16 * RB));
    __builtin_amdgcn_sched_group_barrier(0x100, MI + 4, 0);
#pragma unroll
    for (int gi = 0; gi < NGT; ++gi) {
      const int ks = gi / NG, g = gi % NG, cur = gi & 1, nxt = cur ^ 1;
      if (gi + 1 < NGT) {
        const int ks2 = (gi + 1) / NG, g2 = (gi + 1) % NG;
#pragma unroll
        for (int nj = 0; nj < 4; ++nj) bfr[nxt][nj] = *(const bf16x8*)(sb + ((boff ^ (ks2 * 64)) + (g2 * 4 + nj) * 16 * RB));
        if (ks2 != ks) {
#pragma unroll
          for (int mi = 0; mi < MI; ++mi) af[ks2 % KS][mi] = *(const bf16x8*)(sa + ((aoff ^ (ks2 * 64)) + mi * 16 * RB));
          __builtin_amdgcn_sched_group_barrier(0x100, MI + 4, 0);
        } else {
          __builtin_amdgcn_sched_group_barrier(0x100, 4, 0);
        }
      }
#pragma unroll
      for (int mi = 0; mi < MI; ++mi)
#pragma unroll
        for (int nj = 0; nj < 4; ++nj)
          acc[mi][g * 4 + nj] = SWAP ? __builtin_amdgcn_mfma_f32_16x16x32_bf16(af[ks][mi], bfr[cur][nj], acc[mi][g * 4 + nj], 0, 0, 0)
                                     : __builtin_amdgcn_mfma_f32_16x16x32_bf16(bfr[cur][nj], af[ks][mi], acc[mi][g * 4 + nj], 0, 0, 0);
      __builtin_amdgcn_sched_group_barrier(0x008, MI * 4, 0);
    }
    }
    if (NCH > 1) {
      if (++kin == nk) {
        kin = 0;
        epi(acc, chunk, wr, wc, fr, fq);
        ++chunk;
#pragma unroll
        for (int mi = 0; mi < MI; ++mi)
#pragma unroll
          for (int ni = 0; ni < NI; ++ni) acc[mi][ni] = (f32x4){0.f, 0.f, 0.f, 0.f};
      }
    }
  }
#undef GEMM_STAGE
  if (FLAGS & 2) __syncthreads();
  if (NCH == 1) epi(acc, 0, wr, wc, fr, fq);
  __syncthreads();
}


template <int BN, int NPRE, class FB>
DI void gemm_prestage_b(char* lds, size_t bks, FB rowB) {
  const int tid = otid(), wid = tid >> 6, lane = tid & 63;
  const int lrow = lane >> 3, pc = lane & 7;
  char* ldst = lds + wid * 1024 + lane * 16;
#pragma unroll
  for (int s = 0; s < NPRE; ++s)
#pragma unroll
    for (int i = 0; i < BN / 64; ++i) {
      const int r = (wid + 8 * i) * 8 + lrow;
      const bf16_t* bp = rowB(r) + ((pc ^ ((r >> 1) & 7)) * 8);
      __builtin_amdgcn_global_load_lds((const unsigned*)(bp + s * bks), (unsigned*)(ldst + s * (BN * 128) + i * 8192), 16, 0, 0);
    }
}

template <int WM, int WN, int MI, int NI, bool SWAP, bool NOSTAGE = false, class FA, class FB, class EPI>
DI void gemm_tile_stag(char* lds, int nk, size_t bks, FA rowA, FB rowB, EPI epi) {
  constexpr int BK = 32, BM = WM * MI * 16, BN = WN * NI * 16;
  constexpr int RB = BK * 2, CPR = RB / 16, RPP = 1024 / RB;
  constexpr int PA = BM / RPP / 8, PB = BN / RPP / 8, NP = PA + PB, STG = (BM + BN) * RB;
  const int tid = otid(), wid = tid >> 6, lane = tid & 63, fr = lane & 15, fq = lane >> 4;
  const int wr = wid / WN, wc = wid % WN;
  const int lrow = lane / CPR, pc = lane % CPR;
  const bf16_t* ap[PA];
  const bf16_t* bp[PB];
#pragma unroll
  for (int i = 0; i < PA; ++i) { const int r = (wid + 8 * i) * RPP + lrow; ap[i] = rowA(r) + ((pc ^ ((-(r >> 2)) & 3)) * 8); }
#pragma unroll
  for (int i = 0; i < PB; ++i) { const int r = (wid + 8 * i) * RPP + lrow; bp[i] = rowB(r) + ((pc ^ ((-(r >> 2)) & 3)) * 8); }
  char* ldst = lds + wid * 1024 + lane * 16;
  f32x4 acc[MI][NI];
#pragma unroll
  for (int mi = 0; mi < MI; ++mi)
#pragma unroll
    for (int ni = 0; ni < NI; ++ni) acc[mi][ni] = (f32x4){0.f, 0.f, 0.f, 0.f};
  const int swf = (-(fr >> 2)) & 3;
  const int aoff = (wr * MI * 16 + fr) * RB + ((fq ^ swf) * 16);
  const int boff = BM * RB + (wc * NI * 16 + fr) * RB + ((fq ^ swf) * 16);
#define STAG_STAGE(s, t)                                                                                              \
  do {                                                                                                                \
    _Pragma("unroll") for (int i = 0; i < PA; ++i) __builtin_amdgcn_global_load_lds(                                  \
        (const unsigned*)(ap[i] + (t) * BK), (unsigned*)(ldst + (s) * STG + i * 8192), 16, 0, 0);                     \
    _Pragma("unroll") for (int i = 0; i < PB; ++i) __builtin_amdgcn_global_load_lds(                                  \
        (const unsigned*)(bp[i] + (t) * bks), (unsigned*)(ldst + (s) * STG + BM * RB + i * 8192), 16, 0, 0);          \
  } while (0)
  const int hb = __builtin_amdgcn_readfirstlane(wid >> 2);
  STAG_STAGE(0, 0);
  if (1 < nk) { STAG_STAGE(1, 1); asm volatile("s_waitcnt vmcnt(%0)" ::"n"(NP) : "memory"); }
  else asm volatile("s_waitcnt vmcnt(0)" ::: "memory");
  __builtin_amdgcn_s_barrier();
  asm volatile("" ::: "memory");
  if (hb) { __builtin_amdgcn_s_barrier(); asm volatile("" ::: "memory"); }
  for (int kt = 0; kt < nk; ++kt) {
    const char* sb = lds + (kt & 3) * STG;
    bf16x8 af[MI], bfr[NI];
#pragma unroll
    for (int mi = 0; mi < MI; ++mi) af[mi] = *(const bf16x8*)(sb + (aoff + mi * 16 * RB));
#pragma unroll
    for (int ni = 0; ni < NI; ++ni) bfr[ni] = *(const bf16x8*)(sb + (boff + ni * 16 * RB));
    if (!NOSTAGE && kt + 2 < nk) STAG_STAGE((kt + 2) & 3, kt + 2);
    if (hb) {
      if (kt + 2 < nk) asm volatile("s_waitcnt vmcnt(%0)" ::"n"(NP) : "memory");
      else asm volatile("s_waitcnt vmcnt(0)" ::: "memory");
    }
    __builtin_amdgcn_s_barrier();
    asm volatile("" ::: "memory");
    __builtin_amdgcn_s_setprio(1);
#pragma unroll
    for (int mi = 0; mi < MI; ++mi)
#pragma unroll
      for (int ni = 0; ni < NI; ++ni)
        acc[mi][ni] = SWAP ? __builtin_amdgcn_mfma_f32_16x16x32_bf16(af[mi], bfr[ni], acc[mi][ni], 0, 0, 0)
                           : __builtin_amdgcn_mfma_f32_16x16x32_bf16(bfr[ni], af[mi], acc[mi][ni], 0, 0, 0);
    __builtin_amdgcn_s_setprio(0);
    if (!hb) {
      if (kt + 2 < nk) asm volatile("s_waitcnt vmcnt(%0)" ::"n"(NP) : "memory");
      else asm volatile("s_waitcnt vmcnt(0)" ::: "memory");
    }
    __builtin_amdgcn_s_barrier();
    asm volatile("" ::: "memory");
  }
  if (!hb) { __builtin_amdgcn_s_barrier(); asm volatile("" ::: "memory"); }
#undef STAG_STAGE
  epi(acc, 0, wr, wc, fr, fq);
  __syncthreads();
}

struct ConvT { const float* src; bf16_t* dst; int ldn, N, K, k0, n0, bkl, npad, f8; };
DI ConvT conv_desc(const P& q, int tile) {
  constexpr int nA = 2 * 257 * 128, nB = 2 * 257 * 64, nC = 2 * 16 * 44, nD = 2 * 16 * 16;
  const W w{q.ws, q.out};
  ConvT c;
  c.f8 = 0;
  int t = tile;
  if (t < nA) {
    const int m = t / 128, r = t % 128, l = m / 257, e = m % 257;
    c.src = e < 256 ? q.w_e_in + (size_t)(l * 256 + e) * 1024 * 512 : q.w_sh_in + (size_t)l * 1024 * 512;
    c.dst = (bf16_t*)((char*)w.wei_t() + (size_t)m * 512 * 1024); c.ldn = 512; c.N = 512; c.K = 1024; c.bkl = 128; c.npad = 512; c.k0 = (r / 8) * 64; c.n0 = (r % 8) * 64; c.f8 = 1;
    return c;
  }
  t -= nA;
  if (t < nB) {
    const int m = t / 64, r = t % 64, l = m / 257, e = m % 257;
    c.src = e < 256 ? q.w_e_down + (size_t)(l * 256 + e) * 256 * 1024 : q.w_sh_down + (size_t)l * 256 * 1024;
    c.dst = (bf16_t*)((char*)w.wed_t() + (size_t)m * 1024 * 256); c.ldn = 1024; c.N = 1024; c.K = 256; c.bkl = 128; c.npad = 1024; c.k0 = (r / 16) * 64; c.n0 = (r % 16) * 64; c.f8 = 1;
    return c;
  }
  t -= nB;
  if (t < nC) {
    const int l = t / 704, r = t % 704;
    c.src = q.w_in + (size_t)l * 1024 * INW; c.dst = (bf16_t*)((char*)w.win_t() + (size_t)l * INWP * 1024); c.ldn = INW; c.N = INW; c.K = 1024; c.bkl = 128; c.npad = INWP; c.f8 = 1;
    c.k0 = (r / 44) * 64; c.n0 = (r % 44) * 64;
    return c;
  }
  t -= nC;
  if (t < nD) {
    const int l = t / 256, r = t % 256;
    c.src = q.w_out + (size_t)l * 1024 * 1024; c.dst = (bf16_t*)((char*)w.wout_t() + (size_t)l * 1024 * 1024); c.ldn = 1024; c.N = 1024; c.K = 1024; c.bkl = 128; c.npad = 1024; c.f8 = 1;
    c.k0 = (r / 16) * 64; c.n0 = (r % 16) * 64;
    return c;
  }
  t -= nD;
  {
    const int l = t / 64, r = t % 64;
    c.src = q.w_router + (size_t)l * 1024 * 256; c.dst = w.wr_t() + (size_t)l * 256 * 1024; c.ldn = 256; c.N = 256; c.K = 1024; c.bkl = 32; c.npad = 256;
    c.k0 = (r / 4) * 64; c.n0 = (r % 4) * 64;
  }
  return c;
}

DI void conv_store(const ConvT& c, uint4 v, int rn, int rks) {
  const int kk = c.k0 + rks * 2;
  if (c.f8) {
    const float4 lo = unpack4(make_uint2(v.x, v.y)), hi = unpack4(make_uint2(v.z, v.w));
    const int w0 = pack_fp8x4(lo.x * 64.f, lo.y * 64.f, lo.z * 64.f, lo.w * 64.f);
    const int w1 = pack_fp8x4(hi.x * 64.f, hi.y * 64.f, hi.z * 64.f, hi.w * 64.f);
    char* d8 = (char*)c.dst + (size_t)(kk / c.bkl) * c.npad * c.bkl + (size_t)(c.n0 + rn) * c.bkl + (kk % c.bkl);
    *(uint2*)d8 = make_uint2((unsigned)w0, (unsigned)w1);
  } else {
    *(uint4*)(c.dst + (size_t)(kk / c.bkl) * c.npad * c.bkl + (size_t)(c.n0 + rn) * c.bkl + (kk % c.bkl)) = v;
  }
}

DI void conv_fetch(const P& q, int tile, int nblk, int total, int kp, int ns, float4& a0, float4& b0, float4& a1, float4& b1) {
  const ConvT c0 = conv_desc(q, min(tile, total - 1));
  const ConvT c1 = conv_desc(q, min(tile + nblk, total - 1));
  const int col0 = min(c0.n0 + ns, c0.N - 4), col1 = min(c1.n0 + ns, c1.N - 4);
  a0 = *(const float4*)(c0.src + (size_t)(c0.k0 + 2 * kp) * c0.ldn + col0);
  b0 = *(const float4*)(c0.src + (size_t)(c0.k0 + 2 * kp + 1) * c0.ldn + col0);
  a1 = *(const float4*)(c1.src + (size_t)(c1.k0 + 2 * kp) * c1.ldn + col1);
  b1 = *(const float4*)(c1.src + (size_t)(c1.k0 + 2 * kp + 1) * c1.ldn + col1);
}

DI void phase_convert(const P& q, char* lds, int bid, int nblk) {
  constexpr int total = 2 * 257 * 128 + 2 * 257 * 64 + 2 * 16 * 44 + 2 * 16 * 16 + 2 * 16 * 4;
  const int t = otid();
  const int kp = t >> 4, ns = (t & 15) * 4, rn = t >> 3, rks = (t & 7) * 4;
  int par = 0;
  auto process = [&](int tile, const float4& a0, const float4& b0, const float4& a1, const float4& b1) {
    const bool two = tile + 1 < total;
    const ConvT c0 = conv_desc(q, tile);
    const ConvT c1 = conv_desc(q, two ? tile + 1 : tile);
    unsigned* T0 = (unsigned*)lds + par * (2 * 64 * 33);
    unsigned* T1 = T0 + 64 * 33;
    par ^= 1;
    const unsigned k0m = c0.n0 + ns < c0.N ? 0xffffffffu : 0u, k1m = c1.n0 + ns < c1.N ? 0xffffffffu : 0u;
    T0[(ns + 0) * 33 + kp] = pack2(a0.x, b0.x) & k0m; T0[(ns + 1) * 33 + kp] = pack2(a0.y, b0.y) & k0m;
    T0[(ns + 2) * 33 + kp] = pack2(a0.z, b0.z) & k0m; T0[(ns + 3) * 33 + kp] = pack2(a0.w, b0.w) & k0m;
    T1[(ns + 0) * 33 + kp] = pack2(a1.x, b1.x) & k1m; T1[(ns + 1) * 33 + kp] = pack2(a1.y, b1.y) & k1m;
    T1[(ns + 2) * 33 + kp] = pack2(a1.z, b1.z) & k1m; T1[(ns + 3) * 33 + kp] = pack2(a1.w, b1.w) & k1m;
    __syncthreads();
    uint4 v;
    v.x = T0[rn * 33 + rks]; v.y = T0[rn * 33 + rks + 1]; v.z = T0[rn * 33 + rks + 2]; v.w = T0[rn * 33 + rks + 3];
    conv_store(c0, v, rn, rks);
    if (two) {
      v.x = T1[rn * 33 + rks]; v.y = T1[rn * 33 + rks + 1]; v.z = T1[rn * 33 + rks + 2]; v.w = T1[rn * 33 + rks + 3];
      conv_store(c1, v, rn, rks);
    }
  };
  float4 a0, b0, a1, b1, c0, d0, c1, d1, e0, f0, e1, f1, g0, h0, g1, h1;
  const int step = 2 * nblk;
  conv_fetch(q, 2 * bid, 1, total, kp, ns, a0, b0, a1, b1);
  conv_fetch(q, 2 * bid + step, 1, total, kp, ns, c0, d0, c1, d1);
  conv_fetch(q, 2 * bid + 2 * step, 1, total, kp, ns, e0, f0, e1, f1);
  for (int tile = 2 * bid; tile < total; tile += 4 * step) {
    conv_fetch(q, tile + 3 * step, 1, total, kp, ns, g0, h0, g1, h1);
    process(tile, a0, b0, a1, b1);
    if (tile + step >= total) break;
    conv_fetch(q, tile + 4 * step, 1, total, kp, ns, a0, b0, a1, b1);
    process(tile + step, c0, d0, c1, d1);
    if (tile + 2 * step >= total) break;
    conv_fetch(q, tile + 5 * step, 1, total, kp, ns, c0, d0, c1, d1);
    process(tile + 2 * step, e0, f0, e1, f1);
    if (tile + 3 * step >= total) break;
    conv_fetch(q, tile + 6 * step, 1, total, kp, ns, e0, f0, e1, f1);
    process(tile + 3 * step, g0, h0, g1, h1);
  }
  __syncthreads();
}

DI void phase_mod(const P& q, char* lds, int bid, int nblk) {
  float* sc = (float*)lds;
  float* red = sc + 9 * 1024;
  const int t = otid();
  for (int i = t; i < 9 * 1024; i += NTHR) {
    const int r = i >> 10, k = i & 1023;
    const float v = r < 8 ? q.c[r * 1024 + k] : q.c_ctx[k];
    sc[i] = siluf_(v);
  }
  __syncthreads();
  for (int u = bid; u < 2 * 96; u += nblk) {
    const int l = u / 96, n0 = (u % 96) * 64;
    const int col = t & 63, ksl = t >> 6;
    float a[9];
#pragma unroll
    for (int r = 0; r < 9; ++r) a[r] = 0.f;
    const float* w = q.w_mod + (size_t)l * 1024 * 6144 + n0 + col;
    for (int k = ksl * 128; k < ksl * 128 + 128; ++k) {
      const float wv = w[(size_t)k * 6144];
#pragma unroll
      for (int r = 0; r < 9; ++r) a[r] += sc[r * 1024 + k] * wv;
    }
#pragma unroll
    for (int r = 0; r < 9; ++r) red[(ksl * 9 + r) * 64 + col] = a[r];
    __syncthreads();
    for (int i = t; i < 9 * 64; i += NTHR) {
      const int r = i >> 6, cc = i & 63;
      float s = q.b_mod[l * 6144 + n0 + cc];
#pragma unroll
      for (int q = 0; q < 8; ++q) s += red[(q * 9 + r) * 64 + cc];
      ((W{q.ws, q.out, q.x, q.ctx}).mod())[(size_t)(l * 9 + r) * 6144 + n0 + cc] = s;
    }
    __syncthreads();
  }
  {
    const W w{q.ws, q.out};
    const int gt = bid * NTHR + t, gs = nblk * NTHR;
#define CPY(dst, srcp, n) for (int i = gt; i < (n); i += gs) (dst)[i] = (srcp)[i]
    CPY(w.g_mix(), q.g_mix, 2 * 1024); CPY(w.g_ffn(), q.g_ffn, 2 * 1024); CPY(w.g_final(), q.g_final, 1024);
    CPY(w.rpb(), q.rpb, 2 * 3720); CPY(w.w_pool(), q.w_pool, 2 * 4 * 4096); CPY(w.pool_scale(), q.pool_scale, 2 * 256);
    CPY(w.w_gate_f(), q.w_gate_f, 2 * 16 * 128); CPY(w.w_gate_b(), q.w_gate_b, 2 * 16 * 128);
    CPY(w.b_gate_f(), q.b_gate_f, 2 * 128); CPY(w.b_gate_b(), q.b_gate_b, 2 * 128);
    CPY(w.g_gla(), q.g_gla, 2 * 64); CPY(w.b_router(), q.b_router, 2 * 256);
#undef CPY
    for (int i = gt; i < 2 * 4 * 4096; i += gs) { const int lg = i >> 12, jj = (i >> 6) & 63, ii = i & 63; w.wpt()[i] = f2bf(q.w_pool[lg * 4096 + ii * 64 + jj]); }
  }
  if (bid == 0) {
    for (int i = t; i < 64 * 8; i += NTHR) {
      const int pos = i >> 3, j = i & 7;
      const float inv = powf(10000.f, -(float)j / 8.f);
      const float ang = (float)pos * inv;
      ((W{q.ws, q.out, q.x, q.ctx}).rope())[i * 2] = cosf(ang);
      ((W{q.ws, q.out, q.x, q.ctx}).rope())[i * 2 + 1] = sinf(ang);
    }
  }
}

DI void phase_norm0(const P& q, int bid, int nblk) {
  const W p{q.ws, q.out};
  const int wid = otid() >> 6, lane = otid() & 63;
  for (int row = bid * 8 + wid; row < MT; row += nblk * 8) {
    const float* src = row < MC ? q.ctx + (size_t)row * D : q.x + (size_t)(row - MC) * D;
    const float* m = p.mod() + (size_t)(mod_row(row)) * 6144;
    float4 v[4];
    float ss = 0.f;
#pragma unroll
    for (int i = 0; i < 4; ++i) {
      v[i] = *(const float4*)(src + i * 256 + lane * 4);
      ss += v[i].x * v[i].x + v[i].y * v[i].y + v[i].z * v[i].z + v[i].w * v[i].w;
    }
    ss = wave_sum(ss);
    const float rstd = rsqrtf(ss * (1.f / D) + EPS);
#pragma unroll
    for (int i = 0; i < 4; ++i) {
      const int cidx = i * 256 + lane * 4;
      const float4 gg = *(const float4*)(q.g_mix + cidx);
      const float4 sh = *(const float4*)(m + cidx);
      const float4 scl = *(const float4*)(m + 1024 + cidx);
      const float o0 = v[i].x * rstd * gg.x * (1.f + scl.x) + sh.x;
      const float o1 = v[i].y * rstd * gg.y * (1.f + scl.y) + sh.y;
      const float o2 = v[i].z * rstd * gg.z * (1.f + scl.z) + sh.z;
      const float o3 = v[i].w * rstd * gg.w * (1.f + scl.w) + sh.w;
      const int q8 = pack_fp8x4(o0, o1, o2, o3);
      *(int*)((char*)p.h() + (size_t)row * D + cidx) = q8;
    }
  }
}

DI void phase_norm(const W& p_, int layer, int row_lo, int bid, int nblk) {
  const W p = oq(p_);
  const int wid = otid() >> 6, lane = otid() & 63;
  const float* g = p.g_ffn() + layer * D;
  for (int row = row_lo + bid * 8 + wid; row < MT; row += nblk * 8) {
    const bf16_t* src = p.xres() + (size_t)row * D;
    const float* m = p.mod() + (size_t)(layer * 9 + mod_row(row)) * 6144 + 3072;
    float4 v[4];
    float ss = 0.f;
#pragma unroll
    for (int i = 0; i < 4; ++i) {
      v[i] = unpack4(*(const uint2*)(src + i * 256 + lane * 4));
      ss += v[i].x * v[i].x + v[i].y * v[i].y + v[i].z * v[i].z + v[i].w * v[i].w;
    }
    ss = wave_sum(ss);
    const float rstd = rsqrtf(ss * (1.f / D) + EPS);
#pragma unroll
    for (int i = 0; i < 4; ++i) {
      const int cidx = i * 256 + lane * 4;
      const float4 gg = *(const float4*)(g + cidx);
      const float4 sh = *(const float4*)(m + cidx);
      const float4 scl = *(const float4*)(m + 1024 + cidx);
      const float o0 = v[i].x * rstd * gg.x * (1.f + scl.x) + sh.x;
      const float o1 = v[i].y * rstd * gg.y * (1.f + scl.y) + sh.y;
      const float o2 = v[i].z * rstd * gg.z * (1.f + scl.z) + sh.z;
      const float o3 = v[i].w * rstd * gg.w * (1.f + scl.w) + sh.w;
      uint2 o; o.x = pack2(o0, o1); o.y = pack2(o2, o3);
      *(uint2*)(p.h2() + (size_t)row * D + cidx) = o;
      {
        const int q8 = pack_fp8x4(o0, o1, o2, o3);
        *(int*)(p.h2q() + (size_t)row * D + cidx) = q8;
      }
    }
  }
}

DI size_t hm_off(int row, int h) {
  if (row < MC) return ((size_t)(((row >> 8) * 8 + h) * NCTX + (row & 255))) * 64;
  const int r = row - MC;
  return HM_LAT + ((size_t)(((r >> 12) * 8 + h) * SEQ + (r & 4095))) * 64;
}
DI size_t vt_off(int row, int h, int d) {
  if (row < MC) { const int t = row & 255; return ((size_t)(((row >> 8) * 8 + h) * 4 + (t >> 6))) * 4096 + d * 64 + (t & 63); }
  const int r = row - MC, t = r & 4095;
  return HM_LAT + ((size_t)(((r >> 12) * 8 + h) * 64 + (t >> 6))) * 4096 + d * 64 + (t & 63);
}
DI size_t vtg_off(int row, int h, int v) {
  if (row < MC) { const int t = row & 255; return ((size_t)(((row >> 8) * 4 + h) * 4 + (t >> 6))) * 4096 + v * 64 + (t & 63); }
  const int r = row - MC, t = r & 4095;
  return HMG_LAT + ((size_t)(((r >> 12) * 4 + h) * 64 + (t >> 6))) * 4096 + v * 64 + (t & 63);
}

DI void phase_inproj(const W& p_, int layer, char* lds, int bid, int nblk) {
  const W p = oq(p_);
  constexpr int nM = MT / 256, nN = INWP / 256;
  const char* B8 = (const char*)p.win_t() + (size_t)layer * INWP * 1024;
  for (int u = vbid_of(bid, nblk); u < nM * nN; u += nblk) {
    const int pm = u / nN, pn = u % nN, m0 = pm * 256, n0 = pn * 256;
    auto rowA = [&](int r) { return (const bf16_t*)((const char*)p.h() + (size_t)(m0 + r) * D); };
    auto rowB = [&](int r) { return (const bf16_t*)(B8 + (size_t)(n0 + r) * 128); };
    if (pn == 4 || pn == 5 || pn == 8) {
      auto rowAp = [&](int r) { return rowA((r & ~63) | ((r & 12) << 2) | ((r & 48) >> 2) | (r & 3)); };
      auto epi = [&](const f32x4 (&acc)[4][8], int, int wr, int wc, int fr, int fq) {
        const int row = m0 + wr * 64 + fq * 16;
#pragma unroll
        for (int ni = 0; ni < 8; ++ni) {
          uint4 lo, hi;
          lo.x = pack2(acc[0][ni][0], acc[0][ni][1]); lo.y = pack2(acc[0][ni][2], acc[0][ni][3]);
          lo.z = pack2(acc[1][ni][0], acc[1][ni][1]); lo.w = pack2(acc[1][ni][2], acc[1][ni][3]);
          hi.x = pack2(acc[2][ni][0], acc[2][ni][1]); hi.y = pack2(acc[2][ni][2], acc[2][ni][3]);
          hi.z = pack2(acc[3][ni][0], acc[3][ni][1]); hi.w = pack2(acc[3][ni][2], acc[3][ni][3]);
          bf16_t* dst;
          if (pn == 8) {
            const int col = wc * 128 + ni * 16 + fr;
            dst = p.vtg() + vtg_off(row, col >> 6, col & 63);
          } else {
            const int col = n0 + wc * 128 + ni * 16 + fr - 1024;
            dst = p.vt() + vt_off(row, col >> 6, col & 63);
          }
          *(uint4*)dst = lo; *(uint4*)(dst + 8) = hi;
        }
      };
      gemm_tile<4, 2, 4, 8, 64, 2, true, 1, 4>(lds, 8, 0, (size_t)INWP * 64, rowAp, rowB, epi);
    } else {
      auto rowBp = [&](int r) { return rowB((r & ~127) | ((r & 12) << 3) | ((r & 112) >> 2) | (r & 3)); };
      auto epi = [&](const f32x4 (&acc)[4][8], int, int wr, int wc, int fr, int fq) {
#pragma unroll
        for (int mi = 0; mi < 4; ++mi) {
          const int row = m0 + wr * 64 + mi * 16 + fr;
#pragma unroll
          for (int np = 0; np < 4; ++np) {
            const int col = n0 + wc * 128 + fq * 32 + np * 8;
            const f32x4 v0 = acc[mi][2 * np], v1 = acc[mi][2 * np + 1];
            if (pn < 2) {
              constexpr float QS = 0.125f * 1.4426950408889634f;
              uint4 o; o.x = pack2(v0[0] * QS, v0[1] * QS); o.y = pack2(v0[2] * QS, v0[3] * QS); o.z = pack2(v1[0] * QS, v1[1] * QS); o.w = pack2(v1[2] * QS, v1[3] * QS);
              *(uint4*)(p.qh() + hm_off(row, col >> 6) + (col & 63)) = o;
            } else if (pn < 4) {
              const int c2 = col - 512;
              uint4 o; o.x = pack2(v0[0], v0[1]); o.y = pack2(v0[2], v0[3]); o.z = pack2(v1[0], v1[1]); o.w = pack2(v1[2], v1[3]);
              *(uint4*)(p.kh() + hm_off(row, c2 >> 6) + (c2 & 63)) = o;
            } else if (col < INW) {
              uint4 o; o.x = pack2(v0[0], v0[1]); o.y = pack2(v0[2], v0[3]); o.z = pack2(v1[0], v1[1]); o.w = pack2(v1[2], v1[3]);
              *(uint4*)(p.px() + (size_t)row * INW + col) = o;
            }
          }
        }
      };
      gemm_tile<4, 2, 4, 8, 64, 2, false, 1, 4>(lds, 8, 0, (size_t)INWP * 64, rowA, rowBp, epi);
    }
  }
}


#ifndef PROBE_GEMM
#define PROBE_GEMM 0
#endif
#if PROBE_GEMM
DI void phase_probe_gemm(const W& p_, char* lds, int bid, int nblk) {
  const W p = oq(p_);
  constexpr int nM = MT / 256, nN = INWP / 256;
  const bf16_t* Bt = p.win_t();
  for (int u = bid; u < nM * nN; u += nblk) {
    const int pm = u / nN, pn = u % nN, m0 = pm * 256, n0 = pn * 256;
    auto rowA = [&](int r) { return p.h() + (size_t)(m0 + r) * D; };
    auto rowB = [&](int r) { return Bt + (size_t)(n0 + r) * 32; };
    auto epi = [&](const f32x4 (&acc)[4][8], int, int wr, int wc, int fr, int fq) {
#pragma unroll
      for (int mi = 0; mi < 4; ++mi) {
        const int row = m0 + wr * 64 + mi * 16 + fr;
#pragma unroll
        for (int ni = 0; ni < 8; ++ni) {
          const int col = n0 + wc * 128 + ni * 16 + 4 * fq;
          uint2 o; o.x = pack2(acc[mi][ni][0], acc[mi][ni][1]); o.y = pack2(acc[mi][ni][2], acc[mi][ni][3]);
          *(uint2*)(p.y() + (size_t)row * INWP + col) = o;
        }
      }
    };
#if PROBE_GEMM == 4
    gemm_tile_stag<4, 2, 4, 8, false, true>(lds, 32, (size_t)INWP * 32, rowA, rowB, epi);
#elif PROBE_GEMM == 5
    gemm_tile_stag<4, 2, 4, 8, false, false>(lds, 32, (size_t)INWP * 32, rowA, rowB, epi);
#else
    gemm_tile<4, 2, 4, 8, 32, 4, false, 1>(lds, 32, 0, (size_t)INWP * 32, rowA, rowB, epi);
#endif
  }
}
#endif

template <bool DUMMY>
DI void phase_outproj_t(const W& p_, int layer, char* lds, int row_lo, int bid, int nblk) {
  const W p = oq(p_);
  bf16_t* xres_w = DUMMY ? (bf16_t*)((char*)p.y() + (size_t)9 * MT * 1024) : p.xres();
  const int nM = (MT - row_lo) / 256, nN = 4;
  const char* B8 = (const char*)p.wout_t() + (size_t)layer * 1024 * 1024;
  for (int u = vbid_of(bid, nblk); u < nM * nN; u += nblk) {
    const int pm = u / nN, pn = u % nN, m0 = row_lo + pm * 256, n0 = pn * 256;
    auto rowA = [&](int r) { return (const bf16_t*)((const char*)p.cat() + (size_t)(m0 + r) * D); };
    auto rowB = [&](int r) { return (const bf16_t*)(B8 + (size_t)(n0 + r) * 128); };
    auto rowBp = [&](int r) { return rowB((r & ~127) | ((r & 12) << 3) | ((r & 112) >> 2) | (r & 3)); };
    auto epi = [&](const f32x4 (&acc)[4][8], int, int wr, int wc, int fr, int fq) {
#pragma unroll
      for (int mi = 0; mi < 4; ++mi) {
        const int row = m0 + wr * 64 + mi * 16 + fr;
        const float* xin = row < MC ? p.ctx + (size_t)row * D : p.x + (size_t)(row - MC) * D;
        const float* gate = p.mod() + (size_t)(layer * 9 + mod_row(row)) * 6144 + 2048;
#pragma unroll
        for (int np = 0; np < 4; ++np) {
          const int col = n0 + wc * 128 + fq * 32 + np * 8;
          const f32x4 v0 = acc[mi][2 * np], v1 = acc[mi][2 * np + 1];
          float4 xa, xb;
          if (layer == 0) {
            xa = *(const float4*)(xin + col); xb = *(const float4*)(xin + col + 4);
          } else {
            const uint4 xr = *(const uint4*)(p.xres() + (size_t)row * D + col);
            xa = unpack4(make_uint2(xr.x, xr.y)); xb = unpack4(make_uint2(xr.z, xr.w));
          }
          const float4 ga = *(const float4*)(gate + col), gb = *(const float4*)(gate + col + 4);
          uint4 o;
          o.x = pack2(xa.x + ga.x * v0[0], xa.y + ga.y * v0[1]); o.y = pack2(xa.z + ga.z * v0[2], xa.w + ga.w * v0[3]);
          o.z = pack2(xb.x + gb.x * v1[0], xb.y + gb.y * v1[1]); o.w = pack2(xb.z + gb.z * v1[2], xb.w + gb.w * v1[3]);
          *(uint4*)(xres_w + (size_t)row * D + col) = o;
        }
      }
    };
    gemm_tile<4, 2, 4, 8, 64, 2, false, 1, 4 | 16>(lds, 8, 0, (size_t)1024 * 64, rowA, rowBp, epi);
  }
}
DI void phase_outproj(const W& p, int layer, char* lds, int row_lo, int bid, int nblk) { phase_outproj_t<false>(p, layer, lds, row_lo, bid, nblk); }

DI void moe_unit(const W& p, int layer, char* lds, int e, const int* s_rows);
DI int moe_early_shared(int mrows, int nblk);
DI void phase_router(const W& p_, int layer, char* lds, int row_lo, int bid, int nblk) {
  const W p = oq(p_);
  const int nM = (MT - row_lo) / 256;
  const bf16_t* Bt = p.wr_t() + (size_t)layer * 256 * 1024;
  const int sh0 = moe_early_shared(MT - row_lo, nblk);
  for (int u = vbid_of(bid, nblk); u < nM + sh0; u += nblk) {
    if (u >= nM) {
      int* s_rows = (int*)(lds + 144 * 1024) + 1024;
      __syncthreads();
      if (otid() < 256) s_rows[otid()] = 8 * MT + row_lo + (u - nM) * 256 + otid();
      __syncthreads();
      moe_unit(p, layer, lds, NE, s_rows);
      continue;
    }
    const int m0 = row_lo + u * 256;
    auto rowA = [&](int r) { return p.h2() + (size_t)(m0 + r) * D; };
    auto rowB = [&](int r) { return Bt + (size_t)r * 32; };
    auto epi = [&](const f32x4 (&acc)[4][8], int, int wr, int wc, int fr, int fq) {
#pragma unroll
      for (int mi = 0; mi < 4; ++mi) {
        const int row = m0 + wr * 64 + mi * 16 + fr;
#pragma unroll
        for (int ni = 0; ni < 8; ++ni) {
          const int col = wc * 128 + ni * 16 + 4 * fq;
          *(f32x4*)(p.logits() + (size_t)row * 256 + col) = acc[mi][ni];
        }
      }
    };
    gemm_tile_stag<4, 2, 4, 8, false>(lds, 32, (size_t)256 * 32, rowA, rowB, epi);
  }
}

DI void phase_route(const W& p_, int layer, char* lds, int row_lo, int bid, int nblk) {
  const W p = oq(p_);
  int* lcnt = (int*)lds;
  int* lbase = lcnt + 256;
  int* ent = lbase + 256;
  const int tid = otid(), wid = tid >> 6, lane = tid & 63;
  const int nrows = MT - row_lo;
  const int CHT = (nrows % nblk == 0 && nrows / nblk <= 160) ? nrows / nblk : 128;
  const int nch = nrows / CHT;
  const float NEG = -__builtin_inff();
  for (int ch = bid; ch < nch; ch += nblk) {
    if (tid < 256) lcnt[tid] = 0;
    __syncthreads();
    for (int i = wid; i < CHT; i += 8) {
      const int row = row_lo + ch * CHT + i;
      const float4 lg = *(const float4*)(p.logits() + (size_t)row * 256 + lane * 4);
      const float4 br = *(const float4*)(p.b_router() + layer * 256 + lane * 4);
      float sc[4] = {sigmoidf_(lg.x), sigmoidf_(lg.y), sigmoidf_(lg.z), sigmoidf_(lg.w)};
      float v[4] = {sc[0] + br.x, sc[1] + br.y, sc[2] + br.z, sc[3] + br.w};
      float m1 = NEG, m2 = NEG;
#pragma unroll
      for (int j = 0; j < 4; ++j) { if (v[j] > m1) { m2 = m1; m1 = v[j]; } else if (v[j] > m2) m2 = v[j]; }
      {
        float o1 = dppf<0xB1>(m1), o2 = dppf<0xB1>(m2);
        float n1 = fmaxf(m1, o1), n2 = fmaxf(fminf(m1, o1), fmaxf(m2, o2));
        m1 = n1; m2 = n2;
        o1 = dppf<0x4E>(m1); o2 = dppf<0x4E>(m2);
        n1 = fmaxf(m1, o1); n2 = fmaxf(fminf(m1, o1), fmaxf(m2, o2));
        m1 = n1; m2 = n2;
        o1 = dppf<0x141>(m1); o2 = dppf<0x141>(m2);
        n1 = fmaxf(m1, o1); n2 = fmaxf(fminf(m1, o1), fmaxf(m2, o2));
        m1 = n1; m2 = n2;
      }
      const float gs = m1 + m2;
      const int g = lane >> 3;
      int rank = 0;
#pragma unroll
      for (int gg = 0; gg < 8; ++gg) { const float og = rlanef(gs, gg * 8); rank += (og > gs || (og == gs && gg < g)) ? 1 : 0; }
      if (rank >= 4) { v[0] = NEG; v[1] = NEG; v[2] = NEG; v[3] = NEG; }
      float ssum = 0.f, my_s = 0.f; int my_e = 0;
#pragma unroll
      for (int k = 0; k < 8; ++k) {
        float bv = v[0]; int bj = 0;
#pragma unroll
        for (int j = 1; j < 4; ++j) if (v[j] > bv) { bv = v[j]; bj = j; }
        const float wm = wave_max_dpp(bv);
        const unsigned long long bal = __ballot(bv == wm);
        const int win = __builtin_amdgcn_readfirstlane(__ffsll((long long)bal) - 1);
        const float mysc = bj == 0 ? sc[0] : bj == 1 ? sc[1] : bj == 2 ? sc[2] : sc[3];
        const int ej = __builtin_amdgcn_readlane(bj, win);
        const float su = rlanef(mysc, win);
        if (lane == win) {
#pragma unroll
          for (int j = 0; j < 4; ++j) if (j == bj) v[j] = NEG;
        }
        ssum += su;
        if (lane == k) { my_e = win * 4 + ej; my_s = su; }
      }
      if (lane < 8) {
        const int lpos = atomicAdd(&lcnt[my_e], 1);
        ent[i * 8 + lane] = my_e | (lpos << 8);
        p.wts()[(size_t)row * 8 + lane] = my_s / ssum * 2.5f;
      }
    }
    __syncthreads();
    if (tid < 256) { const int cc = lcnt[tid]; lbase[tid] = cc ? atomicAdd(&p.cnt()[layer * 256 + tid], cc) : 0; }
    __syncthreads();
    for (int j = tid; j < CHT * 8; j += NTHR) {
      const int e = ent[j] & 255, lpos = ent[j] >> 8;
      const int row = row_lo + ch * CHT + (j >> 3);
      p.lists()[(size_t)e * CAP + lbase[e] + lpos] = row * 8 + (j & 7);
    }
    __syncthreads();
  }
}

DI void moe_prefix(const W& p, int layer, int mrows, int* s_pref) {
  int* s_tmp = s_pref + 400;
  const int t = otid();
  __syncthreads();
  if (t < 272) {
    int c = 0;
    if (t < NE) c = (p.cnt()[layer * 256 + t] + 255) >> 8;
    else if (t == NE) c = (mrows + 255) >> 8;
    s_tmp[t] = c;
  }
  __syncthreads();
  int cur = 0;
  for (int off = 1; off < 272; off <<= 1) {
    if (t < 272) s_tmp[(cur ^ 1) * 272 + t] = s_tmp[cur * 272 + t] + (t >= off ? s_tmp[cur * 272 + t - off] : 0);
    cur ^= 1;
    __syncthreads();
  }
  if (t <= NE1) s_pref[t] = t == 0 ? 0 : s_tmp[cur * 272 + t - 1];
  __syncthreads();
}
DI int moe_find(const int* s_pref, int ti) {
  int lo = 0, hi = NE1;
  while (hi - lo > 1) { const int mid = (lo + hi) >> 1; if (s_pref[mid] <= ti) lo = mid; else hi = mid; }
  return lo;
}
DI void moe_rows(const W& p, int layer, int e, int mt, int row_lo, int mrows, int* s_rows) {
  const int t = otid();
  if (t < 128) {
    const int cnt = e < NE ? p.cnt()[layer * 256 + e] : mrows;
    const int r = mt * 128 + t;
    int idx = -1;
    if (r < cnt) idx = e < NE ? p.lists()[(size_t)e * CAP + r] : 8 * MT + row_lo + r;
    s_rows[t] = idx;
  }
  __syncthreads();
}

DI void moe_unit(const W& p, int layer, char* lds, int e, const int* s_rows) {
  const int idx0 = s_rows[0];
  {
    const char* B8 = (const char*)p.wei_t() + (size_t)(layer * NE1 + e) * 512 * 1024;
    auto rowA = [&](int r) {
      int idx = s_rows[r]; if (idx < 0) idx = idx0;
      const int tok = idx < 8 * MT ? (idx >> 3) : idx - 8 * MT;
      return (const bf16_t*)(p.h2q() + (size_t)tok * D);
    };
    auto rowB = [&](int r) {
      const int wq = r >> 7, w = r & 127;
      const int n = w < 64 ? wq * 64 + w : 256 + wq * 64 + (w - 64);
      return (const bf16_t*)(B8 + (size_t)n * 128);
    };
    int stash[4][4];
    auto epi = [&](const f32x4 (&acc)[4][8], int chunk, int wr, int wc, int fr, int fq) {
      int cur[4][4];
#pragma unroll
      for (int mi = 0; mi < 4; ++mi)
#pragma unroll
        for (int ni = 0; ni < 4; ++ni) {
          float o[4];
#pragma unroll
          for (int j = 0; j < 4; ++j) o[j] = siluf_(acc[mi][ni][j]) * acc[mi][ni + 4][j] * 16.f;
          cur[mi][ni] = pack_fp8x4(o[0], o[1], o[2], o[3]);
        }
      if (chunk == 0) {
#pragma unroll
        for (int mi = 0; mi < 4; ++mi)
#pragma unroll
          for (int ni = 0; ni < 4; ++ni) stash[mi][ni] = cur[mi][ni];
      } else {
        __syncthreads();
#pragma unroll
        for (int c2 = 0; c2 < 2; ++c2)
#pragma unroll
          for (int mi = 0; mi < 4; ++mi) {
            const int row = wr * 64 + mi * 16 + fr;
#pragma unroll
            for (int ni = 0; ni < 4; ++ni) {
              const int ch = (wc * 4 + ni) ^ ((row >> 1) & 7);
              *(int*)(lds + c2 * 32768 + row * 128 + ch * 16 + 4 * fq) = c2 == 0 ? stash[mi][ni] : cur[mi][ni];
            }
          }
      }
    };
    gemm_tile<4, 2, 4, 8, 64, 2, false, 2, 4>(lds, 8, (size_t)128 * 64, (size_t)512 * 64, rowA, rowB, epi);
  }
  {
    const char* B8d = (const char*)p.wed_t() + (size_t)(layer * NE1 + e) * 1024 * 256;
    auto rowA = [&](int) { return (const bf16_t*)nullptr; };
    auto rowB2 = [&](int r) { return (const bf16_t*)(B8d + (size_t)((r & ~63) | ((r & 12) << 2) | ((r & 48) >> 2) | (r & 3)) * 128); };
    auto epi = [&](const f32x4 (&acc)[4][8], int nt, int wr, int wc, int fr, int fq) {
#pragma unroll
      for (int mi = 0; mi < 4; ++mi) {
        int dst = s_rows[wr * 64 + mi * 16 + fr];
        if (dst < 0) dst = 9 * MT + (int)blockIdx.x;
        {
          int4 lo, hi;
          lo.x = pack_fp8x4(acc[mi][0][0] * 16.f, acc[mi][0][1] * 16.f, acc[mi][0][2] * 16.f, acc[mi][0][3] * 16.f);
          lo.y = pack_fp8x4(acc[mi][1][0] * 16.f, acc[mi][1][1] * 16.f, acc[mi][1][2] * 16.f, acc[mi][1][3] * 16.f);
          lo.z = pack_fp8x4(acc[mi][2][0] * 16.f, acc[mi][2][1] * 16.f, acc[mi][2][2] * 16.f, acc[mi][2][3] * 16.f);
          lo.w = pack_fp8x4(acc[mi][3][0] * 16.f, acc[mi][3][1] * 16.f, acc[mi][3][2] * 16.f, acc[mi][3][3] * 16.f);
          hi.x = pack_fp8x4(acc[mi][4][0] * 16.f, acc[mi][4][1] * 16.f, acc[mi][4][2] * 16.f, acc[mi][4][3] * 16.f);
          hi.y = pack_fp8x4(acc[mi][5][0] * 16.f, acc[mi][5][1] * 16.f, acc[mi][5][2] * 16.f, acc[mi][5][3] * 16.f);
          hi.z = pack_fp8x4(acc[mi][6][0] * 16.f, acc[mi][6][1] * 16.f, acc[mi][6][2] * 16.f, acc[mi][6][3] * 16.f);
          hi.w = pack_fp8x4(acc[mi][7][0] * 16.f, acc[mi][7][1] * 16.f, acc[mi][7][2] * 16.f, acc[mi][7][3] * 16.f);
          char* yp = (char*)p.y() + (size_t)dst * D + nt * 256 + wc * 128 + fq * 16;
          *(int4*)yp = lo; *(int4*)(yp + 64) = hi;
        }
      }
    };
    gemm_tile<4, 2, 4, 8, 64, 2, false, 4, 1 | 4 | 8 | 32>(lds + 65536, 2, (size_t)256 * 64, (size_t)1024 * 64, rowA, rowB2, epi, lds);
  }
}

DI int moe_early_shared(int mrows, int nblk) {
  const int idle = nblk - mrows / 256;
  return idle <= 0 ? 0 : (idle < mrows / 256 ? idle : mrows / 256);
}

DI void phase_moe(const W& p_, int layer, char* lds, int row_lo, int bid, int nblk) {
  const W p = oq(p_);
  int* s_pref = (int*)(lds + 144 * 1024);
  int* s_rows = s_pref + 1024;
  const int mrows = MT - row_lo;
  const int sh0 = moe_early_shared(mrows, nblk);
  moe_prefix(p, layer, mrows - sh0 * 256, s_pref);
  const int total = s_pref[NE1];
  auto fetch_rows = [&](int uu) -> int {
    int idx = -1;
    const int t = otid();
    if (uu < total && t < 256) {
      const int e2 = moe_find(s_pref, uu), mt2 = uu - s_pref[e2];
      if (e2 < NE) {
        const int cnt = p.cnt()[layer * 256 + e2];
        const int r = mt2 * 256 + t;
        if (r < cnt) idx = p.lists()[(size_t)e2 * CAP + r];
      } else {
        idx = 8 * MT + row_lo + (mt2 + sh0) * 256 + t;
      }
    }
    return idx;
  };
  int pre = fetch_rows(vbid_of(bid, nblk));
  for (int u = vbid_of(bid, nblk); u < total; u += nblk) {
    const int e = moe_find(s_pref, u);
    if (otid() < 256) s_rows[otid()] = pre;
    __syncthreads();
    pre = fetch_rows(u + nblk);
    moe_unit(p, layer, lds, e, s_rows);
  }
}

template <bool DUMMY>
DI void phase_combine_t(const W& p_, int layer, int row_lo, int bid, int nblk) {
  const W p = oq(p_);
  char* scratch = (char*)p.y() + (size_t)9 * MT * 1024;
  bf16_t* xres_w = DUMMY ? (bf16_t*)scratch : p.xres();
  bf16_t* h_w = DUMMY ? p.act() : p.h();
  float* out_w = DUMMY ? (float*)(scratch + ((size_t)128 << 20)) : p.out;
  const int wid = otid() >> 6, lane = otid() & 63;
  const bool last = layer == 1;
  for (int row = row_lo + bid * 8 + wid; row < MT; row += nblk * 8) {
    const float* m = p.mod() + (size_t)(layer * 9 + mod_row(row)) * 6144;
    float w[8];
#pragma unroll
    for (int k = 0; k < 8; ++k) w[k] = p.wts()[(size_t)row * 8 + k];
    float xn[16];
    float ss = 0.f;
#pragma unroll
    for (int i = 0; i < 4; ++i) {
      const int cidx = i * 256 + lane * 4;
      float a[4] = {0.f, 0.f, 0.f, 0.f};
#pragma unroll
      for (int k = 0; k < 9; ++k) {
        const size_t yr = k < 8 ? (size_t)row * 8 + k : (size_t)8 * MT + row;
        const int yv = *(const int*)((const char*)p.y() + yr * D + cidx);
        const float wk = (k < 8 ? w[k] : 1.f) * (1.f / 16.f);
        typedef float f32x2_ __attribute__((ext_vector_type(2)));
        const f32x2_ ylo = __builtin_amdgcn_cvt_pk_f32_fp8(yv, false), yhi = __builtin_amdgcn_cvt_pk_f32_fp8(yv, true);
        a[0] += wk * ylo.x; a[1] += wk * ylo.y; a[2] += wk * yhi.x; a[3] += wk * yhi.y;
      }
      const float4 xv = unpack4(*(const uint2*)(p.xres() + (size_t)row * D + cidx));
      const float4 gv = *(const float4*)(m + 5120 + cidx);
      xn[i * 4 + 0] = xv.x + gv.x * a[0]; xn[i * 4 + 1] = xv.y + gv.y * a[1];
      xn[i * 4 + 2] = xv.z + gv.z * a[2]; xn[i * 4 + 3] = xv.w + gv.w * a[3];
#pragma unroll
      for (int j = 0; j < 4; ++j) ss += xn[i * 4 + j] * xn[i * 4 + j];
    }
    ss = wave_sum(ss);
    const float rstd = rsqrtf(ss * (1.f / D) + EPS);
    if (!last) {
      const float* g = p.g_mix() + (layer + 1) * D;
      const float* m2 = p.mod() + (size_t)((layer + 1) * 9 + mod_row(row)) * 6144;
#pragma unroll
      for (int i = 0; i < 4; ++i) {
        const int cidx = i * 256 + lane * 4;
        { uint2 xo; xo.x = pack2(xn[i * 4], xn[i * 4 + 1]); xo.y = pack2(xn[i * 4 + 2], xn[i * 4 + 3]); *(uint2*)(xres_w + (size_t)row * D + cidx) = xo; }
        const float4 gg = *(const float4*)(g + cidx);
        const float4 sh = *(const float4*)(m2 + cidx);
        const float4 scl = *(const float4*)(m2 + 1024 + cidx);
        const float o0 = xn[i * 4 + 0] * rstd * gg.x * (1.f + scl.x) + sh.x;
        const float o1 = xn[i * 4 + 1] * rstd * gg.y * (1.f + scl.y) + sh.y;
        const float o2 = xn[i * 4 + 2] * rstd * gg.z * (1.f + scl.z) + sh.z;
        const float o3 = xn[i * 4 + 3] * rstd * gg.w * (1.f + scl.w) + sh.w;
        const int q8 = pack_fp8x4(o0, o1, o2, o3);
        *(int*)((char*)h_w + (size_t)row * D + cidx) = q8;
      }
    } else {
#pragma unroll
      for (int i = 0; i < 4; ++i) {
        const int cidx = i * 256 + lane * 4;
        const float4 gg = *(const float4*)(p.g_final() + cidx);
        *(float4*)(out_w + (size_t)(row - MC) * D + cidx) =
            make_float4(xn[i * 4] * rstd * gg.x, xn[i * 4 + 1] * rstd * gg.y, xn[i * 4 + 2] * rstd * gg.z, xn[i * 4 + 3] * rstd * gg.w);
      }
    }
  }
}
DI void phase_combine(const W& p, int layer, int row_lo, int bid, int nblk) { phase_combine_t<false>(p, layer, row_lo, bid, nblk); }

typedef unsigned u32x4 __attribute__((ext_vector_type(4)));
typedef unsigned u32x2 __attribute__((ext_vector_type(2)));
DI bf16x8 bl128(__amdgpu_buffer_rsrc_t rs, unsigned voff, unsigned soff) {
  return __builtin_bit_cast(bf16x8, __builtin_amdgcn_raw_buffer_load_b128(rs, voff, soff, 0));
}
DI u32x2 bl64(__amdgpu_buffer_rsrc_t rs, unsigned voff, unsigned soff) { return __builtin_amdgcn_raw_buffer_load_b64(rs, voff, soff, 0); }

template <bool LOCALPASS>
DI void attn_pass(__amdgpu_buffer_rsrc_t rsK, __amdgpu_buffer_rsrc_t rsV, unsigned kbase, unsigned vbase, const char* cK, const char* cV,
                  const float* s_rpb_h, int r, int c0, int kc0, int kr0, int lane, const bf16x8& qf0, const bf16x8& qf1,
                  float& m_out, float& l_out, f32x4 (&O)[4], const bf16x8 (&kfa)[16]) {
  const int fr = lane & 15, fq = lane >> 4;
  const unsigned vK = (8 * (fr >> 2) + (fr & 3)) * 128 + fq * 32;
  f32x4 S[16];
  if (LOCALPASS) {
    bf16x8 kfb[16];
#pragma unroll
    for (int t = 8; t < 16; ++t) {
      const unsigned so = kbase + ((kr0 + (t >> 1)) * 64 + kc0 + (t & 1) * 4) * 128;
      kfb[2 * (t - 8)] = bl128(rsK, vK, so); kfb[2 * (t - 8) + 1] = bl128(rsK, vK + 16, so);
    }
    __builtin_amdgcn_sched_barrier(0);
#pragma unroll
    for (int t = 0; t < 8; ++t) {
      f32x4 s = (f32x4){0.f, 0.f, 0.f, 0.f};
      s = __builtin_amdgcn_mfma_f32_16x16x32_bf16(kfa[2 * t], qf0, s, 0, 0, 0);
      s = __builtin_amdgcn_mfma_f32_16x16x32_bf16(kfa[2 * t + 1], qf1, s, 0, 0, 0);
      S[t] = s;
    }
#pragma unroll
    for (int t = 8; t < 16; ++t) {
      f32x4 s = (f32x4){0.f, 0.f, 0.f, 0.f};
      s = __builtin_amdgcn_mfma_f32_16x16x32_bf16(kfb[2 * (t - 8)], qf0, s, 0, 0, 0);
      s = __builtin_amdgcn_mfma_f32_16x16x32_bf16(kfb[2 * (t - 8) + 1], qf1, s, 0, 0, 0);
      S[t] = s;
    }
    __builtin_amdgcn_sched_barrier(0);
  } else {
#pragma unroll
    for (int t = 0; t < 16; ++t) {
      const bf16x8 k0 = *(const bf16x8*)(cK + (t * 2) * 1024 + lane * 16);
      const bf16x8 k1 = *(const bf16x8*)(cK + (t * 2 + 1) * 1024 + lane * 16);
      f32x4 s = (f32x4){0.f, 0.f, 0.f, 0.f};
      s = __builtin_amdgcn_mfma_f32_16x16x32_bf16(k0, qf0, s, 0, 0, 0);
      s = __builtin_amdgcn_mfma_f32_16x16x32_bf16(k1, qf1, s, 0, 0, 0);
      S[t] = s;
      if ((t & 3) == 3) __builtin_amdgcn_sched_barrier(0);
    }
  }
  const unsigned vV = (fr * 64 + 8 * fq) * 2;
  bf16x8 vfa[16];
  if (LOCALPASS) {
#pragma unroll
    for (int s = 0; s < 4; ++s)
#pragma unroll
      for (int dt = 0; dt < 4; ++dt) vfa[s * 4 + dt] = bl128(rsV, vV, vbase + ((kr0 + s) * 4096 + dt * 1024 + kc0) * 2);
    __builtin_amdgcn_sched_barrier(0);
  }
  const float NEGB = -1e30f;
  float mx = NEGB;
  if (LOCALPASS) {
    const int qc = c0 + fr;
    const int cs = min(max(qc - 8, 0), 48);
    unsigned vmask = 0;
#pragma unroll
    for (int e = 0; e < 8; ++e) {
      const int kc = kc0 + 8 * fq + e;
      vmask |= (kc >= cs && kc < cs + 16) ? (1u << e) : 0u;
    }
    const int dc0 = kc0 + fq * 8 - qc + 15;
#pragma unroll
    for (int t = 0; t < 16; ++t) {
      const float* bp = s_rpb_h + (kr0 + (t >> 1) - r + 7) * 31;
#pragma unroll
      for (int j = 0; j < 4; ++j) {
        const int e = (t & 1) * 4 + j;
        const int dc = min(max(dc0 + e, 0), 30);
        const float v = ((vmask >> e) & 1u) ? S[t][j] + bp[dc] : NEGB;
        S[t][j] = v;
        mx = fmaxf(mx, v);
      }
    }
  } else {
#pragma unroll
    for (int t = 0; t < 16; ++t)
#pragma unroll
      for (int j = 0; j < 4; ++j) mx = fmaxf(mx, S[t][j]);
  }
  mx = fmaxf(mx, __shfl_xor(mx, 16));
  mx = fmaxf(mx, __shfl_xor(mx, 32));
  float l = 0.f;
#pragma unroll
  for (int t = 0; t < 16; ++t)
#pragma unroll
    for (int j = 0; j < 4; ++j) { const float pv = __builtin_amdgcn_exp2f(S[t][j] - mx); S[t][j] = pv; l += pv; }
  l += __shfl_xor(l, 16);
  l += __shfl_xor(l, 32);
  m_out = mx; l_out = l;
#pragma unroll
  for (int dt = 0; dt < 4; ++dt) O[dt] = (f32x4){0.f, 0.f, 0.f, 0.f};
  bf16x8 pf[8];
#pragma unroll
  for (int s = 0; s < 8; ++s) {
    const unsigned p0 = pack2(S[2 * s][0], S[2 * s][1]), p1 = pack2(S[2 * s][2], S[2 * s][3]);
    const unsigned p2 = pack2(S[2 * s + 1][0], S[2 * s + 1][1]), p3 = pack2(S[2 * s + 1][2], S[2 * s + 1][3]);
    pf[s] = __builtin_bit_cast(bf16x8, (u32x4){p0, p1, p2, p3});
  }
  if (LOCALPASS) {
    bf16x8 vfb[16];
    __builtin_amdgcn_sched_barrier(0);
#pragma unroll
    for (int s = 0; s < 4; ++s)
#pragma unroll
      for (int dt = 0; dt < 4; ++dt) vfb[s * 4 + dt] = bl128(rsV, vV, vbase + ((kr0 + 4 + s) * 4096 + dt * 1024 + kc0) * 2);
    __builtin_amdgcn_sched_barrier(0);
#pragma unroll
    for (int s = 0; s < 4; ++s)
#pragma unroll
      for (int dt = 0; dt < 4; ++dt) O[dt] = __builtin_amdgcn_mfma_f32_16x16x32_bf16(vfa[s * 4 + dt], pf[s], O[dt], 0, 0, 0);
    __builtin_amdgcn_sched_barrier(0);
#pragma unroll
    for (int s = 0; s < 4; ++s)
#pragma unroll
      for (int dt = 0; dt < 4; ++dt) O[dt] = __builtin_amdgcn_mfma_f32_16x16x32_bf16(vfb[s * 4 + dt], pf[4 + s], O[dt], 0, 0, 0);
  } else {
#pragma unroll
    for (int s = 0; s < 8; ++s) {
#pragma unroll
      for (int dt = 0; dt < 4; ++dt) {
        const bf16x8 vf = *(const bf16x8*)(cV + (s * 4 + dt) * 1024 + lane * 16);
        O[dt] = __builtin_amdgcn_mfma_f32_16x16x32_bf16(vf, pf[s], O[dt], 0, 0, 0);
      }
      if ((s & 1) == 1) __builtin_amdgcn_sched_barrier(0);
    }
  }
}

DI void attn_stage_ctx(const W& p, char* dst, int bh, int wid, int lane) {
  const int fr = lane & 15, fq = lane >> 4;
  const bf16_t* Kc = p.kh() + (size_t)bh * NCTX * 64;
  const bf16_t* Vc = p.vt() + (size_t)bh * 4 * 4096;
#pragma unroll
  for (int i = 0; i < 8; ++i) {
    const int pc = wid * 8 + i;
    const bf16_t* src;
    if (pc < 32) {
      const int t = pc >> 1, ks = pc & 1, g = t >> 1, T = t & 1;
      src = Kc + (32 * g + 8 * (fr >> 2) + 4 * T + (fr & 3)) * 64 + 16 * fq + 8 * ks;
    } else {
      const int s = (pc - 32) >> 2, dt = (pc - 32) & 3;
      src = Vc + (s >> 1) * 4096 + (16 * dt + fr) * 64 + (s & 1) * 32 + 8 * fq;
    }
    __builtin_amdgcn_global_load_lds((const unsigned*)src, (unsigned*)(dst + pc * 1024 + lane * 16), 16, 0, 0);
  }
}

template <bool LOCAL, bool QPRE = false>
DI void attn_unit(const W& p, __amdgpu_buffer_rsrc_t rsQ, __amdgpu_buffer_rsrc_t rsK, __amdgpu_buffer_rsrc_t rsV, const char* cK, const char* cV,
                  const float* s_rpb, int b, int h, int r, int qb, int lane, char* nxt_dst = nullptr, int nxt_bh = 0, int wid = 0,
                  bf16x8 qp0 = bf16x8{}, bf16x8 qp1 = bf16x8{}) {
  const int fr = lane & 15, fq = lane >> 4;
  const unsigned bh = (unsigned)(b * 8 + h);
  int c0 = 0, kc0 = 0, kr0 = 0, qrow;
  unsigned qso;
  if (LOCAL) {
    c0 = qb * 16; kc0 = qb == 0 ? 0 : qb == 1 ? 8 : qb == 2 ? 24 : 32;
    kr0 = min(max(r - 4, 0), 56);
    qrow = MC + b * SEQ + r * 64 + c0 + fr;
    qso = (unsigned)(HM_LAT * 2) + (bh * SEQ + r * 64 + c0) * 128;
  } else {
    qrow = b * NCTX + qb * 16 + fr;
    qso = (bh * NCTX + qb * 16) * 128;
  }
  const unsigned vQ = fr * 128 + fq * 32;
  const bf16x8 qf0 = QPRE ? qp0 : bl128(rsQ, vQ, qso), qf1 = QPRE ? qp1 : bl128(rsQ, vQ + 16, qso);
  bf16x8 kfa[16];
  if (LOCAL) {
    const unsigned kbase = (unsigned)(HM_LAT * 2) + bh * SEQ * 64 * 2;
    const unsigned vK = (8 * (fr >> 2) + (fr & 3)) * 128 + fq * 32;
#pragma unroll
    for (int t = 0; t < 8; ++t) {
      const unsigned so = kbase + ((kr0 + (t >> 1)) * 64 + kc0 + (t & 1) * 4) * 128;
      kfa[2 * t] = bl128(rsK, vK, so); kfa[2 * t + 1] = bl128(rsK, vK + 16, so);
    }
    __builtin_amdgcn_sched_barrier(0);
  }
  float m2, l2; f32x4 O[4];
  attn_pass<false>(rsK, rsV, 0u, 0u, cK, cV, s_rpb, r, c0, kc0, kr0, lane, qf0, qf1, m2, l2, O, kfa);
  float l = l2;
  if (nxt_dst) attn_stage_ctx(p, nxt_dst, nxt_bh, wid, lane);
  if (LOCAL) {
    float m1, l1; f32x4 O1[4];
    attn_pass<true>(rsK, rsV, (unsigned)(HM_LAT * 2) + bh * SEQ * 64 * 2, (unsigned)(HM_LAT * 2) + bh * 64 * 4096 * 2, cK, cV, s_rpb + h * 465, r, c0,
                    kc0, kr0, lane, qf0, qf1, m1, l1, O1, kfa);
    const float m = fmaxf(m1, m2);
    const float sc1 = __builtin_amdgcn_exp2f(m1 - m), sc2 = __builtin_amdgcn_exp2f(m2 - m);
    l = l1 * sc1 + l2 * sc2;
#pragma unroll
    for (int dt = 0; dt < 4; ++dt)
#pragma unroll
      for (int j = 0; j < 4; ++j) O[dt][j] = O[dt][j] * sc2 + O1[dt][j] * sc1;
  }
  const float inv_l = 1.f / l;
#pragma unroll
  for (int dt = 0; dt < 4; ++dt) {
    const float sc8 = inv_l * 8.f;
    *(int*)((char*)p.cat() + (size_t)qrow * D + h * 64 + dt * 16 + fq * 4) = pack_fp8x4(O[dt][0] * sc8, O[dt][1] * sc8, O[dt][2] * sc8, O[dt][3] * sc8);
  }
}

DI void phase_attn(const W& p_, int layer, char* lds, int bid, int nblk) {
  const W p = oq(p_);
  float* s_rpb = (float*)lds;
  char* cbuf = lds + 16384;
  const int tid = otid(), lane = tid & 63;
  const int wid = __builtin_amdgcn_readfirstlane(tid >> 6);
  for (int i = tid; i < 8 * 15 * 31; i += NTHR) s_rpb[i] = p.rpb()[layer * 3720 + i] * 1.4426950408889634f;
  const __amdgpu_buffer_rsrc_t rsQ = __builtin_amdgcn_make_buffer_rsrc((void*)p.qh(), 0, (int)(HM_ELEMS * 2), 0x00020000);
  const __amdgpu_buffer_rsrc_t rsK = __builtin_amdgcn_make_buffer_rsrc((void*)p.kh(), 0, (int)(HM_ELEMS * 2), 0x00020000);
  const __amdgpu_buffer_rsrc_t rsV = __builtin_amdgcn_make_buffer_rsrc((void*)p.vt(), 0, (int)(HM_ELEMS * 2), 0x00020000);
  const bool fast = nblk == 256;
  const int npair = fast ? 8 : 64;
  const int xg = bid >> 5, lw = (bid & 31) * 8 + wid;
  attn_stage_ctx(p, cbuf, fast ? xg : 0, wid, lane);
  const unsigned vQp = (lane & 15) * 128 + (lane >> 4) * 32;
  auto qso_of = [&](int ph2) { return (unsigned)(HM_LAT * 2) + ((unsigned)ph2 * SEQ + (lw >> 2) * 64 + (lw & 3) * 16) * 128; };
  bf16x8 qn0 = bf16x8{}, qn1 = bf16x8{};
  if (fast) { qn0 = bl128(rsQ, vQp, qso_of(xg)); qn1 = bl128(rsQ, vQp + 16, qso_of(xg)); }
  for (int sl = 0; sl < npair; ++sl) {
    const int ph = fast ? sl * 8 + xg : sl, h = ph & 7, b = ph >> 3;
    asm volatile("s_waitcnt vmcnt(0)" ::: "memory");
    __syncthreads();
    const char* cK = cbuf + (sl & 1) * 65536;
    const char* cV = cK + 32768;
    char* ndst = sl + 1 < npair ? cbuf + ((sl + 1) & 1) * 65536 : nullptr;
    if (fast) {
      const bf16x8 qc0 = qn0, qc1 = qn1;
      if (sl + 1 < npair) { qn0 = bl128(rsQ, vQp, qso_of((sl + 1) * 8 + xg)); qn1 = bl128(rsQ, vQp + 16, qso_of((sl + 1) * 8 + xg)); }
      attn_unit<true, true>(p, rsQ, rsK, rsV, cK, cV, s_rpb, b, h, lw >> 2, lw & 3, lane, ndst, (sl + 1) * 8 + xg, wid, qc0, qc1);
      if (layer == 0 && (lw >> 4) == sl) attn_unit<false>(p, rsQ, rsK, rsV, cK, cV, s_rpb, b, h, 0, lw & 15, lane);
    } else {
      if (ndst) attn_stage_ctx(p, ndst, sl + 1, wid, lane);
      for (int u = bid * 8 + wid; u < 256; u += nblk * 8) attn_unit<true>(p, rsQ, rsK, rsV, cK, cV, s_rpb, b, h, u >> 2, u & 3, lane);
      if (layer == 0)
        for (int u = bid * 8 + wid; u < 16; u += nblk * 8) attn_unit<false>(p, rsQ, rsK, rsV, cK, cV, s_rpb, b, h, 0, u, lane);
    }
  }
  __syncthreads();
}

DI void phase_pool(const W& p_, int layer, char* lds, int bid, int nblk) {
  const W p = oq(p_);
  float* U = (float*)lds;
  bf16_t* dA = (bf16_t*)(lds + 81920);
  bf16_t* WT = (bf16_t*)(lds + 81920 + 33792);
  const int tid = otid(), wid = tid >> 6, lane = tid & 63, fr = lane & 15, fq = lane >> 4;
  for (int i = tid; i < 4 * 64 * 8; i += NTHR) {
    const int rowj = i >> 3, chk = i & 7;
    *(uint4*)(WT + rowj * 72 + chk * 8) = *(const uint4*)(p.wpt() + (size_t)layer * 16384 + rowj * 64 + chk * 8);
  }
  const int nlat = ML / 64, nctx = layer == 0 ? MC / 64 : 0;
  const int gextra = NB * 4 * NSLOT - nblk * 8;
  const int heavy = (gextra > 0 && gextra < nblk * 4) ? (gextra + 7) / 8 : 0;
  const int ptotal = nlat + nctx;
  const int ufirst = bid < heavy ? ptotal - 1 - bid : bid - heavy;
  const int ustep = bid < heavy ? ptotal : nblk - heavy;
  const int ulimit = bid < heavy ? ptotal : ptotal - heavy;
  for (int u = ufirst; u < ulimit; u += ustep) {
    int row0, L, seq0;
    if (u < nlat) { row0 = MC + u * 64; L = SEQ; seq0 = MC + ((u * 64) / SEQ) * SEQ; }
    else { row0 = (u - nlat) * 64; L = NCTX; seq0 = (row0 / NCTX) * NCTX; }
    const int t0 = row0 - seq0;
    __syncthreads();
#pragma unroll
    for (int k = 0; k < 5; ++k) {
      const int c = tid + NTHR * k, rr = c >> 5, chk = c & 31;
      const int tpos = t0 - 8 + rr;
      uint4 v = make_uint4(0u, 0u, 0u, 0u);
      if (tpos >= 0 && tpos < L) v = *(const uint4*)(p.px() + (size_t)(seq0 + tpos) * INW + 1536 + chk * 8);
      float4 lo4, hi4;
      lo4.x = __uint_as_float(v.x << 16); lo4.y = __uint_as_float(v.x & 0xffff0000u); lo4.z = __uint_as_float(v.y << 16); lo4.w = __uint_as_float(v.y & 0xffff0000u);
      hi4.x = __uint_as_float(v.z << 16); hi4.y = __uint_as_float(v.z & 0xffff0000u); hi4.z = __uint_as_float(v.w << 16); hi4.w = __uint_as_float(v.w & 0xffff0000u);
      *(float4*)(U + rr * 256 + chk * 8) = lo4;
      *(float4*)(U + rr * 256 + chk * 8 + 4) = hi4;
    }
    __syncthreads();
    {
      const int ch = tid & 255, hf = tid >> 8, g = ch >> 6, hw = 1 << g;
      const float* Uc = U + ch;
      int tpos = t0 + hf * 32;
      int lo = max(tpos - hw, 0), hi = min(tpos + hw - 1, L - 1);
      float S = 0.f;
      for (int j = lo; j <= hi; ++j) S += Uc[(j - t0 + 8) * 256];
      for (int tt = 0; tt < 32; ++tt) {
        const float dv = S / (float)(hi - lo + 1) - Uc[(tpos - t0 + 8) * 256];
        dA[(hf * 32 + tt) * 264 + ch] = f2bf(dv);
        ++tpos;
        const int nlo = max(tpos - hw, 0), nhi = min(tpos + hw - 1, L - 1);
        if (nlo > lo) { S -= Uc[(lo - t0 + 8) * 256]; lo = nlo; }
        if (nhi > hi) { S += Uc[(nhi - t0 + 8) * 256]; hi = nhi; }
      }
    }
    __syncthreads();
    {
      const int g = wid & 3, th = wid >> 2;
      f32x4 acc[2][4];
#pragma unroll
      for (int mi = 0; mi < 2; ++mi)
#pragma unroll
        for (int ni = 0; ni < 4; ++ni) acc[mi][ni] = (f32x4){0.f, 0.f, 0.f, 0.f};
#pragma unroll
      for (int ks = 0; ks < 2; ++ks) {
        bf16x8 a[2], b[4];
#pragma unroll
        for (int mi = 0; mi < 2; ++mi) a[mi] = *(const bf16x8*)(dA + (th * 32 + mi * 16 + fr) * 264 + g * 64 + 32 * ks + 8 * fq);
#pragma unroll
        for (int ni = 0; ni < 4; ++ni) b[ni] = *(const bf16x8*)(WT + (g * 64 + ni * 16 + fr) * 72 + 32 * ks + 8 * fq);
#pragma unroll
        for (int mi = 0; mi < 2; ++mi)
#pragma unroll
          for (int ni = 0; ni < 4; ++ni) acc[mi][ni] = __builtin_amdgcn_mfma_f32_16x16x32_bf16(b[ni], a[mi], acc[mi][ni], 0, 0, 0);
      }
#pragma unroll
      for (int mi = 0; mi < 2; ++mi) {
        const int row = row0 + th * 32 + mi * 16 + fr;
#pragma unroll
        for (int ni = 0; ni < 4; ++ni) {
          const int j0 = g * 64 + ni * 16 + 4 * fq;
          const float4 sc = *(const float4*)(p.pool_scale() + layer * 256 + j0);
          *(int*)((char*)p.cat() + (size_t)row * D + 512 + j0) =
              pack_fp8x4(acc[mi][ni][0] * sc.x * 8.f, acc[mi][ni][1] * sc.y * 8.f, acc[mi][ni][2] * sc.z * 8.f, acc[mi][ni][3] * sc.w * 8.f);
        }
      }
    }
  }
  __syncthreads();
}

DI int gla_row0(int b, int slot) { return slot < 4 ? b * NCTX + slot * 64 : MC + b * SEQ + (slot - 4) * 64; }
constexpr int KXT_STRIDE = 72;

DI void phase_gla_c1(const W& p_, int layer, char* lds, int bid, int nblk) {
  const W p = oq(p_);
  const int tid = otid(), lane = tid & 63;
  const int wid = __builtin_amdgcn_readfirstlane(tid >> 6);
  constexpr int WREG = 2 * 32 * KXT_STRIDE * 2 + 4096;
  bf16_t* kxt = (bf16_t*)(lds + wid * WREG);
  bf16_t* al = (bf16_t*)(lds + wid * WREG + 2 * 32 * KXT_STRIDE * 2);
  float* s_rope = (float*)(lds + 8 * WREG);
  for (int i = tid; i < 1024; i += NTHR) s_rope[i] = p.rope()[i];
  __syncthreads();
  const int dir = lane >> 5, d = lane & 31, fr = lane & 15, fq = lane >> 4;
  const __amdgpu_buffer_rsrc_t rsV = __builtin_amdgcn_make_buffer_rsrc((void*)p.vtg(), 0, (int)(HMG_ELEMS * 2), 0x00020000);
  const int half = d >> 4, jf = d & 7;
  const float sgn = ((d >> 3) & 1) ? 1.f : -1.f;
  for (int u = bid * 8 + wid; u < NB * 4 * NSLOT; u += nblk * 8) {
    const int slot = u % NSLOT, bh = u / NSLOT, h = bh & 3, b = bh >> 2;
    const int row0 = gla_row0(b, slot);
    const bool latent = slot >= 4;
#pragma unroll
    for (int j = 0; j < 4; ++j) {
      const int rr = j * 16 + (lane >> 2), chk = lane & 3;
      *(uint4*)(al + rr * 32 + chk * 8) = *(const uint4*)(p.px() + (size_t)(row0 + rr) * INW + 2560 + chk * 8);
    }
    float w2[16];
    {
      const float* w2p = (dir ? p.w_gate_b() : p.w_gate_f()) + layer * 2048 + h * 32 + d;
#pragma unroll
      for (int r = 0; r < 16; ++r) w2[r] = w2p[r * 128];
    }
    const float b2 = (dir ? p.b_gate_b() : p.b_gate_f())[layer * 128 + h * 32 + d];
    bf16_t* gq = p.gqk() + ((size_t)u * 2 + dir) * 4096;
    asm volatile("s_waitcnt lgkmcnt(0)" ::: "memory");
    float bsum = 0.f;
    for (int ib = 0; ib < 4; ++ib) {
      bf16_t qo[16], qp[16], ko[16], kp[16];
#pragma unroll
      for (int k = 0; k < 16; ++k) {
        const int ii = ib * 16 + k, i = dir ? 63 - ii : ii;
        const bf16_t* rowp = p.px() + (size_t)(row0 + i) * INW + h * 32;
        qo[k] = rowp[1792 + d]; qp[k] = rowp[1792 + (d ^ 8)]; ko[k] = rowp[1920 + d]; kp[k] = rowp[1920 + (d ^ 8)];
      }
#pragma unroll
      for (int k = 0; k < 16; ++k) {
        const int ii = ib * 16 + k, i = dir ? 63 - ii : ii;
        const uint4 a0 = *(const uint4*)(al + i * 32 + dir * 16), a1 = *(const uint4*)(al + i * 32 + dir * 16 + 8);
        float lg = b2;
        const unsigned aw[8] = {a0.x, a0.y, a0.z, a0.w, a1.x, a1.y, a1.z, a1.w};
#pragma unroll
        for (int r = 0; r < 8; ++r) {
          lg += __uint_as_float(aw[r] << 16) * w2[2 * r];
          lg += __uint_as_float(aw[r] & 0xffff0000u) * w2[2 * r + 1];
        }
        const float ls = fminf(lg, 0.f) - __logf(1.f + __expf(-fabsf(lg)));
        bsum += ls * (1.f / 16.f);
        const float qov = bf2f(qo[k]) * 0.17677669529663687f, qpv = bf2f(qp[k]) * 0.17677669529663687f;
        const float kov = bf2f(ko[k]), kpv = bf2f(kp[k]);
        float qr = qov, kr = kov;
        if (latent) {
          const int pos = half == 0 ? (slot - 4) : i;
          const float2 cs = *(const float2*)(s_rope + (pos * 8 + jf) * 2);
          qr = qov * cs.x + sgn * qpv * cs.y;
          kr = kov * cs.x + sgn * kpv * cs.y;
        }
        const float eb = __expf(bsum);
        const bf16_t qx = f2bf(qr * eb), kx = f2bf(kr / eb);
        gq[i * 32 + d] = qx;
        gq[2048 + i * 32 + d] = kx;
        kxt[(dir * 32 + d) * KXT_STRIDE + i] = kx;
      }
    }
    const float eblast = __expf(bsum);
    p.gdec()[((size_t)u * 2 + dir) * 32 + d] = eblast;
    asm volatile("s_waitcnt lgkmcnt(0)" ::: "memory");
    const unsigned vbase = (unsigned)((latent ? HMG_LAT + (size_t)(bh * 64 + slot - 4) * 4096 : (size_t)(bh * 4 + slot) * 4096) * 2);
    bf16x8 vf[2][4];
#pragma unroll
    for (int ks = 0; ks < 2; ++ks)
#pragma unroll
      for (int mt = 0; mt < 4; ++mt) vf[ks][mt] = bl128(rsV, (unsigned)(((16 * mt + fr) * 64 + 8 * fq) * 2), vbase + ks * 64);
#pragma unroll
    for (int dd = 0; dd < 2; ++dd) {
      f32x4 acc[4][2];
#pragma unroll
      for (int mt = 0; mt < 4; ++mt)
#pragma unroll
        for (int nt = 0; nt < 2; ++nt) acc[mt][nt] = (f32x4){0.f, 0.f, 0.f, 0.f};
#pragma unroll
      for (int ks = 0; ks < 2; ++ks) {
        bf16x8 kf[2];
#pragma unroll
        for (int nt = 0; nt < 2; ++nt) kf[nt] = *(const bf16x8*)(kxt + (dd * 32 + 16 * nt + fr) * KXT_STRIDE + 32 * ks + 8 * fq);
#pragma unroll
        for (int mt = 0; mt < 4; ++mt)
#pragma unroll
          for (int nt = 0; nt < 2; ++nt) acc[mt][nt] = __builtin_amdgcn_mfma_f32_16x16x32_bf16(vf[ks][mt], kf[nt], acc[mt][nt], 0, 0, 0);
      }
      float* kvp = p.gkv() + ((size_t)u * 2 + dd) * 2048;
#pragma unroll
      for (int nt = 0; nt < 2; ++nt) {
        const float sc = __shfl(eblast, dd * 32 + 16 * nt + fr);
#pragma unroll
        for (int mt = 0; mt < 4; ++mt)
#pragma unroll
          for (int j = 0; j < 4; ++j) kvp[(16 * mt + 4 * fq + j) * 32 + 16 * nt + fr] = acc[mt][nt][j] * sc;
      }
    }
    asm volatile("s_waitcnt lgkmcnt(0)" ::: "memory");
  }
  __syncthreads();
}

DI void phase_gla_scan(const W& p_, int bid, int nblk) {
  const W p = oq(p_);
  bf16_t* sin = (bf16_t*)p.gsin();
  const int nthreads = NB * 4 * 2 * 2048;
  for (int gid = bid * NTHR + otid(); gid < nthreads; gid += nblk * NTHR) {
    const int el = gid & 2047, dir = (gid >> 11) & 1, bh = gid >> 12, d = el & 31;
    float S = 0.f;
    for (int st0 = 0; st0 < NSLOT; st0 += 17) {
      float dk[17], kv[17];
#pragma unroll
      for (int j = 0; j < 17; ++j) {
        const int st = st0 + j;
        const int slot = dir == 0 ? st : (st < 4 ? 3 - st : NSLOT + 3 - st);
        const size_t base = ((size_t)(bh * NSLOT + slot)) * 2 + dir;
        dk[j] = p.gdec()[base * 32 + d];
        kv[j] = p.gkv()[base * 2048 + el];
      }
#pragma unroll
      for (int j = 0; j < 17; ++j) {
        const int st = st0 + j;
        const int slot = dir == 0 ? st : (st < 4 ? 3 - st : NSLOT + 3 - st);
        const size_t base = ((size_t)(bh * NSLOT + slot)) * 2 + dir;
        sin[base * 2048 + el] = f2bf(S);
        S = dk[j] * S + kv[j];
      }
    }
  }
}

DI void phase_gla_c3(const W& p_, int layer, char* lds, int bid, int nblk) {
  (void)lds;
  const W p = oq(p_);
  const int tid = otid(), lane = tid & 63;
  const int wid = __builtin_amdgcn_readfirstlane(tid >> 6);
  const int fr = lane & 15, fq = lane >> 4;
  const __amdgpu_buffer_rsrc_t rsV = __builtin_amdgcn_make_buffer_rsrc((void*)p.vtg(), 0, (int)(HMG_ELEMS * 2), 0x00020000);
  const __amdgpu_buffer_rsrc_t rsQ = __builtin_amdgcn_make_buffer_rsrc((void*)p.gqk(), 0, (int)((size_t)NB * 4 * NSLOT * 16384), 0x00020000);
  const __amdgpu_buffer_rsrc_t rsS = __builtin_amdgcn_make_buffer_rsrc((void*)p.gsin(), 0, (int)((size_t)NB * 4 * NSLOT * 2 * 4096), 0x00020000);
  const int slot_lo = layer == 0 ? 0 : 4;
  const int nsl = NSLOT - slot_lo;
  const unsigned vfrag = (unsigned)(fr * 64 + fq * 16);
  for (int uu = bid * 8 + wid; uu < NB * 4 * nsl; uu += nblk * 8) {
    const int slot = slot_lo + uu % nsl, bh = uu / nsl, h = bh & 3, b = bh >> 2;
    const int u = bh * NSLOT + slot;
    const bool latent = slot >= 4;
    const int row0 = gla_row0(b, slot);
    const unsigned qbase = (unsigned)u * 16384u;
    bf16x8 QF[4], QB[4];
#pragma unroll
    for (int ct = 0; ct < 4; ++ct) { QF[ct] = bl128(rsQ, vfrag, qbase + ct * 1024); QB[ct] = bl128(rsQ, vfrag, qbase + 8192 + ct * 1024); }
    f32x4 O[4][4];
#pragma unroll
    for (int mt = 0; mt < 4; ++mt)
#pragma unroll
      for (int ct = 0; ct < 4; ++ct) O[mt][ct] = (f32x4){0.f, 0.f, 0.f, 0.f};
    const unsigned vbase = (unsigned)((latent ? HMG_LAT + (size_t)(bh * 64 + slot - 4) * 4096 : (size_t)(bh * 4 + slot) * 4096) * 2);
    const unsigned vV = (unsigned)((fr * 64 + 4 * fq) * 2);
#pragma unroll
    for (int ks = 0; ks < 2; ++ks) {
      f32x4 Pt[2][4];
#pragma unroll
      for (int t2 = 0; t2 < 2; ++t2) {
        const int st = 2 * ks + t2;
        const bf16x8 KFs = bl128(rsQ, vfrag, qbase + 4096 + st * 1024), KBs = bl128(rsQ, vfrag, qbase + 8192 + 4096 + st * 1024);
#pragma unroll
        for (int ct = 0; ct < 4; ++ct) {
          const f32x4 z = (f32x4){0.f, 0.f, 0.f, 0.f};
          if (st < ct) Pt[t2][ct] = __builtin_amdgcn_mfma_f32_16x16x32_bf16(KFs, QF[ct], z, 0, 0, 0);
          else if (st > ct) Pt[t2][ct] = __builtin_amdgcn_mfma_f32_16x16x32_bf16(KBs, QB[ct], z, 0, 0, 0);
          else {
            const f32x4 f = __builtin_amdgcn_mfma_f32_16x16x32_bf16(KFs, QF[ct], z, 0, 0, 0);
            const f32x4 g = __builtin_amdgcn_mfma_f32_16x16x32_bf16(KBs, QB[ct], z, 0, 0, 0);
#pragma unroll
            for (int j = 0; j < 4; ++j) { const int s = 4 * fq + j; Pt[t2][ct][j] = (s <= fr ? f[j] : 0.f) + (s >= fr ? g[j] : 0.f); }
          }
        }
      }
      bf16x8 pf[4];
#pragma unroll
      for (int ct = 0; ct < 4; ++ct)
        pf[ct] = __builtin_bit_cast(bf16x8, (u32x4){pack2(Pt[0][ct][0], Pt[0][ct][1]), pack2(Pt[0][ct][2], Pt[0][ct][3]),
                                                     pack2(Pt[1][ct][0], Pt[1][ct][1]), pack2(Pt[1][ct][2], Pt[1][ct][3])});
#pragma unroll
      for (int mt = 0; mt < 4; ++mt) {
        const unsigned so = vbase + (unsigned)((mt * 16 * 64 + 32 * ks) * 2);
        const u32x2 v0 = bl64(rsV, vV, so), v1 = bl64(rsV, vV + 32, so);
        const bf16x8 vf = __builtin_bit_cast(bf16x8, (u32x4){v0.x, v0.y, v1.x, v1.y});
#pragma unroll
        for (int ct = 0; ct < 4; ++ct) O[mt][ct] = __builtin_amdgcn_mfma_f32_16x16x32_bf16(vf, pf[ct], O[mt][ct], 0, 0, 0);
      }
    }
    const unsigned sbase = (unsigned)u * 8192u;
#pragma unroll
    for (int mt = 0; mt < 4; ++mt) {
      const bf16x8 sf = bl128(rsS, vfrag, sbase + mt * 1024), sb = bl128(rsS, vfrag, sbase + 4096 + mt * 1024);
#pragma unroll
      for (int ct = 0; ct < 4; ++ct) {
        O[mt][ct] = __builtin_amdgcn_mfma_f32_16x16x32_bf16(sf, QF[ct], O[mt][ct], 0, 0, 0);
        O[mt][ct] = __builtin_amdgcn_mfma_f32_16x16x32_bf16(sb, QB[ct], O[mt][ct], 0, 0, 0);
      }
    }
#pragma unroll
    for (int ct = 0; ct < 4; ++ct) {
      float ss = 0.f;
#pragma unroll
      for (int mt = 0; mt < 4; ++mt)
#pragma unroll
        for (int j = 0; j < 4; ++j) ss += O[mt][ct][j] * O[mt][ct][j];
      ss += __shfl_xor(ss, 16); ss += __shfl_xor(ss, 32);
      const float rstd = rsqrtf(ss * (1.f / 64.f) + EPS);
      const int row = row0 + 16 * ct + fr;
#pragma unroll
      for (int mt = 0; mt < 4; ++mt) {
        const int v0 = 16 * mt + 4 * fq;
        const uint2 rv = *(const uint2*)(p.px() + (size_t)row * INW + 2304 + h * 64 + v0);
        const float4 gg = *(const float4*)(p.g_gla() + layer * 64 + v0);
        const float r0 = O[mt][ct][0] * rstd * gg.x * siluf_(__uint_as_float(rv.x << 16));
        const float r1 = O[mt][ct][1] * rstd * gg.y * siluf_(__uint_as_float(rv.x & 0xffff0000u));
        const float r2 = O[mt][ct][2] * rstd * gg.z * siluf_(__uint_as_float(rv.y << 16));
        const float r3 = O[mt][ct][3] * rstd * gg.w * siluf_(__uint_as_float(rv.y & 0xffff0000u));
        *(int*)((char*)p.cat() + (size_t)row * D + 768 + h * 64 + v0) = pack_fp8x4(r0 * 8.f, r1 * 8.f, r2 * 8.f, r3 * 8.f);
      }
    }
  }
}

#define XB_TMO      128
#define XB_XCNT(j)  (256  + 64 * (j))
#define XB_XSUB(j)  (1280 + 64 * (j))
#define XB_XGEN(j)  (2304 + 64 * (j))
#define XB_TOP      3328
#define XB_TOPGEN   3392
#define XCD_BAR_WORDS 3456
#define XB_SPIN_CAP (1u << 18)
#define LAS __attribute__((address_space(3)))

__device__ __forceinline__ unsigned xb_ld(unsigned* p)              { return __hip_atomic_load(p, __ATOMIC_RELAXED, __HIP_MEMORY_SCOPE_AGENT); }
__device__ __forceinline__ unsigned xb_add(unsigned* p, unsigned v) { return __hip_atomic_fetch_add(p, v, __ATOMIC_RELAXED, __HIP_MEMORY_SCOPE_AGENT); }
__device__ __forceinline__ unsigned xb_xcc_id() { return (unsigned)__builtin_amdgcn_s_getreg((3 << 11) | 20) & 0xFu; }
#define XB_SPIN(cond, bar) do { unsigned _sp = 0; while (cond) { __builtin_amdgcn_s_sleep(1); \
    if ((++_sp & 255u) == 0u) { if (xb_ld(&(bar)[XB_TMO])) break; if (_sp > XB_SPIN_CAP) { atomicAdd(&(bar)[XB_TMO], 1u); break; } } } } while (0)

struct XcdBarrier { unsigned* bar; unsigned x; volatile LAS unsigned* st; };

__device__ __forceinline__ XcdBarrier xcd_barrier_post(unsigned* bar, volatile LAS unsigned* st) {
    XcdBarrier b; b.bar = bar; b.x = xb_xcc_id(); b.st = st;
    if (threadIdx.x == 0) (void)xb_add(&bar[XB_XCNT(b.x)], 1u);
    return b;
}
__device__ __forceinline__ void xcd_barrier_complete(unsigned* bar, unsigned x, unsigned& nloc, unsigned& nx) {
    const unsigned G = gridDim.x * gridDim.y * gridDim.z;
    unsigned sum, cnt, mine, sp = 0u;
    for (;;) {
        sum = 0u; cnt = 0u; mine = 0u;
#pragma unroll
        for (unsigned j = 0; j < 16; ++j) { const unsigned c = xb_ld(&bar[XB_XCNT(j)]); sum += c; cnt += (c > 0u) ? 1u : 0u; mine = (j == x) ? c : mine; }
        if (sum == G) break;
        __builtin_amdgcn_s_sleep(1);
        if ((++sp & 255u) == 0u) { if (xb_ld(&bar[XB_TMO])) break; if (sp > XB_SPIN_CAP) { atomicAdd(&bar[XB_TMO], 1u); break; } }
    }
    nloc = mine > 0u ? mine : 1u; nx = cnt > 0u ? cnt : 1u;
}
__device__ __forceinline__ void xcd_barrier(const XcdBarrier& b) {
    asm volatile("s_waitcnt vmcnt(0)" ::: "memory");
    __syncthreads();
    if (threadIdx.x == 0) {
        unsigned long long bv = (unsigned long long)b.bar; unsigned bx = b.x;
        asm volatile("" : "+s"(bv), "+s"(bx));
        unsigned* bar = (unsigned*)(__attribute__((address_space(1))) unsigned*)bv;
        __builtin_amdgcn_s_waitcnt(0);
        unsigned nloc = b.st[0], nx = b.st[1];
        if (nloc == 0u) { xcd_barrier_complete(bar, bx, nloc, nx); b.st[0] = nloc; b.st[1] = nx; }
        const unsigned old = xb_add(&bar[XB_XSUB(bx)], 1u);
        const unsigned gen = old / nloc;
        if (old + 1u == (gen + 1u) * nloc) {
            __builtin_amdgcn_fence(__ATOMIC_RELEASE, "agent");
            asm volatile("s_waitcnt vmcnt(0)" ::: "memory");
            const unsigned og = xb_add(&bar[XB_TOP], 1u);
            const unsigned tg = og / nx;
            if (og + 1u == (tg + 1u) * nx) xb_add(&bar[XB_TOPGEN], 1u);
            else XB_SPIN(xb_ld(&bar[XB_TOPGEN]) == tg, bar);
            __builtin_amdgcn_fence(__ATOMIC_ACQUIRE, "agent");
            xb_add(&bar[XB_XGEN(bx)], 1u);
            asm volatile("s_waitcnt vmcnt(0)" ::: "memory");
        } else {
            XB_SPIN(xb_ld(&bar[XB_XGEN(bx)]) == gen, bar);
            __builtin_amdgcn_fence(__ATOMIC_ACQUIRE, "agent");
            asm volatile("s_waitcnt vmcnt(0)" ::: "memory");
        }
    }
    __syncthreads();
}

__global__ void __launch_bounds__(NTHR, 2) k_fwd(P q) {
  extern __shared__ __attribute__((aligned(16))) char lds[];
  const int bid = blockIdx.x, nblk = gridDim.x;
  if (threadIdx.x < 4) ((unsigned*)(lds + LDS_BYTES - 16))[threadIdx.x] = 0u;
  __syncthreads();
  XcdBarrier bar = xcd_barrier_post((unsigned*)(q.ws + OFF_BAR), (volatile LAS unsigned*)(lds + LDS_BYTES - 16));
  int* s_vb = (int*)(lds + LDS_BYTES - 32);
  if (threadIdx.x == 0) {
    const int xcc = (int)xb_xcc_id();
    s_vb[1] = xcc;
    s_vb[2] = (int)__hip_atomic_fetch_add((unsigned*)(q.ws + OFF_CNT) + 768 + xcc, 1u, __ATOMIC_RELAXED, __HIP_MEMORY_SCOPE_AGENT);
  }
#define GB() xcd_barrier(bar)
#ifndef PROBE_DUP
#define PROBE_DUP 0
#endif
#if PROBE_DUP == 1
#define DUP1(x) x
#else
#define DUP1(x) (void)0
#endif
#if PROBE_DUP == 2
#define DUP2(x) x
#else
#define DUP2(x) (void)0
#endif
#if PROBE_DUP == 3
#define DUP3(x) x
#else
#define DUP3(x) (void)0
#endif
#if PROBE_DUP == 4
#define DUP4(x) x
#else
#define DUP4(x) (void)0
#endif
#if PROBE_DUP == 5
#define DUP5(x) x
#else
#define DUP5(x) (void)0
#endif
#if PROBE_DUP == 6
#define DUP6(x) x
#else
#define DUP6(x) (void)0
#endif
#if PROBE_DUP == 7
#define DUP7(x) x
#else
#define DUP7(x) (void)0
#endif
#if PROBE_DUP == 8
#define DUP8(x) x
#else
#define DUP8(x) (void)0
#endif
#if PROBE_DUP == 9
#define DUP9(x) x
#else
#define DUP9(x) (void)0
#endif
  phase_convert(q, lds, bid, nblk);
  phase_mod(q, lds, bid, nblk);
  DUP3(phase_convert(q, lds, bid, nblk)); DUP3(phase_mod(q, lds, bid, nblk));
  GB();
  if (threadIdx.x == 0) {
    const unsigned* rc = (const unsigned*)(q.ws + OFF_CNT) + 768;
    const int per = nblk >> 3;
    bool ok = (nblk & 7) == 0;
    for (int j = 0; j < 16; ++j) {
      const int c = (int)__hip_atomic_load(rc + j, __ATOMIC_RELAXED, __HIP_MEMORY_SCOPE_AGENT);
      ok = ok && (j < 8 ? c == per : c == 0);
    }
    s_vb[0] = ok ? s_vb[1] * per + s_vb[2] : ((nblk & 7) == 0 ? (bid & 7) * per + (bid >> 3) : bid);
  }
  __syncthreads();
  const int vb = __builtin_amdgcn_readfirstlane(s_vb[0]);
  phase_norm0(q, bid, nblk);
  DUP3(phase_norm0(q, bid, nblk));
  GB();
  const W p{q.ws, q.out, q.x, q.ctx};
#define LAYER(layer, row_lo, LASTGB)                          \
  do {                                                        \
    phase_inproj(p, layer, lds, vb, nblk);                   \
    DUP7(phase_inproj(p, layer, lds, vb, nblk));             \
    GB();                                                     \
    phase_gla_c1(p, layer, lds, vb, nblk);                   \
    phase_pool(p, layer, lds, vb, nblk);                     \
    DUP6(phase_gla_c1(p, layer, lds, vb, nblk)); DUP5(phase_pool(p, layer, lds, vb, nblk)); \
    GB();                                                     \
    phase_gla_scan(p, vb, nblk);                             \
    phase_attn(p, layer, lds, vb, nblk);                     \
    DUP6(phase_gla_scan(p, vb, nblk)); DUP4(phase_attn(p, layer, lds, vb, nblk)); \
    GB();                                                     \
    phase_gla_c3(p, layer, lds, vb, nblk);                   \
    DUP6(phase_gla_c3(p, layer, lds, vb, nblk));             \
    GB();                                                     \
    DUP2(phase_outproj_t<true>(p, layer, lds, row_lo, vb, nblk)); \
    phase_outproj(p, layer, lds, row_lo, vb, nblk);          \
    GB();                                                     \
    phase_norm(p, layer, row_lo, vb, nblk);                  \
    DUP3(phase_norm(p, layer, row_lo, vb, nblk));            \
    GB();                                                     \
    phase_router(p, layer, lds, row_lo, vb, nblk);           \
    DUP1(phase_router(p, layer, lds, row_lo, vb, nblk));     \
    GB();                                                     \
    phase_route(p, layer, lds, row_lo, vb, nblk);            \
    GB();                                                     \
    phase_moe(p, layer, lds, row_lo, vb, nblk);              \
    DUP8(phase_moe(p, layer, lds, row_lo, vb, nblk));        \
    GB();                                                     \
    DUP9(phase_combine_t<true>(p, layer, row_lo, vb, nblk)); \
    phase_combine(p, layer, row_lo, vb, nblk);               \
    LASTGB;                                                   \
  } while (0)
#if PROBE_GEMM
  phase_probe_gemm(p, lds, vb, nblk);
  GB();
#endif
  LAYER(0, 0, GB());
  LAYER(1, MC, (void)0);
#undef LAYER
#undef GB
}

}

extern "C" void kernel_launch(void* const* d_in, const int* in_sizes, int n_in, void* d_out, int out_size, void* d_ws,
                              size_t ws_size, hipStream_t stream) {
  (void)in_sizes; (void)n_in; (void)out_size;
  P p{};
  const float* const* in = (const float* const*)d_in;
  p.x = in[0]; p.c = in[1]; p.ctx = in[2]; p.c_ctx = in[3]; p.w_mod = in[4]; p.b_mod = in[5]; p.g_mix = in[6]; p.w_in = in[7];
  p.rpb = in[8]; p.w_pool = in[9]; p.pool_scale = in[10]; p.w_gate_f = in[11]; p.b_gate_f = in[12]; p.w_gate_b = in[13];
  p.b_gate_b = in[14]; p.g_gla = in[15]; p.w_out = in[16]; p.g_ffn = in[17]; p.w_router = in[18]; p.b_router = in[19];
  p.w_e_in = in[20]; p.w_e_down = in[21]; p.w_sh_in = in[22]; p.w_sh_down = in[23]; p.g_final = in[24];
  p.out = (float*)d_out;
  p.ws = (char*)d_ws;
  char* ws = (char*)d_ws;
  if (ws_size < WS_TOTAL) { fprintf(stderr, "workspace too small: %zu < %zu\n", ws_size, (size_t)WS_TOTAL); }
  static int grid = 0;
  if (!grid) {
    (void)hipFuncSetAttribute((const void*)k_fwd, hipFuncAttributeMaxDynamicSharedMemorySize, LDS_BYTES);
    int dev = 0, cus = 0, per_cu = 0;
    (void)hipGetDevice(&dev);
    (void)hipDeviceGetAttribute(&cus, hipDeviceAttributeMultiprocessorCount, dev);
    (void)hipOccupancyMaxActiveBlocksPerMultiprocessor(&per_cu, (const void*)k_fwd, NTHR, LDS_BYTES);
    if (per_cu < 1) { fprintf(stderr, "k_fwd: occupancy query says 0 blocks per CU\n"); per_cu = 1; }
    grid = cus > 0 ? cus : 256;
  }
  (void)hipMemsetAsync(ws, 0, ZERO_BYTES, stream);
  hipLaunchKernelGGL(k_fwd, dim3(grid), dim3(NTHR), LDS_BYTES, stream, p);
}
```

```cpp
#include <hip/hip_runtime.h>
#include <stdint.h>
#include <stdio.h>

#define DI __device__ __forceinline__
typedef unsigned short bf16_t;
typedef short bf16x8 __attribute__((ext_vector_type(8)));
typedef short bf16x4 __attribute__((ext_vector_type(4)));
typedef float f32x4 __attribute__((ext_vector_type(4)));

namespace {
constexpr int D = 1024, NB = 8, SEQ = 4096, NCTX = 256;
constexpr int MC = NB * NCTX, ML = NB * SEQ, MT = MC + ML;
constexpr int INW = 2592, INWP = 2816;
constexpr int NE = 256, NE1 = 257;
constexpr int NTHR = 512;
constexpr int LDS_BYTES = 152 * 1024;
constexpr int CAP = MT;
constexpr int NSLOT = 68;
constexpr float EPS = 1e-6f;

struct P {
  const float *x, *c, *ctx, *c_ctx, *w_mod, *b_mod, *g_mix, *w_in, *rpb, *w_pool, *pool_scale,
      *w_gate_f, *b_gate_f, *w_gate_b, *b_gate_b, *g_gla, *w_out, *g_ffn, *w_router, *b_router,
      *w_e_in, *w_e_down, *w_sh_in, *w_sh_down, *g_final;
  float* out;
  char* ws;
};

constexpr size_t al256(size_t x) { return (x + 255) & ~(size_t)255; }
constexpr size_t OFF_BAR = 0;
constexpr size_t OFF_CNT = OFF_BAR + 16384;
constexpr size_t ZERO_BYTES = 16384 + 4096;
constexpr size_t OFF_MOD = OFF_CNT + 4096;
constexpr size_t OFF_ROPE = OFF_MOD + al256((size_t)2 * 9 * 6144 * 4);
constexpr size_t OFF_GMIX = OFF_ROPE + al256(64 * 8 * 2 * 4);
constexpr size_t OFF_GFFN = OFF_GMIX + al256(2 * 1024 * 4);
constexpr size_t OFF_GFINAL = OFF_GFFN + al256(2 * 1024 * 4);
constexpr size_t OFF_RPB = OFF_GFINAL + al256(1024 * 4);
constexpr size_t OFF_WPOOL = OFF_RPB + al256(2 * 3720 * 4);
constexpr size_t OFF_PSCALE = OFF_WPOOL + al256(2 * 4 * 4096 * 4);
constexpr size_t OFF_WGF = OFF_PSCALE + al256(2 * 256 * 4);
constexpr size_t OFF_WGB = OFF_WGF + al256(2 * 16 * 128 * 4);
constexpr size_t OFF_BGF = OFF_WGB + al256(2 * 16 * 128 * 4);
constexpr size_t OFF_BGB = OFF_BGF + al256(2 * 128 * 4);
constexpr size_t OFF_GGLA = OFF_BGB + al256(2 * 128 * 4);
constexpr size_t OFF_BROUTER = OFF_GGLA + al256(2 * 64 * 4);
constexpr size_t OFF_WIN = OFF_BROUTER + al256(2 * 256 * 4);
constexpr size_t OFF_WOUT = OFF_WIN + al256((size_t)2 * INWP * 1024 * 2);
constexpr size_t OFF_WR = OFF_WOUT + al256((size_t)2 * 1024 * 1024 * 2);
constexpr size_t OFF_WEI = OFF_WR + al256((size_t)2 * 256 * 1024 * 2);
constexpr size_t OFF_WED = OFF_WEI + al256((size_t)2 * NE1 * 512 * 1024 * 2);
constexpr size_t OFF_H = OFF_WED + al256((size_t)2 * NE1 * 1024 * 256 * 2);
constexpr size_t OFF_CAT = OFF_H + al256((size_t)MT * D * 2);
constexpr size_t OFF_H2 = OFF_CAT + al256((size_t)MT * D * 2);
constexpr size_t OFF_PX = OFF_H2 + al256((size_t)MT * D * 2);
constexpr size_t OFF_ACT = OFF_PX + al256((size_t)MT * INW * 2);
constexpr size_t OFF_Y = OFF_ACT + al256((size_t)9 * MT * 256 * 2);
constexpr size_t OFF_XRES = OFF_Y + al256((size_t)9 * MT * D * 2);
constexpr size_t OFF_LOGITS = OFF_XRES + al256((size_t)MT * D * 4);
constexpr size_t OFF_WTS = OFF_LOGITS + al256((size_t)MT * 256 * 4);
constexpr size_t OFF_GKV = OFF_WTS + al256((size_t)MT * 8 * 4);
constexpr size_t OFF_GDEC = OFF_GKV + al256((size_t)NB * 4 * NSLOT * 2 * 2048 * 4);
constexpr size_t OFF_GSIN = OFF_GDEC + al256((size_t)NB * 4 * NSLOT * 2 * 32 * 4);
constexpr size_t OFF_LISTS = OFF_GSIN + al256((size_t)NB * 4 * NSLOT * 2 * 2048 * 4);
constexpr size_t OFF_QH = OFF_LISTS + al256((size_t)NE * CAP * 4);
constexpr size_t HM_LAT = (size_t)NB * 8 * NCTX * 64;
constexpr size_t HM_ELEMS = (size_t)NB * 8 * (NCTX + SEQ) * 64;
constexpr size_t OFF_KH = OFF_QH + al256(HM_ELEMS * 2);
constexpr size_t OFF_VT = OFF_KH + al256(HM_ELEMS * 2);
constexpr size_t HMG_LAT = (size_t)NB * 4 * 64 * NCTX;
constexpr size_t HMG_ELEMS = (size_t)NB * 4 * 64 * (NCTX + SEQ);
constexpr size_t OFF_VTG = OFF_VT + al256(HM_ELEMS * 2);
constexpr size_t OFF_GQK = OFF_VTG + al256(HMG_ELEMS * 2);
constexpr size_t OFF_WPT = OFF_GQK + al256((size_t)NB * 4 * NSLOT * 2 * 2 * 2048 * 2);
constexpr size_t OFF_H2Q = OFF_WPT + al256((size_t)2 * 4 * 4096 * 2);
constexpr size_t WS_TOTAL = OFF_H2Q + al256((size_t)MT * 1024);

struct W {
  char* ws; float* out; const float* x; const float* ctx;
#define WF(T, name, OFF) DI T* name() const { return (T*)(ws + OFF); }
  WF(unsigned, bar, OFF_BAR) WF(int, cnt, OFF_CNT) WF(float, mod, OFF_MOD) WF(float, rope, OFF_ROPE)
  WF(float, g_mix, OFF_GMIX) WF(float, g_ffn, OFF_GFFN) WF(float, g_final, OFF_GFINAL) WF(float, rpb, OFF_RPB)
  WF(float, w_pool, OFF_WPOOL) WF(float, pool_scale, OFF_PSCALE) WF(float, w_gate_f, OFF_WGF) WF(float, w_gate_b, OFF_WGB)
  WF(float, b_gate_f, OFF_BGF) WF(float, b_gate_b, OFF_BGB) WF(float, g_gla, OFF_GGLA) WF(float, b_router, OFF_BROUTER)
  WF(bf16_t, win_t, OFF_WIN) WF(bf16_t, wout_t, OFF_WOUT) WF(bf16_t, wr_t, OFF_WR) WF(bf16_t, wei_t, OFF_WEI) WF(bf16_t, wed_t, OFF_WED)
  WF(bf16_t, h, OFF_H) WF(bf16_t, cat, OFF_CAT) WF(bf16_t, h2, OFF_H2) WF(bf16_t, px, OFF_PX) WF(bf16_t, act, OFF_ACT) WF(bf16_t, y, OFF_Y)
  WF(bf16_t, xres, OFF_XRES) WF(float, logits, OFF_LOGITS) WF(float, wts, OFF_WTS) WF(float, gkv, OFF_GKV) WF(float, gdec, OFF_GDEC)
  WF(float, gsin, OFF_GSIN) WF(int, lists, OFF_LISTS) WF(bf16_t, qh, OFF_QH) WF(bf16_t, kh, OFF_KH) WF(bf16_t, vt, OFF_VT) WF(bf16_t, vtg, OFF_VTG) WF(bf16_t, gqk, OFF_GQK) WF(bf16_t, wpt, OFF_WPT) WF(unsigned char, h2q, OFF_H2Q)
#undef WF
};

DI float bf2f(bf16_t v) { return __uint_as_float(((unsigned)v) << 16); }
DI bf16_t f2bf(float f) { unsigned u = __float_as_uint(f); u += 0x7fffu + ((u >> 16) & 1u); return (bf16_t)(u >> 16); }
typedef float f32x2v __attribute__((ext_vector_type(2)));
typedef __bf16 bf16x2v __attribute__((ext_vector_type(2)));
DI unsigned pack2(float lo, float hi) {
  const f32x2v v = {lo, hi};
  return __builtin_bit_cast(unsigned, __builtin_convertvector(v, bf16x2v));
}
DI int pack_fp8x4(float a, float b, float c, float d) {
  a = __builtin_amdgcn_fmed3f(a, -440.f, 440.f); b = __builtin_amdgcn_fmed3f(b, -440.f, 440.f);
  c = __builtin_amdgcn_fmed3f(c, -440.f, 440.f); d = __builtin_amdgcn_fmed3f(d, -440.f, 440.f);
  int w = __builtin_amdgcn_cvt_pk_fp8_f32(a, b, 0, false);
  return __builtin_amdgcn_cvt_pk_fp8_f32(c, d, w, true);
}
DI float4 unpack4(uint2 v) { return make_float4(__uint_as_float(v.x << 16), __uint_as_float(v.x & 0xffff0000u), __uint_as_float(v.y << 16), __uint_as_float(v.y & 0xffff0000u)); }
DI float wave_sum(float v) { for (int o = 32; o; o >>= 1) v += __shfl_xor(v, o); return v; }
DI float wave_max(float v) { for (int o = 32; o; o >>= 1) v = fmaxf(v, __shfl_xor(v, o)); return v; }
template <int CTRL> DI float dppf(float v) { return __int_as_float(__builtin_amdgcn_update_dpp(__float_as_int(v), __float_as_int(v), CTRL, 0xf, 0xf, false)); }
DI float rlanef(float v, int l) { return __int_as_float(__builtin_amdgcn_readlane(__float_as_int(v), l)); }
DI float wave_max_dpp(float v) {
  v = fmaxf(v, dppf<0xB1>(v));
  v = fmaxf(v, dppf<0x4E>(v));
  v = fmaxf(v, dppf<0x141>(v));
  v = fmaxf(v, dppf<0x140>(v));
  return fmaxf(fmaxf(rlanef(v, 0), rlanef(v, 16)), fmaxf(rlanef(v, 32), rlanef(v, 48)));
}
DI int otid() { int t = threadIdx.x; asm volatile("" : "+v"(t)); return t; }
DI float sigmoidf_(float x) { return 1.f / (1.f + __expf(-x)); }
DI float siluf_(float x) { return x / (1.f + __expf(-x)); }
DI int vbid_of(int bid, int nblk) { (void)nblk; return bid; }
DI int mod_row(int row) { return row < MC ? 8 : ((row - MC) >> 12); }

typedef __attribute__((address_space(1))) char gchar;
typedef __attribute__((address_space(1))) float gfloat;
DI W oq(const W& w) {
  unsigned long long v = (unsigned long long)w.ws;
  asm volatile("" : "+s"(v));
  W r; r.ws = (char*)(gchar*)v; r.out = w.out; r.x = w.x; r.ctx = w.ctx;
  return r;
}

struct NoHook { DI void operator()() const {} };
template <int WM, int WN, int MI, int NI, int BK, int NS, bool SWAP, int NCH, int FLAGS = 0, class FA, class FB, class EPI, class HK = NoHook>
DI void gemm_tile(char* lds, int nk, size_t bstride, size_t bks, FA rowA, FB rowB, EPI epi, const char* ares = nullptr, HK hook = HK()) {
  constexpr int BM = WM * MI * 16, BN = WN * NI * 16;
  constexpr int RB = BK * 2, CPR = RB / 16, RPP = 1024 / RB;
  constexpr bool ARES = (FLAGS & 1) != 0;
  constexpr int PA = ARES ? 0 : BM / RPP / 8, PB = BN / RPP / 8, NP = PA + PB, BOFF = ARES ? 0 : BM * RB, STG = BOFF + BN * RB, KS = BK / 32;
  static_assert(WM * WN == 8, "8 waves");
  static_assert(BK == 32 || BK == 64, "BK");
  const int tid = otid(), wid = tid >> 6, lane = tid & 63, fr = lane & 15, fq = lane >> 4;
  const int wr = wid / WN, wc = wid % WN;
  const int lrow = lane / CPR, pc = lane % CPR;
  const bf16_t* ap[PA > 0 ? PA : 1];
  const bf16_t* bp[PB];
#pragma unroll
  for (int i = 0; i < PA; ++i) {
    const int r = (wid + 8 * i) * RPP + lrow;
    const int sw = BK == 64 ? ((r >> 1) & 7) : ((-(r >> 2)) & 3);
    ap[i] = rowA(r) + ((pc ^ sw) * 8);
  }
#pragma unroll
  for (int i = 0; i < PB; ++i) {
    const int r = (wid + 8 * i) * RPP + lrow;
    const int sw = BK == 64 ? ((r >> 1) & 7) : ((-(r >> 2)) & 3);
    bp[i] = rowB(r) + ((pc ^ sw) * 8);
  }
  char* ldst = lds + wid * 1024 + lane * 16;
  f32x4 acc[MI][NI];
#pragma unroll
  for (int mi = 0; mi < MI; ++mi)
#pragma unroll
    for (int ni = 0; ni < NI; ++ni) acc[mi][ni] = (f32x4){0.f, 0.f, 0.f, 0.f};
  const int swf = BK == 64 ? (fr >> 1) : ((-(fr >> 2)) & 3);
  const int aoff = (wr * MI * 16 + fr) * RB + ((fq ^ swf) * 16);
  const int boff = BOFF + (wc * NI * 16 + fr) * RB + ((fq ^ swf) * 16);
#define GEMM_STAGE(s, t)                                                                                              \
  do {                                                                                                                \
    const int kt_ = NCH == 1 ? (t) : (t) % nk;                                                                        \
    const size_t bo_ = NCH == 1 ? (size_t)0 : (size_t)((t) / nk) * bstride;                                           \
    _Pragma("unroll") for (int i = 0; i < PA; ++i) __builtin_amdgcn_global_load_lds(                                  \
        (const unsigned*)(ap[i] + kt_ * BK), (unsigned*)(ldst + (s) * STG + i * 8192), 16, 0, 0);                     \
    _Pragma("unroll") for (int i = 0; i < PB; ++i) __builtin_amdgcn_global_load_lds(                                  \
        (const unsigned*)(bp[i] + bo_ + kt_ * bks), (unsigned*)(ldst + (s) * STG + BOFF + i * 8192), 16, 0, 0);      \
  } while (0)
  const int ntile = NCH * nk;
  if constexpr ((FLAGS & 64) == 0) {
#pragma unroll
    for (int s = 0; s < NS - 1; ++s)
      if (s < ntile) GEMM_STAGE(s, s);
  }
  int slot = 0, nslot = NS - 1;
  int kin = 0, chunk = 0;
#pragma nounroll
  for (int kt = 0; kt < ntile; ++kt) {
    if constexpr ((FLAGS & 32) != 0) {
      static_assert(NS == 2 && NCH > 1, "store-aware wait: 2-slot ring, chunked stream");
      if (kin == 0 && kt > 0) asm volatile("s_waitcnt vmcnt(8)" ::: "memory");
      else asm volatile("s_waitcnt vmcnt(0)" ::: "memory");
    } else {
      if (kt + NS - 2 < ntile) asm volatile("s_waitcnt vmcnt(%0)" ::"n"((NS - 2) * NP) : "memory");
      else asm volatile("s_waitcnt vmcnt(0)" ::: "memory");
    }
    __builtin_amdgcn_s_barrier();
    asm volatile("" ::: "memory");
    if (kt + NS - 1 < ntile) GEMM_STAGE(nslot, kt + NS - 1);
    if (kt == ntile - 1) hook();
    const char* sb = lds + slot * STG;
    const char* sa = ARES ? ares + (NCH == 1 ? kt : kin) * (BM * RB) : sb;
    slot = slot + 1 == NS ? 0 : slot + 1;
    nslot = nslot + 1 == NS ? 0 : nslot + 1;
    if constexpr ((FLAGS & 4) != 0) {
      static_assert(BK == 64 && NI % 4 == 0, "fp8 path: 128-byte rows, column tiles in groups of 4");
      typedef int i32x4v __attribute__((ext_vector_type(4)));
      typedef int i32x8v __attribute__((ext_vector_type(8)));
      constexpr int ASC = (FLAGS & 8) ? 0x7b7b7b7b : (FLAGS & 16) ? 0x7c7c7c7c : 0x7f7f7f7f;
      i32x4v a0[MI], a1[MI];
#pragma unroll
      for (int mi = 0; mi < MI; ++mi) {
        a0[mi] = *(const i32x4v*)(sa + (aoff + mi * 16 * RB));
        a1[mi] = *(const i32x4v*)(sa + ((aoff ^ 64) + mi * 16 * RB));
      }
      constexpr int GW = NI > 4 ? 2 : 4, NG8 = NI / GW;
      i32x4v b0[2][GW], b1[2][GW];
#pragma unroll
      for (int nj = 0; nj < GW; ++nj) {
        b0[0][nj] = *(const i32x4v*)(sb + (boff + nj * 16 * RB));
        b1[0][nj] = *(const i32x4v*)(sb + ((boff ^ 64) + nj * 16 * RB));
      }
      __builtin_amdgcn_sched_group_barrier(0x100, 2 * MI + 2 * GW, 0);
#pragma unroll
      for (int g = 0; g < NG8; ++g) {
        const int cur = g & 1, nxt = cur ^ 1;
        if (g + 1 < NG8) {
#pragma unroll
          for (int nj = 0; nj < GW; ++nj) {
            b0[nxt][nj] = *(const i32x4v*)(sb + (boff + ((g + 1) * GW + nj) * 16 * RB));
            b1[nxt][nj] = *(const i32x4v*)(sb + ((boff ^ 64) + ((g + 1) * GW + nj) * 16 * RB));
          }
          __builtin_amdgcn_sched_group_barrier(0x100, 2 * GW, 0);
        }
#pragma unroll
        for (int mi = 0; mi < MI; ++mi)
#pragma unroll
          for (int nj = 0; nj < GW; ++nj) {
            const i32x8v av = __builtin_shufflevector(a0[mi], a1[mi], 0, 1, 2, 3, 4, 5, 6, 7);
            const i32x8v bv = __builtin_shufflevector(b0[cur][nj], b1[cur][nj], 0, 1, 2, 3, 4, 5, 6, 7);
            acc[mi][g * GW + nj] = SWAP ? __builtin_amdgcn_mfma_scale_f32_16x16x128_f8f6f4(av, bv, acc[mi][g * GW + nj], 0, 0, 0, ASC, 0, 0x79797979)
                                        : __builtin_amdgcn_mfma_scale_f32_16x16x128_f8f6f4(bv, av, acc[mi][g * GW + nj], 0, 0, 0, 0x79797979, 0, ASC);
          }
        __builtin_amdgcn_sched_group_barrier(0x008, MI * GW, 0);
      }
    } else {
    constexpr int NG = NI / 4, NGT = KS * NG;
    bf16x8 af[KS][MI], bfr[2][4];
#pragma unroll
    for (int mi = 0; mi < MI; ++mi) af[0][mi] = *(const bf16x8*)(sa + (aoff + mi * 16 * RB));
#pragma unroll
    for (int nj = 0; nj < 4; ++nj) bfr[0][nj] = *(const bf16x8*)(sb + (boff + nj * 16 * RB));
    __builtin_amdgcn_sched_group_barrier(0x100, MI + 4, 0);
#pragma unroll
    for (int gi = 0; gi < NGT; ++gi) {
      const int ks = gi / NG, g = gi % NG, cur = gi & 1, nxt = cur ^ 1;
      if (gi + 1 < NGT) {
        const int ks2 = (gi + 1) / NG, g2 = (gi + 1) % NG;
#pragma unroll
        for (int nj = 0; nj < 4; ++nj) bfr[nxt][nj] = *(const bf16x8*)(sb + ((boff ^ (ks2 * 64)) + (g2 * 4 + nj) * 16 * RB));
        if (ks2 != ks) {
#pragma unroll
          for (int mi = 0; mi < MI; ++mi) af[ks2 % KS][mi] = *(const bf16x8*)(sa + ((aoff ^ (ks2 * 64)) + mi * 16 * RB));
          __builtin_amdgcn_sched_group_barrier(0x100, MI + 4, 0);
        } else {
          __builtin_amdgcn_sched_group_barrier(0x100, 4, 0);
        }
      }
#pragma unroll
      for (int mi = 0; mi < MI; ++mi)
#pragma unroll
        for (int nj = 0; nj < 4; ++nj)
          acc[mi][g * 4 + nj] = SWAP ? __builtin_amdgcn_mfma_f32_16x16x32_bf16(af[ks][mi], bfr[cur][nj], acc[mi][g * 4 + nj], 0, 0, 0)
                                     : __builtin_amdgcn_mfma_f32_16x16x32_bf16(bfr[cur][nj], af[ks][mi], acc[mi][g * 4 + nj], 0, 0, 0);
      __builtin_amdgcn_sched_group_barrier(0x008, MI * 4, 0);
    }
    }
    if (NCH > 1) {
      if (++kin == nk) {
        kin = 0;
        epi(acc, chunk, wr, wc, fr, fq);
        ++chunk;
#pragma unroll
        for (int mi = 0; mi < MI; ++mi)
#pragma unroll
          for (int ni = 0; ni < NI; ++ni) acc[mi][ni] = (f32x4){0.f, 0.f, 0.f, 0.f};
      }
    }
  }
#undef GEMM_STAGE
  if (FLAGS & 2) __syncthreads();
  if (NCH == 1) epi(acc, 0, wr, wc, fr, fq);
  __syncthreads();
}


template <int BN, int NPRE, class FB>
DI void gemm_prestage_b(char* lds, size_t bks, FB rowB) {
  const int tid = otid(), wid = tid >> 6, lane = tid & 63;
  const int lrow = lane >> 3, pc = lane & 7;
  char* ldst = lds + wid * 1024 + lane * 16;
#pragma unroll
  for (int s = 0; s < NPRE; ++s)
#pragma unroll
    for (int i = 0; i < BN / 64; ++i) {
      const int r = (wid + 8 * i) * 8 + lrow;
      const bf16_t* bp = rowB(r) + ((pc ^ ((r >> 1) & 7)) * 8);
      __builtin_amdgcn_global_load_lds((const unsigned*)(bp + s * bks), (unsigned*)(ldst + s * (BN * 128) + i * 8192), 16, 0, 0);
    }
}

template <int WM, int WN, int MI, int NI, bool SWAP, bool NOSTAGE = false, class FA, class FB, class EPI>
DI void gemm_tile_stag(char* lds, int nk, size_t bks, FA rowA, FB rowB, EPI epi) {
  constexpr int BK = 32, BM = WM * MI * 16, BN = WN * NI * 16;
  constexpr int RB = BK * 2, CPR = RB / 16, RPP = 1024 / RB;
  constexpr int PA = BM / RPP / 8, PB = BN / RPP / 8, NP = PA + PB, STG = (BM + BN) * RB;
  const int tid = otid(), wid = tid >> 6, lane = tid & 63, fr = lane & 15, fq = lane >> 4;
  const int wr = wid / WN, wc = wid % WN;
  const int lrow = lane / CPR, pc = lane % CPR;
  const bf16_t* ap[PA];
  const bf16_t* bp[PB];
#pragma unroll
  for (int i = 0; i < PA; ++i) { const int r = (wid + 8 * i) * RPP + lrow; ap[i] = rowA(r) + ((pc ^ ((-(r >> 2)) & 3)) * 8); }
#pragma unroll
  for (int i = 0; i < PB; ++i) { const int r = (wid + 8 * i) * RPP + lrow; bp[i] = rowB(r) + ((pc ^ ((-(r >> 2)) & 3)) * 8); }
  char* ldst = lds + wid * 1024 + lane * 16;
  f32x4 acc[MI][NI];
#pragma unroll
  for (int mi = 0; mi < MI; ++mi)
#pragma unroll
    for (int ni = 0; ni < NI; ++ni) acc[mi][ni] = (f32x4){0.f, 0.f, 0.f, 0.f};
  const int swf = (-(fr >> 2)) & 3;
  const int aoff = (wr * MI * 16 + fr) * RB + ((fq ^ swf) * 16);
  const int boff = BM * RB + (wc * NI * 16 + fr) * RB + ((fq ^ swf) * 16);
#define STAG_STAGE(s, t)                                                                                              \
  do {                                                                                                                \
    _Pragma("unroll") for (int i = 0; i < PA; ++i) __builtin_amdgcn_global_load_lds(                                  \
        (const unsigned*)(ap[i] + (t) * BK), (unsigned*)(ldst + (s) * STG + i * 8192), 16, 0, 0);                     \
    _Pragma("unroll") for (int i = 0; i < PB; ++i) __builtin_amdgcn_global_load_lds(                                  \
        (const unsigned*)(bp[i] + (t) * bks), (unsigned*)(ldst + (s) * STG + BM * RB + i * 8192), 16, 0, 0);          \
  } while (0)
  const int hb = __builtin_amdgcn_readfirstlane(wid >> 2);
  STAG_STAGE(0, 0);
  if (1 < nk) { STAG_STAGE(1, 1); asm volatile("s_waitcnt vmcnt(%0)" ::"n"(NP) : "memory"); }
  else asm volatile("s_waitcnt vmcnt(0)" ::: "memory");
  __builtin_amdgcn_s_barrier();
  asm volatile("" ::: "memory");
  if (hb) { __builtin_amdgcn_s_barrier(); asm volatile("" ::: "memory"); }
  for (int kt = 0; kt < nk; ++kt) {
    const char* sb = lds + (kt & 3) * STG;
    bf16x8 af[MI], bfr[NI];
#pragma unroll
    for (int mi = 0; mi < MI; ++mi) af[mi] = *(const bf16x8*)(sb + (aoff + mi * 16 * RB));
#pragma unroll
    for (int ni = 0; ni < NI; ++ni) bfr[ni] = *(const bf16x8*)(sb + (boff + ni * 16 * RB));
    if (!NOSTAGE && kt + 2 < nk) STAG_STAGE((kt + 2) & 3, kt + 2);
    if (hb) {
      if (kt + 2 < nk) asm volatile("s_waitcnt vmcnt(%0)" ::"n"(NP) : "memory");
      else asm volatile("s_waitcnt vmcnt(0)" ::: "memory");
    }
    __builtin_amdgcn_s_barrier();
    asm volatile("" ::: "memory");
    __builtin_amdgcn_s_setprio(1);
#pragma unroll
    for (int mi = 0; mi < MI; ++mi)
#pragma unroll
      for (int ni = 0; ni < NI; ++ni)
        acc[mi][ni] = SWAP ? __builtin_amdgcn_mfma_f32_16x16x32_bf16(af[mi], bfr[ni], acc[mi][ni], 0, 0, 0)
                           : __builtin_amdgcn_mfma_f32_16x16x32_bf16(bfr[ni], af[mi], acc[mi][ni], 0, 0, 0);
    __builtin_amdgcn_s_setprio(0);
    if (!hb) {
      if (kt + 2 < nk) asm volatile("s_waitcnt vmcnt(%0)" ::"n"(NP) : "memory");
      else asm volatile("s_waitcnt vmcnt(0)" ::: "memory");
    }
    __builtin_amdgcn_s_barrier();
    asm volatile("" ::: "memory");
  }
  if (!hb) { __builtin_amdgcn_s_barrier(); asm volatile("" ::: "memory"); }
#undef STAG_STAGE
  epi(acc, 0, wr, wc, fr, fq);
  __syncthreads();
}

struct ConvT { const float* src; bf16_t* dst; int ldn, N, K, k0, n0, bkl, npad, f8; };
DI ConvT conv_desc(const P& q, int tile) {
  constexpr int nA = 2 * 257 * 128, nB = 2 * 257 * 64, nC = 2 * 16 * 44, nD = 2 * 16 * 16;
  const W w{q.ws, q.out};
  ConvT c;
  c.f8 = 0;
  int t = tile;
  if (t < nA) {
    const int m = t / 128, r = t % 128, l = m / 257, e = m % 257;
    c.src = e < 256 ? q.w_e_in + (size_t)(l * 256 + e) * 1024 * 512 : q.w_sh_in + (size_t)l * 1024 * 512;
    c.dst = (bf16_t*)((char*)w.wei_t() + (size_t)m * 512 * 1024); c.ldn = 512; c.N = 512; c.K = 1024; c.bkl = 128; c.npad = 512; c.k0 = (r / 8) * 64; c.n0 = (r % 8) * 64; c.f8 = 1;
    return c;
  }
  t -= nA;
  if (t < nB) {
    const int m = t / 64, r = t % 64, l = m / 257, e = m % 257;
    c.src = e < 256 ? q.w_e_down + (size_t)(l * 256 + e) * 256 * 1024 : q.w_sh_down + (size_t)l * 256 * 1024;
    c.dst = (bf16_t*)((char*)w.wed_t() + (size_t)m * 1024 * 256); c.ldn = 1024; c.N = 1024; c.K = 256; c.bkl = 128; c.npad = 1024; c.k0 = (r / 16) * 64; c.n0 = (r % 16) * 64; c.f8 = 1;
    return c;
  }
  t -= nB;
  if (t < nC) {
    const int l = t / 704, r = t % 704;
    c.src = q.w_in + (size_t)l * 1024 * INW; c.dst = (bf16_t*)((char*)w.win_t() + (size_t)l * INWP * 1024); c.ldn = INW; c.N = INW; c.K = 1024; c.bkl = 128; c.npad = INWP; c.f8 = 1;
    c.k0 = (r / 44) * 64; c.n0 = (r % 44) * 64;
    return c;
  }
  t -= nC;
  if (t < nD) {
    const int l = t / 256, r = t % 256;
    c.src = q.w_out + (size_t)l * 1024 * 1024; c.dst = (bf16_t*)((char*)w.wout_t() + (size_t)l * 1024 * 1024); c.ldn = 1024; c.N = 1024; c.K = 1024; c.bkl = 128; c.npad = 1024; c.f8 = 1;
    c.k0 = (r / 16) * 64; c.n0 = (r % 16) * 64;
    return c;
  }
  t -= nD;
  {
    const int l = t / 64, r = t % 64;
    c.src = q.w_router + (size_t)l * 1024 * 256; c.dst = w.wr_t() + (size_t)l * 256 * 1024; c.ldn = 256; c.N = 256; c.K = 1024; c.bkl = 32; c.npad = 256;
    c.k0 = (r / 4) * 64; c.n0 = (r % 4) * 64;
  }
  return c;
}

DI void conv_store(const ConvT& c, uint4 v, int rn, int rks) {
  const int kk = c.k0 + rks * 2;
  if (c.f8) {
    const float4 lo = unpack4(make_uint2(v.x, v.y)), hi = unpack4(make_uint2(v.z, v.w));
    const int w0 = pack_fp8x4(lo.x * 64.f, lo.y * 64.f, lo.z * 64.f, lo.w * 64.f);
    const int w1 = pack_fp8x4(hi.x * 64.f, hi.y * 64.f, hi.z * 64.f, hi.w * 64.f);
    char* d8 = (char*)c.dst + (size_t)(kk / c.bkl) * c.npad * c.bkl + (size_t)(c.n0 + rn) * c.bkl + (kk % c.bkl);
    *(uint2*)d8 = make_uint2((unsigned)w0, (unsigned)w1);
  } else {
    *(uint4*)(c.dst + (size_t)(kk / c.bkl) * c.npad * c.bkl + (size_t)(c.n0 + rn) * c.bkl + (kk % c.bkl)) = v;
  }
}

DI void conv_fetch(const P& q, int tile, int nblk, int total, int kp, int ns, float4& a0, float4& b0, float4& a1, float4& b1) {
  const ConvT c0 = conv_desc(q, min(tile, total - 1));
  const ConvT c1 = conv_desc(q, min(tile + nblk, total - 1));
  const int col0 = min(c0.n0 + ns, c0.N - 4), col1 = min(c1.n0 + ns, c1.N - 4);
  a0 = *(const float4*)(c0.src + (size_t)(c0.k0 + 2 * kp) * c0.ldn + col0);
  b0 = *(const float4*)(c0.src + (size_t)(c0.k0 + 2 * kp + 1) * c0.ldn + col0);
  a1 = *(const float4*)(c1.src + (size_t)(c1.k0 + 2 * kp) * c1.ldn + col1);
  b1 = *(const float4*)(c1.src + (size_t)(c1.k0 + 2 * kp + 1) * c1.ldn + col1);
}

DI void phase_convert(const P& q, char* lds, int bid, int nblk) {
  constexpr int total = 2 * 257 * 128 + 2 * 257 * 64 + 2 * 16 * 44 + 2 * 16 * 16 + 2 * 16 * 4;
  const int t = otid();
  const int kp = t >> 4, ns = (t & 15) * 4, rn = t >> 3, rks = (t & 7) * 4;
  int par = 0;
  auto process = [&](int tile, const float4& a0, const float4& b0, const float4& a1, const float4& b1) {
    const bool two = tile + 1 < total;
    const ConvT c0 = conv_desc(q, tile);
    const ConvT c1 = conv_desc(q, two ? tile + 1 : tile);
    unsigned* T0 = (unsigned*)lds + par * (2 * 64 * 33);
    unsigned* T1 = T0 + 64 * 33;
    par ^= 1;
    const unsigned k0m = c0.n0 + ns < c0.N ? 0xffffffffu : 0u, k1m = c1.n0 + ns < c1.N ? 0xffffffffu : 0u;
    T0[(ns + 0) * 33 + kp] = pack2(a0.x, b0.x) & k0m; T0[(ns + 1) * 33 + kp] = pack2(a0.y, b0.y) & k0m;
    T0[(ns + 2) * 33 + kp] = pack2(a0.z, b0.z) & k0m; T0[(ns + 3) * 33 + kp] = pack2(a0.w, b0.w) & k0m;
    T1[(ns + 0) * 33 + kp] = pack2(a1.x, b1.x) & k1m; T1[(ns + 1) * 33 + kp] = pack2(a1.y, b1.y) & k1m;
    T1[(ns + 2) * 33 + kp] = pack2(a1.z, b1.z) & k1m; T1[(ns + 3) * 33 + kp] = pack2(a1.w, b1.w) & k1m;
    __syncthreads();
    uint4 v;
    v.x = T0[rn * 33 + rks]; v.y = T0[rn * 33 + rks + 1]; v.z = T0[rn * 33 + rks + 2]; v.w = T0[rn * 33 + rks + 3];
    conv_store(c0, v, rn, rks);
    if (two) {
      v.x = T1[rn * 33 + rks]; v.y = T1[rn * 33 + rks + 1]; v.z = T1[rn * 33 + rks + 2]; v.w = T1[rn * 33 + rks + 3];
      conv_store(c1, v, rn, rks);
    }
  };
  float4 a0, b0, a1, b1, c0, d0, c1, d1, e0, f0, e1, f1, g0, h0, g1, h1;
  const int step = 2 * nblk;
  conv_fetch(q, 2 * bid, 1, total, kp, ns, a0, b0, a1, b1);
  conv_fetch(q, 2 * bid + step, 1, total, kp, ns, c0, d0, c1, d1);
  conv_fetch(q, 2 * bid + 2 * step, 1, total, kp, ns, e0, f0, e1, f1);
  for (int tile = 2 * bid; tile < total; tile += 4 * step) {
    conv_fetch(q, tile + 3 * step, 1, total, kp, ns, g0, h0, g1, h1);
    process(tile, a0, b0, a1, b1);
    if (tile + step >= total) break;
    conv_fetch(q, tile + 4 * step, 1, total, kp, ns, a0, b0, a1, b1);
    process(tile + step, c0, d0, c1, d1);
    if (tile + 2 * step >= total) break;
    conv_fetch(q, tile + 5 * step, 1, total, kp, ns, c0, d0, c1, d1);
    process(tile + 2 * step, e0, f0, e1, f1);
    if (tile + 3 * step >= total) break;
    conv_fetch(q, tile + 6 * step, 1, total, kp, ns, e0, f0, e1, f1);
    process(tile + 3 * step, g0, h0, g1, h1);
  }
  __syncthreads();
}

DI void phase_mod(const P& q, char* lds, int bid, int nblk) {
  float* sc = (float*)lds;
  float* red = sc + 9 * 1024;
  const int t = otid();
  for (int i = t; i < 9 * 1024; i += NTHR) {
    const int r = i >> 10, k = i & 1023;
    const float v = r < 8 ? q.c[r * 1024 + k] : q.c_ctx[k];
    sc[i] = siluf_(v);
  }
  __syncthreads();
  for (int u = bid; u < 2 * 96; u += nblk) {
    const int l = u / 96, n0 = (u % 96) * 64;
    const int col = t & 63, ksl = t >> 6;
    float a[9];
#pragma unroll
    for (int r = 0; r < 9; ++r) a[r] = 0.f;
    const float* w = q.w_mod + (size_t)l * 1024 * 6144 + n0 + col;
    for (int k = ksl * 128; k < ksl * 128 + 128; ++k) {
      const float wv = w[(size_t)k * 6144];
#pragma unroll
      for (int r = 0; r < 9; ++r) a[r] += sc[r * 1024 + k] * wv;
    }
#pragma unroll
    for (int r = 0; r < 9; ++r) red[(ksl * 9 + r) * 64 + col] = a[r];
    __syncthreads();
    for (int i = t; i < 9 * 64; i += NTHR) {
      const int r = i >> 6, cc = i & 63;
      float s = q.b_mod[l * 6144 + n0 + cc];
#pragma unroll
      for (int q = 0; q < 8; ++q) s += red[(q * 9 + r) * 64 + cc];
      ((W{q.ws, q.out, q.x, q.ctx}).mod())[(size_t)(l * 9 + r) * 6144 + n0 + cc] = s;
    }
    __syncthreads();
  }
  {
    const W w{q.ws, q.out};
    const int gt = bid * NTHR + t, gs = nblk * NTHR;
#define CPY(dst, srcp, n) for (int i = gt; i < (n); i += gs) (dst)[i] = (srcp)[i]
    CPY(w.g_mix(), q.g_mix, 2 * 1024); CPY(w.g_ffn(), q.g_ffn, 2 * 1024); CPY(w.g_final(), q.g_final, 1024);
    CPY(w.rpb(), q.rpb, 2 * 3720); CPY(w.w_pool(), q.w_pool, 2 * 4 * 4096); CPY(w.pool_scale(), q.pool_scale, 2 * 256);
    CPY(w.w_gate_f(), q.w_gate_f, 2 * 16 * 128); CPY(w.w_gate_b(), q.w_gate_b, 2 * 16 * 128);
    CPY(w.b_gate_f(), q.b_gate_f, 2 * 128); CPY(w.b_gate_b(), q.b_gate_b, 2 * 128);
    CPY(w.g_gla(), q.g_gla, 2 * 64); CPY(w.b_router(), q.b_router, 2 * 256);
#undef CPY
    for (int i = gt; i < 2 * 4 * 4096; i += gs) { const int lg = i >> 12, jj = (i >> 6) & 63, ii = i & 63; w.wpt()[i] = f2bf(q.w_pool[lg * 4096 + ii * 64 + jj]); }
  }
  if (bid == 0) {
    for (int i = t; i < 64 * 8; i += NTHR) {
      const int pos = i >> 3, j = i & 7;
      const float inv = powf(10000.f, -(float)j / 8.f);
      const float ang = (float)pos * inv;
      ((W{q.ws, q.out, q.x, q.ctx}).rope())[i * 2] = cosf(ang);
      ((W{q.ws, q.out, q.x, q.ctx}).rope())[i * 2 + 1] = sinf(ang);
    }
  }
}

DI void phase_norm0(const P& q, int bid, int nblk) {
  const W p{q.ws, q.out};
  const int wid = otid() >> 6, lane = otid() & 63;
  for (int row = bid * 8 + wid; row < MT; row += nblk * 8) {
    const float* src = row < MC ? q.ctx + (size_t)row * D : q.x + (size_t)(row - MC) * D;
    const float* m = p.mod() + (size_t)(mod_row(row)) * 6144;
    float4 v[4];
    float ss = 0.f;
#pragma unroll
    for (int i = 0; i < 4; ++i) {
      v[i] = *(const float4*)(src + i * 256 + lane * 4);
      ss += v[i].x * v[i].x + v[i].y * v[i].y + v[i].z * v[i].z + v[i].w * v[i].w;
    }
    ss = wave_sum(ss);
    const float rstd = rsqrtf(ss * (1.f / D) + EPS);
#pragma unroll
    for (int i = 0; i < 4; ++i) {
      const int cidx = i * 256 + lane * 4;
      const float4 gg = *(const float4*)(q.g_mix + cidx);
      const float4 sh = *(const float4*)(m + cidx);
      const float4 scl = *(const float4*)(m + 1024 + cidx);
      const float o0 = v[i].x * rstd * gg.x * (1.f + scl.x) + sh.x;
      const float o1 = v[i].y * rstd * gg.y * (1.f + scl.y) + sh.y;
      const float o2 = v[i].z * rstd * gg.z * (1.f + scl.z) + sh.z;
      const float o3 = v[i].w * rstd * gg.w * (1.f + scl.w) + sh.w;
      const int q8 = pack_fp8x4(o0, o1, o2, o3);
      *(int*)((char*)p.h() + (size_t)row * D + cidx) = q8;
    }
  }
}

DI void phase_norm(const W& p_, int layer, int row_lo, int bid, int nblk) {
  const W p = oq(p_);
  const int wid = otid() >> 6, lane = otid() & 63;
  const float* g = p.g_ffn() + layer * D;
  for (int row = row_lo + bid * 8 + wid; row < MT; row += nblk * 8) {
    const bf16_t* src = p.xres() + (size_t)row * D;
    const float* m = p.mod() + (size_t)(layer * 9 + mod_row(row)) * 6144 + 3072;
    float4 v[4];
    float ss = 0.f;
#pragma unroll
    for (int i = 0; i < 4; ++i) {
      v[i] = unpack4(*(const uint2*)(src + i * 256 + lane * 4));
      ss += v[i].x * v[i].x + v[i].y * v[i].y + v[i].z * v[i].z + v[i].w * v[i].w;
    }
    ss = wave_sum(ss);
    const float rstd = rsqrtf(ss * (1.f / D) + EPS);
#pragma unroll
    for (int i = 0; i < 4; ++i) {
      const int cidx = i * 256 + lane * 4;
      const float4 gg = *(const float4*)(g + cidx);
      const float4 sh = *(const float4*)(m + cidx);
      const float4 scl = *(const float4*)(m + 1024 + cidx);
      const float o0 = v[i].x * rstd * gg.x * (1.f + scl.x) + sh.x;
      const float o1 = v[i].y * rstd * gg.y * (1.f + scl.y) + sh.y;
      const float o2 = v[i].z * rstd * gg.z * (1.f + scl.z) + sh.z;
      const float o3 = v[i].w * rstd * gg.w * (1.f + scl.w) + sh.w;
      uint2 o; o.x = pack2(o0, o1); o.y = pack2(o2, o3);
      *(uint2*)(p.h2() + (size_t)row * D + cidx) = o;
      {
        const int q8 = pack_fp8x4(o0, o1, o2, o3);
        *(int*)(p.h2q() + (size_t)row * D + cidx) = q8;
      }
    }
  }
}

DI size_t hm_off(int row, int h) {
  if (row < MC) return ((size_t)(((row >> 8) * 8 + h) * NCTX + (row & 255))) * 64;
  const int r = row - MC;
  return HM_LAT + ((size_t)(((r >> 12) * 8 + h) * SEQ + (r & 4095))) * 64;
}
DI size_t vt_off(int row, int h, int d) {
  if (row < MC) { const int t = row & 255; return ((size_t)(((row >> 8) * 8 + h) * 4 + (t >> 6))) * 4096 + d * 64 + (t & 63); }
  const int r = row - MC, t = r & 4095;
  return HM_LAT + ((size_t)(((r >> 12) * 8 + h) * 64 + (t >> 6))) * 4096 + d * 64 + (t & 63);
}
DI size_t vtg_off(int row, int h, int v) {
  if (row < MC) { const int t = row & 255; return ((size_t)(((row >> 8) * 4 + h) * 4 + (t >> 6))) * 4096 + v * 64 + (t & 63); }
  const int r = row - MC, t = r & 4095;
  return HMG_LAT + ((size_t)(((r >> 12) * 4 + h) * 64 + (t >> 6))) * 4096 + v * 64 + (t & 63);
}

DI void phase_inproj(const W& p_, int layer, char* lds, int bid, int nblk) {
  const W p = oq(p_);
  constexpr int nM = MT / 256, nN = INWP / 256;
  const char* B8 = (const char*)p.win_t() + (size_t)layer * INWP * 1024;
  constexpr int NP1 = 6, U1 = nM * NP1;
  for (int u = vbid_of(bid, nblk); u < nM * nN; u += nblk) {
    const int pm = u < U1 ? u / NP1 : (u - U1) / (nN - NP1), pn = u < U1 ? u % NP1 : NP1 + (u - U1) % (nN - NP1);
    const int m0 = pm * 256, n0 = pn * 256;
    auto rowA = [&](int r) { return (const bf16_t*)((const char*)p.h() + (size_t)(m0 + r) * D); };
    auto rowB = [&](int r) { return (const bf16_t*)(B8 + (size_t)(n0 + r) * 128); };
    if (pn == 4 || pn == 5 || pn == 8) {
      auto rowAp = [&](int r) { return rowA((r & ~63) | ((r & 12) << 2) | ((r & 48) >> 2) | (r & 3)); };
      auto epi = [&](const f32x4 (&acc)[4][8], int, int wr, int wc, int fr, int fq) {
        const int row = m0 + wr * 64 + fq * 16;
#pragma unroll
        for (int ni = 0; ni < 8; ++ni) {
          uint4 lo, hi;
          lo.x = pack2(acc[0][ni][0], acc[0][ni][1]); lo.y = pack2(acc[0][ni][2], acc[0][ni][3]);
          lo.z = pack2(acc[1][ni][0], acc[1][ni][1]); lo.w = pack2(acc[1][ni][2], acc[1][ni][3]);
          hi.x = pack2(acc[2][ni][0], acc[2][ni][1]); hi.y = pack2(acc[2][ni][2], acc[2][ni][3]);
          hi.z = pack2(acc[3][ni][0], acc[3][ni][1]); hi.w = pack2(acc[3][ni][2], acc[3][ni][3]);
          bf16_t* dst;
          if (pn == 8) {
            const int col = wc * 128 + ni * 16 + fr;
            dst = p.vtg() + vtg_off(row, col >> 6, col & 63);
          } else {
            const int col = n0 + wc * 128 + ni * 16 + fr - 1024;
            dst = p.vt() + vt_off(row, col >> 6, col & 63);
          }
          *(uint4*)dst = lo; *(uint4*)(dst + 8) = hi;
        }
      };
      gemm_tile<4, 2, 4, 8, 64, 2, true, 1, 4>(lds, 8, 0, (size_t)INWP * 64, rowAp, rowB, epi);
    } else {
      auto rowBp = [&](int r) { return rowB((r & ~127) | ((r & 12) << 3) | ((r & 112) >> 2) | (r & 3)); };
      auto epi = [&](const f32x4 (&acc)[4][8], int, int wr, int wc, int fr, int fq) {
#pragma unroll
        for (int mi = 0; mi < 4; ++mi) {
          const int row = m0 + wr * 64 + mi * 16 + fr;
#pragma unroll
          for (int np = 0; np < 4; ++np) {
            const int col = n0 + wc * 128 + fq * 32 + np * 8;
            const f32x4 v0 = acc[mi][2 * np], v1 = acc[mi][2 * np + 1];
            if (pn < 2) {
              constexpr float QS = 0.125f * 1.4426950408889634f;
              uint4 o; o.x = pack2(v0[0] * QS, v0[1] * QS); o.y = pack2(v0[2] * QS, v0[3] * QS); o.z = pack2(v1[0] * QS, v1[1] * QS); o.w = pack2(v1[2] * QS, v1[3] * QS);
              *(uint4*)(p.qh() + hm_off(row, col >> 6) + (col & 63)) = o;
            } else if (pn < 4) {
              const int c2 = col - 512;
              uint4 o; o.x = pack2(v0[0], v0[1]); o.y = pack2(v0[2], v0[3]); o.z = pack2(v1[0], v1[1]); o.w = pack2(v1[2], v1[3]);
              *(uint4*)(p.kh() + hm_off(row, c2 >> 6) + (c2 & 63)) = o;
            } else if (col < INW) {
              uint4 o; o.x = pack2(v0[0], v0[1]); o.y = pack2(v0[2], v0[3]); o.z = pack2(v1[0], v1[1]); o.w = pack2(v1[2], v1[3]);
              *(uint4*)(p.px() + (size_t)row * INW + col) = o;
            }
          }
        }
      };
      gemm_tile<4, 2, 4, 8, 64, 2, false, 1, 4>(lds, 8, 0, (size_t)INWP * 64, rowA, rowBp, epi);
    }
  }
}


#ifndef PROBE_GEMM
#define PROBE_GEMM 0
#endif
#if PROBE_GEMM
DI void phase_probe_gemm(const W& p_, char* lds, int bid, int nblk) {
  const W p = oq(p_);
  constexpr int nM = MT / 256, nN = INWP / 256;
  const bf16_t* Bt = p.win_t();
  for (int u = bid; u < nM * nN; u += nblk) {
    const int pm = u / nN, pn = u % nN, m0 = pm * 256, n0 = pn * 256;
    auto rowA = [&](int r) { return p.h() + (size_t)(m0 + r) * D; };
    auto rowB = [&](int r) { return Bt + (size_t)(n0 + r) * 32; };
    auto epi = [&](const f32x4 (&acc)[4][8], int, int wr, int wc, int fr, int fq) {
#pragma unroll
      for (int mi = 0; mi < 4; ++mi) {
        const int row = m0 + wr * 64 + mi * 16 + fr;
#pragma unroll
        for (int ni = 0; ni < 8; ++ni) {
          const int col = n0 + wc * 128 + ni * 16 + 4 * fq;
          uint2 o; o.x = pack2(acc[mi][ni][0], acc[mi][ni][1]); o.y = pack2(acc[mi][ni][2], acc[mi][ni][3]);
          *(uint2*)(p.y() + (size_t)row * INWP + col) = o;
        }
      }
    };
#if PROBE_GEMM == 4
    gemm_tile_stag<4, 2, 4, 8, false, true>(lds, 32, (size_t)INWP * 32, rowA, rowB, epi);
#elif PROBE_GEMM == 5
    gemm_tile_stag<4, 2, 4, 8, false, false>(lds, 32, (size_t)INWP * 32, rowA, rowB, epi);
#else
    gemm_tile<4, 2, 4, 8, 32, 4, false, 1>(lds, 32, 0, (size_t)INWP * 32, rowA, rowB, epi);
#endif
  }
}
#endif

template <bool DUMMY>
DI void phase_outproj_t(const W& p_, int layer, char* lds, int row_lo, int bid, int nblk) {
  const W p = oq(p_);
  bf16_t* xres_w = DUMMY ? (bf16_t*)((char*)p.y() + (size_t)9 * MT * 1024) : p.xres();
  const int nM = (MT - row_lo) / 256, nN = 4;
  const char* B8 = (const char*)p.wout_t() + (size_t)layer * 1024 * 1024;
  for (int u = vbid_of(bid, nblk); u < nM * nN; u += nblk) {
    const int pm = u / nN, pn = u % nN, m0 = row_lo + pm * 256, n0 = pn * 256;
    auto rowA = [&](int r) { return (const bf16_t*)((const char*)p.cat() + (size_t)(m0 + r) * D); };
    auto rowB = [&](int r) { return (const bf16_t*)(B8 + (size_t)(n0 + r) * 128); };
    auto rowBp = [&](int r) { return rowB((r & ~127) | ((r & 12) << 3) | ((r & 112) >> 2) | (r & 3)); };
    auto epi = [&](const f32x4 (&acc)[4][8], int, int wr, int wc, int fr, int fq) {
#pragma unroll
      for (int mi = 0; mi < 4; ++mi) {
        const int row = m0 + wr * 64 + mi * 16 + fr;
        const float* xin = row < MC ? p.ctx + (size_t)row * D : p.x + (size_t)(row - MC) * D;
        const float* gate = p.mod() + (size_t)(layer * 9 + mod_row(row)) * 6144 + 2048;
#pragma unroll
        for (int np = 0; np < 4; ++np) {
          const int col = n0 + wc * 128 + fq * 32 + np * 8;
          const f32x4 v0 = acc[mi][2 * np], v1 = acc[mi][2 * np + 1];
          float4 xa, xb;
          if (layer == 0) {
            xa = *(const float4*)(xin + col); xb = *(const float4*)(xin + col + 4);
          } else {
            const uint4 xr = *(const uint4*)(p.xres() + (size_t)row * D + col);
            xa = unpack4(make_uint2(xr.x, xr.y)); xb = unpack4(make_uint2(xr.z, xr.w));
          }
          const float4 ga = *(const float4*)(gate + col), gb = *(const float4*)(gate + col + 4);
          uint4 o;
          o.x = pack2(xa.x + ga.x * v0[0], xa.y + ga.y * v0[1]); o.y = pack2(xa.z + ga.z * v0[2], xa.w + ga.w * v0[3]);
          o.z = pack2(xb.x + gb.x * v1[0], xb.y + gb.y * v1[1]); o.w = pack2(xb.z + gb.z * v1[2], xb.w + gb.w * v1[3]);
          *(uint4*)(xres_w + (size_t)row * D + col) = o;
        }
      }
    };
    gemm_tile<4, 2, 4, 8, 64, 2, false, 1, 4 | 16>(lds, 8, 0, (size_t)1024 * 64, rowA, rowBp, epi);
  }
}
DI void phase_outproj(const W& p, int layer, char* lds, int row_lo, int bid, int nblk) { phase_outproj_t<false>(p, layer, lds, row_lo, bid, nblk); }

DI void moe_unit(const W& p, int layer, char* lds, int e, const int* s_rows);
DI int moe_early_shared(int mrows, int nblk);
DI void phase_router(const W& p_, int layer, char* lds, int row_lo, int bid, int nblk) {
  const W p = oq(p_);
  const int nM = (MT - row_lo) / 256;
  const bf16_t* Bt = p.wr_t() + (size_t)layer * 256 * 1024;
  const int sh0 = moe_early_shared(MT - row_lo, nblk);
  for (int u = vbid_of(bid, nblk); u < nM + sh0; u += nblk) {
    if (u >= nM) {
      int* s_rows = (int*)(lds + 144 * 1024) + 1024;
      __syncthreads();
      if (otid() < 256) s_rows[otid()] = 8 * MT + row_lo + (u - nM) * 256 + otid();
      __syncthreads();
      moe_unit(p, layer, lds, NE, s_rows);
      continue;
    }
    const int m0 = row_lo + u * 256;
    auto rowA = [&](int r) { return p.h2() + (size_t)(m0 + r) * D; };
    auto rowB = [&](int r) { return Bt + (size_t)r * 32; };
    auto epi = [&](const f32x4 (&acc)[4][8], int, int wr, int wc, int fr, int fq) {
#pragma unroll
      for (int mi = 0; mi < 4; ++mi) {
        const int row = m0 + wr * 64 + mi * 16 + fr;
#pragma unroll
        for (int ni = 0; ni < 8; ++ni) {
          const int col = wc * 128 + ni * 16 + 4 * fq;
          *(f32x4*)(p.logits() + (size_t)row * 256 + col) = acc[mi][ni];
        }
      }
    };
    gemm_tile_stag<4, 2, 4, 8, false>(lds, 32, (size_t)256 * 32, rowA, rowB, epi);
  }
}

DI void phase_route(const W& p_, int layer, char* lds, int row_lo, int bid, int nblk) {
  const W p = oq(p_);
  int* lcnt = (int*)lds;
  int* lbase = lcnt + 256;
  int* ent = lbase + 256;
  const int tid = otid(), wid = tid >> 6, lane = tid & 63;
  const int nrows = MT - row_lo;
  const int CHT = (nrows % nblk == 0 && nrows / nblk <= 160) ? nrows / nblk : 128;
  const int nch = nrows / CHT;
  const float NEG = -__builtin_inff();
  for (int ch = bid; ch < nch; ch += nblk) {
    if (tid < 256) lcnt[tid] = 0;
    __syncthreads();
    for (int i = wid; i < CHT; i += 8) {
      const int row = row_lo + ch * CHT + i;
      const float4 lg = *(const float4*)(p.logits() + (size_t)row * 256 + lane * 4);
      const float4 br = *(const float4*)(p.b_router() + layer * 256 + lane * 4);
      float sc[4] = {sigmoidf_(lg.x), sigmoidf_(lg.y), sigmoidf_(lg.z), sigmoidf_(lg.w)};
      float v[4] = {sc[0] + br.x, sc[1] + br.y, sc[2] + br.z, sc[3] + br.w};
      float m1 = NEG, m2 = NEG;
#pragma unroll
      for (int j = 0; j < 4; ++j) { if (v[j] > m1) { m2 = m1; m1 = v[j]; } else if (v[j] > m2) m2 = v[j]; }
      {
        float o1 = dppf<0xB1>(m1), o2 = dppf<0xB1>(m2);
        float n1 = fmaxf(m1, o1), n2 = fmaxf(fminf(m1, o1), fmaxf(m2, o2));
        m1 = n1; m2 = n2;
        o1 = dppf<0x4E>(m1); o2 = dppf<0x4E>(m2);
        n1 = fmaxf(m1, o1); n2 = fmaxf(fminf(m1, o1), fmaxf(m2, o2));
        m1 = n1; m2 = n2;
        o1 = dppf<0x141>(m1); o2 = dppf<0x141>(m2);
        n1 = fmaxf(m1, o1); n2 = fmaxf(fminf(m1, o1), fmaxf(m2, o2));
        m1 = n1; m2 = n2;
      }
      const float gs = m1 + m2;
      const int g = lane >> 3;
      int rank = 0;
#pragma unroll
      for (int gg = 0; gg < 8; ++gg) { const float og = rlanef(gs, gg * 8); rank += (og > gs || (og == gs && gg < g)) ? 1 : 0; }
      if (rank >= 4) { v[0] = NEG; v[1] = NEG; v[2] = NEG; v[3] = NEG; }
      float ssum = 0.f, my_s = 0.f; int my_e = 0;
#pragma unroll
      for (int k = 0; k < 8; ++k) {
        float bv = v[0]; int bj = 0;
#pragma unroll
        for (int j = 1; j < 4; ++j) if (v[j] > bv) { bv = v[j]; bj = j; }
        const float wm = wave_max_dpp(bv);
        const unsigned long long bal = __ballot(bv == wm);
        const int win = __builtin_amdgcn_readfirstlane(__ffsll((long long)bal) - 1);
        const float mysc = bj == 0 ? sc[0] : bj == 1 ? sc[1] : bj == 2 ? sc[2] : sc[3];
        const int ej = __builtin_amdgcn_readlane(bj, win);
        const float su = rlanef(mysc, win);
        if (lane == win) {
#pragma unroll
          for (int j = 0; j < 4; ++j) if (j == bj) v[j] = NEG;
        }
        ssum += su;
        if (lane == k) { my_e = win * 4 + ej; my_s = su; }
      }
      if (lane < 8) {
        const int lpos = atomicAdd(&lcnt[my_e], 1);
        ent[i * 8 + lane] = my_e | (lpos << 8);
        p.wts()[(size_t)row * 8 + lane] = my_s / ssum * 2.5f;
      }
    }
    __syncthreads();
    if (tid < 256) { const int cc = lcnt[tid]; lbase[tid] = cc ? atomicAdd(&p.cnt()[layer * 256 + tid], cc) : 0; }
    __syncthreads();
    for (int j = tid; j < CHT * 8; j += NTHR) {
      const int e = ent[j] & 255, lpos = ent[j] >> 8;
      const int row = row_lo + ch * CHT + (j >> 3);
      p.lists()[(size_t)e * CAP + lbase[e] + lpos] = row * 8 + (j & 7);
    }
    __syncthreads();
  }
}

DI void moe_prefix(const W& p, int layer, int mrows, int* s_pref) {
  int* s_tmp = s_pref + 400;
  const int t = otid();
  __syncthreads();
  if (t < 272) {
    int c = 0;
    if (t < NE) c = (p.cnt()[layer * 256 + t] + 255) >> 8;
    else if (t == NE) c = (mrows + 255) >> 8;
    s_tmp[t] = c;
  }
  __syncthreads();
  int cur = 0;
  for (int off = 1; off < 272; off <<= 1) {
    if (t < 272) s_tmp[(cur ^ 1) * 272 + t] = s_tmp[cur * 272 + t] + (t >= off ? s_tmp[cur * 272 + t - off] : 0);
    cur ^= 1;
    __syncthreads();
  }
  if (t <= NE1) s_pref[t] = t == 0 ? 0 : s_tmp[cur * 272 + t - 1];
  __syncthreads();
}
DI int moe_find(const int* s_pref, int ti) {
  int lo = 0, hi = NE1;
  while (hi - lo > 1) { const int mid = (lo + hi) >> 1; if (s_pref[mid] <= ti) lo = mid; else hi = mid; }
  return lo;
}
DI void moe_rows(const W& p, int layer, int e, int mt, int row_lo, int mrows, int* s_rows) {
  const int t = otid();
  if (t < 128) {
    const int cnt = e < NE ? p.cnt()[layer * 256 + e] : mrows;
    const int r = mt * 128 + t;
    int idx = -1;
    if (r < cnt) idx = e < NE ? p.lists()[(size_t)e * CAP + r] : 8 * MT + row_lo + r;
    s_rows[t] = idx;
  }
  __syncthreads();
}

DI void moe_unit(const W& p, int layer, char* lds, int e, const int* s_rows) {
  const int idx0 = s_rows[0];
  {
    const char* B8 = (const char*)p.wei_t() + (size_t)(layer * NE1 + e) * 512 * 1024;
    auto rowA = [&](int r) {
      int idx = s_rows[r]; if (idx < 0) idx = idx0;
      const int tok = idx < 8 * MT ? (idx >> 3) : idx - 8 * MT;
      return (const bf16_t*)(p.h2q() + (size_t)tok * D);
    };
    auto rowB = [&](int r) {
      const int wq = r >> 7, w = r & 127;
      const int n = w < 64 ? wq * 64 + w : 256 + wq * 64 + (w - 64);
      return (const bf16_t*)(B8 + (size_t)n * 128);
    };
    int stash[4][4];
    auto epi = [&](const f32x4 (&acc)[4][8], int chunk, int wr, int wc, int fr, int fq) {
      int cur[4][4];
#pragma unroll
      for (int mi = 0; mi < 4; ++mi)
#pragma unroll
        for (int ni = 0; ni < 4; ++ni) {
          float o[4];
#pragma unroll
          for (int j = 0; j < 4; ++j) o[j] = siluf_(acc[mi][ni][j]) * acc[mi][ni + 4][j] * 16.f;
          cur[mi][ni] = pack_fp8x4(o[0], o[1], o[2], o[3]);
        }
      if (chunk == 0) {
#pragma unroll
        for (int mi = 0; mi < 4; ++mi)
#pragma unroll
          for (int ni = 0; ni < 4; ++ni) stash[mi][ni] = cur[mi][ni];
      } else {
        __syncthreads();
#pragma unroll
        for (int c2 = 0; c2 < 2; ++c2)
#pragma unroll
          for (int mi = 0; mi < 4; ++mi) {
            const int row = wr * 64 + mi * 16 + fr;
#pragma unroll
            for (int ni = 0; ni < 4; ++ni) {
              const int ch = (wc * 4 + ni) ^ ((row >> 1) & 7);
              *(int*)(lds + c2 * 32768 + row * 128 + ch * 16 + 4 * fq) = c2 == 0 ? stash[mi][ni] : cur[mi][ni];
            }
          }
      }
    };
    gemm_tile<4, 2, 4, 8, 64, 2, false, 2, 4>(lds, 8, (size_t)128 * 64, (size_t)512 * 64, rowA, rowB, epi);
  }
  {
    const char* B8d = (const char*)p.wed_t() + (size_t)(layer * NE1 + e) * 1024 * 256;
    auto rowA = [&](int) { return (const bf16_t*)nullptr; };
    auto rowB2 = [&](int r) { return (const bf16_t*)(B8d + (size_t)((r & ~63) | ((r & 12) << 2) | ((r & 48) >> 2) | (r & 3)) * 128); };
    auto epi = [&](const f32x4 (&acc)[4][8], int nt, int wr, int wc, int fr, int fq) {
#pragma unroll
      for (int mi = 0; mi < 4; ++mi) {
        int dst = s_rows[wr * 64 + mi * 16 + fr];
        if (dst < 0) dst = 9 * MT + (int)blockIdx.x;
        {
          int4 lo, hi;
          lo.x = pack_fp8x4(acc[mi][0][0] * 16.f, acc[mi][0][1] * 16.f, acc[mi][0][2] * 16.f, acc[mi][0][3] * 16.f);
          lo.y = pack_fp8x4(acc[mi][1][0] * 16.f, acc[mi][1][1] * 16.f, acc[mi][1][2] * 16.f, acc[mi][1][3] * 16.f);
          lo.z = pack_fp8x4(acc[mi][2][0] * 16.f, acc[mi][2][1] * 16.f, acc[mi][2][2] * 16.f, acc[mi][2][3] * 16.f);
          lo.w = pack_fp8x4(acc[mi][3][0] * 16.f, acc[mi][3][1] * 16.f, acc[mi][3][2] * 16.f, acc[mi][3][3] * 16.f);
          hi.x = pack_fp8x4(acc[mi][4][0] * 16.f, acc[mi][4][1] * 16.f, acc[mi][4][2] * 16.f, acc[mi][4][3] * 16.f);
          hi.y = pack_fp8x4(acc[mi][5][0] * 16.f, acc[mi][5][1] * 16.f, acc[mi][5][2] * 16.f, acc[mi][5][3] * 16.f);
          hi.z = pack_fp8x4(acc[mi][6][0] * 16.f, acc[mi][6][1] * 16.f, acc[mi][6][2] * 16.f, acc[mi][6][3] * 16.f);
          hi.w = pack_fp8x4(acc[mi][7][0] * 16.f, acc[mi][7][1] * 16.f, acc[mi][7][2] * 16.f, acc[mi][7][3] * 16.f);
          char* yp = (char*)p.y() + (size_t)dst * D + nt * 256 + wc * 128 + fq * 16;
          *(int4*)yp = lo; *(int4*)(yp + 64) = hi;
        }
      }
    };
    gemm_tile<4, 2, 4, 8, 64, 2, false, 4, 1 | 4 | 8 | 32>(lds + 65536, 2, (size_t)256 * 64, (size_t)1024 * 64, rowA, rowB2, epi, lds);
  }
}

DI int moe_early_shared(int mrows, int nblk) {
  const int idle = nblk - mrows / 256;
  return idle <= 0 ? 0 : (idle < mrows / 256 ? idle : mrows / 256);
}

DI void phase_moe(const W& p_, int layer, char* lds, int row_lo, int bid, int nblk) {
  const W p = oq(p_);
  int* s_pref = (int*)(lds + 144 * 1024);
  int* s_rows = s_pref + 1024;
  const int mrows = MT - row_lo;
  const int sh0 = moe_early_shared(mrows, nblk);
  moe_prefix(p, layer, mrows - sh0 * 256, s_pref);
  const int total = s_pref[NE1];
  auto fetch_rows = [&](int uu) -> int {
    int idx = -1;
    const int t = otid();
    if (uu < total && t < 256) {
      const int e2 = moe_find(s_pref, uu), mt2 = uu - s_pref[e2];
      if (e2 < NE) {
        const int cnt = p.cnt()[layer * 256 + e2];
        const int r = mt2 * 256 + t;
        if (r < cnt) idx = p.lists()[(size_t)e2 * CAP + r];
      } else {
        idx = 8 * MT + row_lo + (mt2 + sh0) * 256 + t;
      }
    }
    return idx;
  };
  int pre = fetch_rows(vbid_of(bid, nblk));
  for (int u = vbid_of(bid, nblk); u < total; u += nblk) {
    const int e = moe_find(s_pref, u);
    if (otid() < 256) s_rows[otid()] = pre;
    __syncthreads();
    pre = fetch_rows(u + nblk);
    moe_unit(p, layer, lds, e, s_rows);
  }
}

template <bool DUMMY>
DI void phase_combine_t(const W& p_, int layer, int row_lo, int bid, int nblk) {
  const W p = oq(p_);
  char* scratch = (char*)p.y() + (size_t)9 * MT * 1024;
  bf16_t* xres_w = DUMMY ? (bf16_t*)scratch : p.xres();
  bf16_t* h_w = DUMMY ? p.act() : p.h();
  float* out_w = DUMMY ? (float*)(scratch + ((size_t)128 << 20)) : p.out;
  const int wid = otid() >> 6, lane = otid() & 63;
  const bool last = layer == 1;
  for (int row = row_lo + bid * 8 + wid; row < MT; row += nblk * 8) {
    const float* m = p.mod() + (size_t)(layer * 9 + mod_row(row)) * 6144;
    float w[8];
#pragma unroll
    for (int k = 0; k < 8; ++k) w[k] = p.wts()[(size_t)row * 8 + k];
    float xn[16];
    float ss = 0.f;
#pragma unroll
    for (int i = 0; i < 4; ++i) {
      const int cidx = i * 256 + lane * 4;
      float a[4] = {0.f, 0.f, 0.f, 0.f};
#pragma unroll
      for (int k = 0; k < 9; ++k) {
        const size_t yr = k < 8 ? (size_t)row * 8 + k : (size_t)8 * MT + row;
        const int yv = *(const int*)((const char*)p.y() + yr * D + cidx);
        const float wk = (k < 8 ? w[k] : 1.f) * (1.f / 16.f);
        typedef float f32x2_ __attribute__((ext_vector_type(2)));
        const f32x2_ ylo = __builtin_amdgcn_cvt_pk_f32_fp8(yv, false), yhi = __builtin_amdgcn_cvt_pk_f32_fp8(yv, true);
        a[0] += wk * ylo.x; a[1] += wk * ylo.y; a[2] += wk * yhi.x; a[3] += wk * yhi.y;
      }
      const float4 xv = unpack4(*(const uint2*)(p.xres() + (size_t)row * D + cidx));
      const float4 gv = *(const float4*)(m + 5120 + cidx);
      xn[i * 4 + 0] = xv.x + gv.x * a[0]; xn[i * 4 + 1] = xv.y + gv.y * a[1];
      xn[i * 4 + 2] = xv.z + gv.z * a[2]; xn[i * 4 + 3] = xv.w + gv.w * a[3];
#pragma unroll
      for (int j = 0; j < 4; ++j) ss += xn[i * 4 + j] * xn[i * 4 + j];
    }
    ss = wave_sum(ss);
    const float rstd = rsqrtf(ss * (1.f / D) + EPS);
    if (!last) {
      const float* g = p.g_mix() + (layer + 1) * D;
      const float* m2 = p.mod() + (size_t)((layer + 1) * 9 + mod_row(row)) * 6144;
#pragma unroll
      for (int i = 0; i < 4; ++i) {
        const int cidx = i * 256 + lane * 4;
        { uint2 xo; xo.x = pack2(xn[i * 4], xn[i * 4 + 1]); xo.y = pack2(xn[i * 4 + 2], xn[i * 4 + 3]); *(uint2*)(xres_w + (size_t)row * D + cidx) = xo; }
        const float4 gg = *(const float4*)(g + cidx);
        const float4 sh = *(const float4*)(m2 + cidx);
        const float4 scl = *(const float4*)(m2 + 1024 + cidx);
        const float o0 = xn[i * 4 + 0] * rstd * gg.x * (1.f + scl.x) + sh.x;
        const float o1 = xn[i * 4 + 1] * rstd * gg.y * (1.f + scl.y) + sh.y;
        const float o2 = xn[i * 4 + 2] * rstd * gg.z * (1.f + scl.z) + sh.z;
        const float o3 = xn[i * 4 + 3] * rstd * gg.w * (1.f + scl.w) + sh.w;
        const int q8 = pack_fp8x4(o0, o1, o2, o3);
        *(int*)((char*)h_w + (size_t)row * D + cidx) = q8;
      }
    } else {
#pragma unroll
      for (int i = 0; i < 4; ++i) {
        const int cidx = i * 256 + lane * 4;
        const float4 gg = *(const float4*)(p.g_final() + cidx);
        *(float4*)(out_w + (size_t)(row - MC) * D + cidx) =
            make_float4(xn[i * 4] * rstd * gg.x, xn[i * 4 + 1] * rstd * gg.y, xn[i * 4 + 2] * rstd * gg.z, xn[i * 4 + 3] * rstd * gg.w);
      }
    }
  }
}
DI void phase_combine(const W& p, int layer, int row_lo, int bid, int nblk) { phase_combine_t<false>(p, layer, row_lo, bid, nblk); }

typedef unsigned u32x4 __attribute__((ext_vector_type(4)));
typedef unsigned u32x2 __attribute__((ext_vector_type(2)));
DI bf16x8 bl128(__amdgpu_buffer_rsrc_t rs, unsigned voff, unsigned soff) {
  return __builtin_bit_cast(bf16x8, __builtin_amdgcn_raw_buffer_load_b128(rs, voff, soff, 0));
}
DI u32x2 bl64(__amdgpu_buffer_rsrc_t rs, unsigned voff, unsigned soff) { return __builtin_amdgcn_raw_buffer_load_b64(rs, voff, soff, 0); }

template <bool LOCALPASS>
DI void attn_pass(__amdgpu_buffer_rsrc_t rsK, __amdgpu_buffer_rsrc_t rsV, unsigned kbase, unsigned vbase, const char* cK, const char* cV,
                  const float* s_rpb_h, int r, int c0, int kc0, int kr0, int lane, const bf16x8& qf0, const bf16x8& qf1,
                  float& m_out, float& l_out, f32x4 (&O)[4], const bf16x8 (&kfa)[16]) {
  const int fr = lane & 15, fq = lane >> 4;
  const unsigned vK = (8 * (fr >> 2) + (fr & 3)) * 128 + fq * 32;
  f32x4 S[16];
  if (LOCALPASS) {
    bf16x8 kfb[16];
#pragma unroll
    for (int t = 8; t < 16; ++t) {
      const unsigned so = kbase + ((kr0 + (t >> 1)) * 64 + kc0 + (t & 1) * 4) * 128;
      kfb[2 * (t - 8)] = bl128(rsK, vK, so); kfb[2 * (t - 8) + 1] = bl128(rsK, vK + 16, so);
    }
    __builtin_amdgcn_sched_barrier(0);
#pragma unroll
    for (int t = 0; t < 8; ++t) {
      f32x4 s = (f32x4){0.f, 0.f, 0.f, 0.f};
      s = __builtin_amdgcn_mfma_f32_16x16x32_bf16(kfa[2 * t], qf0, s, 0, 0, 0);
      s = __builtin_amdgcn_mfma_f32_16x16x32_bf16(kfa[2 * t + 1], qf1, s, 0, 0, 0);
      S[t] = s;
    }
#pragma unroll
    for (int t = 8; t < 16; ++t) {
      f32x4 s = (f32x4){0.f, 0.f, 0.f, 0.f};
      s = __builtin_amdgcn_mfma_f32_16x16x32_bf16(kfb[2 * (t - 8)], qf0, s, 0, 0, 0);
      s = __builtin_amdgcn_mfma_f32_16x16x32_bf16(kfb[2 * (t - 8) + 1], qf1, s, 0, 0, 0);
      S[t] = s;
    }
    __builtin_amdgcn_sched_barrier(0);
  } else {
#pragma unroll
    for (int t = 0; t < 16; ++t) {
      const bf16x8 k0 = *(const bf16x8*)(cK + (t * 2) * 1024 + lane * 16);
      const bf16x8 k1 = *(const bf16x8*)(cK + (t * 2 + 1) * 1024 + lane * 16);
      f32x4 s = (f32x4){0.f, 0.f, 0.f, 0.f};
      s = __builtin_amdgcn_mfma_f32_16x16x32_bf16(k0, qf0, s, 0, 0, 0);
      s = __builtin_amdgcn_mfma_f32_16x16x32_bf16(k1, qf1, s, 0, 0, 0);
      S[t] = s;
      if ((t & 3) == 3) __builtin_amdgcn_sched_barrier(0);
    }
  }
  const unsigned vV = (fr * 64 + 8 * fq) * 2;
  bf16x8 vfa[16];
  if (LOCALPASS) {
#pragma unroll
    for (int s = 0; s < 4; ++s)
#pragma unroll
      for (int dt = 0; dt < 4; ++dt) vfa[s * 4 + dt] = bl128(rsV, vV, vbase + ((kr0 + s) * 4096 + dt * 1024 + kc0) * 2);
    __builtin_amdgcn_sched_barrier(0);
  }
  const float NEGB = -1e30f;
  float mx = NEGB;
  if (LOCALPASS) {
    const int qc = c0 + fr;
    const int cs = min(max(qc - 8, 0), 48);
    unsigned vmask = 0;
#pragma unroll
    for (int e = 0; e < 8; ++e) {
      const int kc = kc0 + 8 * fq + e;
      vmask |= (kc >= cs && kc < cs + 16) ? (1u << e) : 0u;
    }
    const int dc0 = kc0 + fq * 8 - qc + 15;
#pragma unroll
    for (int t = 0; t < 16; ++t) {
      const float* bp = s_rpb_h + (kr0 + (t >> 1) - r + 7) * 31;
#pragma unroll
      for (int j = 0; j < 4; ++j) {
        const int e = (t & 1) * 4 + j;
        const int dc = min(max(dc0 + e, 0), 30);
        const float v = ((vmask >> e) & 1u) ? S[t][j] + bp[dc] : NEGB;
        S[t][j] = v;
        mx = fmaxf(mx, v);
      }
    }
  } else {
#pragma unroll
    for (int t = 0; t < 16; ++t)
#pragma unroll
      for (int j = 0; j < 4; ++j) mx = fmaxf(mx, S[t][j]);
  }
  mx = fmaxf(mx, __shfl_xor(mx, 16));
  mx = fmaxf(mx, __shfl_xor(mx, 32));
  float l = 0.f;
#pragma unroll
  for (int t = 0; t < 16; ++t)
#pragma unroll
    for (int j = 0; j < 4; ++j) { const float pv = __builtin_amdgcn_exp2f(S[t][j] - mx); S[t][j] = pv; l += pv; }
  l += __shfl_xor(l, 16);
  l += __shfl_xor(l, 32);
  m_out = mx; l_out = l;
#pragma unroll
  for (int dt = 0; dt < 4; ++dt) O[dt] = (f32x4){0.f, 0.f, 0.f, 0.f};
  bf16x8 pf[8];
#pragma unroll
  for (int s = 0; s < 8; ++s) {
    const unsigned p0 = pack2(S[2 * s][0], S[2 * s][1]), p1 = pack2(S[2 * s][2], S[2 * s][3]);
    const unsigned p2 = pack2(S[2 * s + 1][0], S[2 * s + 1][1]), p3 = pack2(S[2 * s + 1][2], S[2 * s + 1][3]);
    pf[s] = __builtin_bit_cast(bf16x8, (u32x4){p0, p1, p2, p3});
  }
  if (LOCALPASS) {
    bf16x8 vfb[16];
    __builtin_amdgcn_sched_barrier(0);
#pragma unroll
    for (int s = 0; s < 4; ++s)
#pragma unroll
      for (int dt = 0; dt < 4; ++dt) vfb[s * 4 + dt] = bl128(rsV, vV, vbase + ((kr0 + 4 + s) * 4096 + dt * 1024 + kc0) * 2);
    __builtin_amdgcn_sched_barrier(0);
#pragma unroll
    for (int s = 0; s < 4; ++s)
#pragma unroll
      for (int dt = 0; dt < 4; ++dt) O[dt] = __builtin_amdgcn_mfma_f32_16x16x32_bf16(vfa[s * 4 + dt], pf[s], O[dt], 0, 0, 0);
    __builtin_amdgcn_sched_barrier(0);
#pragma unroll
    for (int s = 0; s < 4; ++s)
#pragma unroll
      for (int dt = 0; dt < 4; ++dt) O[dt] = __builtin_amdgcn_mfma_f32_16x16x32_bf16(vfb[s * 4 + dt], pf[4 + s], O[dt], 0, 0, 0);
  } else {
#pragma unroll
    for (int s = 0; s < 8; ++s) {
#pragma unroll
      for (int dt = 0; dt < 4; ++dt) {
        const bf16x8 vf = *(const bf16x8*)(cV + (s * 4 + dt) * 1024 + lane * 16);
        O[dt] = __builtin_amdgcn_mfma_f32_16x16x32_bf16(vf, pf[s], O[dt], 0, 0, 0);
      }
      if ((s & 1) == 1) __builtin_amdgcn_sched_barrier(0);
    }
  }
}

DI void attn_stage_ctx(const W& p, char* dst, int bh, int wid, int lane) {
  const int fr = lane & 15, fq = lane >> 4;
  const bf16_t* Kc = p.kh() + (size_t)bh * NCTX * 64;
  const bf16_t* Vc = p.vt() + (size_t)bh * 4 * 4096;
#pragma unroll
  for (int i = 0; i < 8; ++i) {
    const int pc = wid * 8 + i;
    const bf16_t* src;
    if (pc < 32) {
      const int t = pc >> 1, ks = pc & 1, g = t >> 1, T = t & 1;
      src = Kc + (32 * g + 8 * (fr >> 2) + 4 * T + (fr & 3)) * 64 + 16 * fq + 8 * ks;
    } else {
      const int s = (pc - 32) >> 2, dt = (pc - 32) & 3;
      src = Vc + (s >> 1) * 4096 + (16 * dt + fr) * 64 + (s & 1) * 32 + 8 * fq;
    }
    __builtin_amdgcn_global_load_lds((const unsigned*)src, (unsigned*)(dst + pc * 1024 + lane * 16), 16, 0, 0);
  }
}

template <bool LOCAL, bool QPRE = false>
DI void attn_unit(const W& p, __amdgpu_buffer_rsrc_t rsQ, __amdgpu_buffer_rsrc_t rsK, __amdgpu_buffer_rsrc_t rsV, const char* cK, const char* cV,
                  const float* s_rpb, int b, int h, int r, int qb, int lane, char* nxt_dst = nullptr, int nxt_bh = 0, int wid = 0,
                  bf16x8 qp0 = bf16x8{}, bf16x8 qp1 = bf16x8{}) {
  const int fr = lane & 15, fq = lane >> 4;
  const unsigned bh = (unsigned)(b * 8 + h);
  int c0 = 0, kc0 = 0, kr0 = 0, qrow;
  unsigned qso;
  if (LOCAL) {
    c0 = qb * 16; kc0 = qb == 0 ? 0 : qb == 1 ? 8 : qb == 2 ? 24 : 32;
    kr0 = min(max(r - 4, 0), 56);
    qrow = MC + b * SEQ + r * 64 + c0 + fr;
    qso = (unsigned)(HM_LAT * 2) + (bh * SEQ + r * 64 + c0) * 128;
  } else {
    qrow = b * NCTX + qb * 16 + fr;
    qso = (bh * NCTX + qb * 16) * 128;
  }
  const unsigned vQ = fr * 128 + fq * 32;
  const bf16x8 qf0 = QPRE ? qp0 : bl128(rsQ, vQ, qso), qf1 = QPRE ? qp1 : bl128(rsQ, vQ + 16, qso);
  if (nxt_dst) attn_stage_ctx(p, nxt_dst, nxt_bh, wid, lane);
  bf16x8 kfa[16];
  if (LOCAL) {
    const unsigned kbase = (unsigned)(HM_LAT * 2) + bh * SEQ * 64 * 2;
    const unsigned vK = (8 * (fr >> 2) + (fr & 3)) * 128 + fq * 32;
#pragma unroll
    for (int t = 0; t < 8; ++t) {
      const unsigned so = kbase + ((kr0 + (t >> 1)) * 64 + kc0 + (t & 1) * 4) * 128;
      kfa[2 * t] = bl128(rsK, vK, so); kfa[2 * t + 1] = bl128(rsK, vK + 16, so);
    }
    __builtin_amdgcn_sched_barrier(0);
  }
  float m2, l2; f32x4 O[4];
  attn_pass<false>(rsK, rsV, 0u, 0u, cK, cV, s_rpb, r, c0, kc0, kr0, lane, qf0, qf1, m2, l2, O, kfa);
  float l = l2;
  if (LOCAL) {
    float m1, l1; f32x4 O1[4];
    attn_pass<true>(rsK, rsV, (unsigned)(HM_LAT * 2) + bh * SEQ * 64 * 2, (unsigned)(HM_LAT * 2) + bh * 64 * 4096 * 2, cK, cV, s_rpb + h * 465, r, c0,
                    kc0, kr0, lane, qf0, qf1, m1, l1, O1, kfa);
    const float m = fmaxf(m1, m2);
    const float sc1 = __builtin_amdgcn_exp2f(m1 - m), sc2 = __builtin_amdgcn_exp2f(m2 - m);
    l = l1 * sc1 + l2 * sc2;
#pragma unroll
    for (int dt = 0; dt < 4; ++dt)
#pragma unroll
      for (int j = 0; j < 4; ++j) O[dt][j] = O[dt][j] * sc2 + O1[dt][j] * sc1;
  }
  const float inv_l = 1.f / l;
#pragma unroll
  for (int dt = 0; dt < 4; ++dt) {
    const float sc8 = inv_l * 8.f;
    *(int*)((char*)p.cat() + (size_t)qrow * D + h * 64 + dt * 16 + fq * 4) = pack_fp8x4(O[dt][0] * sc8, O[dt][1] * sc8, O[dt][2] * sc8, O[dt][3] * sc8);
  }
}

DI void phase_attn(const W& p_, int layer, char* lds, int bid, int nblk) {
  const W p = oq(p_);
  float* s_rpb = (float*)lds;
  char* cbuf = lds + 16384;
  const int tid = otid(), lane = tid & 63;
  const int wid = __builtin_amdgcn_readfirstlane(tid >> 6);
  for (int i = tid; i < 8 * 15 * 31; i += NTHR) s_rpb[i] = p.rpb()[layer * 3720 + i] * 1.4426950408889634f;
  const __amdgpu_buffer_rsrc_t rsQ = __builtin_amdgcn_make_buffer_rsrc((void*)p.qh(), 0, (int)(HM_ELEMS * 2), 0x00020000);
  const __amdgpu_buffer_rsrc_t rsK = __builtin_amdgcn_make_buffer_rsrc((void*)p.kh(), 0, (int)(HM_ELEMS * 2), 0x00020000);
  const __amdgpu_buffer_rsrc_t rsV = __builtin_amdgcn_make_buffer_rsrc((void*)p.vt(), 0, (int)(HM_ELEMS * 2), 0x00020000);
  const bool fast = nblk == 256;
  const int npair = fast ? 8 : 64;
  const int xg = bid >> 5, lw = (bid & 31) * 8 + wid;
  attn_stage_ctx(p, cbuf, fast ? xg : 0, wid, lane);
  const unsigned vQp = (lane & 15) * 128 + (lane >> 4) * 32;
  auto qso_of = [&](int ph2) { return (unsigned)(HM_LAT * 2) + ((unsigned)ph2 * SEQ + (lw >> 2) * 64 + (lw & 3) * 16) * 128; };
  bf16x8 qn0 = bf16x8{}, qn1 = bf16x8{};
  if (fast) { qn0 = bl128(rsQ, vQp, qso_of(xg)); qn1 = bl128(rsQ, vQp + 16, qso_of(xg)); }
  for (int sl = 0; sl < npair; ++sl) {
    const int ph = fast ? sl * 8 + xg : sl, h = ph & 7, b = ph >> 3;
    asm volatile("s_waitcnt vmcnt(0)" ::: "memory");
    __syncthreads();
    const char* cK = cbuf + (sl & 1) * 65536;
    const char* cV = cK + 32768;
    char* ndst = sl + 1 < npair ? cbuf + ((sl + 1) & 1) * 65536 : nullptr;
    if (fast) {
      const bf16x8 qc0 = qn0, qc1 = qn1;
      if (sl + 1 < npair) { qn0 = bl128(rsQ, vQp, qso_of((sl + 1) * 8 + xg)); qn1 = bl128(rsQ, vQp + 16, qso_of((sl + 1) * 8 + xg)); }
      attn_unit<true, true>(p, rsQ, rsK, rsV, cK, cV, s_rpb, b, h, lw >> 2, lw & 3, lane, ndst, (sl + 1) * 8 + xg, wid, qc0, qc1);
      if (layer == 0 && (lw >> 4) == sl) attn_unit<false>(p, rsQ, rsK, rsV, cK, cV, s_rpb, b, h, 0, lw & 15, lane);
    } else {
      if (ndst) attn_stage_ctx(p, ndst, sl + 1, wid, lane);
      for (int u = bid * 8 + wid; u < 256; u += nblk * 8) attn_unit<true>(p, rsQ, rsK, rsV, cK, cV, s_rpb, b, h, u >> 2, u & 3, lane);
      if (layer == 0)
        for (int u = bid * 8 + wid; u < 16; u += nblk * 8) attn_unit<false>(p, rsQ, rsK, rsV, cK, cV, s_rpb, b, h, 0, u, lane);
    }
  }
  __syncthreads();
}

DI void phase_pool(const W& p_, int layer, char* lds, int bid, int nblk) {
  const W p = oq(p_);
  float* U = (float*)lds;
  bf16_t* dA = (bf16_t*)(lds + 81920);
  bf16_t* WT = (bf16_t*)(lds + 81920 + 33792);
  const int tid = otid(), wid = tid >> 6, lane = tid & 63, fr = lane & 15, fq = lane >> 4;
  for (int i = tid; i < 4 * 64 * 8; i += NTHR) {
    const int rowj = i >> 3, chk = i & 7;
    *(uint4*)(WT + rowj * 72 + chk * 8) = *(const uint4*)(p.wpt() + (size_t)layer * 16384 + rowj * 64 + chk * 8);
  }
  const int nlat = ML / 64, nctx = layer == 0 ? MC / 64 : 0;
  const int gextra = NB * 4 * NSLOT - nblk * 8;
  const int heavy = (gextra > 0 && gextra < nblk * 4) ? (gextra + 7) / 8 : 0;
  const int ptotal = nlat + nctx;
  const int ufirst = bid < heavy ? ptotal - 1 - bid : bid - heavy;
  const int ustep = bid < heavy ? ptotal : nblk - heavy;
  const int ulimit = bid < heavy ? ptotal : ptotal - heavy;
  for (int u = ufirst; u < ulimit; u += ustep) {
    int row0, L, seq0;
    if (u < nlat) { row0 = MC + u * 64; L = SEQ; seq0 = MC + ((u * 64) / SEQ) * SEQ; }
    else { row0 = (u - nlat) * 64; L = NCTX; seq0 = (row0 / NCTX) * NCTX; }
    const int t0 = row0 - seq0;
    __syncthreads();
#pragma unroll
    for (int k = 0; k < 5; ++k) {
      const int c = tid + NTHR * k, rr = c >> 5, chk = c & 31;
      const int tpos = t0 - 8 + rr;
      uint4 v = make_uint4(0u, 0u, 0u, 0u);
      if (tpos >= 0 && tpos < L) v = *(const uint4*)(p.px() + (size_t)(seq0 + tpos) * INW + 1536 + chk * 8);
      float4 lo4, hi4;
      lo4.x = __uint_as_float(v.x << 16); lo4.y = __uint_as_float(v.x & 0xffff0000u); lo4.z = __uint_as_float(v.y << 16); lo4.w = __uint_as_float(v.y & 0xffff0000u);
      hi4.x = __uint_as_float(v.z << 16); hi4.y = __uint_as_float(v.z & 0xffff0000u); hi4.z = __uint_as_float(v.w << 16); hi4.w = __uint_as_float(v.w & 0xffff0000u);
      *(float4*)(U + rr * 256 + chk * 8) = lo4;
      *(float4*)(U + rr * 256 + chk * 8 + 4) = hi4;
    }
    __syncthreads();
    {
      const int ch = tid & 255, hf = tid >> 8, g = ch >> 6, hw = 1 << g;
      const float* Uc = U + ch;
      int tpos = t0 + hf * 32;
      int lo = max(tpos - hw, 0), hi = min(tpos + hw - 1, L - 1);
      float S = 0.f;
      for (int j = lo; j <= hi; ++j) S += Uc[(j - t0 + 8) * 256];
      for (int tt = 0; tt < 32; ++tt) {
        const float dv = S / (float)(hi - lo + 1) - Uc[(tpos - t0 + 8) * 256];
        dA[(hf * 32 + tt) * 264 + ch] = f2bf(dv);
        ++tpos;
        const int nlo = max(tpos - hw, 0), nhi = min(tpos + hw - 1, L - 1);
        if (nlo > lo) { S -= Uc[(lo - t0 + 8) * 256]; lo = nlo; }
        if (nhi > hi) { S += Uc[(nhi - t0 + 8) * 256]; hi = nhi; }
      }
    }
    __syncthreads();
    {
      const int g = wid & 3, th = wid >> 2;
      f32x4 acc[2][4];
#pragma unroll
      for (int mi = 0; mi < 2; ++mi)
#pragma unroll
        for (int ni = 0; ni < 4; ++ni) acc[mi][ni] = (f32x4){0.f, 0.f, 0.f, 0.f};
#pragma unroll
      for (int ks = 0; ks < 2; ++ks) {
        bf16x8 a[2], b[4];
#pragma unroll
        for (int mi = 0; mi < 2; ++mi) a[mi] = *(const bf16x8*)(dA + (th * 32 + mi * 16 + fr) * 264 + g * 64 + 32 * ks + 8 * fq);
#pragma unroll
        for (int ni = 0; ni < 4; ++ni) b[ni] = *(const bf16x8*)(WT + (g * 64 + ni * 16 + fr) * 72 + 32 * ks + 8 * fq);
#pragma unroll
        for (int mi = 0; mi < 2; ++mi)
#pragma unroll
          for (int ni = 0; ni < 4; ++ni) acc[mi][ni] = __builtin_amdgcn_mfma_f32_16x16x32_bf16(b[ni], a[mi], acc[mi][ni], 0, 0, 0);
      }
#pragma unroll
      for (int mi = 0; mi < 2; ++mi) {
        const int row = row0 + th * 32 + mi * 16 + fr;
#pragma unroll
        for (int ni = 0; ni < 4; ++ni) {
          const int j0 = g * 64 + ni * 16 + 4 * fq;
          const float4 sc = *(const float4*)(p.pool_scale() + layer * 256 + j0);
          *(int*)((char*)p.cat() + (size_t)row * D + 512 + j0) =
              pack_fp8x4(acc[mi][ni][0] * sc.x * 8.f, acc[mi][ni][1] * sc.y * 8.f, acc[mi][ni][2] * sc.z * 8.f, acc[mi][ni][3] * sc.w * 8.f);
        }
      }
    }
  }
  __syncthreads();
}

DI int gla_row0(int b, int slot) { return slot < 4 ? b * NCTX + slot * 64 : MC + b * SEQ + (slot - 4) * 64; }
constexpr int KXT_STRIDE = 72;

DI void phase_gla_c1(const W& p_, int layer, char* lds, int bid, int nblk) {
  const W p = oq(p_);
  const int tid = otid(), lane = tid & 63;
  const int wid = __builtin_amdgcn_readfirstlane(tid >> 6);
  constexpr int WREG = 2 * 32 * KXT_STRIDE * 2 + 4096;
  bf16_t* kxt = (bf16_t*)(lds + wid * WREG);
  bf16_t* al = (bf16_t*)(lds + wid * WREG + 2 * 32 * KXT_STRIDE * 2);
  float* s_rope = (float*)(lds + 8 * WREG);
  for (int i = tid; i < 1024; i += NTHR) s_rope[i] = p.rope()[i];
  __syncthreads();
  const int dir = lane >> 5, d = lane & 31, fr = lane & 15, fq = lane >> 4;
  const __amdgpu_buffer_rsrc_t rsV = __builtin_amdgcn_make_buffer_rsrc((void*)p.vtg(), 0, (int)(HMG_ELEMS * 2), 0x00020000);
  const int half = d >> 4, jf = d & 7;
  const float sgn = ((d >> 3) & 1) ? 1.f : -1.f;
  for (int u = bid * 8 + wid; u < NB * 4 * NSLOT; u += nblk * 8) {
    const int slot = u % NSLOT, bh = u / NSLOT, h = bh & 3, b = bh >> 2;
    const int row0 = gla_row0(b, slot);
    const bool latent = slot >= 4;
#pragma unroll
    for (int j = 0; j < 4; ++j) {
      const int rr = j * 16 + (lane >> 2), chk = lane & 3;
      *(uint4*)(al + rr * 32 + chk * 8) = *(const uint4*)(p.px() + (size_t)(row0 + rr) * INW + 2560 + chk * 8);
    }
    float w2[16];
    {
      const float* w2p = (dir ? p.w_gate_b() : p.w_gate_f()) + layer * 2048 + h * 32 + d;
#pragma unroll
      for (int r = 0; r < 16; ++r) w2[r] = w2p[r * 128];
    }
    const float b2 = (dir ? p.b_gate_b() : p.b_gate_f())[layer * 128 + h * 32 + d];
    bf16_t* gq = p.gqk() + ((size_t)u * 2 + dir) * 4096;
    asm volatile("s_waitcnt lgkmcnt(0)" ::: "memory");
    float bsum = 0.f;
    for (int ib = 0; ib < 4; ++ib) {
      bf16_t qo[16], qp[16], ko[16], kp[16];
#pragma unroll
      for (int k = 0; k < 16; ++k) {
        const int ii = ib * 16 + k, i = dir ? 63 - ii : ii;
        const bf16_t* rowp = p.px() + (size_t)(row0 + i) * INW + h * 32;
        qo[k] = rowp[1792 + d]; qp[k] = rowp[1792 + (d ^ 8)]; ko[k] = rowp[1920 + d]; kp[k] = rowp[1920 + (d ^ 8)];
      }
#pragma unroll
      for (int k = 0; k < 16; ++k) {
        const int ii = ib * 16 + k, i = dir ? 63 - ii : ii;
        const uint4 a0 = *(const uint4*)(al + i * 32 + dir * 16), a1 = *(const uint4*)(al + i * 32 + dir * 16 + 8);
        float lg = b2;
        const unsigned aw[8] = {a0.x, a0.y, a0.z, a0.w, a1.x, a1.y, a1.z, a1.w};
#pragma unroll
        for (int r = 0; r < 8; ++r) {
          lg += __uint_as_float(aw[r] << 16) * w2[2 * r];
          lg += __uint_as_float(aw[r] & 0xffff0000u) * w2[2 * r + 1];
        }
        const float ls = fminf(lg, 0.f) - __logf(1.f + __expf(-fabsf(lg)));
        bsum += ls * (1.f / 16.f);
        const float qov = bf2f(qo[k]) * 0.17677669529663687f, qpv = bf2f(qp[k]) * 0.17677669529663687f;
        const float kov = bf2f(ko[k]), kpv = bf2f(kp[k]);
        float qr = qov, kr = kov;
        if (latent) {
          const int pos = half == 0 ? (slot - 4) : i;
          const float2 cs = *(const float2*)(s_rope + (pos * 8 + jf) * 2);
          qr = qov * cs.x + sgn * qpv * cs.y;
          kr = kov * cs.x + sgn * kpv * cs.y;
        }
        const float eb = __expf(bsum);
        const bf16_t qx = f2bf(qr * eb), kx = f2bf(kr / eb);
        gq[i * 32 + d] = qx;
        gq[2048 + i * 32 + d] = kx;
        kxt[(dir * 32 + d) * KXT_STRIDE + i] = kx;
      }
    }
    const float eblast = __expf(bsum);
    p.gdec()[((size_t)u * 2 + dir) * 32 + d] = eblast;
    asm volatile("s_waitcnt lgkmcnt(0)" ::: "memory");
    const unsigned vbase = (unsigned)((latent ? HMG_LAT + (size_t)(bh * 64 + slot - 4) * 4096 : (size_t)(bh * 4 + slot) * 4096) * 2);
    bf16x8 vf[2][4];
#pragma unroll
    for (int ks = 0; ks < 2; ++ks)
#pragma unroll
      for (int mt = 0; mt < 4; ++mt) vf[ks][mt] = bl128(rsV, (unsigned)(((16 * mt + fr) * 64 + 8 * fq) * 2), vbase + ks * 64);
#pragma unroll
    for (int dd = 0; dd < 2; ++dd) {
      f32x4 acc[4][2];
#pragma unroll
      for (int mt = 0; mt < 4; ++mt)
#pragma unroll
        for (int nt = 0; nt < 2; ++nt) acc[mt][nt] = (f32x4){0.f, 0.f, 0.f, 0.f};
#pragma unroll
      for (int ks = 0; ks < 2; ++ks) {
        bf16x8 kf[2];
#pragma unroll
        for (int nt = 0; nt < 2; ++nt) kf[nt] = *(const bf16x8*)(kxt + (dd * 32 + 16 * nt + fr) * KXT_STRIDE + 32 * ks + 8 * fq);
#pragma unroll
        for (int mt = 0; mt < 4; ++mt)
#pragma unroll
          for (int nt = 0; nt < 2; ++nt) acc[mt][nt] = __builtin_amdgcn_mfma_f32_16x16x32_bf16(vf[ks][mt], kf[nt], acc[mt][nt], 0, 0, 0);
      }
      float* kvp = p.gkv() + ((size_t)u * 2 + dd) * 2048;
#pragma unroll
      for (int nt = 0; nt < 2; ++nt) {
        const float sc = __shfl(eblast, dd * 32 + 16 * nt + fr);
#pragma unroll
        for (int mt = 0; mt < 4; ++mt)
#pragma unroll
          for (int j = 0; j < 4; ++j) kvp[(16 * mt + 4 * fq + j) * 32 + 16 * nt + fr] = acc[mt][nt][j] * sc;
      }
    }
    asm volatile("s_waitcnt lgkmcnt(0)" ::: "memory");
  }
  __syncthreads();
}

DI void phase_gla_scan(const W& p_, int bid, int nblk) {
  const W p = oq(p_);
  bf16_t* sin = (bf16_t*)p.gsin();
  const int nthreads = NB * 4 * 2 * 2048;
  for (int gid = bid * NTHR + otid(); gid < nthreads; gid += nblk * NTHR) {
    const int el = gid & 2047, dir = (gid >> 11) & 1, bh = gid >> 12, d = el & 31;
    float S = 0.f;
    for (int st0 = 0; st0 < NSLOT; st0 += 17) {
      float dk[17], kv[17];
#pragma unroll
      for (int j = 0; j < 17; ++j) {
        const int st = st0 + j;
        const int slot = dir == 0 ? st : (st < 4 ? 3 - st : NSLOT + 3 - st);
        const size_t base = ((size_t)(bh * NSLOT + slot)) * 2 + dir;
        dk[j] = p.gdec()[base * 32 + d];
        kv[j] = p.gkv()[base * 2048 + el];
      }
#pragma unroll
      for (int j = 0; j < 17; ++j) {
        const int st = st0 + j;
        const int slot = dir == 0 ? st : (st < 4 ? 3 - st : NSLOT + 3 - st);
        const size_t base = ((size_t)(bh * NSLOT + slot)) * 2 + dir;
        sin[base * 2048 + el] = f2bf(S);
        S = dk[j] * S + kv[j];
      }
    }
  }
}

DI void phase_gla_c3(const W& p_, int layer, char* lds, int bid, int nblk) {
  (void)lds;
  const W p = oq(p_);
  const int tid = otid(), lane = tid & 63;
  const int wid = __builtin_amdgcn_readfirstlane(tid >> 6);
  const int fr = lane & 15, fq = lane >> 4;
  const __amdgpu_buffer_rsrc_t rsV = __builtin_amdgcn_make_buffer_rsrc((void*)p.vtg(), 0, (int)(HMG_ELEMS * 2), 0x00020000);
  const __amdgpu_buffer_rsrc_t rsQ = __builtin_amdgcn_make_buffer_rsrc((void*)p.gqk(), 0, (int)((size_t)NB * 4 * NSLOT * 16384), 0x00020000);
  const __amdgpu_buffer_rsrc_t rsS = __builtin_amdgcn_make_buffer_rsrc((void*)p.gsin(), 0, (int)((size_t)NB * 4 * NSLOT * 2 * 4096), 0x00020000);
  const int slot_lo = layer == 0 ? 0 : 4;
  const int nsl = NSLOT - slot_lo;
  const unsigned vfrag = (unsigned)(fr * 64 + fq * 16);
  for (int uu = bid * 8 + wid; uu < NB * 4 * nsl; uu += nblk * 8) {
    const int slot = slot_lo + uu % nsl, bh = uu / nsl, h = bh & 3, b = bh >> 2;
    const int u = bh * NSLOT + slot;
    const bool latent = slot >= 4;
    const int row0 = gla_row0(b, slot);
    const unsigned qbase = (unsigned)u * 16384u;
    bf16x8 QF[4], QB[4];
#pragma unroll
    for (int ct = 0; ct < 4; ++ct) { QF[ct] = bl128(rsQ, vfrag, qbase + ct * 1024); QB[ct] = bl128(rsQ, vfrag, qbase + 8192 + ct * 1024); }
    f32x4 O[4][4];
#pragma unroll
    for (int mt = 0; mt < 4; ++mt)
#pragma unroll
      for (int ct = 0; ct < 4; ++ct) O[mt][ct] = (f32x4){0.f, 0.f, 0.f, 0.f};
    const unsigned vbase = (unsigned)((latent ? HMG_LAT + (size_t)(bh * 64 + slot - 4) * 4096 : (size_t)(bh * 4 + slot) * 4096) * 2);
    const unsigned vV = (unsigned)((fr * 64 + 4 * fq) * 2);
#pragma unroll
    for (int ks = 0; ks < 2; ++ks) {
      f32x4 Pt[2][4];
#pragma unroll
      for (int t2 = 0; t2 < 2; ++t2) {
        const int st = 2 * ks + t2;
        const bf16x8 KFs = bl128(rsQ, vfrag, qbase + 4096 + st * 1024), KBs = bl128(rsQ, vfrag, qbase + 8192 + 4096 + st * 1024);
#pragma unroll
        for (int ct = 0; ct < 4; ++ct) {
          const f32x4 z = (f32x4){0.f, 0.f, 0.f, 0.f};
          if (st < ct) Pt[t2][ct] = __builtin_amdgcn_mfma_f32_16x16x32_bf16(KFs, QF[ct], z, 0, 0, 0);
          else if (st > ct) Pt[t2][ct] = __builtin_amdgcn_mfma_f32_16x16x32_bf16(KBs, QB[ct], z, 0, 0, 0);
          else {
            const f32x4 f = __builtin_amdgcn_mfma_f32_16x16x32_bf16(KFs, QF[ct], z, 0, 0, 0);
            const f32x4 g = __builtin_amdgcn_mfma_f32_16x16x32_bf16(KBs, QB[ct], z, 0, 0, 0);
#pragma unroll
            for (int j = 0; j < 4; ++j) { const int s = 4 * fq + j; Pt[t2][ct][j] = (s <= fr ? f[j] : 0.f) + (s >= fr ? g[j] : 0.f); }
          }
        }
      }
      bf16x8 pf[4];
#pragma unroll
      for (int ct = 0; ct < 4; ++ct)
        pf[ct] = __builtin_bit_cast(bf16x8, (u32x4){pack2(Pt[0][ct][0], Pt[0][ct][1]), pack2(Pt[0][ct][2], Pt[0][ct][3]),
                                                     pack2(Pt[1][ct][0], Pt[1][ct][1]), pack2(Pt[1][ct][2], Pt[1][ct][3])});
#pragma unroll
      for (int mt = 0; mt < 4; ++mt) {
        const unsigned so = vbase + (unsigned)((mt * 16 * 64 + 32 * ks) * 2);
        const u32x2 v0 = bl64(rsV, vV, so), v1 = bl64(rsV, vV + 32, so);
        const bf16x8 vf = __builtin_bit_cast(bf16x8, (u32x4){v0.x, v0.y, v1.x, v1.y});
#pragma unroll
        for (int ct = 0; ct < 4; ++ct) O[mt][ct] = __builtin_amdgcn_mfma_f32_16x16x32_bf16(vf, pf[ct], O[mt][ct], 0, 0, 0);
      }
    }
    const unsigned sbase = (unsigned)u * 8192u;
#pragma unroll
    for (int mt = 0; mt < 4; ++mt) {
      const bf16x8 sf = bl128(rsS, vfrag, sbase + mt * 1024), sb = bl128(rsS, vfrag, sbase + 4096 + mt * 1024);
#pragma unroll
      for (int ct = 0; ct < 4; ++ct) {
        O[mt][ct] = __builtin_amdgcn_mfma_f32_16x16x32_bf16(sf, QF[ct], O[mt][ct], 0, 0, 0);
        O[mt][ct] = __builtin_amdgcn_mfma_f32_16x16x32_bf16(sb, QB[ct], O[mt][ct], 0, 0, 0);
      }
    }
#pragma unroll
    for (int ct = 0; ct < 4; ++ct) {
      float ss = 0.f;
#pragma unroll
      for (int mt = 0; mt < 4; ++mt)
#pragma unroll
        for (int j = 0; j < 4; ++j) ss += O[mt][ct][j] * O[mt][ct][j];
      ss += __shfl_xor(ss, 16); ss += __shfl_xor(ss, 32);
      const float rstd = rsqrtf(ss * (1.f / 64.f) + EPS);
      const int row = row0 + 16 * ct + fr;
#pragma unroll
      for (int mt = 0; mt < 4; ++mt) {
        const int v0 = 16 * mt + 4 * fq;
        const uint2 rv = *(const uint2*)(p.px() + (size_t)row * INW + 2304 + h * 64 + v0);
        const float4 gg = *(const float4*)(p.g_gla() + layer * 64 + v0);
        const float r0 = O[mt][ct][0] * rstd * gg.x * siluf_(__uint_as_float(rv.x << 16));
        const float r1 = O[mt][ct][1] * rstd * gg.y * siluf_(__uint_as_float(rv.x & 0xffff0000u));
        const float r2 = O[mt][ct][2] * rstd * gg.z * siluf_(__uint_as_float(rv.y << 16));
        const float r3 = O[mt][ct][3] * rstd * gg.w * siluf_(__uint_as_float(rv.y & 0xffff0000u));
        *(int*)((char*)p.cat() + (size_t)row * D + 768 + h * 64 + v0) = pack_fp8x4(r0 * 8.f, r1 * 8.f, r2 * 8.f, r3 * 8.f);
      }
    }
  }
}

#define XB_TMO      128
#define XB_XCNT(j)  (256  + 64 * (j))
#define XB_XSUB(j)  (1280 + 64 * (j))
#define XB_XGEN(j)  (2304 + 64 * (j))
#define XB_TOP      3328
#define XB_TOPGEN   3392
#define XCD_BAR_WORDS 3456
#define XB_SPIN_CAP (1u << 18)
#define LAS __attribute__((address_space(3)))

__device__ __forceinline__ unsigned xb_ld(unsigned* p)              { return __hip_atomic_load(p, __ATOMIC_RELAXED, __HIP_MEMORY_SCOPE_AGENT); }
__device__ __forceinline__ unsigned xb_add(unsigned* p, unsigned v) { return __hip_atomic_fetch_add(p, v, __ATOMIC_RELAXED, __HIP_MEMORY_SCOPE_AGENT); }
__device__ __forceinline__ unsigned xb_xcc_id() { return (unsigned)__builtin_amdgcn_s_getreg((3 << 11) | 20) & 0xFu; }
#define XB_SPIN(cond, bar) do { unsigned _sp = 0; while (cond) { __builtin_amdgcn_s_sleep(1); \
    if ((++_sp & 255u) == 0u) { if (xb_ld(&(bar)[XB_TMO])) break; if (_sp > XB_SPIN_CAP) { atomicAdd(&(bar)[XB_TMO], 1u); break; } } } } while (0)

struct XcdBarrier { unsigned* bar; unsigned x; volatile LAS unsigned* st; };

__device__ __forceinline__ XcdBarrier xcd_barrier_post(unsigned* bar, volatile LAS unsigned* st) {
    XcdBarrier b; b.bar = bar; b.x = xb_xcc_id(); b.st = st;
    if (threadIdx.x == 0) (void)xb_add(&bar[XB_XCNT(b.x)], 1u);
    return b;
}
__device__ __forceinline__ void xcd_barrier_complete(unsigned* bar, unsigned x, unsigned& nloc, unsigned& nx) {
    const unsigned G = gridDim.x * gridDim.y * gridDim.z;
    unsigned sum, cnt, mine, sp = 0u;
    for (;;) {
        sum = 0u; cnt = 0u; mine = 0u;
#pragma unroll
        for (unsigned j = 0; j < 16; ++j) { const unsigned c = xb_ld(&bar[XB_XCNT(j)]); sum += c; cnt += (c > 0u) ? 1u : 0u; mine = (j == x) ? c : mine; }
        if (sum == G) break;
        __builtin_amdgcn_s_sleep(1);
        if ((++sp & 255u) == 0u) { if (xb_ld(&bar[XB_TMO])) break; if (sp > XB_SPIN_CAP) { atomicAdd(&bar[XB_TMO], 1u); break; } }
    }
    nloc = mine > 0u ? mine : 1u; nx = cnt > 0u ? cnt : 1u;
}
__device__ __forceinline__ void xcd_barrier(const XcdBarrier& b) {
    asm volatile("s_waitcnt vmcnt(0)" ::: "memory");
    __syncthreads();
    if (threadIdx.x == 0) {
        unsigned long long bv = (unsigned long long)b.bar; unsigned bx = b.x;
        asm volatile("" : "+s"(bv), "+s"(bx));
        unsigned* bar = (unsigned*)(__attribute__((address_space(1))) unsigned*)bv;
        __builtin_amdgcn_s_waitcnt(0);
        unsigned nloc = b.st[0], nx = b.st[1];
        if (nloc == 0u) { xcd_barrier_complete(bar, bx, nloc, nx); b.st[0] = nloc; b.st[1] = nx; }
        const unsigned old = xb_add(&bar[XB_XSUB(bx)], 1u);
        const unsigned gen = old / nloc;
        if (old + 1u == (gen + 1u) * nloc) {
            __builtin_amdgcn_fence(__ATOMIC_RELEASE, "agent");
            asm volatile("s_waitcnt vmcnt(0)" ::: "memory");
            const unsigned og = xb_add(&bar[XB_TOP], 1u);
            const unsigned tg = og / nx;
            if (og + 1u == (tg + 1u) * nx) xb_add(&bar[XB_TOPGEN], 1u);
            else XB_SPIN(xb_ld(&bar[XB_TOPGEN]) == tg, bar);
            __builtin_amdgcn_fence(__ATOMIC_ACQUIRE, "agent");
            xb_add(&bar[XB_XGEN(bx)], 1u);
            asm volatile("s_waitcnt vmcnt(0)" ::: "memory");
        } else {
            XB_SPIN(xb_ld(&bar[XB_XGEN(bx)]) == gen, bar);
            __builtin_amdgcn_fence(__ATOMIC_ACQUIRE, "agent");
            asm volatile("s_waitcnt vmcnt(0)" ::: "memory");
        }
    }
    __syncthreads();
}

__global__ void __launch_bounds__(NTHR, 2) k_fwd(P q) {
  extern __shared__ __attribute__((aligned(16))) char lds[];
  const int bid = blockIdx.x, nblk = gridDim.x;
  if (threadIdx.x < 4) ((unsigned*)(lds + LDS_BYTES - 16))[threadIdx.x] = 0u;
  __syncthreads();
  XcdBarrier bar = xcd_barrier_post((unsigned*)(q.ws + OFF_BAR), (volatile LAS unsigned*)(lds + LDS_BYTES - 16));
  int* s_vb = (int*)(lds + LDS_BYTES - 32);
  if (threadIdx.x == 0) {
    const int xcc = (int)xb_xcc_id();
    s_vb[1] = xcc;
    s_vb[2] = (int)__hip_atomic_fetch_add((unsigned*)(q.ws + OFF_CNT) + 768 + xcc, 1u, __ATOMIC_RELAXED, __HIP_MEMORY_SCOPE_AGENT);
  }
#define GB() xcd_barrier(bar)
#ifndef PROBE_DUP
#define PROBE_DUP 0
#endif
#if PROBE_DUP == 1
#define DUP1(x) x
#else
#define DUP1(x) (void)0
#endif
#if PROBE_DUP == 2
#define DUP2(x) x
#else
#define DUP2(x) (void)0
#endif
#if PROBE_DUP == 3
#define DUP3(x) x
#else
#define DUP3(x) (void)0
#endif
#if PROBE_DUP == 4
#define DUP4(x) x
#else
#define DUP4(x) (void)0
#endif
#if PROBE_DUP == 5
#define DUP5(x) x
#else
#define DUP5(x) (void)0
#endif
#if PROBE_DUP == 6
#define DUP6(x) x
#else
#define DUP6(x) (void)0
#endif
#if PROBE_DUP == 7
#define DUP7(x) x
#else
#define DUP7(x) (void)0
#endif
#if PROBE_DUP == 8
#define DUP8(x) x
#else
#define DUP8(x) (void)0
#endif
#if PROBE_DUP == 9
#define DUP9(x) x
#else
#define DUP9(x) (void)0
#endif
  phase_convert(q, lds, bid, nblk);
  phase_mod(q, lds, bid, nblk);
  DUP3(phase_convert(q, lds, bid, nblk)); DUP3(phase_mod(q, lds, bid, nblk));
  GB();
  if (threadIdx.x == 0) {
    const unsigned* rc = (const unsigned*)(q.ws + OFF_CNT) + 768;
    const int per = nblk >> 3;
    bool ok = (nblk & 7) == 0;
    for (int j = 0; j < 16; ++j) {
      const int c = (int)__hip_atomic_load(rc + j, __ATOMIC_RELAXED, __HIP_MEMORY_SCOPE_AGENT);
      ok = ok && (j < 8 ? c == per : c == 0);
    }
    s_vb[0] = ok ? s_vb[1] * per + s_vb[2] : ((nblk & 7) == 0 ? (bid & 7) * per + (bid >> 3) : bid);
  }
  __syncthreads();
  const int vb = __builtin_amdgcn_readfirstlane(s_vb[0]);
  phase_norm0(q, bid, nblk);
  DUP3(phase_norm0(q, bid, nblk));
  GB();
  const W p{q.ws, q.out, q.x, q.ctx};
#define LAYER(layer, row_lo, LASTGB)                          \
  do {                                                        \
    phase_inproj(p, layer, lds, vb, nblk);                   \
    DUP7(phase_inproj(p, layer, lds, vb, nblk));             \
    GB();                                                     \
    phase_gla_c1(p, layer, lds, vb, nblk);                   \
    phase_pool(p, layer, lds, vb, nblk);                     \
    DUP6(phase_gla_c1(p, layer, lds, vb, nblk)); DUP5(phase_pool(p, layer, lds, vb, nblk)); \
    GB();                                                     \
    phase_gla_scan(p, vb, nblk);                             \
    phase_attn(p, layer, lds, vb, nblk);                     \
    DUP6(phase_gla_scan(p, vb, nblk)); DUP4(phase_attn(p, layer, lds, vb, nblk)); \
    GB();                                                     \
    phase_gla_c3(p, layer, lds, vb, nblk);                   \
    DUP6(phase_gla_c3(p, layer, lds, vb, nblk));             \
    GB();                                                     \
    DUP2(phase_outproj_t<true>(p, layer, lds, row_lo, vb, nblk)); \
    phase_outproj(p, layer, lds, row_lo, vb, nblk);          \
    GB();                                                     \
    phase_norm(p, layer, row_lo, vb, nblk);                  \
    DUP3(phase_norm(p, layer, row_lo, vb, nblk));            \
    GB();                                                     \
    phase_router(p, layer, lds, row_lo, vb, nblk);           \
    DUP1(phase_router(p, layer, lds, row_lo, vb, nblk));     \
    GB();                                                     \
    phase_route(p, layer, lds, row_lo, vb, nblk);            \
    GB();                                                     \
    phase_moe(p, layer, lds, row_lo, vb, nblk);              \
    DUP8(phase_moe(p, layer, lds, row_lo, vb, nblk));        \
    GB();                                                     \
    DUP9(phase_combine_t<true>(p, layer, row_lo, vb, nblk)); \
    phase_combine(p, layer, row_lo, vb, nblk);               \
    LASTGB;                                                   \
  } while (0)
#if PROBE_GEMM
  phase_probe_gemm(p, lds, vb, nblk);
  GB();
#endif
  LAYER(0, 0, GB());
  LAYER(1, MC, (void)0);
#undef LAYER
#undef GB
}

}

extern "C" void kernel_launch(void* const* d_in, const int* in_sizes, int n_in, void* d_out, int out_size, void* d_ws,
                              size_t ws_size, hipStream_t stream) {
  (void)in_sizes; (void)n_in; (void)out_size;
  P p{};
  const float* const* in = (const float* const*)d_in;
  p.x = in[0]; p.c = in[1]; p.ctx = in[2]; p.c_ctx = in[3]; p.w_mod = in[4]; p.b_mod = in[5]; p.g_mix = in[6]; p.w_in = in[7];
  p.rpb = in[8]; p.w_pool = in[9]; p.pool_scale = in[10]; p.w_gate_f = in[11]; p.b_gate_f = in[12]; p.w_gate_b = in[13];
  p.b_gate_b = in[14]; p.g_gla = in[15]; p.w_out = in[16]; p.g_ffn = in[17]; p.w_router = in[18]; p.b_router = in[19];
  p.w_e_in = in[20]; p.w_e_down = in[21]; p.w_sh_in = in[22]; p.w_sh_down = in[23]; p.g_final = in[24];
  p.out = (float*)d_out;
  p.ws = (char*)d_ws;
  char* ws = (char*)d_ws;
  if (ws_size < WS_TOTAL) { fprintf(stderr, "workspace too small: %zu < %zu\n", ws_size, (size_t)WS_TOTAL); }
  static int grid = 0;
  if (!grid) {
    (void)hipFuncSetAttribute((const void*)k_fwd, hipFuncAttributeMaxDynamicSharedMemorySize, LDS_BYTES);
    int dev = 0, cus = 0, per_cu = 0;
    (void)hipGetDevice(&dev);
    (void)hipDeviceGetAttribute(&cus, hipDeviceAttributeMultiprocessorCount, dev);
    (void)hipOccupancyMaxActiveBlocksPerMultiprocessor(&per_cu, (const void*)k_fwd, NTHR, LDS_BYTES);
    if (per_cu < 1) { fprintf(stderr, "k_fwd: occupancy query says 0 blocks per CU\n"); per_cu = 1; }
    grid = cus > 0 ? cus : 256;
  }
  (void)hipMemsetAsync(ws, 0, ZERO_BYTES, stream);
  hipLaunchKernelGGL(k_fwd, dim3(grid), dim3(NTHR), LDS_BYTES, stream, p);
}
```

```cpp
#include <hip/hip_runtime.h>
#include <stdint.h>
#include <stdio.h>

#define DI __device__ __forceinline__
typedef unsigned short bf16_t;
typedef short bf16x8 __attribute__((ext_vector_type(8)));
typedef short bf16x4 __attribute__((ext_vector_type(4)));
typedef float f32x4 __attribute__((ext_vector_type(4)));

namespace {
constexpr int D = 1024, NB = 8, SEQ = 4096, NCTX = 256;
constexpr int MC = NB * NCTX, ML = NB * SEQ, MT = MC + ML;
constexpr int INW = 2592, INWP = 2816;
constexpr int NE = 256, NE1 = 257;
constexpr int NTHR = 512;
constexpr int LDS_BYTES = 152 * 1024;
constexpr int CAP = MT;
constexpr int NSLOT = 68;
constexpr float EPS = 1e-6f;

struct P {
  const float *x, *c, *ctx, *c_ctx, *w_mod, *b_mod, *g_mix, *w_in, *rpb, *w_pool, *pool_scale,
      *w_gate_f, *b_gate_f, *w_gate_b, *b_gate_b, *g_gla, *w_out, *g_ffn, *w_router, *b_router,
      *w_e_in, *w_e_down, *w_sh_in, *w_sh_down, *g_final;
  float* out;
  char* ws;
};

constexpr size_t al256(size_t x) { return (x + 255) & ~(size_t)255; }
constexpr size_t OFF_BAR = 0;
constexpr size_t OFF_CNT = OFF_BAR + 16384;
constexpr size_t ZERO_BYTES = 16384 + 4096;
constexpr size_t OFF_MOD = OFF_CNT + 4096;
constexpr size_t OFF_ROPE = OFF_MOD + al256((size_t)2 * 9 * 6144 * 4);
constexpr size_t OFF_GMIX = OFF_ROPE + al256(64 * 8 * 2 * 4);
constexpr size_t OFF_GFFN = OFF_GMIX + al256(2 * 1024 * 4);
constexpr size_t OFF_GFINAL = OFF_GFFN + al256(2 * 1024 * 4);
constexpr size_t OFF_RPB = OFF_GFINAL + al256(1024 * 4);
constexpr size_t OFF_WPOOL = OFF_RPB + al256(2 * 3720 * 4);
constexpr size_t OFF_PSCALE = OFF_WPOOL + al256(2 * 4 * 4096 * 4);
constexpr size_t OFF_WGF = OFF_PSCALE + al256(2 * 256 * 4);
constexpr size_t OFF_WGB = OFF_WGF + al256(2 * 16 * 128 * 4);
constexpr size_t OFF_BGF = OFF_WGB + al256(2 * 16 * 128 * 4);
constexpr size_t OFF_BGB = OFF_BGF + al256(2 * 128 * 4);
constexpr size_t OFF_GGLA = OFF_BGB + al256(2 * 128 * 4);
constexpr size_t OFF_BROUTER = OFF_GGLA + al256(2 * 64 * 4);
constexpr size_t OFF_WIN = OFF_BROUTER + al256(2 * 256 * 4);
constexpr size_t OFF_WOUT = OFF_WIN + al256((size_t)2 * INWP * 1024 * 2);
constexpr size_t OFF_WR = OFF_WOUT + al256((size_t)2 * 1024 * 1024 * 2);
constexpr size_t OFF_WEI = OFF_WR + al256((size_t)2 * 256 * 1024 * 2);
constexpr size_t OFF_WED = OFF_WEI + al256((size_t)2 * NE1 * 512 * 1024 * 2);
constexpr size_t OFF_H = OFF_WED + al256((size_t)2 * NE1 * 1024 * 256 * 2);
constexpr size_t OFF_CAT = OFF_H + al256((size_t)MT * D * 2);
constexpr size_t OFF_H2 = OFF_CAT + al256((size_t)MT * D * 2);
constexpr size_t OFF_PX = OFF_H2 + al256((size_t)MT * D * 2);
constexpr size_t OFF_ACT = OFF_PX + al256((size_t)MT * INW * 2);
constexpr size_t OFF_Y = OFF_ACT + al256((size_t)9 * MT * 256 * 2);
constexpr size_t OFF_XRES = OFF_Y + al256((size_t)9 * MT * D * 2);
constexpr size_t OFF_LOGITS = OFF_XRES + al256((size_t)MT * D * 4);
constexpr size_t OFF_WTS = OFF_LOGITS + al256((size_t)MT * 256 * 4);
constexpr size_t OFF_GKV = OFF_WTS + al256((size_t)MT * 8 * 4);
constexpr size_t OFF_GDEC = OFF_GKV + al256((size_t)NB * 4 * NSLOT * 2 * 2048 * 4);
constexpr size_t OFF_GSIN = OFF_GDEC + al256((size_t)NB * 4 * NSLOT * 2 * 32 * 4);
constexpr size_t OFF_LISTS = OFF_GSIN + al256((size_t)NB * 4 * NSLOT * 2 * 2048 * 4);
constexpr size_t OFF_QH = OFF_LISTS + al256((size_t)NE * CAP * 4);
constexpr size_t HM_LAT = (size_t)NB * 8 * NCTX * 64;
constexpr size_t HM_ELEMS = (size_t)NB * 8 * (NCTX + SEQ) * 64;
constexpr size_t OFF_KH = OFF_QH + al256(HM_ELEMS * 2);
constexpr size_t OFF_VT = OFF_KH + al256(HM_ELEMS * 2);
constexpr size_t HMG_LAT = (size_t)NB * 4 * 64 * NCTX;
constexpr size_t HMG_ELEMS = (size_t)NB * 4 * 64 * (NCTX + SEQ);
constexpr size_t OFF_VTG = OFF_VT + al256(HM_ELEMS * 2);
constexpr size_t OFF_GQK = OFF_VTG + al256(HMG_ELEMS * 2);
constexpr size_t OFF_WPT = OFF_GQK + al256((size_t)NB * 4 * NSLOT * 2 * 2 * 2048 * 2);
constexpr size_t OFF_H2Q = OFF_WPT + al256((size_t)2 * 4 * 4096 * 2);
constexpr size_t WS_TOTAL = OFF_H2Q + al256((size_t)MT * 1024);

struct W {
  char* ws; float* out; const float* x; const float* ctx;
#define WF(T, name, OFF) DI T* name() const { return (T*)(ws + OFF); }
  WF(unsigned, bar, OFF_BAR) WF(int, cnt, OFF_CNT) WF(float, mod, OFF_MOD) WF(float, rope, OFF_ROPE)
  WF(float, g_mix, OFF_GMIX) WF(float, g_ffn, OFF_GFFN) WF(float, g_final, OFF_GFINAL) WF(float, rpb, OFF_RPB)
  WF(float, w_pool, OFF_WPOOL) WF(float, pool_scale, OFF_PSCALE) WF(float, w_gate_f, OFF_WGF) WF(float, w_gate_b, OFF_WGB)
  WF(float, b_gate_f, OFF_BGF) WF(float, b_gate_b, OFF_BGB) WF(float, g_gla, OFF_GGLA) WF(float, b_router, OFF_BROUTER)
  WF(bf16_t, win_t, OFF_WIN) WF(bf16_t, wout_t, OFF_WOUT) WF(bf16_t, wr_t, OFF_WR) WF(bf16_t, wei_t, OFF_WEI) WF(bf16_t, wed_t, OFF_WED)
  WF(bf16_t, h, OFF_H) WF(bf16_t, cat, OFF_CAT) WF(bf16_t, h2, OFF_H2) WF(bf16_t, px, OFF_PX) WF(bf16_t, act, OFF_ACT) WF(bf16_t, y, OFF_Y)
  WF(bf16_t, xres, OFF_XRES) WF(float, logits, OFF_LOGITS) WF(float, wts, OFF_WTS) WF(float, gkv, OFF_GKV) WF(float, gdec, OFF_GDEC)
  WF(float, gsin, OFF_GSIN) WF(int, lists, OFF_LISTS) WF(bf16_t, qh, OFF_QH) WF(bf16_t, kh, OFF_KH) WF(bf16_t, vt, OFF_VT) WF(bf16_t, vtg, OFF_VTG) WF(bf16_t, gqk, OFF_GQK) WF(bf16_t, wpt, OFF_WPT) WF(unsigned char, h2q, OFF_H2Q)
#undef WF
};

DI float bf2f(bf16_t v) { return __uint_as_float(((unsigned)v) << 16); }
DI bf16_t f2bf(float f) { unsigned u = __float_as_uint(f); u += 0x7fffu + ((u >> 16) & 1u); return (bf16_t)(u >> 16); }
typedef float f32x2v __attribute__((ext_vector_type(2)));
typedef __bf16 bf16x2v __attribute__((ext_vector_type(2)));
DI unsigned pack2(float lo, float hi) {
  const f32x2v v = {lo, hi};
  return __builtin_bit_cast(unsigned, __builtin_convertvector(v, bf16x2v));
}
DI int pack_fp8x4(float a, float b, float c, float d) {
  a = __builtin_amdgcn_fmed3f(a, -440.f, 440.f); b = __builtin_amdgcn_fmed3f(b, -440.f, 440.f);
  c = __builtin_amdgcn_fmed3f(c, -440.f, 440.f); d = __builtin_amdgcn_fmed3f(d, -440.f, 440.f);
  int w = __builtin_amdgcn_cvt_pk_fp8_f32(a, b, 0, false);
  return __builtin_amdgcn_cvt_pk_fp8_f32(c, d, w, true);
}
DI float4 unpack4(uint2 v) { return make_float4(__uint_as_float(v.x << 16), __uint_as_float(v.x & 0xffff0000u), __uint_as_float(v.y << 16), __uint_as_float(v.y & 0xffff0000u)); }
DI float wave_sum(float v) { for (int o = 32; o; o >>= 1) v += __shfl_xor(v, o); return v; }
DI float wave_max(float v) { for (int o = 32; o; o >>= 1) v = fmaxf(v, __shfl_xor(v, o)); return v; }
template <int CTRL> DI float dppf(float v) { return __int_as_float(__builtin_amdgcn_update_dpp(__float_as_int(v), __float_as_int(v), CTRL, 0xf, 0xf, false)); }
DI float rlanef(float v, int l) { return __int_as_float(__builtin_amdgcn_readlane(__float_as_int(v), l)); }
DI float wave_max_dpp(float v) {
  v = fmaxf(v, dppf<0xB1>(v));
  v = fmaxf(v, dppf<0x4E>(v));
  v = fmaxf(v, dppf<0x141>(v));
  v = fmaxf(v, dppf<0x140>(v));
  return fmaxf(fmaxf(rlanef(v, 0), rlanef(v, 16)), fmaxf(rlanef(v, 32), rlanef(v, 48)));
}
DI int otid() { int t = threadIdx.x; asm volatile("" : "+v"(t)); return t; }
DI float sigmoidf_(float x) { return 1.f / (1.f + __expf(-x)); }
DI float siluf_(float x) { return x / (1.f + __expf(-x)); }
DI int vbid_of(int bid, int nblk) { (void)nblk; return bid; }
DI int mod_row(int row) { return row < MC ? 8 : ((row - MC) >> 12); }

typedef __attribute__((address_space(1))) char gchar;
typedef __attribute__((address_space(1))) float gfloat;
DI W oq(const W& w) {
  unsigned long long v = (unsigned long long)w.ws;
  asm volatile("" : "+s"(v));
  W r; r.ws = (char*)(gchar*)v; r.out = w.out; r.x = w.x; r.ctx = w.ctx;
  return r;
}

struct NoHook { DI void operator()() const {} };
template <int WM, int WN, int MI, int NI, int BK, int NS, bool SWAP, int NCH, int FLAGS = 0, class FA, class FB, class EPI, class HK = NoHook>
DI void gemm_tile(char* lds, int nk, size_t bstride, size_t bks, FA rowA, FB rowB, EPI epi, const char* ares = nullptr, HK hook = HK()) {
  constexpr int BM = WM * MI * 16, BN = WN * NI * 16;
  constexpr int RB = BK * 2, CPR = RB / 16, RPP = 1024 / RB;
  constexpr bool ARES = (FLAGS & 1) != 0;
  constexpr int PA = ARES ? 0 : BM / RPP / 8, PB = BN / RPP / 8, NP = PA + PB, BOFF = ARES ? 0 : BM * RB, STG = BOFF + BN * RB, KS = BK / 32;
  static_assert(WM * WN == 8, "8 waves");
  static_assert(BK == 32 || BK == 64, "BK");
  const int tid = otid(), wid = tid >> 6, lane = tid & 63, fr = lane & 15, fq = lane >> 4;
  const int wr = wid / WN, wc = wid % WN;
  const int lrow = lane / CPR, pc = lane % CPR;
  const bf16_t* ap[PA > 0 ? PA : 1];
  const bf16_t* bp[PB];
#pragma unroll
  for (int i = 0; i < PA; ++i) {
    const int r = (wid + 8 * i) * RPP + lrow;
    const int sw = BK == 64 ? ((r >> 1) & 7) : ((-(r >> 2)) & 3);
    ap[i] = rowA(r) + ((pc ^ sw) * 8);
  }
#pragma unroll
  for (int i = 0; i < PB; ++i) {
    const int r = (wid + 8 * i) * RPP + lrow;
    const int sw = BK == 64 ? ((r >> 1) & 7) : ((-(r >> 2)) & 3);
    bp[i] = rowB(r) + ((pc ^ sw) * 8);
  }
  char* ldst = lds + wid * 1024 + lane * 16;
  f32x4 acc[MI][NI];
#pragma unroll
  for (int mi = 0; mi < MI; ++mi)
#pragma unroll
    for (int ni = 0; ni < NI; ++ni) acc[mi][ni] = (f32x4){0.f, 0.f, 0.f, 0.f};
  const int swf = BK == 64 ? (fr >> 1) : ((-(fr >> 2)) & 3);
  const int aoff = (wr * MI * 16 + fr) * RB + ((fq ^ swf) * 16);
  const int boff = BOFF + (wc * NI * 16 + fr) * RB + ((fq ^ swf) * 16);
#define GEMM_STAGE(s, t)                                                                                              \
  do {                                                                                                                \
    const int kt_ = NCH == 1 ? (t) : (t) % nk;                                                                        \
    const size_t bo_ = NCH == 1 ? (size_t)0 : (size_t)((t) / nk) * bstride;                                           \
    _Pragma("unroll") for (int i = 0; i < PA; ++i) __builtin_amdgcn_global_load_lds(                                  \
        (const unsigned*)(ap[i] + kt_ * BK), (unsigned*)(ldst + (s) * STG + i * 8192), 16, 0, 0);                     \
    _Pragma("unroll") for (int i = 0; i < PB; ++i) __builtin_amdgcn_global_load_lds(                                  \
        (const unsigned*)(bp[i] + bo_ + kt_ * bks), (unsigned*)(ldst + (s) * STG + BOFF + i * 8192), 16, 0, 0);      \
  } while (0)
  const int ntile = NCH * nk;
  if constexpr ((FLAGS & 64) == 0) {
#pragma unroll
    for (int s = 0; s < NS - 1; ++s)
      if (s < ntile) GEMM_STAGE(s, s);
  }
  int slot = 0, nslot = NS - 1;
  int kin = 0, chunk = 0;
#pragma nounroll
  for (int kt = 0; kt < ntile; ++kt) {
    if constexpr ((FLAGS & 32) != 0) {
      static_assert(NS == 2 && NCH > 1, "store-aware wait: 2-slot ring, chunked stream");
      if (kin == 0 && kt > 0) asm volatile("s_waitcnt vmcnt(8)" ::: "memory");
      else asm volatile("s_waitcnt vmcnt(0)" ::: "memory");
    } else {
      if (kt + NS - 2 < ntile) asm volatile("s_waitcnt vmcnt(%0)" ::"n"((NS - 2) * NP) : "memory");
      else asm volatile("s_waitcnt vmcnt(0)" ::: "memory");
    }
    __builtin_amdgcn_s_barrier();
    asm volatile("" ::: "memory");
    if (kt + NS - 1 < ntile) GEMM_STAGE(nslot, kt + NS - 1);
    if (kt == ntile - 1) hook();
    const char* sb = lds + slot * STG;
    const char* sa = ARES ? ares + (NCH == 1 ? kt : kin) * (BM * RB) : sb;
    slot = slot + 1 == NS ? 0 : slot + 1;
    nslot = nslot + 1 == NS ? 0 : nslot + 1;
    if constexpr ((FLAGS & 4) != 0) {
      static_assert(BK == 64 && NI % 4 == 0, "fp8 path: 128-byte rows, column tiles in groups of 4");
      typedef int i32x4v __attribute__((ext_vector_type(4)));
      typedef int i32x8v __attribute__((ext_vector_type(8)));
      constexpr int ASC = (FLAGS & 8) ? 0x7b7b7b7b : (FLAGS & 16) ? 0x7c7c7c7c : 0x7f7f7f7f;
      i32x4v a0[MI], a1[MI];
#pragma unroll
      for (int mi = 0; mi < MI; ++mi) {
        a0[mi] = *(const i32x4v*)(sa + (aoff + mi * 16 * RB));
        a1[mi] = *(const i32x4v*)(sa + ((aoff ^ 64) + mi * 16 * RB));
      }
      constexpr int GW = NI > 4 ? 2 : 4, NG8 = NI / GW;
      i32x4v b0[2][GW], b1[2][GW];
#pragma unroll
      for (int nj = 0; nj < GW; ++nj) {
        b0[0][nj] = *(const i32x4v*)(sb + (boff + nj * 16 * RB));
        b1[0][nj] = *(const i32x4v*)(sb + ((boff ^ 64) + nj * 16 * RB));
      }
      __builtin_amdgcn_sched_group_barrier(0x100, 2 * MI + 2 * GW, 0);
#pragma unroll
      for (int g = 0; g < NG8; ++g) {
        const int cur = g & 1, nxt = cur ^ 1;
        if (g + 1 < NG8) {
#pragma unroll
          for (int nj = 0; nj < GW; ++nj) {
            b0[nxt][nj] = *(const i32x4v*)(sb + (boff + ((g + 1) * GW + nj) * 16 * RB));
            b1[nxt][nj] = *(const i32x4v*)(sb + ((boff ^ 64) + ((g + 1) * GW + nj) * 16 * RB));
          }
          __builtin_amdgcn_sched_group_barrier(0x100, 2 * GW, 0);
        }
#pragma unroll
        for (int mi = 0; mi < MI; ++mi)
#pragma unroll
          for (int nj = 0; nj < GW; ++nj) {
            const i32x8v av = __builtin_shufflevector(a0[mi], a1[mi], 0, 1, 2, 3, 4, 5, 6, 7);
            const i32x8v bv = __builtin_shufflevector(b0[cur][nj], b1[cur][nj], 0, 1, 2, 3, 4, 5, 6, 7);
            acc[mi][g * GW + nj] = SWAP ? __builtin_amdgcn_mfma_scale_f32_16x16x128_f8f6f4(av, bv, acc[mi][g * GW + nj], 0, 0, 0, ASC, 0, 0x79797979)
                                        : __builtin_amdgcn_mfma_scale_f32_16x16x128_f8f6f4(bv, av, acc[mi][g * GW + nj], 0, 0, 0, 0x79797979, 0, ASC);
          }
        __builtin_amdgcn_sched_group_barrier(0x008, MI * GW, 0);
      }
    } else {
    constexpr int NG = NI / 4, NGT = KS * NG;
    bf16x8 af[KS][MI], bfr[2][4];
#pragma unroll
    for (int mi = 0; mi < MI; ++mi) af[0][mi] = *(const bf16x8*)(sa + (aoff + mi * 16 * RB));
#pragma unroll
    for (int nj = 0; nj < 4; ++nj) bfr[0][nj] = *(const bf16x8*)(sb + (boff + nj * 16 * RB));
    __builtin_amdgcn_sched_group_barrier(0x100, MI + 4, 0);
#pragma unroll
    for (int gi = 0; gi < NGT; ++gi) {
      const int ks = gi / NG, g = gi % NG, cur = gi & 1, nxt = cur ^ 1;
      if (gi + 1 < NGT) {
        const int ks2 = (gi + 1) / NG, g2 = (gi + 1) % NG;
#pragma unroll
        for (int nj = 0; nj < 4; ++nj) bfr[nxt][nj] = *(const bf16x8*)(sb + ((boff ^ (ks2 * 64)) + (g2 * 4 + nj) * 16 * RB));
        if (ks2 != ks) {
#pragma unroll
          for (int mi = 0; mi < MI; ++mi) af[ks2 % KS][mi] = *(const bf16x8*)(sa + ((aoff ^ (ks2 * 64)) + mi * 16 * RB));
          __builtin_amdgcn_sched_group_barrier(0x100, MI + 4, 0);
        } else {
          __builtin_amdgcn_sched_group_barrier(0x100, 4, 0);
        }
      }
#pragma unroll
      for (int mi = 0; mi < MI; ++mi)
#pragma unroll
        for (int nj = 0; nj < 4; ++nj)
          acc[mi][g * 4 + nj] = SWAP ? __builtin_amdgcn_mfma_f32_16x16x32_bf16(af[ks][mi], bfr[cur][nj], acc[mi][g * 4 + nj], 0, 0, 0)
                                     : __builtin_amdgcn_mfma_f32_16x16x32_bf16(bfr[cur][nj], af[ks][mi], acc[mi][g * 4 + nj], 0, 0, 0);
      __builtin_amdgcn_sched_group_barrier(0x008, MI * 4, 0);
    }
    }
    if (NCH > 1) {
      if (++kin == nk) {
        kin = 0;
        epi(acc, chunk, wr, wc, fr, fq);
        ++chunk;
#pragma unroll
        for (int mi = 0; mi < MI; ++mi)
#pragma unroll
          for (int ni = 0; ni < NI; ++ni) acc[mi][ni] = (f32x4){0.f, 0.f, 0.f, 0.f};
      }
    }
  }
#undef GEMM_STAGE
  if (FLAGS & 2) __syncthreads();
  if (NCH == 1) epi(acc, 0, wr, wc, fr, fq);
  __syncthreads();
}


template <int BN, int NPRE, class FB>
DI void gemm_prestage_b(char* lds, size_t bks, FB rowB) {
  const int tid = otid(), wid = tid >> 6, lane = tid & 63;
  const int lrow = lane >> 3, pc = lane & 7;
  char* ldst = lds + wid * 1024 + lane * 16;
#pragma unroll
  for (int s = 0; s < NPRE; ++s)
#pragma unroll
    for (int i = 0; i < BN / 64; ++i) {
      const int r = (wid + 8 * i) * 8 + lrow;
      const bf16_t* bp = rowB(r) + ((pc ^ ((r >> 1) & 7)) * 8);
      __builtin_amdgcn_global_load_lds((const unsigned*)(bp + s * bks), (unsigned*)(ldst + s * (BN * 128) + i * 8192), 16, 0, 0);
    }
}

template <int WM, int WN, int MI, int NI, bool SWAP, bool NOSTAGE = false, class FA, class FB, class EPI>
DI void gemm_tile_stag(char* lds, int nk, size_t bks, FA rowA, FB rowB, EPI epi) {
  constexpr int BK = 32, BM = WM * MI * 16, BN = WN * NI * 16;
  constexpr int RB = BK * 2, CPR = RB / 16, RPP = 1024 / RB;
  constexpr int PA = BM / RPP / 8, PB = BN / RPP / 8, NP = PA + PB, STG = (BM + BN) * RB;
  const int tid = otid(), wid = tid >> 6, lane = tid & 63, fr = lane & 15, fq = lane >> 4;
  const int wr = wid / WN, wc = wid % WN;
  const int lrow = lane / CPR, pc = lane % CPR;
  const bf16_t* ap[PA];
  const bf16_t* bp[PB];
#pragma unroll
  for (int i = 0; i < PA; ++i) { const int r = (wid + 8 * i) * RPP + lrow; ap[i] = rowA(r) + ((pc ^ ((-(r >> 2)) & 3)) * 8); }
#pragma unroll
  for (int i = 0; i < PB; ++i) { const int r = (wid + 8 * i) * RPP + lrow; bp[i] = rowB(r) + ((pc ^ ((-(r >> 2)) & 3)) * 8); }
  char* ldst = lds + wid * 1024 + lane * 16;
  f32x4 acc[MI][NI];
#pragma unroll
  for (int mi = 0; mi < MI; ++mi)
#pragma unroll
    for (int ni = 0; ni < NI; ++ni) acc[mi][ni] = (f32x4){0.f, 0.f, 0.f, 0.f};
  const int swf = (-(fr >> 2)) & 3;
  const int aoff = (wr * MI * 16 + fr) * RB + ((fq ^ swf) * 16);
  const int boff = BM * RB + (wc * NI * 16 + fr) * RB + ((fq ^ swf) * 16);
#define STAG_STAGE(s, t)                                                                                              \
  do {                                                                                                                \
    _Pragma("unroll") for (int i = 0; i < PA; ++i) __builtin_amdgcn_global_load_lds(                                  \
        (const unsigned*)(ap[i] + (t) * BK), (unsigned*)(ldst + (s) * STG + i * 8192), 16, 0, 0);                     \
    _Pragma("unroll") for (int i = 0; i < PB; ++i) __builtin_amdgcn_global_load_lds(                                  \
        (const unsigned*)(bp[i] + (t) * bks), (unsigned*)(ldst + (s) * STG + BM * RB + i * 8192), 16, 0, 0);          \
  } while (0)
  const int hb = __builtin_amdgcn_readfirstlane(wid >> 2);
  STAG_STAGE(0, 0);
  if (1 < nk) { STAG_STAGE(1, 1); asm volatile("s_waitcnt vmcnt(%0)" ::"n"(NP) : "memory"); }
  else asm volatile("s_waitcnt vmcnt(0)" ::: "memory");
  __builtin_amdgcn_s_barrier();
  asm volatile("" ::: "memory");
  if (hb) { __builtin_amdgcn_s_barrier(); asm volatile("" ::: "memory"); }
  for (int kt = 0; kt < nk; ++kt) {
    const char* sb = lds + (kt & 3) * STG;
    bf16x8 af[MI], bfr[NI];
#pragma unroll
    for (int mi = 0; mi < MI; ++mi) af[mi] = *(const bf16x8*)(sb + (aoff + mi * 16 * RB));
#pragma unroll
    for (int ni = 0; ni < NI; ++ni) bfr[ni] = *(const bf16x8*)(sb + (boff + ni * 16 * RB));
    if (!NOSTAGE && kt + 2 < nk) STAG_STAGE((kt + 2) & 3, kt + 2);
    if (hb) {
      if (kt + 2 < nk) asm volatile("s_waitcnt vmcnt(%0)" ::"n"(NP) : "memory");
      else asm volatile("s_waitcnt vmcnt(0)" ::: "memory");
    }
    __builtin_amdgcn_s_barrier();
    asm volatile("" ::: "memory");
    __builtin_amdgcn_s_setprio(1);
#pragma unroll
    for (int mi = 0; mi < MI; ++mi)
#pragma unroll
      for (int ni = 0; ni < NI; ++ni)
        acc[mi][ni] = SWAP ? __builtin_amdgcn_mfma_f32_16x16x32_bf16(af[mi], bfr[ni], acc[mi][ni], 0, 0, 0)
                           : __builtin_amdgcn_mfma_f32_16x16x32_bf16(bfr[ni], af[mi], acc[mi][ni], 0, 0, 0);
    __builtin_amdgcn_s_setprio(0);
    if (!hb) {
      if (kt + 2 < nk) asm volatile("s_waitcnt vmcnt(%0)" ::"n"(NP) : "memory");
      else asm volatile("s_waitcnt vmcnt(0)" ::: "memory");
    }
    __builtin_amdgcn_s_barrier();
    asm volatile("" ::: "memory");
  }
  if (!hb) { __builtin_amdgcn_s_barrier(); asm volatile("" ::: "memory"); }
#undef STAG_STAGE
  epi(acc, 0, wr, wc, fr, fq);
  __syncthreads();
}

struct ConvT { const float* src; bf16_t* dst; int ldn, N, K, k0, n0, bkl, npad, f8; };
DI ConvT conv_desc(const P& q, int tile) {
  constexpr int nA = 2 * 257 * 128, nB = 2 * 257 * 64, nC = 2 * 16 * 44, nD = 2 * 16 * 16;
  const W w{q.ws, q.out};
  ConvT c;
  c.f8 = 0;
  int t = tile;
  if (t < nA) {
    const int m = t / 128, r = t % 128, l = m / 257, e = m % 257;
    c.src = e < 256 ? q.w_e_in + (size_t)(l * 256 + e) * 1024 * 512 : q.w_sh_in + (size_t)l * 1024 * 512;
    c.dst = (bf16_t*)((char*)w.wei_t() + (size_t)m * 512 * 1024); c.ldn = 512; c.N = 512; c.K = 1024; c.bkl = 128; c.npad = 512; c.k0 = (r / 8) * 64; c.n0 = (r % 8) * 64; c.f8 = 1;
    return c;
  }
  t -= nA;
  if (t < nB) {
    const int m = t / 64, r = t % 64, l = m / 257, e = m % 257;
    c.src = e < 256 ? q.w_e_down + (size_t)(l * 256 + e) * 256 * 1024 : q.w_sh_down + (size_t)l * 256 * 1024;
    c.dst = (bf16_t*)((char*)w.wed_t() + (size_t)m * 1024 * 256); c.ldn = 1024; c.N = 1024; c.K = 256; c.bkl = 128; c.npad = 1024; c.k0 = (r / 16) * 64; c.n0 = (r % 16) * 64; c.f8 = 1;
    return c;
  }
  t -= nB;
  if (t < nC) {
    const int l = t / 704, r = t % 704;
    c.src = q.w_in + (size_t)l * 1024 * INW; c.dst = (bf16_t*)((char*)w.win_t() + (size_t)l * INWP * 1024); c.ldn = INW; c.N = INW; c.K = 1024; c.bkl = 128; c.npad = INWP; c.f8 = 1;
    c.k0 = (r / 44) * 64; c.n0 = (r % 44) * 64;
    return c;
  }
  t -= nC;
  if (t < nD) {
    const int l = t / 256, r = t % 256;
    c.src = q.w_out + (size_t)l * 1024 * 1024; c.dst = (bf16_t*)((char*)w.wout_t() + (size_t)l * 1024 * 1024); c.ldn = 1024; c.N = 1024; c.K = 1024; c.bkl = 128; c.npad = 1024; c.f8 = 1;
    c.k0 = (r / 16) * 64; c.n0 = (r % 16) * 64;
    return c;
  }
  t -= nD;
  {
    const int l = t / 64, r = t % 64;
    c.src = q.w_router + (size_t)l * 1024 * 256; c.dst = w.wr_t() + (size_t)l * 256 * 1024; c.ldn = 256; c.N = 256; c.K = 1024; c.bkl = 32; c.npad = 256;
    c.k0 = (r / 4) * 64; c.n0 = (r % 4) * 64;
  }
  return c;
}

DI void conv_store(const ConvT& c, uint4 v, int rn, int rks) {
  const int kk = c.k0 + rks * 2;
  if (c.f8) {
    const float4 lo = unpack4(make_uint2(v.x, v.y)), hi = unpack4(make_uint2(v.z, v.w));
    const int w0 = pack_fp8x4(lo.x * 64.f, lo.y * 64.f, lo.z * 64.f, lo.w * 64.f);
    const int w1 = pack_fp8x4(hi.x * 64.f, hi.y * 64.f, hi.z * 64.f, hi.w * 64.f);
    char* d8 = (char*)c.dst + (size_t)(kk / c.bkl) * c.npad * c.bkl + (size_t)(c.n0 + rn) * c.bkl + (kk % c.bkl);
    *(uint2*)d8 = make_uint2((unsigned)w0, (unsigned)w1);
  } else {
    *(uint4*)(c.dst + (size_t)(kk / c.bkl) * c.npad * c.bkl + (size_t)(c.n0 + rn) * c.bkl + (kk % c.bkl)) = v;
  }
}

DI void conv_fetch(const P& q, int tile, int nblk, int total, int kp, int ns, float4& a0, float4& b0, float4& a1, float4& b1) {
  const ConvT c0 = conv_desc(q, min(tile, total - 1));
  const ConvT c1 = conv_desc(q, min(tile + nblk, total - 1));
  const int col0 = min(c0.n0 + ns, c0.N - 4), col1 = min(c1.n0 + ns, c1.N - 4);
  a0 = *(const float4*)(c0.src + (size_t)(c0.k0 + 2 * kp) * c0.ldn + col0);
  b0 = *(const float4*)(c0.src + (size_t)(c0.k0 + 2 * kp + 1) * c0.ldn + col0);
  a1 = *(const float4*)(c1.src + (size_t)(c1.k0 + 2 * kp) * c1.ldn + col1);
  b1 = *(const float4*)(c1.src + (size_t)(c1.k0 + 2 * kp + 1) * c1.ldn + col1);
}

DI void phase_convert(const P& q, char* lds, int bid, int nblk) {
  constexpr int total = 2 * 257 * 128 + 2 * 257 * 64 + 2 * 16 * 44 + 2 * 16 * 16 + 2 * 16 * 4;
  const int t = otid();
  const int kp = t >> 4, ns = (t & 15) * 4, rn = t >> 3, rks = (t & 7) * 4;
  int par = 0;
  auto process = [&](int tile, const float4& a0, const float4& b0, const float4& a1, const float4& b1) {
    const bool two = tile + 1 < total;
    const ConvT c0 = conv_desc(q, tile);
    const ConvT c1 = conv_desc(q, two ? tile + 1 : tile);
    unsigned* T0 = (unsigned*)lds + par * (2 * 64 * 33);
    unsigned* T1 = T0 + 64 * 33;
    par ^= 1;
    const unsigned k0m = c0.n0 + ns < c0.N ? 0xffffffffu : 0u, k1m = c1.n0 + ns < c1.N ? 0xffffffffu : 0u;
    T0[(ns + 0) * 33 + kp] = pack2(a0.x, b0.x) & k0m; T0[(ns + 1) * 33 + kp] = pack2(a0.y, b0.y) & k0m;
    T0[(ns + 2) * 33 + kp] = pack2(a0.z, b0.z) & k0m; T0[(ns + 3) * 33 + kp] = pack2(a0.w, b0.w) & k0m;
    T1[(ns + 0) * 33 + kp] = pack2(a1.x, b1.x) & k1m; T1[(ns + 1) * 33 + kp] = pack2(a1.y, b1.y) & k1m;
    T1[(ns + 2) * 33 + kp] = pack2(a1.z, b1.z) & k1m; T1[(ns + 3) * 33 + kp] = pack2(a1.w, b1.w) & k1m;
    __syncthreads();
    uint4 v;
    v.x = T0[rn * 33 + rks]; v.y = T0[rn * 33 + rks + 1]; v.z = T0[rn * 33 + rks + 2]; v.w = T0[rn * 33 + rks + 3];
    conv_store(c0, v, rn, rks);
    if (two) {
      v.x = T1[rn * 33 + rks]; v.y = T1[rn * 33 + rks + 1]; v.z = T1[rn * 33 + rks + 2]; v.w = T1[rn * 33 + rks + 3];
      conv_store(c1, v, rn, rks);
    }
  };
  float4 a0, b0, a1, b1, c0, d0, c1, d1, e0, f0, e1, f1, g0, h0, g1, h1;
  const int step = 2 * nblk;
  conv_fetch(q, 2 * bid, 1, total, kp, ns, a0, b0, a1, b1);
  conv_fetch(q, 2 * bid + step, 1, total, kp, ns, c0, d0, c1, d1);
  conv_fetch(q, 2 * bid + 2 * step, 1, total, kp, ns, e0, f0, e1, f1);
  for (int tile = 2 * bid; tile < total; tile += 4 * step) {
    conv_fetch(q, tile + 3 * step, 1, total, kp, ns, g0, h0, g1, h1);
    process(tile, a0, b0, a1, b1);
    if (tile + step >= total) break;
    conv_fetch(q, tile + 4 * step, 1, total, kp, ns, a0, b0, a1, b1);
    process(tile + step, c0, d0, c1, d1);
    if (tile + 2 * step >= total) break;
    conv_fetch(q, tile + 5 * step, 1, total, kp, ns, c0, d0, c1, d1);
    process(tile + 2 * step, e0, f0, e1, f1);
    if (tile + 3 * step >= total) break;
    conv_fetch(q, tile + 6 * step, 1, total, kp, ns, e0, f0, e1, f1);
    process(tile + 3 * step, g0, h0, g1, h1);
  }
  __syncthreads();
}

DI void phase_mod(const P& q, char* lds, int bid, int nblk) {
  float* sc = (float*)lds;
  float* red = sc + 9 * 1024;
  const int t = otid();
  for (int i = t; i < 9 * 1024; i += NTHR) {
    const int r = i >> 10, k = i & 1023;
    const float v = r < 8 ? q.c[r * 1024 + k] : q.c_ctx[k];
    sc[i] = siluf_(v);
  }
  __syncthreads();
  for (int u = bid; u < 2 * 96; u += nblk) {
    const int l = u / 96, n0 = (u % 96) * 64;
    const int col = t & 63, ksl = t >> 6;
    float a[9];
#pragma unroll
    for (int r = 0; r < 9; ++r) a[r] = 0.f;
    const float* w = q.w_mod + (size_t)l * 1024 * 6144 + n0 + col;
    for (int k = ksl * 128; k < ksl * 128 + 128; ++k) {
      const float wv = w[(size_t)k * 6144];
#pragma unroll
      for (int r = 0; r < 9; ++r) a[r] += sc[r * 1024 + k] * wv;
    }
#pragma unroll
    for (int r = 0; r < 9; ++r) red[(ksl * 9 + r) * 64 + col] = a[r];
    __syncthreads();
    for (int i = t; i < 9 * 64; i += NTHR) {
      const int r = i >> 6, cc = i & 63;
      float s = q.b_mod[l * 6144 + n0 + cc];
#pragma unroll
      for (int q = 0; q < 8; ++q) s += red[(q * 9 + r) * 64 + cc];
      ((W{q.ws, q.out, q.x, q.ctx}).mod())[(size_t)(l * 9 + r) * 6144 + n0 + cc] = s;
    }
    __syncthreads();
  }
  {
    const W w{q.ws, q.out};
    const int gt = bid * NTHR + t, gs = nblk * NTHR;
#define CPY(dst, srcp, n) for (int i = gt; i < (n); i += gs) (dst)[i] = (srcp)[i]
    CPY(w.g_mix(), q.g_mix, 2 * 1024); CPY(w.g_ffn(), q.g_ffn, 2 * 1024); CPY(w.g_final(), q.g_final, 1024);
    CPY(w.rpb(), q.rpb, 2 * 3720); CPY(w.w_pool(), q.w_pool, 2 * 4 * 4096); CPY(w.pool_scale(), q.pool_scale, 2 * 256);
    CPY(w.w_gate_f(), q.w_gate_f, 2 * 16 * 128); CPY(w.w_gate_b(), q.w_gate_b, 2 * 16 * 128);
    CPY(w.b_gate_f(), q.b_gate_f, 2 * 128); CPY(w.b_gate_b(), q.b_gate_b, 2 * 128);
    CPY(w.g_gla(), q.g_gla, 2 * 64); CPY(w.b_router(), q.b_router, 2 * 256);
#undef CPY
    for (int i = gt; i < 2 * 4 * 4096; i += gs) { const int lg = i >> 12, jj = (i >> 6) & 63, ii = i & 63; w.wpt()[i] = f2bf(q.w_pool[lg * 4096 + ii * 64 + jj]); }
  }
  if (bid == 0) {
    for (int i = t; i < 64 * 8; i += NTHR) {
      const int pos = i >> 3, j = i & 7;
      const float inv = powf(10000.f, -(float)j / 8.f);
      const float ang = (float)pos * inv;
      ((W{q.ws, q.out, q.x, q.ctx}).rope())[i * 2] = cosf(ang);
      ((W{q.ws, q.out, q.x, q.ctx}).rope())[i * 2 + 1] = sinf(ang);
    }
  }
}

DI void phase_norm0(const P& q, int bid, int nblk) {
  const W p{q.ws, q.out};
  const int wid = otid() >> 6, lane = otid() & 63;
  for (int row = bid * 8 + wid; row < MT; row += nblk * 8) {
    const float* src = row < MC ? q.ctx + (size_t)row * D : q.x + (size_t)(row - MC) * D;
    const float* m = p.mod() + (size_t)(mod_row(row)) * 6144;
    float4 v[4];
    float ss = 0.f;
#pragma unroll
    for (int i = 0; i < 4; ++i) {
      v[i] = *(const float4*)(src + i * 256 + lane * 4);
      ss += v[i].x * v[i].x + v[i].y * v[i].y + v[i].z * v[i].z + v[i].w * v[i].w;
    }
    ss = wave_sum(ss);
    const float rstd = rsqrtf(ss * (1.f / D) + EPS);
#pragma unroll
    for (int i = 0; i < 4; ++i) {
      const int cidx = i * 256 + lane * 4;
      const float4 gg = *(const float4*)(q.g_mix + cidx);
      const float4 sh = *(const float4*)(m + cidx);
      const float4 scl = *(const float4*)(m + 1024 + cidx);
      const float o0 = v[i].x * rstd * gg.x * (1.f + scl.x) + sh.x;
      const float o1 = v[i].y * rstd * gg.y * (1.f + scl.y) + sh.y;
      const float o2 = v[i].z * rstd * gg.z * (1.f + scl.z) + sh.z;
      const float o3 = v[i].w * rstd * gg.w * (1.f + scl.w) + sh.w;
      const int q8 = pack_fp8x4(o0, o1, o2, o3);
      *(int*)((char*)p.h() + (size_t)row * D + cidx) = q8;
    }
  }
}

DI void phase_norm(const W& p_, int layer, int row_lo, int bid, int nblk) {
  const W p = oq(p_);
  const int wid = otid() >> 6, lane = otid() & 63;
  const float* g = p.g_ffn() + layer * D;
  for (int row = row_lo + bid * 8 + wid; row < MT; row += nblk * 8) {
    const bf16_t* src = p.xres() + (size_t)row * D;
    const float* m = p.mod() + (size_t)(layer * 9 + mod_row(row)) * 6144 + 3072;
    float4 v[4];
    float ss = 0.f;
#pragma unroll
    for (int i = 0; i < 4; ++i) {
      v[i] = unpack4(*(const uint2*)(src + i * 256 + lane * 4));
      ss += v[i].x * v[i].x + v[i].y * v[i].y + v[i].z * v[i].z + v[i].w * v[i].w;
    }
    ss = wave_sum(ss);
    const float rstd = rsqrtf(ss * (1.f / D) + EPS);
#pragma unroll
    for (int i = 0; i < 4; ++i) {
      const int cidx = i * 256 + lane * 4;
      const float4 gg = *(const float4*)(g + cidx);
      const float4 sh = *(const float4*)(m + cidx);
      const float4 scl = *(const float4*)(m + 1024 + cidx);
      const float o0 = v[i].x * rstd * gg.x * (1.f + scl.x) + sh.x;
      const float o1 = v[i].y * rstd * gg.y * (1.f + scl.y) + sh.y;
      const float o2 = v[i].z * rstd * gg.z * (1.f + scl.z) + sh.z;
      const float o3 = v[i].w * rstd * gg.w * (1.f + scl.w) + sh.w;
      uint2 o; o.x = pack2(o0, o1); o.y = pack2(o2, o3);
      *(uint2*)(p.h2() + (size_t)row * D + cidx) = o;
      {
        const int q8 = pack_fp8x4(o0, o1, o2, o3);
        *(int*)(p.h2q() + (size_t)row * D + cidx) = q8;
      }
    }
  }
}

DI size_t hm_off(int row, int h) {
  if (row < MC) return ((size_t)(((row >> 8) * 8 + h) * NCTX + (row & 255))) * 64;
  const int r = row - MC;
  return HM_LAT + ((size_t)(((r >> 12) * 8 + h) * SEQ + (r & 4095))) * 64;
}
DI size_t vt_off(int row, int h, int d) {
  if (row < MC) { const int t = row & 255; return ((size_t)(((row >> 8) * 8 + h) * 4 + (t >> 6))) * 4096 + d * 64 + (t & 63); }
  const int r = row - MC, t = r & 4095;
  return HM_LAT + ((size_t)(((r >> 12) * 8 + h) * 64 + (t >> 6))) * 4096 + d * 64 + (t & 63);
}
DI size_t vtg_off(int row, int h, int v) {
  if (row < MC) { const int t = row & 255; return ((size_t)(((row >> 8) * 4 + h) * 4 + (t >> 6))) * 4096 + v * 64 + (t & 63); }
  const int r = row - MC, t = r & 4095;
  return HMG_LAT + ((size_t)(((r >> 12) * 4 + h) * 64 + (t >> 6))) * 4096 + v * 64 + (t & 63);
}

DI void phase_inproj(const W& p_, int layer, char* lds, int bid, int nblk) {
  const W p = oq(p_);
  constexpr int nM = MT / 256, nN = INWP / 256;
  const char* B8 = (const char*)p.win_t() + (size_t)layer * INWP * 1024;
  constexpr int NP1 = 6, U1 = nM * NP1;
  for (int u = vbid_of(bid, nblk); u < nM * nN; u += nblk) {
    const int pm = u < U1 ? u / NP1 : (u - U1) / (nN - NP1), pn = u < U1 ? u % NP1 : NP1 + (u - U1) % (nN - NP1);
    const int m0 = pm * 256, n0 = pn * 256;
    auto rowA = [&](int r) { return (const bf16_t*)((const char*)p.h() + (size_t)(m0 + r) * D); };
    auto rowB = [&](int r) { return (const bf16_t*)(B8 + (size_t)(n0 + r) * 128); };
    if (pn == 4 || pn == 5 || pn == 8) {
      auto rowAp = [&](int r) { return rowA((r & ~63) | ((r & 12) << 2) | ((r & 48) >> 2) | (r & 3)); };
      auto epi = [&](const f32x4 (&acc)[4][8], int, int wr, int wc, int fr, int fq) {
        const int row = m0 + wr * 64 + fq * 16;
#pragma unroll
        for (int ni = 0; ni < 8; ++ni) {
          uint4 lo, hi;
          lo.x = pack2(acc[0][ni][0], acc[0][ni][1]); lo.y = pack2(acc[0][ni][2], acc[0][ni][3]);
          lo.z = pack2(acc[1][ni][0], acc[1][ni][1]); lo.w = pack2(acc[1][ni][2], acc[1][ni][3]);
          hi.x = pack2(acc[2][ni][0], acc[2][ni][1]); hi.y = pack2(acc[2][ni][2], acc[2][ni][3]);
          hi.z = pack2(acc[3][ni][0], acc[3][ni][1]); hi.w = pack2(acc[3][ni][2], acc[3][ni][3]);
          bf16_t* dst;
          if (pn == 8) {
            const int col = wc * 128 + ni * 16 + fr;
            dst = p.vtg() + vtg_off(row, col >> 6, col & 63);
          } else {
            const int col = n0 + wc * 128 + ni * 16 + fr - 1024;
            dst = p.vt() + vt_off(row, col >> 6, col & 63);
          }
          *(uint4*)dst = lo; *(uint4*)(dst + 8) = hi;
        }
      };
      gemm_tile<4, 2, 4, 8, 64, 2, true, 1, 4>(lds, 8, 0, (size_t)INWP * 64, rowAp, rowB, epi);
    } else {
      auto rowBp = [&](int r) { return rowB((r & ~127) | ((r & 12) << 3) | ((r & 112) >> 2) | (r & 3)); };
      auto epi = [&](const f32x4 (&acc)[4][8], int, int wr, int wc, int fr, int fq) {
#pragma unroll
        for (int mi = 0; mi < 4; ++mi) {
          const int row = m0 + wr * 64 + mi * 16 + fr;
#pragma unroll
          for (int np = 0; np < 4; ++np) {
            const int col = n0 + wc * 128 + fq * 32 + np * 8;
            const f32x4 v0 = acc[mi][2 * np], v1 = acc[mi][2 * np + 1];
            if (pn < 2) {
              constexpr float QS = 0.125f * 1.4426950408889634f;
              uint4 o; o.x = pack2(v0[0] * QS, v0[1] * QS); o.y = pack2(v0[2] * QS, v0[3] * QS); o.z = pack2(v1[0] * QS, v1[1] * QS); o.w = pack2(v1[2] * QS, v1[3] * QS);
              *(uint4*)(p.qh() + hm_off(row, col >> 6) + (col & 63)) = o;
            } else if (pn < 4) {
              const int c2 = col - 512;
              uint4 o; o.x = pack2(v0[0], v0[1]); o.y = pack2(v0[2], v0[3]); o.z = pack2(v1[0], v1[1]); o.w = pack2(v1[2], v1[3]);
              *(uint4*)(p.kh() + hm_off(row, c2 >> 6) + (c2 & 63)) = o;
            } else if (col < INW) {
              uint4 o; o.x = pack2(v0[0], v0[1]); o.y = pack2(v0[2], v0[3]); o.z = pack2(v1[0], v1[1]); o.w = pack2(v1[2], v1[3]);
              *(uint4*)(p.px() + (size_t)row * INW + col) = o;
            }
          }
        }
      };
      gemm_tile<4, 2, 4, 8, 64, 2, false, 1, 4>(lds, 8, 0, (size_t)INWP * 64, rowA, rowBp, epi);
    }
  }
}


#ifndef PROBE_GEMM
#define PROBE_GEMM 0
#endif
#if PROBE_GEMM
DI void phase_probe_gemm(const W& p_, char* lds, int bid, int nblk) {
  const W p = oq(p_);
  constexpr int nM = MT / 256, nN = INWP / 256;
  const bf16_t* Bt = p.win_t();
  for (int u = bid; u < nM * nN; u += nblk) {
    const int pm = u / nN, pn = u % nN, m0 = pm * 256, n0 = pn * 256;
    auto rowA = [&](int r) { return p.h() + (size_t)(m0 + r) * D; };
    auto rowB = [&](int r) { return Bt + (size_t)(n0 + r) * 32; };
    auto epi = [&](const f32x4 (&acc)[4][8], int, int wr, int wc, int fr, int fq) {
#pragma unroll
      for (int mi = 0; mi < 4; ++mi) {
        const int row = m0 + wr * 64 + mi * 16 + fr;
#pragma unroll
        for (int ni = 0; ni < 8; ++ni) {
          const int col = n0 + wc * 128 + ni * 16 + 4 * fq;
          uint2 o; o.x = pack2(acc[mi][ni][0], acc[mi][ni][1]); o.y = pack2(acc[mi][ni][2], acc[mi][ni][3]);
          *(uint2*)(p.y() + (size_t)row * INWP + col) = o;
        }
      }
    };
#if PROBE_GEMM == 4
    gemm_tile_stag<4, 2, 4, 8, false, true>(lds, 32, (size_t)INWP * 32, rowA, rowB, epi);
#elif PROBE_GEMM == 5
    gemm_tile_stag<4, 2, 4, 8, false, false>(lds, 32, (size_t)INWP * 32, rowA, rowB, epi);
#else
    gemm_tile<4, 2, 4, 8, 32, 4, false, 1>(lds, 32, 0, (size_t)INWP * 32, rowA, rowB, epi);
#endif
  }
}
#endif

template <bool DUMMY>
DI void phase_outproj_t(const W& p_, int layer, char* lds, int row_lo, int bid, int nblk) {
  const W p = oq(p_);
  bf16_t* xres_w = DUMMY ? (bf16_t*)((char*)p.y() + (size_t)9 * MT * 1024) : p.xres();
  const int nM = (MT - row_lo) / 256, nN = 4;
  const char* B8 = (const char*)p.wout_t() + (size_t)layer * 1024 * 1024;
  for (int u = vbid_of(bid, nblk); u < nM * nN; u += nblk) {
    const int pm = u / nN, pn = u % nN, m0 = row_lo + pm * 256, n0 = pn * 256;
    auto rowA = [&](int r) { return (const bf16_t*)((const char*)p.cat() + (size_t)(m0 + r) * D); };
    auto rowB = [&](int r) { return (const bf16_t*)(B8 + (size_t)(n0 + r) * 128); };
    auto rowBp = [&](int r) { return rowB((r & ~127) | ((r & 12) << 3) | ((r & 112) >> 2) | (r & 3)); };
    auto epi = [&](const f32x4 (&acc)[4][8], int, int wr, int wc, int fr, int fq) {
#pragma unroll
      for (int mi = 0; mi < 4; ++mi) {
        const int row = m0 + wr * 64 + mi * 16 + fr;
        const float* xin = row < MC ? p.ctx + (size_t)row * D : p.x + (size_t)(row - MC) * D;
        const float* gate = p.mod() + (size_t)(layer * 9 + mod_row(row)) * 6144 + 2048;
#pragma unroll
        for (int np = 0; np < 4; ++np) {
          const int col = n0 + wc * 128 + fq * 32 + np * 8;
          const f32x4 v0 = acc[mi][2 * np], v1 = acc[mi][2 * np + 1];
          float4 xa, xb;
          if (layer == 0) {
            xa = *(const float4*)(xin + col); xb = *(const float4*)(xin + col + 4);
          } else {
            const uint4 xr = *(const uint4*)(p.xres() + (size_t)row * D + col);
            xa = unpack4(make_uint2(xr.x, xr.y)); xb = unpack4(make_uint2(xr.z, xr.w));
          }
          const float4 ga = *(const float4*)(gate + col), gb = *(const float4*)(gate + col + 4);
          uint4 o;
          o.x = pack2(xa.x + ga.x * v0[0], xa.y + ga.y * v0[1]); o.y = pack2(xa.z + ga.z * v0[2], xa.w + ga.w * v0[3]);
          o.z = pack2(xb.x + gb.x * v1[0], xb.y + gb.y * v1[1]); o.w = pack2(xb.z + gb.z * v1[2], xb.w + gb.w * v1[3]);
          *(uint4*)(xres_w + (size_t)row * D + col) = o;
        }
      }
    };
    gemm_tile<4, 2, 4, 8, 64, 2, false, 1, 4 | 16>(lds, 8, 0, (size_t)1024 * 64, rowA, rowBp, epi);
  }
}
DI void phase_outproj(const W& p, int layer, char* lds, int row_lo, int bid, int nblk) { phase_outproj_t<false>(p, layer, lds, row_lo, bid, nblk); }

DI void moe_unit(const W& p, int layer, char* lds, int e, const int* s_rows);
DI int moe_early_shared(int mrows, int nblk);
DI void phase_router(const W& p_, int layer, char* lds, int row_lo, int bid, int nblk) {
  const W p = oq(p_);
  const int nM = (MT - row_lo) / 256;
  const bf16_t* Bt = p.wr_t() + (size_t)layer * 256 * 1024;
  const int sh0 = moe_early_shared(MT - row_lo, nblk);
  for (int u = vbid_of(bid, nblk); u < nM + sh0; u += nblk) {
    if (u >= nM) {
      int* s_rows = (int*)(lds + 144 * 1024) + 1024;
      __syncthreads();
      if (otid() < 256) s_rows[otid()] = 8 * MT + row_lo + (u - nM) * 256 + otid();
      __syncthreads();
      moe_unit(p, layer, lds, NE, s_rows);
      continue;
    }
    const int m0 = row_lo + u * 256;
    auto rowA = [&](int r) { return p.h2() + (size_t)(m0 + r) * D; };
    auto rowB = [&](int r) { return Bt + (size_t)r * 32; };
    auto epi = [&](const f32x4 (&acc)[4][8], int, int wr, int wc, int fr, int fq) {
#pragma unroll
      for (int mi = 0; mi < 4; ++mi) {
        const int row = m0 + wr * 64 + mi * 16 + fr;
#pragma unroll
        for (int ni = 0; ni < 8; ++ni) {
          const int col = wc * 128 + ni * 16 + 4 * fq;
          *(f32x4*)(p.logits() + (size_t)row * 256 + col) = acc[mi][ni];
        }
      }
    };
    gemm_tile_stag<4, 2, 4, 8, false>(lds, 32, (size_t)256 * 32, rowA, rowB, epi);
  }
}

DI void phase_route(const W& p_, int layer, char* lds, int row_lo, int bid, int nblk) {
  const W p = oq(p_);
  int* lcnt = (int*)lds;
  int* lbase = lcnt + 256;
  int* ent = lbase + 256;
  const int tid = otid(), wid = tid >> 6, lane = tid & 63;
  const int nrows = MT - row_lo;
  const int CHT = (nrows % nblk == 0 && nrows / nblk <= 160) ? nrows / nblk : 128;
  const int nch = nrows / CHT;
  const float NEG = -__builtin_inff();
  for (int ch = bid; ch < nch; ch += nblk) {
    if (tid < 256) lcnt[tid] = 0;
    __syncthreads();
    for (int i = wid; i < CHT; i += 8) {
      const int row = row_lo + ch * CHT + i;
      const float4 lg = *(const float4*)(p.logits() + (size_t)row * 256 + lane * 4);
      const float4 br = *(const float4*)(p.b_router() + layer * 256 + lane * 4);
      float sc[4] = {sigmoidf_(lg.x), sigmoidf_(lg.y), sigmoidf_(lg.z), sigmoidf_(lg.w)};
      float v[4] = {sc[0] + br.x, sc[1] + br.y, sc[2] + br.z, sc[3] + br.w};
      float m1 = NEG, m2 = NEG;
#pragma unroll
      for (int j = 0; j < 4; ++j) { if (v[j] > m1) { m2 = m1; m1 = v[j]; } else if (v[j] > m2) m2 = v[j]; }
      {
        float o1 = dppf<0xB1>(m1), o2 = dppf<0xB1>(m2);
        float n1 = fmaxf(m1, o1), n2 = fmaxf(fminf(m1, o1), fmaxf(m2, o2));
        m1 = n1; m2 = n2;
        o1 = dppf<0x4E>(m1); o2 = dppf<0x4E>(m2);
        n1 = fmaxf(m1, o1); n2 = fmaxf(fminf(m1, o1), fmaxf(m2, o2));
        m1 = n1; m2 = n2;
        o1 = dppf<0x141>(m1); o2 = dppf<0x141>(m2);
        n1 = fmaxf(m1, o1); n2 = fmaxf(fminf(m1, o1), fmaxf(m2, o2));
        m1 = n1; m2 = n2;
      }
      const float gs = m1 + m2;
      const int g = lane >> 3;
      int rank = 0;
#pragma unroll
      for (int gg = 0; gg < 8; ++gg) { const float og = rlanef(gs, gg * 8); rank += (og > gs || (og == gs && gg < g)) ? 1 : 0; }
      if (rank >= 4) { v[0] = NEG; v[1] = NEG; v[2] = NEG; v[3] = NEG; }
      float ssum = 0.f, my_s = 0.f; int my_e = 0;
#pragma unroll
      for (int k = 0; k < 8; ++k) {
        float bv = v[0]; int bj = 0;
#pragma unroll
        for (int j = 1; j < 4; ++j) if (v[j] > bv) { bv = v[j]; bj = j; }
        const float wm = wave_max_dpp(bv);
        const unsigned long long bal = __ballot(bv == wm);
        const int win = __builtin_amdgcn_readfirstlane(__ffsll((long long)bal) - 1);
        const float mysc = bj == 0 ? sc[0] : bj == 1 ? sc[1] : bj == 2 ? sc[2] : sc[3];
        const int ej = __builtin_amdgcn_readlane(bj, win);
        const float su = rlanef(mysc, win);
        if (lane == win) {
#pragma unroll
          for (int j = 0; j < 4; ++j) if (j == bj) v[j] = NEG;
        }
        ssum += su;
        if (lane == k) { my_e = win * 4 + ej; my_s = su; }
      }
      if (lane < 8) {
        const int lpos = atomicAdd(&lcnt[my_e], 1);
        ent[i * 8 + lane] = my_e | (lpos << 8);
        p.wts()[(size_t)row * 8 + lane] = my_s / ssum * 2.5f;
      }
    }
    __syncthreads();
    if (tid < 256) { const int cc = lcnt[tid]; lbase[tid] = cc ? atomicAdd(&p.cnt()[layer * 256 + tid], cc) : 0; }
    __syncthreads();
    for (int j = tid; j < CHT * 8; j += NTHR) {
      const int e = ent[j] & 255, lpos = ent[j] >> 8;
      const int row = row_lo + ch * CHT + (j >> 3);
      p.lists()[(size_t)e * CAP + lbase[e] + lpos] = row * 8 + (j & 7);
    }
    __syncthreads();
  }
}

DI void moe_prefix(const W& p, int layer, int mrows, int* s_pref) {
  int* s_tmp = s_pref + 400;
  const int t = otid();
  __syncthreads();
  if (t < 272) {
    int c = 0;
    if (t < NE) c = (p.cnt()[layer * 256 + t] + 255) >> 8;
    else if (t == NE) c = (mrows + 255) >> 8;
    s_tmp[t] = c;
  }
  __syncthreads();
  int cur = 0;
  for (int off = 1; off < 272; off <<= 1) {
    if (t < 272) s_tmp[(cur ^ 1) * 272 + t] = s_tmp[cur * 272 + t] + (t >= off ? s_tmp[cur * 272 + t - off] : 0);
    cur ^= 1;
    __syncthreads();
  }
  if (t <= NE1) s_pref[t] = t == 0 ? 0 : s_tmp[cur * 272 + t - 1];
  __syncthreads();
}
DI int moe_find(const int* s_pref, int ti) {
  int lo = 0, hi = NE1;
  while (hi - lo > 1) { const int mid = (lo + hi) >> 1; if (s_pref[mid] <= ti) lo = mid; else hi = mid; }
  return lo;
}
DI void moe_rows(const W& p, int layer, int e, int mt, int row_lo, int mrows, int* s_rows) {
  const int t = otid();
  if (t < 128) {
    const int cnt = e < NE ? p.cnt()[layer * 256 + e] : mrows;
    const int r = mt * 128 + t;
    int idx = -1;
    if (r < cnt) idx = e < NE ? p.lists()[(size_t)e * CAP + r] : 8 * MT + row_lo + r;
    s_rows[t] = idx;
  }
  __syncthreads();
}

DI void moe_unit(const W& p, int layer, char* lds, int e, const int* s_rows) {
  const int idx0 = s_rows[0];
  {
    const char* B8 = (const char*)p.wei_t() + (size_t)(layer * NE1 + e) * 512 * 1024;
    auto rowA = [&](int r) {
      int idx = s_rows[r]; if (idx < 0) idx = idx0;
      const int tok = idx < 8 * MT ? (idx >> 3) : idx - 8 * MT;
      return (const bf16_t*)(p.h2q() + (size_t)tok * D);
    };
    auto rowB = [&](int r) {
      const int wq = r >> 7, w = r & 127;
      const int n = w < 64 ? wq * 64 + w : 256 + wq * 64 + (w - 64);
      return (const bf16_t*)(B8 + (size_t)n * 128);
    };
    int stash[4][4];
    auto epi = [&](const f32x4 (&acc)[4][8], int chunk, int wr, int wc, int fr, int fq) {
      int cur[4][4];
#pragma unroll
      for (int mi = 0; mi < 4; ++mi)
#pragma unroll
        for (int ni = 0; ni < 4; ++ni) {
          float o[4];
#pragma unroll
          for (int j = 0; j < 4; ++j) o[j] = siluf_(acc[mi][ni][j]) * acc[mi][ni + 4][j] * 16.f;
          cur[mi][ni] = pack_fp8x4(o[0], o[1], o[2], o[3]);
        }
      if (chunk == 0) {
#pragma unroll
        for (int mi = 0; mi < 4; ++mi)
#pragma unroll
          for (int ni = 0; ni < 4; ++ni) stash[mi][ni] = cur[mi][ni];
      } else {
        __syncthreads();
#pragma unroll
        for (int c2 = 0; c2 < 2; ++c2)
#pragma unroll
          for (int mi = 0; mi < 4; ++mi) {
            const int row = wr * 64 + mi * 16 + fr;
#pragma unroll
            for (int ni = 0; ni < 4; ++ni) {
              const int ch = (wc * 4 + ni) ^ ((row >> 1) & 7);
              *(int*)(lds + c2 * 32768 + row * 128 + ch * 16 + 4 * fq) = c2 == 0 ? stash[mi][ni] : cur[mi][ni];
            }
          }
      }
    };
    gemm_tile<4, 2, 4, 8, 64, 2, false, 2, 4>(lds, 8, (size_t)128 * 64, (size_t)512 * 64, rowA, rowB, epi);
  }
  {
    const char* B8d = (const char*)p.wed_t() + (size_t)(layer * NE1 + e) * 1024 * 256;
    auto rowA = [&](int) { return (const bf16_t*)nullptr; };
    auto rowB2 = [&](int r) { return (const bf16_t*)(B8d + (size_t)((r & ~63) | ((r & 12) << 2) | ((r & 48) >> 2) | (r & 3)) * 128); };
    auto epi = [&](const f32x4 (&acc)[4][8], int nt, int wr, int wc, int fr, int fq) {
#pragma unroll
      for (int mi = 0; mi < 4; ++mi) {
        int dst = s_rows[wr * 64 + mi * 16 + fr];
        if (dst < 0) dst = 9 * MT + (int)blockIdx.x;
        {
          int4 lo, hi;
          lo.x = pack_fp8x4(acc[mi][0][0] * 16.f, acc[mi][0][1] * 16.f, acc[mi][0][2] * 16.f, acc[mi][0][3] * 16.f);
          lo.y = pack_fp8x4(acc[mi][1][0] * 16.f, acc[mi][1][1] * 16.f, acc[mi][1][2] * 16.f, acc[mi][1][3] * 16.f);
          lo.z = pack_fp8x4(acc[mi][2][0] * 16.f, acc[mi][2][1] * 16.f, acc[mi][2][2] * 16.f, acc[mi][2][3] * 16.f);
          lo.w = pack_fp8x4(acc[mi][3][0] * 16.f, acc[mi][3][1] * 16.f, acc[mi][3][2] * 16.f, acc[mi][3][3] * 16.f);
          hi.x = pack_fp8x4(acc[mi][4][0] * 16.f, acc[mi][4][1] * 16.f, acc[mi][4][2] * 16.f, acc[mi][4][3] * 16.f);
          hi.y = pack_fp8x4(acc[mi][5][0] * 16.f, acc[mi][5][1] * 16.f, acc[mi][5][2] * 16.f, acc[mi][5][3] * 16.f);
          hi.z = pack_fp8x4(acc[mi][6][0] * 16.f, acc[mi][6][1] * 16.f, acc[mi][6][2] * 16.f, acc[mi][6][3] * 16.f);
          hi.w = pack_fp8x4(acc[mi][7][0] * 16.f, acc[mi][7][1] * 16.f, acc[mi][7][2] * 16.f, acc[mi][7][3] * 16.f);
          char* yp = (char*)p.y() + (size_t)dst * D + nt * 256 + wc * 128 + fq * 16;
          *(int4*)yp = lo; *(int4*)(yp + 64) = hi;
        }
      }
    };
    gemm_tile<4, 2, 4, 8, 64, 2, false, 4, 1 | 4 | 8 | 32>(lds + 65536, 2, (size_t)256 * 64, (size_t)1024 * 64, rowA, rowB2, epi, lds);
  }
}

DI int moe_early_shared(int mrows, int nblk) {
  const int idle = nblk - mrows / 256;
  return idle <= 0 ? 0 : (idle < mrows / 256 ? idle : mrows / 256);
}

DI void phase_moe(const W& p_, int layer, char* lds, int row_lo, int bid, int nblk) {
  const W p = oq(p_);
  int* s_pref = (int*)(lds + 144 * 1024);
  int* s_rows = s_pref + 1024;
  const int mrows = MT - row_lo;
  const int sh0 = moe_early_shared(mrows, nblk);
  moe_prefix(p, layer, mrows - sh0 * 256, s_pref);
  const int total = s_pref[NE1];
  auto fetch_rows = [&](int uu) -> int {
    int idx = -1;
    const int t = otid();
    if (uu < total && t < 256) {
      const int e2 = moe_find(s_pref, uu), mt2 = uu - s_pref[e2];
      if (e2 < NE) {
        const int cnt = p.cnt()[layer * 256 + e2];
        const int r = mt2 * 256 + t;
        if (r < cnt) idx = p.lists()[(size_t)e2 * CAP + r];
      } else {
        idx = 8 * MT + row_lo + (mt2 + sh0) * 256 + t;
      }
    }
    return idx;
  };
  int pre = fetch_rows(vbid_of(bid, nblk));
  for (int u = vbid_of(bid, nblk); u < total; u += nblk) {
    const int e = moe_find(s_pref, u);
    if (otid() < 256) s_rows[otid()] = pre;
    __syncthreads();
    pre = fetch_rows(u + nblk);
    moe_unit(p, layer, lds, e, s_rows);
  }
}

template <bool DUMMY>
DI void phase_combine_t(const W& p_, int layer, int row_lo, int bid, int nblk) {
  const W p = oq(p_);
  char* scratch = (char*)p.y() + (size_t)9 * MT * 1024;
  bf16_t* xres_w = DUMMY ? (bf16_t*)scratch : p.xres();
  bf16_t* h_w = DUMMY ? p.act() : p.h();
  float* out_w = DUMMY ? (float*)(scratch + ((size_t)128 << 20)) : p.out;
  const int wid = otid() >> 6, lane = otid() & 63;
  const bool last = layer == 1;
  for (int row = row_lo + bid * 8 + wid; row < MT; row += nblk * 8) {
    const float* m = p.mod() + (size_t)(layer * 9 + mod_row(row)) * 6144;
    float w[8];
#pragma unroll
    for (int k = 0; k < 8; ++k) w[k] = p.wts()[(size_t)row * 8 + k];
    float xn[16];
    float ss = 0.f;
#pragma unroll
    for (int i = 0; i < 4; ++i) {
      const int cidx = i * 256 + lane * 4;
      float a[4] = {0.f, 0.f, 0.f, 0.f};
#pragma unroll
      for (int k = 0; k < 9; ++k) {
        const size_t yr = k < 8 ? (size_t)row * 8 + k : (size_t)8 * MT + row;
        const int yv = *(const int*)((const char*)p.y() + yr * D + cidx);
        const float wk = (k < 8 ? w[k] : 1.f) * (1.f / 16.f);
        typedef float f32x2_ __attribute__((ext_vector_type(2)));
        const f32x2_ ylo = __builtin_amdgcn_cvt_pk_f32_fp8(yv, false), yhi = __builtin_amdgcn_cvt_pk_f32_fp8(yv, true);
        a[0] += wk * ylo.x; a[1] += wk * ylo.y; a[2] += wk * yhi.x; a[3] += wk * yhi.y;
      }
      const float4 xv = unpack4(*(const uint2*)(p.xres() + (size_t)row * D + cidx));
      const float4 gv = *(const float4*)(m + 5120 + cidx);
      xn[i * 4 + 0] = xv.x + gv.x * a[0]; xn[i * 4 + 1] = xv.y + gv.y * a[1];
      xn[i * 4 + 2] = xv.z + gv.z * a[2]; xn[i * 4 + 3] = xv.w + gv.w * a[3];
#pragma unroll
      for (int j = 0; j < 4; ++j) ss += xn[i * 4 + j] * xn[i * 4 + j];
    }
    ss = wave_sum(ss);
    const float rstd = rsqrtf(ss * (1.f / D) + EPS);
    if (!last) {
      const float* g = p.g_mix() + (layer + 1) * D;
      const float* m2 = p.mod() + (size_t)((layer + 1) * 9 + mod_row(row)) * 6144;
#pragma unroll
      for (int i = 0; i < 4; ++i) {
        const int cidx = i * 256 + lane * 4;
        { uint2 xo; xo.x = pack2(xn[i * 4], xn[i * 4 + 1]); xo.y = pack2(xn[i * 4 + 2], xn[i * 4 + 3]); *(uint2*)(xres_w + (size_t)row * D + cidx) = xo; }
        const float4 gg = *(const float4*)(g + cidx);
        const float4 sh = *(const float4*)(m2 + cidx);
        const float4 scl = *(const float4*)(m2 + 1024 + cidx);
        const float o0 = xn[i * 4 + 0] * rstd * gg.x * (1.f + scl.x) + sh.x;
        const float o1 = xn[i * 4 + 1] * rstd * gg.y * (1.f + scl.y) + sh.y;
        const float o2 = xn[i * 4 + 2] * rstd * gg.z * (1.f + scl.z) + sh.z;
        const float o3 = xn[i * 4 + 3] * rstd * gg.w * (1.f + scl.w) + sh.w;
        const int q8 = pack_fp8x4(o0, o1, o2, o3);
        *(int*)((char*)h_w + (size_t)row * D + cidx) = q8;
      }
    } else {
#pragma unroll
      for (int i = 0; i < 4; ++i) {
        const int cidx = i * 256 + lane * 4;
        const float4 gg = *(const float4*)(p.g_final() + cidx);
        *(float4*)(out_w + (size_t)(row - MC) * D + cidx) =
            make_float4(xn[i * 4] * rstd * gg.x, xn[i * 4 + 1] * rstd * gg.y, xn[i * 4 + 2] * rstd * gg.z, xn[i * 4 + 3] * rstd * gg.w);
      }
    }
  }
}
DI void phase_combine(const W& p, int layer, int row_lo, int bid, int nblk) { phase_combine_t<false>(p, layer, row_lo, bid, nblk); }

typedef unsigned u32x4 __attribute__((ext_vector_type(4)));
typedef unsigned u32x2 __attribute__((ext_vector_type(2)));
DI bf16x8 bl128(__amdgpu_buffer_rsrc_t rs, unsigned voff, unsigned soff) {
  return __builtin_bit_cast(bf16x8, __builtin_amdgcn_raw_buffer_load_b128(rs, voff, soff, 0));
}
DI u32x2 bl64(__amdgpu_buffer_rsrc_t rs, unsigned voff, unsigned soff) { return __builtin_amdgcn_raw_buffer_load_b64(rs, voff, soff, 0); }

template <bool LOCALPASS>
DI void attn_pass(__amdgpu_buffer_rsrc_t rsK, __amdgpu_buffer_rsrc_t rsV, unsigned kbase, unsigned vbase, const char* cK, const char* cV,
                  const float* s_rpb_h, int r, int c0, int kc0, int kr0, int lane, const bf16x8& qf0, const bf16x8& qf1,
                  float& m_out, float& l_out, f32x4 (&O)[4], const bf16x8 (&kfa)[16]) {
  const int fr = lane & 15, fq = lane >> 4;
  const unsigned vK = (8 * (fr >> 2) + (fr & 3)) * 128 + fq * 32;
  f32x4 S[16];
  if (LOCALPASS) {
    bf16x8 kfb[16];
#pragma unroll
    for (int t = 8; t < 16; ++t) {
      const unsigned so = kbase + ((kr0 + (t >> 1)) * 64 + kc0 + (t & 1) * 4) * 128;
      kfb[2 * (t - 8)] = bl128(rsK, vK, so); kfb[2 * (t - 8) + 1] = bl128(rsK, vK + 16, so);
    }
    __builtin_amdgcn_sched_barrier(0);
#pragma unroll
    for (int t = 0; t < 8; ++t) {
      f32x4 s = (f32x4){0.f, 0.f, 0.f, 0.f};
      s = __builtin_amdgcn_mfma_f32_16x16x32_bf16(kfa[2 * t], qf0, s, 0, 0, 0);
      s = __builtin_amdgcn_mfma_f32_16x16x32_bf16(kfa[2 * t + 1], qf1, s, 0, 0, 0);
      S[t] = s;
    }
#pragma unroll
    for (int t = 8; t < 16; ++t) {
      f32x4 s = (f32x4){0.f, 0.f, 0.f, 0.f};
      s = __builtin_amdgcn_mfma_f32_16x16x32_bf16(kfb[2 * (t - 8)], qf0, s, 0, 0, 0);
      s = __builtin_amdgcn_mfma_f32_16x16x32_bf16(kfb[2 * (t - 8) + 1], qf1, s, 0, 0, 0);
      S[t] = s;
    }
    __builtin_amdgcn_sched_barrier(0);
  } else {
#pragma unroll
    for (int t = 0; t < 16; ++t) {
      const bf16x8 k0 = *(const bf16x8*)(cK + (t * 2) * 1024 + lane * 16);
      const bf16x8 k1 = *(const bf16x8*)(cK + (t * 2 + 1) * 1024 + lane * 16);
      f32x4 s = (f32x4){0.f, 0.f, 0.f, 0.f};
      s = __builtin_amdgcn_mfma_f32_16x16x32_bf16(k0, qf0, s, 0, 0, 0);
      s = __builtin_amdgcn_mfma_f32_16x16x32_bf16(k1, qf1, s, 0, 0, 0);
      S[t] = s;
      if ((t & 3) == 3) __builtin_amdgcn_sched_barrier(0);
    }
  }
  const unsigned vV = (fr * 64 + 8 * fq) * 2;
  bf16x8 vfa[16];
  if (LOCALPASS) {
#pragma unroll
    for (int s = 0; s < 4; ++s)
#pragma unroll
      for (int dt = 0; dt < 4; ++dt) vfa[s * 4 + dt] = bl128(rsV, vV, vbase + ((kr0 + s) * 4096 + dt * 1024 + kc0) * 2);
    __builtin_amdgcn_sched_barrier(0);
  }
  const float NEGB = -1e30f;
  float mx = NEGB;
  if (LOCALPASS) {
    const int qc = c0 + fr;
    const int cs = min(max(qc - 8, 0), 48);
    unsigned vmask = 0;
#pragma unroll
    for (int e = 0; e < 8; ++e) {
      const int kc = kc0 + 8 * fq + e;
      vmask |= (kc >= cs && kc < cs + 16) ? (1u << e) : 0u;
    }
    const int dc0 = kc0 + fq * 8 - qc + 15;
#pragma unroll
    for (int t = 0; t < 16; ++t) {
      const float* bp = s_rpb_h + (kr0 + (t >> 1) - r + 7) * 31;
#pragma unroll
      for (int j = 0; j < 4; ++j) {
        const int e = (t & 1) * 4 + j;
        const int dc = min(max(dc0 + e, 0), 30);
        const float v = ((vmask >> e) & 1u) ? S[t][j] + bp[dc] : NEGB;
        S[t][j] = v;
        mx = fmaxf(mx, v);
      }
    }
  } else {
#pragma unroll
    for (int t = 0; t < 16; ++t)
#pragma unroll
      for (int j = 0; j < 4; ++j) mx = fmaxf(mx, S[t][j]);
  }
  mx = fmaxf(mx, __shfl_xor(mx, 16));
  mx = fmaxf(mx, __shfl_xor(mx, 32));
  float l = 0.f;
#pragma unroll
  for (int t = 0; t < 16; ++t)
#pragma unroll
    for (int j = 0; j < 4; ++j) { const float pv = __builtin_amdgcn_exp2f(S[t][j] - mx); S[t][j] = pv; l += pv; }
  l += __shfl_xor(l, 16);
  l += __shfl_xor(l, 32);
  m_out = mx; l_out = l;
#pragma unroll
  for (int dt = 0; dt < 4; ++dt) O[dt] = (f32x4){0.f, 0.f, 0.f, 0.f};
  bf16x8 pf[8];
#pragma unroll
  for (int s = 0; s < 8; ++s) {
    const unsigned p0 = pack2(S[2 * s][0], S[2 * s][1]), p1 = pack2(S[2 * s][2], S[2 * s][3]);
    const unsigned p2 = pack2(S[2 * s + 1][0], S[2 * s + 1][1]), p3 = pack2(S[2 * s + 1][2], S[2 * s + 1][3]);
    pf[s] = __builtin_bit_cast(bf16x8, (u32x4){p0, p1, p2, p3});
  }
  if (LOCALPASS) {
    bf16x8 vfb[16];
    __builtin_amdgcn_sched_barrier(0);
#pragma unroll
    for (int s = 0; s < 4; ++s)
#pragma unroll
      for (int dt = 0; dt < 4; ++dt) vfb[s * 4 + dt] = bl128(rsV, vV, vbase + ((kr0 + 4 + s) * 4096 + dt * 1024 + kc0) * 2);
    __builtin_amdgcn_sched_barrier(0);
#pragma unroll
    for (int s = 0; s < 4; ++s)
#pragma unroll
      for (int dt = 0; dt < 4; ++dt) O[dt] = __builtin_amdgcn_mfma_f32_16x16x32_bf16(vfa[s * 4 + dt], pf[s], O[dt], 0, 0, 0);
    __builtin_amdgcn_sched_barrier(0);
#pragma unroll
    for (int s = 0; s < 4; ++s)
#pragma unroll
      for (int dt = 0; dt < 4; ++dt) O[dt] = __builtin_amdgcn_mfma_f32_16x16x32_bf16(vfb[s * 4 + dt], pf[4 + s], O[dt], 0, 0, 0);
  } else {
#pragma unroll
    for (int s = 0; s < 8; ++s) {
#pragma unroll
      for (int dt = 0; dt < 4; ++dt) {
        const bf16x8 vf = *(const bf16x8*)(cV + (s * 4 + dt) * 1024 + lane * 16);
        O[dt] = __builtin_amdgcn_mfma_f32_16x16x32_bf16(vf, pf[s], O[dt], 0, 0, 0);
      }
      if ((s & 1) == 1) __builtin_amdgcn_sched_barrier(0);
    }
  }
}

DI void attn_stage_ctx(const W& p, char* dst, int bh, int wid, int lane) {
  const int fr = lane & 15, fq = lane >> 4;
  const bf16_t* Kc = p.kh() + (size_t)bh * NCTX * 64;
  const bf16_t* Vc = p.vt() + (size_t)bh * 4 * 4096;
#pragma unroll
  for (int i = 0; i < 8; ++i) {
    const int pc = wid * 8 + i;
    const bf16_t* src;
    if (pc < 32) {
      const int t = pc >> 1, ks = pc & 1, g = t >> 1, T = t & 1;
      src = Kc + (32 * g + 8 * (fr >> 2) + 4 * T + (fr & 3)) * 64 + 16 * fq + 8 * ks;
    } else {
      const int s = (pc - 32) >> 2, dt = (pc - 32) & 3;
      src = Vc + (s >> 1) * 4096 + (16 * dt + fr) * 64 + (s & 1) * 32 + 8 * fq;
    }
    __builtin_amdgcn_global_load_lds((const unsigned*)src, (unsigned*)(dst + pc * 1024 + lane * 16), 16, 0, 0);
  }
}

template <bool LOCAL, bool QPRE = false>
DI void attn_unit(const W& p, __amdgpu_buffer_rsrc_t rsQ, __amdgpu_buffer_rsrc_t rsK, __amdgpu_buffer_rsrc_t rsV, const char* cK, const char* cV,
                  const float* s_rpb, int b, int h, int r, int qb, int lane, char* nxt_dst = nullptr, int nxt_bh = 0, int wid = 0,
                  bf16x8 qp0 = bf16x8{}, bf16x8 qp1 = bf16x8{}) {
  const int fr = lane & 15, fq = lane >> 4;
  const unsigned bh = (unsigned)(b * 8 + h);
  int c0 = 0, kc0 = 0, kr0 = 0, qrow;
  unsigned qso;
  if (LOCAL) {
    c0 = qb * 16; kc0 = qb == 0 ? 0 : qb == 1 ? 8 : qb == 2 ? 24 : 32;
    kr0 = min(max(r - 4, 0), 56);
    qrow = MC + b * SEQ + r * 64 + c0 + fr;
    qso = (unsigned)(HM_LAT * 2) + (bh * SEQ + r * 64 + c0) * 128;
  } else {
    qrow = b * NCTX + qb * 16 + fr;
    qso = (bh * NCTX + qb * 16) * 128;
  }
  const unsigned vQ = fr * 128 + fq * 32;
  const bf16x8 qf0 = QPRE ? qp0 : bl128(rsQ, vQ, qso), qf1 = QPRE ? qp1 : bl128(rsQ, vQ + 16, qso);
  if (nxt_dst) attn_stage_ctx(p, nxt_dst, nxt_bh, wid, lane);
  bf16x8 kfa[16];
  if (LOCAL) {
    const unsigned kbase = (unsigned)(HM_LAT * 2) + bh * SEQ * 64 * 2;
    const unsigned vK = (8 * (fr >> 2) + (fr & 3)) * 128 + fq * 32;
#pragma unroll
    for (int t = 0; t < 8; ++t) {
      const unsigned so = kbase + ((kr0 + (t >> 1)) * 64 + kc0 + (t & 1) * 4) * 128;
      kfa[2 * t] = bl128(rsK, vK, so); kfa[2 * t + 1] = bl128(rsK, vK + 16, so);
    }
    __builtin_amdgcn_sched_barrier(0);
  }
  float m2, l2; f32x4 O[4];
  attn_pass<false>(rsK, rsV, 0u, 0u, cK, cV, s_rpb, r, c0, kc0, kr0, lane, qf0, qf1, m2, l2, O, kfa);
  float l = l2;
  if (LOCAL) {
    float m1, l1; f32x4 O1[4];
    attn_pass<true>(rsK, rsV, (unsigned)(HM_LAT * 2) + bh * SEQ * 64 * 2, (unsigned)(HM_LAT * 2) + bh * 64 * 4096 * 2, cK, cV, s_rpb + h * 465, r, c0,
                    kc0, kr0, lane, qf0, qf1, m1, l1, O1, kfa);
    const float m = fmaxf(m1, m2);
    const float sc1 = __builtin_amdgcn_exp2f(m1 - m), sc2 = __builtin_amdgcn_exp2f(m2 - m);
    l = l1 * sc1 + l2 * sc2;
#pragma unroll
    for (int dt = 0; dt < 4; ++dt)
#pragma unroll
      for (int j = 0; j < 4; ++j) O[dt][j] = O[dt][j] * sc2 + O1[dt][j] * sc1;
  }
  const float inv_l = 1.f / l;
#pragma unroll
  for (int dt = 0; dt < 4; ++dt) {
    const float sc8 = inv_l * 8.f;
    *(int*)((char*)p.cat() + (size_t)qrow * D + h * 64 + dt * 16 + fq * 4) = pack_fp8x4(O[dt][0] * sc8, O[dt][1] * sc8, O[dt][2] * sc8, O[dt][3] * sc8);
  }
}

DI void phase_attn(const W& p_, int layer, char* lds, int bid, int nblk) {
  const W p = oq(p_);
  float* s_rpb = (float*)lds;
  char* cbuf = lds + 16384;
  const int tid = otid(), lane = tid & 63;
  const int wid = __builtin_amdgcn_readfirstlane(tid >> 6);
  for (int i = tid; i < 8 * 15 * 31; i += NTHR) s_rpb[i] = p.rpb()[layer * 3720 + i] * 1.4426950408889634f;
  const __amdgpu_buffer_rsrc_t rsQ = __builtin_amdgcn_make_buffer_rsrc((void*)p.qh(), 0, (int)(HM_ELEMS * 2), 0x00020000);
  const __amdgpu_buffer_rsrc_t rsK = __builtin_amdgcn_make_buffer_rsrc((void*)p.kh(), 0, (int)(HM_ELEMS * 2), 0x00020000);
  const __amdgpu_buffer_rsrc_t rsV = __builtin_amdgcn_make_buffer_rsrc((void*)p.vt(), 0, (int)(HM_ELEMS * 2), 0x00020000);
  const bool fast = nblk == 256;
  const int npair = fast ? 8 : 64;
  const int xg = bid >> 5, lw = (bid & 31) * 8 + wid;
  attn_stage_ctx(p, cbuf, fast ? xg : 0, wid, lane);
  const unsigned vQp = (lane & 15) * 128 + (lane >> 4) * 32;
  auto qso_of = [&](int ph2) { return (unsigned)(HM_LAT * 2) + ((unsigned)ph2 * SEQ + (lw >> 2) * 64 + (lw & 3) * 16) * 128; };
  bf16x8 qn0 = bf16x8{}, qn1 = bf16x8{};
  if (fast) { qn0 = bl128(rsQ, vQp, qso_of(xg)); qn1 = bl128(rsQ, vQp + 16, qso_of(xg)); }
  for (int sl = 0; sl < npair; ++sl) {
    const int ph = fast ? sl * 8 + xg : sl, h = ph & 7, b = ph >> 3;
    asm volatile("s_waitcnt vmcnt(0)" ::: "memory");
    __syncthreads();
    const char* cK = cbuf + (sl & 1) * 65536;
    const char* cV = cK + 32768;
    char* ndst = sl + 1 < npair ? cbuf + ((sl + 1) & 1) * 65536 : nullptr;
    if (fast) {
      const bf16x8 qc0 = qn0, qc1 = qn1;
      if (sl + 1 < npair) { qn0 = bl128(rsQ, vQp, qso_of((sl + 1) * 8 + xg)); qn1 = bl128(rsQ, vQp + 16, qso_of((sl + 1) * 8 + xg)); }
      attn_unit<true, true>(p, rsQ, rsK, rsV, cK, cV, s_rpb, b, h, lw >> 2, lw & 3, lane, ndst, (sl + 1) * 8 + xg, wid, qc0, qc1);
      if (layer == 0 && (lw >> 4) == sl) attn_unit<false>(p, rsQ, rsK, rsV, cK, cV, s_rpb, b, h, 0, lw & 15, lane);
    } else {
      if (ndst) attn_stage_ctx(p, ndst, sl + 1, wid, lane);
      for (int u = bid * 8 + wid; u < 256; u += nblk * 8) attn_unit<true>(p, rsQ, rsK, rsV, cK, cV, s_rpb, b, h, u >> 2, u & 3, lane);
      if (layer == 0)
        for (int u = bid * 8 + wid; u < 16; u += nblk * 8) attn_unit<false>(p, rsQ, rsK, rsV, cK, cV, s_rpb, b, h, 0, u, lane);
    }
  }
  __syncthreads();
}

DI void phase_pool(const W& p_, int layer, char* lds, int bid, int nblk) {
  const W p = oq(p_);
  float* U = (float*)lds;
  bf16_t* dA = (bf16_t*)(lds + 81920);
  bf16_t* WT = (bf16_t*)(lds + 81920 + 33792);
  const int tid = otid(), wid = tid >> 6, lane = tid & 63, fr = lane & 15, fq = lane >> 4;
  for (int i = tid; i < 4 * 64 * 8; i += NTHR) {
    const int rowj = i >> 3, chk = i & 7;
    *(uint4*)(WT + rowj * 72 + chk * 8) = *(const uint4*)(p.wpt() + (size_t)layer * 16384 + rowj * 64 + chk * 8);
  }
  const int nlat = ML / 64, nctx = layer == 0 ? MC / 64 : 0;
  const int gextra = NB * 4 * NSLOT - nblk * 8;
  const int heavy = (gextra > 0 && gextra < nblk * 4) ? (gextra + 7) / 8 : 0;
  const int ptotal = nlat + nctx;
  const int ufirst = bid < heavy ? ptotal - 1 - bid : bid - heavy;
  const int ustep = bid < heavy ? ptotal : nblk - heavy;
  const int ulimit = bid < heavy ? ptotal : ptotal - heavy;
  for (int u = ufirst; u < ulimit; u += ustep) {
    int row0, L, seq0;
    if (u < nlat) { row0 = MC + u * 64; L = SEQ; seq0 = MC + ((u * 64) / SEQ) * SEQ; }
    else { row0 = (u - nlat) * 64; L = NCTX; seq0 = (row0 / NCTX) * NCTX; }
    const int t0 = row0 - seq0;
    __syncthreads();
#pragma unroll
    for (int k = 0; k < 5; ++k) {
      const int c = tid + NTHR * k, rr = c >> 5, chk = c & 31;
      const int tpos = t0 - 8 + rr;
      uint4 v = make_uint4(0u, 0u, 0u, 0u);
      if (tpos >= 0 && tpos < L) v = *(const uint4*)(p.px() + (size_t)(seq0 + tpos) * INW + 1536 + chk * 8);
      float4 lo4, hi4;
      lo4.x = __uint_as_float(v.x << 16); lo4.y = __uint_as_float(v.x & 0xffff0000u); lo4.z = __uint_as_float(v.y << 16); lo4.w = __uint_as_float(v.y & 0xffff0000u);
      hi4.x = __uint_as_float(v.z << 16); hi4.y = __uint_as_float(v.z & 0xffff0000u); hi4.z = __uint_as_float(v.w << 16); hi4.w = __uint_as_float(v.w & 0xffff0000u);
      *(float4*)(U + rr * 256 + chk * 8) = lo4;
      *(float4*)(U + rr * 256 + chk * 8 + 4) = hi4;
    }
    __syncthreads();
    {
      const int ch = tid & 255, hf = tid >> 8, g = ch >> 6, hw = 1 << g;
      const float* Uc = U + ch;
      int tpos = t0 + hf * 32;
      int lo = max(tpos - hw, 0), hi = min(tpos + hw - 1, L - 1);
      float S = 0.f;
      for (int j = lo; j <= hi; ++j) S += Uc[(j - t0 + 8) * 256];
      for (int tt = 0; tt < 32; ++tt) {
        const float dv = S / (float)(hi - lo + 1) - Uc[(tpos - t0 + 8) * 256];
        dA[(hf * 32 + tt) * 264 + ch] = f2bf(dv);
        ++tpos;
        const int nlo = max(tpos - hw, 0), nhi = min(tpos + hw - 1, L - 1);
        if (nlo > lo) { S -= Uc[(lo - t0 + 8) * 256]; lo = nlo; }
        if (nhi > hi) { S += Uc[(nhi - t0 + 8) * 256]; hi = nhi; }
      }
    }
    __syncthreads();
    {
      const int g = wid & 3, th = wid >> 2;
      f32x4 acc[2][4];
#pragma unroll
      for (int mi = 0; mi < 2; ++mi)
#pragma unroll
        for (int ni = 0; ni < 4; ++ni) acc[mi][ni] = (f32x4){0.f, 0.f, 0.f, 0.f};
#pragma unroll
      for (int ks = 0; ks < 2; ++ks) {
        bf16x8 a[2], b[4];
#pragma unroll
        for (int mi = 0; mi < 2; ++mi) a[mi] = *(const bf16x8*)(dA + (th * 32 + mi * 16 + fr) * 264 + g * 64 + 32 * ks + 8 * fq);
#pragma unroll
        for (int ni = 0; ni < 4; ++ni) b[ni] = *(const bf16x8*)(WT + (g * 64 + ni * 16 + fr) * 72 + 32 * ks + 8 * fq);
#pragma unroll
        for (int mi = 0; mi < 2; ++mi)
#pragma unroll
          for (int ni = 0; ni < 4; ++ni) acc[mi][ni] = __builtin_amdgcn_mfma_f32_16x16x32_bf16(b[ni], a[mi], acc[mi][ni], 0, 0, 0);
      }
#pragma unroll
      for (int mi = 0; mi < 2; ++mi) {
        const int row = row0 + th * 32 + mi * 16 + fr;
#pragma unroll
        for (int ni = 0; ni < 4; ++ni) {
          const int j0 = g * 64 + ni * 16 + 4 * fq;
          const float4 sc = *(const float4*)(p.pool_scale() + layer * 256 + j0);
          *(int*)((char*)p.cat() + (size_t)row * D + 512 + j0) =
              pack_fp8x4(acc[mi][ni][0] * sc.x * 8.f, acc[mi][ni][1] * sc.y * 8.f, acc[mi][ni][2] * sc.z * 8.f, acc[mi][ni][3] * sc.w * 8.f);
        }
      }
    }
  }
  __syncthreads();
}

DI int gla_row0(int b, int slot) { return slot < 4 ? b * NCTX + slot * 64 : MC + b * SEQ + (slot - 4) * 64; }
constexpr int KXT_STRIDE = 72;

DI void phase_gla_c1(const W& p_, int layer, char* lds, int bid, int nblk) {
  const W p = oq(p_);
  const int tid = otid(), lane = tid & 63;
  const int wid = __builtin_amdgcn_readfirstlane(tid >> 6);
  constexpr int WREG = 2 * 32 * KXT_STRIDE * 2 + 4096;
  bf16_t* kxt = (bf16_t*)(lds + wid * WREG);
  bf16_t* al = (bf16_t*)(lds + wid * WREG + 2 * 32 * KXT_STRIDE * 2);
  float* s_rope = (float*)(lds + 8 * WREG);
  for (int i = tid; i < 1024; i += NTHR) s_rope[i] = p.rope()[i];
  __syncthreads();
  const int dir = lane >> 5, d = lane & 31, fr = lane & 15, fq = lane >> 4;
  const __amdgpu_buffer_rsrc_t rsV = __builtin_amdgcn_make_buffer_rsrc((void*)p.vtg(), 0, (int)(HMG_ELEMS * 2), 0x00020000);
  const int half = d >> 4, jf = d & 7;
  const float sgn = ((d >> 3) & 1) ? 1.f : -1.f;
  for (int u = bid * 8 + wid; u < NB * 4 * NSLOT; u += nblk * 8) {
    const int slot = u % NSLOT, bh = u / NSLOT, h = bh & 3, b = bh >> 2;
    const int row0 = gla_row0(b, slot);
    const bool latent = slot >= 4;
#pragma unroll
    for (int j = 0; j < 4; ++j) {
      const int rr = j * 16 + (lane >> 2), chk = lane & 3;
      *(uint4*)(al + rr * 32 + chk * 8) = *(const uint4*)(p.px() + (size_t)(row0 + rr) * INW + 2560 + chk * 8);
    }
    float w2[16];
    {
      const float* w2p = (dir ? p.w_gate_b() : p.w_gate_f()) + layer * 2048 + h * 32 + d;
#pragma unroll
      for (int r = 0; r < 16; ++r) w2[r] = w2p[r * 128];
    }
    const float b2 = (dir ? p.b_gate_b() : p.b_gate_f())[layer * 128 + h * 32 + d];
    bf16_t* gq = p.gqk() + ((size_t)u * 2 + dir) * 4096;
    asm volatile("s_waitcnt lgkmcnt(0)" ::: "memory");
    float bsum = 0.f;
    for (int ib = 0; ib < 4; ++ib) {
      bf16_t qo[16], ko[16];
#pragma unroll
      for (int k = 0; k < 16; ++k) {
        const int ii = ib * 16 + k, i = dir ? 63 - ii : ii;
        const bf16_t* rowp = p.px() + (size_t)(row0 + i) * INW + h * 32;
        qo[k] = rowp[1792 + d]; ko[k] = rowp[1920 + d];
      }
#pragma unroll
      for (int k = 0; k < 16; ++k) {
        const int ii = ib * 16 + k, i = dir ? 63 - ii : ii;
        const uint4 a0 = *(const uint4*)(al + i * 32 + dir * 16), a1 = *(const uint4*)(al + i * 32 + dir * 16 + 8);
        float lg = b2;
        const unsigned aw[8] = {a0.x, a0.y, a0.z, a0.w, a1.x, a1.y, a1.z, a1.w};
#pragma unroll
        for (int r = 0; r < 8; ++r) {
          lg += __uint_as_float(aw[r] << 16) * w2[2 * r];
          lg += __uint_as_float(aw[r] & 0xffff0000u) * w2[2 * r + 1];
        }
        const float ls = fminf(lg, 0.f) - __logf(1.f + __expf(-fabsf(lg)));
        bsum += ls * (1.f / 16.f);
        const float qov = bf2f(qo[k]) * 0.17677669529663687f, kov = bf2f(ko[k]);
        const float qpv = dppf<0x128>(qov), kpv = dppf<0x128>(kov);
        float qr = qov, kr = kov;
        if (latent) {
          const int pos = half == 0 ? (slot - 4) : i;
          const float2 cs = *(const float2*)(s_rope + (pos * 8 + jf) * 2);
          qr = qov * cs.x + sgn * qpv * cs.y;
          kr = kov * cs.x + sgn * kpv * cs.y;
        }
        const float eb = __expf(bsum);
        const bf16_t qx = f2bf(qr * eb), kx = f2bf(kr / eb);
        gq[i * 32 + d] = qx;
        gq[2048 + i * 32 + d] = kx;
        kxt[(dir * 32 + d) * KXT_STRIDE + i] = kx;
      }
    }
    const float eblast = __expf(bsum);
    p.gdec()[((size_t)u * 2 + dir) * 32 + d] = eblast;
    asm volatile("s_waitcnt lgkmcnt(0)" ::: "memory");
    const unsigned vbase = (unsigned)((latent ? HMG_LAT + (size_t)(bh * 64 + slot - 4) * 4096 : (size_t)(bh * 4 + slot) * 4096) * 2);
    bf16x8 vf[2][4];
#pragma unroll
    for (int ks = 0; ks < 2; ++ks)
#pragma unroll
      for (int mt = 0; mt < 4; ++mt) vf[ks][mt] = bl128(rsV, (unsigned)(((16 * mt + fr) * 64 + 8 * fq) * 2), vbase + ks * 64);
#pragma unroll
    for (int dd = 0; dd < 2; ++dd) {
      f32x4 acc[4][2];
#pragma unroll
      for (int mt = 0; mt < 4; ++mt)
#pragma unroll
        for (int nt = 0; nt < 2; ++nt) acc[mt][nt] = (f32x4){0.f, 0.f, 0.f, 0.f};
#pragma unroll
      for (int ks = 0; ks < 2; ++ks) {
        bf16x8 kf[2];
#pragma unroll
        for (int nt = 0; nt < 2; ++nt) kf[nt] = *(const bf16x8*)(kxt + (dd * 32 + 16 * nt + fr) * KXT_STRIDE + 32 * ks + 8 * fq);
#pragma unroll
        for (int mt = 0; mt < 4; ++mt)
#pragma unroll
          for (int nt = 0; nt < 2; ++nt) acc[mt][nt] = __builtin_amdgcn_mfma_f32_16x16x32_bf16(vf[ks][mt], kf[nt], acc[mt][nt], 0, 0, 0);
      }
      float* kvp = p.gkv() + ((size_t)u * 2 + dd) * 2048;
#pragma unroll
      for (int nt = 0; nt < 2; ++nt) {
        const float sc = __shfl(eblast, dd * 32 + 16 * nt + fr);
#pragma unroll
        for (int mt = 0; mt < 4; ++mt)
#pragma unroll
          for (int j = 0; j < 4; ++j) kvp[(16 * mt + 4 * fq + j) * 32 + 16 * nt + fr] = acc[mt][nt][j] * sc;
      }
    }
    asm volatile("s_waitcnt lgkmcnt(0)" ::: "memory");
  }
  __syncthreads();
}

DI void phase_gla_scan(const W& p_, int bid, int nblk) {
  const W p = oq(p_);
  bf16_t* sin = (bf16_t*)p.gsin();
  const int nthreads = NB * 4 * 2 * 2048;
  for (int gid = bid * NTHR + otid(); gid < nthreads; gid += nblk * NTHR) {
    const int el = gid & 2047, dir = (gid >> 11) & 1, bh = gid >> 12, d = el & 31;
    float S = 0.f;
    for (int st0 = 0; st0 < NSLOT; st0 += 17) {
      float dk[17], kv[17];
#pragma unroll
      for (int j = 0; j < 17; ++j) {
        const int st = st0 + j;
        const int slot = dir == 0 ? st : (st < 4 ? 3 - st : NSLOT + 3 - st);
        const size_t base = ((size_t)(bh * NSLOT + slot)) * 2 + dir;
        dk[j] = p.gdec()[base * 32 + d];
        kv[j] = p.gkv()[base * 2048 + el];
      }
#pragma unroll
      for (int j = 0; j < 17; ++j) {
        const int st = st0 + j;
        const int slot = dir == 0 ? st : (st < 4 ? 3 - st : NSLOT + 3 - st);
        const size_t base = ((size_t)(bh * NSLOT + slot)) * 2 + dir;
        sin[base * 2048 + el] = f2bf(S);
        S = dk[j] * S + kv[j];
      }
    }
  }
}

DI void phase_gla_c3(const W& p_, int layer, char* lds, int bid, int nblk) {
  (void)lds;
  const W p = oq(p_);
  const int tid = otid(), lane = tid & 63;
  const int wid = __builtin_amdgcn_readfirstlane(tid >> 6);
  const int fr = lane & 15, fq = lane >> 4;
  const __amdgpu_buffer_rsrc_t rsV = __builtin_amdgcn_make_buffer_rsrc((void*)p.vtg(), 0, (int)(HMG_ELEMS * 2), 0x00020000);
  const __amdgpu_buffer_rsrc_t rsQ = __builtin_amdgcn_make_buffer_rsrc((void*)p.gqk(), 0, (int)((size_t)NB * 4 * NSLOT * 16384), 0x00020000);
  const __amdgpu_buffer_rsrc_t rsS = __builtin_amdgcn_make_buffer_rsrc((void*)p.gsin(), 0, (int)((size_t)NB * 4 * NSLOT * 2 * 4096), 0x00020000);
  const int slot_lo = layer == 0 ? 0 : 4;
  const int nsl = NSLOT - slot_lo;
  const unsigned vfrag = (unsigned)(fr * 64 + fq * 16);
  for (int uu = bid * 8 + wid; uu < NB * 4 * nsl; uu += nblk * 8) {
    const int slot = slot_lo + uu % nsl, bh = uu / nsl, h = bh & 3, b = bh >> 2;
    const int u = bh * NSLOT + slot;
    const bool latent = slot >= 4;
    const int row0 = gla_row0(b, slot);
    const unsigned qbase = (unsigned)u * 16384u;
    bf16x8 QF[4], QB[4];
#pragma unroll
    for (int ct = 0; ct < 4; ++ct) { QF[ct] = bl128(rsQ, vfrag, qbase + ct * 1024); QB[ct] = bl128(rsQ, vfrag, qbase + 8192 + ct * 1024); }
    f32x4 O[4][4];
#pragma unroll
    for (int mt = 0; mt < 4; ++mt)
#pragma unroll
      for (int ct = 0; ct < 4; ++ct) O[mt][ct] = (f32x4){0.f, 0.f, 0.f, 0.f};
    const unsigned vbase = (unsigned)((latent ? HMG_LAT + (size_t)(bh * 64 + slot - 4) * 4096 : (size_t)(bh * 4 + slot) * 4096) * 2);
    const unsigned vV = (unsigned)((fr * 64 + 4 * fq) * 2);
#pragma unroll
    for (int ks = 0; ks < 2; ++ks) {
      f32x4 Pt[2][4];
#pragma unroll
      for (int t2 = 0; t2 < 2; ++t2) {
        const int st = 2 * ks + t2;
        const bf16x8 KFs = bl128(rsQ, vfrag, qbase + 4096 + st * 1024), KBs = bl128(rsQ, vfrag, qbase + 8192 + 4096 + st * 1024);
#pragma unroll
        for (int ct = 0; ct < 4; ++ct) {
          const f32x4 z = (f32x4){0.f, 0.f, 0.f, 0.f};
          if (st < ct) Pt[t2][ct] = __builtin_amdgcn_mfma_f32_16x16x32_bf16(KFs, QF[ct], z, 0, 0, 0);
          else if (st > ct) Pt[t2][ct] = __builtin_amdgcn_mfma_f32_16x16x32_bf16(KBs, QB[ct], z, 0, 0, 0);
          else {
            const f32x4 f = __builtin_amdgcn_mfma_f32_16x16x32_bf16(KFs, QF[ct], z, 0, 0, 0);
            const f32x4 g = __builtin_amdgcn_mfma_f32_16x16x32_bf16(KBs, QB[ct], z, 0, 0, 0);
#pragma unroll
            for (int j = 0; j < 4; ++j) { const int s = 4 * fq + j; Pt[t2][ct][j] = (s <= fr ? f[j] : 0.f) + (s >= fr ? g[j] : 0.f); }
          }
        }
      }
      bf16x8 pf[4];
#pragma unroll
      for (int ct = 0; ct < 4; ++ct)
        pf[ct] = __builtin_bit_cast(bf16x8, (u32x4){pack2(Pt[0][ct][0], Pt[0][ct][1]), pack2(Pt[0][ct][2], Pt[0][ct][3]),
                                                     pack2(Pt[1][ct][0], Pt[1][ct][1]), pack2(Pt[1][ct][2], Pt[1][ct][3])});
#pragma unroll
      for (int mt = 0; mt < 4; ++mt) {
        const unsigned so = vbase + (unsigned)((mt * 16 * 64 + 32 * ks) * 2);
        const u32x2 v0 = bl64(rsV, vV, so), v1 = bl64(rsV, vV + 32, so);
        const bf16x8 vf = __builtin_bit_cast(bf16x8, (u32x4){v0.x, v0.y, v1.x, v1.y});
#pragma unroll
        for (int ct = 0; ct < 4; ++ct) O[mt][ct] = __builtin_amdgcn_mfma_f32_16x16x32_bf16(vf, pf[ct], O[mt][ct], 0, 0, 0);
      }
    }
    const unsigned sbase = (unsigned)u * 8192u;
#pragma unroll
    for (int mt = 0; mt < 4; ++mt) {
      const bf16x8 sf = bl128(rsS, vfrag, sbase + mt * 1024), sb = bl128(rsS, vfrag, sbase + 4096 + mt * 1024);
#pragma unroll
      for (int ct = 0; ct < 4; ++ct) {
        O[mt][ct] = __builtin_amdgcn_mfma_f32_16x16x32_bf16(sf, QF[ct], O[mt][ct], 0, 0, 0);
        O[mt][ct] = __builtin_amdgcn_mfma_f32_16x16x32_bf16(sb, QB[ct], O[mt][ct], 0, 0, 0);
      }
    }
#pragma unroll
    for (int ct = 0; ct < 4; ++ct) {
      float ss = 0.f;
#pragma unroll
      for (int mt = 0; mt < 4; ++mt)
#pragma unroll
        for (int j = 0; j < 4; ++j) ss += O[mt][ct][j] * O[mt][ct][j];
      ss += __shfl_xor(ss, 16); ss += __shfl_xor(ss, 32);
      const float rstd = rsqrtf(ss * (1.f / 64.f) + EPS);
      const int row = row0 + 16 * ct + fr;
#pragma unroll
      for (int mt = 0; mt < 4; ++mt) {
        const int v0 = 16 * mt + 4 * fq;
        const uint2 rv = *(const uint2*)(p.px() + (size_t)row * INW + 2304 + h * 64 + v0);
        const float4 gg = *(const float4*)(p.g_gla() + layer * 64 + v0);
        const float r0 = O[mt][ct][0] * rstd * gg.x * siluf_(__uint_as_float(rv.x << 16));
        const float r1 = O[mt][ct][1] * rstd * gg.y * siluf_(__uint_as_float(rv.x & 0xffff0000u));
        const float r2 = O[mt][ct][2] * rstd * gg.z * siluf_(__uint_as_float(rv.y << 16));
        const float r3 = O[mt][ct][3] * rstd * gg.w * siluf_(__uint_as_float(rv.y & 0xffff0000u));
        *(int*)((char*)p.cat() + (size_t)row * D + 768 + h * 64 + v0) = pack_fp8x4(r0 * 8.f, r1 * 8.f, r2 * 8.f, r3 * 8.f);
      }
    }
  }
}

#define XB_TMO      128
#define XB_XCNT(j)  (256  + 64 * (j))
#define XB_XSUB(j)  (1280 + 64 * (j))
#define XB_XGEN(j)  (2304 + 64 * (j))
#define XB_TOP      3328
#define XB_TOPGEN   3392
#define XCD_BAR_WORDS 3456
#define XB_SPIN_CAP (1u << 18)
#define LAS __attribute__((address_space(3)))

__device__ __forceinline__ unsigned xb_ld(unsigned* p)              { return __hip_atomic_load(p, __ATOMIC_RELAXED, __HIP_MEMORY_SCOPE_AGENT); }
__device__ __forceinline__ unsigned xb_add(unsigned* p, unsigned v) { return __hip_atomic_fetch_add(p, v, __ATOMIC_RELAXED, __HIP_MEMORY_SCOPE_AGENT); }
__device__ __forceinline__ unsigned xb_xcc_id() { return (unsigned)__builtin_amdgcn_s_getreg((3 << 11) | 20) & 0xFu; }
#define XB_SPIN(cond, bar) do { unsigned _sp = 0; while (cond) { __builtin_amdgcn_s_sleep(1); \
    if ((++_sp & 255u) == 0u) { if (xb_ld(&(bar)[XB_TMO])) break; if (_sp > XB_SPIN_CAP) { atomicAdd(&(bar)[XB_TMO], 1u); break; } } } } while (0)

struct XcdBarrier { unsigned* bar; unsigned x; volatile LAS unsigned* st; };

__device__ __forceinline__ XcdBarrier xcd_barrier_post(unsigned* bar, volatile LAS unsigned* st) {
    XcdBarrier b; b.bar = bar; b.x = xb_xcc_id(); b.st = st;
    if (threadIdx.x == 0) (void)xb_add(&bar[XB_XCNT(b.x)], 1u);
    return b;
}
__device__ __forceinline__ void xcd_barrier_complete(unsigned* bar, unsigned x, unsigned& nloc, unsigned& nx) {
    const unsigned G = gridDim.x * gridDim.y * gridDim.z;
    unsigned sum, cnt, mine, sp = 0u;
    for (;;) {
        sum = 0u; cnt = 0u; mine = 0u;
#pragma unroll
        for (unsigned j = 0; j < 16; ++j) { const unsigned c = xb_ld(&bar[XB_XCNT(j)]); sum += c; cnt += (c > 0u) ? 1u : 0u; mine = (j == x) ? c : mine; }
        if (sum == G) break;
        __builtin_amdgcn_s_sleep(1);
        if ((++sp & 255u) == 0u) { if (xb_ld(&bar[XB_TMO])) break; if (sp > XB_SPIN_CAP) { atomicAdd(&bar[XB_TMO], 1u); break; } }
    }
    nloc = mine > 0u ? mine : 1u; nx = cnt > 0u ? cnt : 1u;
}
__device__ __forceinline__ void xcd_barrier(const XcdBarrier& b) {
    asm volatile("s_waitcnt vmcnt(0)" ::: "memory");
    __syncthreads();
    if (threadIdx.x == 0) {
        unsigned long long bv = (unsigned long long)b.bar; unsigned bx = b.x;
        asm volatile("" : "+s"(bv), "+s"(bx));
        unsigned* bar = (unsigned*)(__attribute__((address_space(1))) unsigned*)bv;
        __builtin_amdgcn_s_waitcnt(0);
        unsigned nloc = b.st[0], nx = b.st[1];
        if (nloc == 0u) { xcd_barrier_complete(bar, bx, nloc, nx); b.st[0] = nloc; b.st[1] = nx; }
        const unsigned old = xb_add(&bar[XB_XSUB(bx)], 1u);
        const unsigned gen = old / nloc;
        if (old + 1u == (gen + 1u) * nloc) {
            __builtin_amdgcn_fence(__ATOMIC_RELEASE, "agent");
            asm volatile("s_waitcnt vmcnt(0)" ::: "memory");
            const unsigned og = xb_add(&bar[XB_TOP], 1u);
            const unsigned tg = og / nx;
            if (og + 1u == (tg + 1u) * nx) xb_add(&bar[XB_TOPGEN], 1u);
            else XB_SPIN(xb_ld(&bar[XB_TOPGEN]) == tg, bar);
            __builtin_amdgcn_fence(__ATOMIC_ACQUIRE, "agent");
            xb_add(&bar[XB_XGEN(bx)], 1u);
            asm volatile("s_waitcnt vmcnt(0)" ::: "memory");
        } else {
            XB_SPIN(xb_ld(&bar[XB_XGEN(bx)]) == gen, bar);
            __builtin_amdgcn_fence(__ATOMIC_ACQUIRE, "agent");
            asm volatile("s_waitcnt vmcnt(0)" ::: "memory");
        }
    }
    __syncthreads();
}

__global__ void __launch_bounds__(NTHR, 2) k_fwd(P q) {
  extern __shared__ __attribute__((aligned(16))) char lds[];
  const int bid = blockIdx.x, nblk = gridDim.x;
  if (threadIdx.x < 4) ((unsigned*)(lds + LDS_BYTES - 16))[threadIdx.x] = 0u;
  __syncthreads();
  XcdBarrier bar = xcd_barrier_post((unsigned*)(q.ws + OFF_BAR), (volatile LAS unsigned*)(lds + LDS_BYTES - 16));
  int* s_vb = (int*)(lds + LDS_BYTES - 32);
  if (threadIdx.x == 0) {
    const int xcc = (int)xb_xcc_id();
    s_vb[1] = xcc;
    s_vb[2] = (int)__hip_atomic_fetch_add((unsigned*)(q.ws + OFF_CNT) + 768 + xcc, 1u, __ATOMIC_RELAXED, __HIP_MEMORY_SCOPE_AGENT);
  }
#define GB() xcd_barrier(bar)
#ifndef PROBE_DUP
#define PROBE_DUP 0
#endif
#if PROBE_DUP == 1
#define DUP1(x) x
#else
#define DUP1(x) (void)0
#endif
#if PROBE_DUP == 2
#define DUP2(x) x
#else
#define DUP2(x) (void)0
#endif
#if PROBE_DUP == 3
#define DUP3(x) x
#else
#define DUP3(x) (void)0
#endif
#if PROBE_DUP == 4
#define DUP4(x) x
#else
#define DUP4(x) (void)0
#endif
#if PROBE_DUP == 5
#define DUP5(x) x
#else
#define DUP5(x) (void)0
#endif
#if PROBE_DUP == 6
#define DUP6(x) x
#else
#define DUP6(x) (void)0
#endif
#if PROBE_DUP == 7
#define DUP7(x) x
#else
#define DUP7(x) (void)0
#endif
#if PROBE_DUP == 8
#define DUP8(x) x
#else
#define DUP8(x) (void)0
#endif
#if PROBE_DUP == 9
#define DUP9(x) x
#else
#define DUP9(x) (void)0
#endif
  phase_convert(q, lds, bid, nblk);
  phase_mod(q, lds, bid, nblk);
  DUP3(phase_convert(q, lds, bid, nblk)); DUP3(phase_mod(q, lds, bid, nblk));
  GB();
  if (threadIdx.x == 0) {
    const unsigned* rc = (const unsigned*)(q.ws + OFF_CNT) + 768;
    const int per = nblk >> 3;
    bool ok = (nblk & 7) == 0;
    for (int j = 0; j < 16; ++j) {
      const int c = (int)__hip_atomic_load(rc + j, __ATOMIC_RELAXED, __HIP_MEMORY_SCOPE_AGENT);
      ok = ok && (j < 8 ? c == per : c == 0);
    }
    s_vb[0] = ok ? s_vb[1] * per + s_vb[2] : ((nblk & 7) == 0 ? (bid & 7) * per + (bid >> 3) : bid);
  }
  __syncthreads();
  const int vb = __builtin_amdgcn_readfirstlane(s_vb[0]);
  phase_norm0(q, bid, nblk);
  DUP3(phase_norm0(q, bid, nblk));
  GB();
  const W p{q.ws, q.out, q.x, q.ctx};
#define LAYER(layer, row_lo, LASTGB)                          \
  do {                                                        \
    phase_inproj(p, layer, lds, vb, nblk);                   \
    DUP7(phase_inproj(p, layer, lds, vb, nblk));             \
    GB();                                                     \
    phase_gla_c1(p, layer, lds, vb, nblk);                   \
    phase_pool(p, layer, lds, vb, nblk);                     \
    DUP6(phase_gla_c1(p, layer, lds, vb, nblk)); DUP5(phase_pool(p, layer, lds, vb, nblk)); \
    GB();                                                     \
    phase_gla_scan(p, vb, nblk);                             \
    phase_attn(p, layer, lds, vb, nblk);                     \
    DUP6(phase_gla_scan(p, vb, nblk)); DUP4(phase_attn(p, layer, lds, vb, nblk)); \
    GB();                                                     \
    phase_gla_c3(p, layer, lds, vb, nblk);                   \
    DUP6(phase_gla_c3(p, layer, lds, vb, nblk));             \
    GB();                                                     \
    DUP2(phase_outproj_t<true>(p, layer, lds, row_lo, vb, nblk)); \
    phase_outproj(p, layer, lds, row_lo, vb, nblk);          \
    GB();                                                     \
    phase_norm(p, layer, row_lo, vb, nblk);                  \
    DUP3(phase_norm(p, layer, row_lo, vb, nblk));            \
    GB();                                                     \
    phase_router(p, layer, lds, row_lo, vb, nblk);           \
    DUP1(phase_router(p, layer, lds, row_lo, vb, nblk));     \
    GB();                                                     \
    phase_route(p, layer, lds, row_lo, vb, nblk);            \
    GB();                                                     \
    phase_moe(p, layer, lds, row_lo, vb, nblk);              \
    DUP8(phase_moe(p, layer, lds, row_lo, vb, nblk));        \
    GB();                                                     \
    DUP9(phase_combine_t<true>(p, layer, row_lo, vb, nblk)); \
    phase_combine(p, layer, row_lo, vb, nblk);               \
    LASTGB;                                                   \
  } while (0)
#if PROBE_GEMM
  phase_probe_gemm(p, lds, vb, nblk);
  GB();
#endif
  LAYER(0, 0, GB());
  LAYER(1, MC, (void)0);
#undef LAYER
#undef GB
}

}

extern "C" void kernel_launch(void* const* d_in, const int* in_sizes, int n_in, void* d_out, int out_size, void* d_ws,
                              size_t ws_size, hipStream_t stream) {
  (void)in_sizes; (void)n_in; (void)out_size;
  P p{};
  const float* const* in = (const float* const*)d_in;
  p.x = in[0]; p.c = in[1]; p.ctx = in[2]; p.c_ctx = in[3]; p.w_mod = in[4]; p.b_mod = in[5]; p.g_mix = in[6]; p.w_in = in[7];
  p.rpb = in[8]; p.w_pool = in[9]; p.pool_scale = in[10]; p.w_gate_f = in[11]; p.b_gate_f = in[12]; p.w_gate_b = in[13];
  p.b_gate_b = in[14]; p.g_gla = in[15]; p.w_out = in[16]; p.g_ffn = in[17]; p.w_router = in[18]; p.b_router = in[19];
  p.w_e_in = in[20]; p.w_e_down = in[21]; p.w_sh_in = in[22]; p.w_sh_down = in[23]; p.g_final = in[24];
  p.out = (float*)d_out;
  p.ws = (char*)d_ws;
  char* ws = (char*)d_ws;
  if (ws_size < WS_TOTAL) { fprintf(stderr, "workspace too small: %zu < %zu\n", ws_size, (size_t)WS_TOTAL); }
  static int grid = 0;
  if (!grid) {
    (void)hipFuncSetAttribute((const void*)k_fwd, hipFuncAttributeMaxDynamicSharedMemorySize, LDS_BYTES);
    int dev = 0, cus = 0, per_cu = 0;
    (void)hipGetDevice(&dev);
    (void)hipDeviceGetAttribute(&cus, hipDeviceAttributeMultiprocessorCount, dev);
    (void)hipOccupancyMaxActiveBlocksPerMultiprocessor(&per_cu, (const void*)k_fwd, NTHR, LDS_BYTES);
    if (per_cu < 1) { fprintf(stderr, "k_fwd: occupancy query says 0 blocks per CU\n"); per_cu = 1; }
    grid = cus > 0 ? cus : 256;
  }
  (void)hipMemsetAsync(ws, 0, ZERO_BYTES, stream);
  hipLaunchKernelGGL(k_fwd, dim3(grid), dim3(NTHR), LDS_BYTES, stream, p);
}
```
